# Optimizing an MI355X kernel written in HIP

```python
import math
import jax, jax.numpy as jnp
from jax import lax
import numpy as np

D_MODEL = 1024
BATCH = 16
SEQ = 4096
DEPTH = 4

N_MIXERS = 2
N_HGRN_LAYERS = (DEPTH + 1) // 2
N_ATTN_LAYERS = DEPTH // 2

HGRN_EXPAND = 128
HGRN_HEADS = D_MODEL // HGRN_EXPAND
HGRN_HEAD_K = HGRN_EXPAND
HGRN_HEAD_V = D_MODEL // HGRN_HEADS
HGRN_CHUNK = 32

ATTN_HEAD_DIM = 64
ATTN_HEADS = D_MODEL // (2 * ATTN_HEAD_DIM)
ATTN_BLOCK = 128
ROPE_THETA = 10000.0

MOE_GROUPS = 4
MOE_EXPERTS_PER_GROUP = 8
MOE_EXPERTS = MOE_GROUPS * MOE_EXPERTS_PER_GROUP
MOE_TOP_K = 2
MOE_FF = D_MODEL // 2
MOE_BLOCK = 256

DEEPNORM_ALPHA = (2 * DEPTH) ** 0.25
DEEPNORM_BETA = (8 * DEPTH) ** -0.25
NORM_EPS = 1e-5

kernel_name = "hybrid_hgrn2_diffattn_hmoe_deepnorm"


def layer_norm(x, g, b):
    xf = x.astype(jnp.float32)
    mu = jnp.mean(xf, axis=-1, keepdims=True)
    var = jnp.mean(jnp.square(xf - mu), axis=-1, keepdims=True)
    y = (xf - mu) * lax.rsqrt(var + NORM_EPS) * g.astype(jnp.float32) + b.astype(jnp.float32)
    return y.astype(x.dtype)


def rms_norm(x, w):
    xf = x.astype(jnp.float32)
    return xf * lax.rsqrt(jnp.mean(jnp.square(xf), axis=-1, keepdims=True) + NORM_EPS) * w.astype(jnp.float32)


def rope(t):
    S, d = t.shape[1], t.shape[-1]
    half = d // 2
    inv_freq = ROPE_THETA ** (-jnp.arange(half, dtype=jnp.float32) / half)
    ang = jnp.arange(S, dtype=jnp.float32)[:, None] * inv_freq[None, :]
    cos = jnp.cos(ang)[None, :, None, :]
    sin = jnp.sin(ang)[None, :, None, :]
    tf = t.astype(jnp.float32)
    t1, t2 = tf[..., :half], tf[..., half:]
    return jnp.concatenate([t1 * cos - t2 * sin, t2 * cos + t1 * sin], axis=-1).astype(t.dtype)


def hgrn2_mixer(h, w_in, w_out, lower_bound, norm_w):
    B, S, D = h.shape
    H, K, V, C = HGRN_HEADS, HGRN_HEAD_K, HGRN_HEAD_V, HGRN_CHUNK
    n_chunks = S // C
    q, z, v, gate = jnp.split(h @ w_in, 4, axis=-1)
    z = z.astype(jnp.float32)
    lb = lower_bound.astype(jnp.float32)
    log_f = jnp.logaddexp(jax.nn.log_sigmoid(z), jnp.log(lb) + jax.nn.log_sigmoid(-z))
    k = (1.0 - lb) * jax.nn.sigmoid(-z)

    def to_chunks(t, dh):
        return t.astype(jnp.float32).reshape(B, n_chunks, C, H, dh).transpose(1, 0, 3, 2, 4)

    causal = jnp.tril(jnp.ones((C, C), dtype=bool))[:, :, None]

    def chunk_step(state, inp):
        q_c, k_c, v_c, g_c = inp
        b = jnp.cumsum(g_c, axis=2)
        o_inter = jnp.einsum('bhtk,bhkv->bhtv', q_c * jnp.exp(b), state)
        rel = b[:, :, :, None, :] - b[:, :, None, :, :]
        decay = jnp.where(causal, jnp.exp(jnp.where(causal, rel, 0.0)), 0.0)
        scores = jnp.einsum('bhtk,bhsk,bhtsk->bhts', q_c, k_c, decay)
        o_c = o_inter + jnp.einsum('bhts,bhsv->bhtv', scores, v_c)
        b_last = b[:, :, -1:, :]
        state = (jnp.exp(b_last[:, :, 0, :, None]) * state
                 + jnp.einsum('bhsk,bhsv->bhkv', k_c * jnp.exp(b_last - b), v_c))
        return state, o_c

    state0 = jnp.zeros((B, H, K, V), jnp.float32)
    _, o = lax.scan(chunk_step, state0,
                    (to_chunks(q, K), to_chunks(k, K), to_chunks(v, V), to_chunks(log_f, K)))
    o = o.transpose(1, 0, 3, 2, 4).reshape(B, S, H, V)
    o = rms_norm(o, norm_w) * jax.nn.silu(gate.astype(jnp.float32).reshape(B, S, H, V))
    return o.reshape(B, S, D).astype(h.dtype) @ w_out


def diff_attention(h, w_in, w_out, lam_params, subln_w, lambda_init):
    B, S, D = h.shape
    H, d, Q = ATTN_HEADS, ATTN_HEAD_DIM, ATTN_BLOCK
    q, k, v = jnp.split(h @ w_in, 3, axis=-1)
    q = rope(q.reshape(B, S, 2 * H, d)).reshape(B, S, H, 2, d).transpose(0, 2, 3, 1, 4)
    k = rope(k.reshape(B, S, 2 * H, d)).reshape(B, S, H, 2, d).transpose(0, 2, 3, 1, 4)
    v = v.reshape(B, S, H, 2 * d).transpose(0, 2, 1, 3).astype(jnp.float32)
    lp = lam_params.astype(jnp.float32)
    lam = jnp.exp(jnp.sum(lp[0] * lp[1])) - jnp.exp(jnp.sum(lp[2] * lp[3])) + lambda_init
    scale = d ** -0.5
    outs = []
    for blk in range(S // Q):
        q0, kend = blk * Q, (blk + 1) * Q
        s = jnp.einsum('bhmqd,bhmkd->bhmqk', q[:, :, :, q0:kend], k[:, :, :, :kend]).astype(jnp.float32) * scale
        mask = (q0 + jnp.arange(Q))[:, None] >= jnp.arange(kend)[None, :]
        p = jax.nn.softmax(jnp.where(mask, s, -jnp.inf), axis=-1)
        a = p[:, :, 0] - lam * p[:, :, 1]
        outs.append(jnp.einsum('bhqk,bhkv->bhqv', a, v[:, :, :kend]))
    o = jnp.concatenate(outs, axis=2)
    o = rms_norm(o, subln_w) * (1.0 - lambda_init)
    return o.transpose(0, 2, 1, 3).reshape(B, S, D).astype(h.dtype) @ w_out


def hierarchical_moe(h, wg, bg, we, be, w1, w3, w2):
    B, S, D = h.shape
    N = B * S
    E, G, EPG, T = MOE_EXPERTS, MOE_GROUPS, MOE_EXPERTS_PER_GROUP, MOE_BLOCK
    xf = h.reshape(N, D)
    g_prob = jax.nn.softmax((xf @ wg).astype(jnp.float32) + bg.astype(jnp.float32), axis=-1)
    g_w, g_idx = lax.top_k(g_prob, 1)
    e_logits = (xf @ we).astype(jnp.float32).reshape(N, G, EPG) + be.astype(jnp.float32).reshape(G, EPG)
    e_prob = jax.nn.softmax(jnp.take_along_axis(e_logits, g_idx[:, :, None], axis=1)[:, 0], axis=-1)
    e_w, e_loc = lax.top_k(e_prob, MOE_TOP_K)
    weights = g_w * (e_w / jnp.sum(e_w, axis=-1, keepdims=True))
    expert = g_idx * EPG + e_loc

    A = N * MOE_TOP_K
    eid = expert.reshape(A)
    tok = jnp.repeat(jnp.arange(N, dtype=jnp.int32), MOE_TOP_K)
    wt = weights.reshape(A)
    order = jnp.argsort(eid)
    eid_s, tok_s, wt_s = eid[order], tok[order], wt[order]
    counts = jnp.bincount(eid, length=E)
    start = jnp.cumsum(counts) - counts
    padded = ((counts + T - 1) // T) * T
    pad_end = jnp.cumsum(padded)
    pad_start = pad_end - padded
    dest = pad_start[eid_s] + (jnp.arange(A, dtype=jnp.int32) - start[eid_s])
    L = A + E * T
    NB = L // T
    buf_tok = jnp.full((L,), N, jnp.int32).at[dest].set(tok_s)
    buf_w = jnp.zeros((L,), jnp.float32).at[dest].set(wt_s)
    blk_expert = jnp.minimum(jnp.searchsorted(pad_end, jnp.arange(NB, dtype=jnp.int32) * T, side='right'), E - 1)
    x_pad = jnp.concatenate([xf, jnp.zeros((1, D), xf.dtype)], axis=0)
    x_buf = x_pad[buf_tok].reshape(NB, T, D)

    def expert_block(args):
        xb, e = args
        return (jax.nn.silu(xb @ w1[e]) * (xb @ w3[e])) @ w2[e]

    y_buf = lax.map(expert_block, (x_buf, blk_expert)).reshape(L, D)
    y = jax.ops.segment_sum(y_buf.astype(jnp.float32) * buf_w[:, None], buf_tok, num_segments=N + 1)[:N]
    return y.reshape(B, S, D).astype(h.dtype)


def setup_inputs(seed: int = 0) -> dict:
    key = jax.random.key(seed)
    ks = jax.random.split(key, 24)
    D, F, E = D_MODEL, MOE_FF, MOE_EXPERTS
    nrm = lambda k, shape, s: jax.random.normal(k, shape, jnp.float32) * s
    hgrn_w_in = nrm(ks[6], (N_HGRN_LAYERS, D, 4 * D), D ** -0.5)
    hgrn_w_in = hgrn_w_in.at[:, :, 2 * D:3 * D].multiply(DEEPNORM_BETA)
    attn_w_in = nrm(ks[10], (N_ATTN_LAYERS, D, 3 * D), D ** -0.5)
    attn_w_in = attn_w_in.at[:, :, 2 * D:].multiply(DEEPNORM_BETA)
    return {
        "x": nrm(ks[0], (BATCH, SEQ, D), 1.0),
        "c": nrm(ks[1], (BATCH, D), 1.0),
        "ada_w": nrm(ks[2], (DEPTH, D, 6 * D), 0.5 * D ** -0.5),
        "ada_b": nrm(ks[3], (DEPTH, 6 * D), 0.02),
        "ln_g": 1.0 + nrm(ks[4], (DEPTH, 2, D), 0.02),
        "ln_b": nrm(ks[5], (DEPTH, 2, D), 0.02),
        "hgrn_w_in": hgrn_w_in,
        "hgrn_w_out": nrm(ks[7], (N_HGRN_LAYERS, D, D), DEEPNORM_BETA * D ** -0.5),
        "hgrn_lb": nrm(ks[8], (N_HGRN_LAYERS, HGRN_HEADS * HGRN_HEAD_K), 0.5),
        "hgrn_norm_w": 1.0 + nrm(ks[9], (N_HGRN_LAYERS, HGRN_HEAD_V), 0.02),
        "attn_w_in": attn_w_in,
        "attn_w_out": nrm(ks[11], (N_ATTN_LAYERS, D, D), DEEPNORM_BETA * D ** -0.5),
        "attn_lambda": nrm(ks[12], (N_ATTN_LAYERS, 4, ATTN_HEAD_DIM), 0.1),
        "attn_subln_w": 1.0 + nrm(ks[13], (N_ATTN_LAYERS, 2 * ATTN_HEAD_DIM), 0.02),
        "router_g_w": nrm(ks[14], (DEPTH, D, MOE_GROUPS), D ** -0.5),
        "router_g_b": nrm(ks[15], (DEPTH, MOE_GROUPS), 0.01),
        "router_e_w": nrm(ks[16], (DEPTH, D, E), D ** -0.5),
        "router_e_b": nrm(ks[17], (DEPTH, E), 0.01),
        "moe_w1": nrm(ks[18], (DEPTH, E, D, F), D ** -0.5),
        "moe_w3": nrm(ks[19], (DEPTH, E, D, F), D ** -0.5),
        "moe_w2": nrm(ks[20], (DEPTH, E, F, D), DEEPNORM_BETA * F ** -0.5),
    }


def reference(x, c, ada_w, ada_b, ln_g, ln_b, hgrn_w_in, hgrn_w_out, hgrn_lb, hgrn_norm_w,
              attn_w_in, attn_w_out, attn_lambda, attn_subln_w, router_g_w, router_g_b,
              router_e_w, router_e_b, moe_w1, moe_w3, moe_w2):
    lb_all = jnp.cumsum(jax.nn.softmax(hgrn_lb.astype(jnp.float32), axis=0), axis=0)
    lb_all = lb_all - lb_all[0:1]
    cond = jax.nn.silu(c.astype(jnp.float32))
    for i in range(DEPTH):
        mod = (cond @ ada_w[i].astype(jnp.float32) + ada_b[i].astype(jnp.float32)).astype(x.dtype)
        sh1, sc1, g1, sh2, sc2, g2 = jnp.split(mod[:, None, :], 6, axis=-1)
        h = x * (1 + sc1) + sh1
        j = i // N_MIXERS
        if i % N_MIXERS == 0:
            y = hgrn2_mixer(h, hgrn_w_in[j], hgrn_w_out[j], lb_all[j], hgrn_norm_w[j])
        else:
            lambda_init = 0.8 - 0.6 * math.exp(-0.3 * i)
            y = diff_attention(h, attn_w_in[j], attn_w_out[j], attn_lambda[j], attn_subln_w[j], lambda_init)
        x = layer_norm(DEEPNORM_ALPHA * x + g1 * y, ln_g[i, 0], ln_b[i, 0])
        h = x * (1 + sc2) + sh2
        y = hierarchical_moe(h, router_g_w[i], router_g_b[i], router_e_w[i], router_e_b[i],
                             moe_w1[i], moe_w3[i], moe_w2[i])
        x = layer_norm(DEEPNORM_ALPHA * x + g2 * y, ln_g[i, 1], ln_b[i, 1])
    return x
```

```cpp
#include <hip/hip_runtime.h>
#include <cstdio>
#include <cstdint>
namespace pg8 {
#define PG8_LAS __attribute__((address_space(3)))
typedef unsigned short bf16_t;
typedef short bf16x8 __attribute__((ext_vector_type(8)));
typedef float f32x4 __attribute__((ext_vector_type(4)));
typedef unsigned u32x4 __attribute__((ext_vector_type(4)));
constexpr int BM = 256, BK = 64, HALF = 128, HTB = HALF * BK * 2  , STAGE_BYTES = 8 * HTB, NXCD = 8, WGM = 8;

__host__ __device__ __forceinline__ int lds_byte(int r, int c) { const int st = (r >> 4) * 2 + (c >> 5), rr = r & 15, cc = c & 31, ob = rr * 64 + cc * 2; return st * 1024 + (ob ^ (((ob >> 9) & 1) << 5)); }
__host__ __device__ __forceinline__ void stage_rc(int b, int& R, int& C) { const int st = b / 1024, sb = b % 1024, swz = sb ^ (((sb >> 9) & 1) << 5); R = (st >> 1) * 16 + swz / 64; C = (st & 1) * 32 + (swz % 64) / 2; }
__host__ __device__ __forceinline__ int perm32(int rho) { const int n = rho >> 4, i = rho & 15; return 8 * (i >> 2) + 4 * n + (i & 3); }

struct Unit { int pm, pn, e; };
struct Gemm { const bf16_t* A; const bf16_t* Bt; int M, N, K; size_t estride; };

struct StaticOrder {
    int nM, nN, nwg, G, c;
    __host__ __device__ void init(int M, int N, int G_, int c_) { nM = M / BM; nN = N / BM; nwg = nM * nN; G = G_; c = c_; }
    __host__ __device__ bool next(int i, Unit& u) const {
        const long L = (long)i * G + c; if (L >= nwg) return false;
        int wgid = (int)L; { const int q = nwg / NXCD, r = nwg % NXCD, xcd = wgid % NXCD, off = wgid / NXCD; wgid = (xcd < r ? xcd * (q + 1) : r * (q + 1) + (xcd - r) * q) + off; }
        const int nig = WGM * nN, gid = wgid / nig, fm = gid * WGM, gsz = (nM - fm) < WGM ? (nM - fm) : WGM;
        u.pm = fm + ((wgid % nig) % gsz); u.pn = (wgid % nig) / gsz; u.e = 0; return true;
    }
    __device__ __forceinline__ void a_ready(const Unit&) const {}
    __device__ __forceinline__ void done(const Unit&) const {}
};

__device__ __forceinline__ unsigned cvt_pk_bf16(float lo, float hi) { unsigned r; asm volatile("v_cvt_pk_bf16_f32 %0, %1, %2" : "=v"(r) : "v"(lo), "v"(hi)); return r; }
typedef float f32x2 __attribute__((ext_vector_type(2)));
__device__ __forceinline__ f32x2 gelu_pk(f32x2 v) {
    const f32x2 av = __builtin_elementwise_abs(v), d = av * 0.2316418882f + 1.0f;
    f32x2 t; t.x = __builtin_amdgcn_rcpf(d.x); t.y = __builtin_amdgcn_rcpf(d.y);
    f32x2 q = t * 0.5307027145f + (-0.7265760135f); q = q * t + 0.7107068705f; q = q * t + (-0.142248368f); q = q * t + 0.127414796f; q = q * t;
    const f32x2 s = (v * v) * (-0.72134752044f);
    f32x2 e; e.x = __builtin_amdgcn_exp2f(s.x); e.y = __builtin_amdgcn_exp2f(s.y);
    const f32x2 m = v * (q * e), r = v - m;
    f32x2 o; o.x = v.x < 0.f ? m.x : r.x; o.y = v.y < 0.f ? m.y : r.y; return o;
}

template <int ACT  > struct EpiBf16 {
    static constexpr bool PERM = true, AFTER_DRAIN = false; static_assert(ACT == 0 || ACT == 1, "EpiBf16: ACT is 0 (none) or 1 (gelu_pk)");
    bf16_t* O; int ldc; const float* bias; int split_cols; size_t split_stride; float scale0;
    __device__ __forceinline__ void operator()(const f32x4 (&acc)[2][2][4][2], const Unit& u, int wr, int wc, int fr, int fq) const {
        const int row0 = u.pm * BM + wr * 64 + fr; int colt = u.pn * BM; bf16_t* base = O;
        float sc = 1.f; if (split_cols) { const int t = colt / split_cols; base += (size_t)t * split_stride; colt -= t * split_cols; if (t == 0) sc = scale0; }
        const int col0 = colt + wc * 32 + 8 * fq, bcol0 = u.pn * BM + wc * 32 + 8 * fq;
        f32x4 bv[2][2];
#pragma unroll
        for (int bj = 0; bj < 2; ++bj)
#pragma unroll
            for (int n = 0; n < 2; ++n) bv[bj][n] = bias ? *(const f32x4*)(bias + bcol0 + bj * HALF + 4 * n) : (f32x4){0.f, 0.f, 0.f, 0.f};
#pragma unroll
        for (int ai = 0; ai < 2; ++ai)
#pragma unroll
            for (int m = 0; m < 4; ++m) { bf16_t* rowp = base + (size_t)(row0 + ai * HALF + m * 16) * ldc + col0;
#pragma unroll
                for (int bj = 0; bj < 2; ++bj) { f32x4 v0 = acc[ai][bj][m][0] + bv[bj][0], v1 = acc[ai][bj][m][1] + bv[bj][1];
                    if (ACT == 1) { f32x2 a = gelu_pk((f32x2){v0[0], v0[1]}), b = gelu_pk((f32x2){v0[2], v0[3]}), c = gelu_pk((f32x2){v1[0], v1[1]}), d = gelu_pk((f32x2){v1[2], v1[3]});
                        v0 = (f32x4){a.x, a.y, b.x, b.y}; v1 = (f32x4){c.x, c.y, d.x, d.y}; }
                    v0 = v0 * sc; v1 = v1 * sc; u32x4 w; w.x = cvt_pk_bf16(v0[0], v0[1]); w.y = cvt_pk_bf16(v0[2], v0[3]); w.z = cvt_pk_bf16(v1[0], v1[1]); w.w = cvt_pk_bf16(v1[2], v1[3]);
                    *(u32x4*)(rowp + bj * HALF) = w; } }
    }
};

template <class Epi, class Sched, bool ALIGN_EPI = false, bool SP2 = false>
__device__ __forceinline__ void gemm_phase(PG8_LAS unsigned char* lds, const Gemm g, const Sched& S, const Epi& E, const int tid) {
        const int wid = __builtin_amdgcn_readfirstlane(tid >> 6), lane = tid & 63, wr = wid >> 2, wc = wid & 3, fr = lane & 15, fq = lane >> 4;
    const int K = g.K, nt = K / BK;
    unsigned voffA[2], voffB[2];
#pragma unroll
    for (int i = 0; i < 2; ++i) { int R, C; stage_rc(tid * 16 + i * 8192, R, C); const int Rb = Epi::PERM ? ((R & ~31) + perm32(R & 31)) : R;
        voffA[i] = (unsigned)(R * K + C) * 2u; voffB[i] = (unsigned)(Rb * K + C) * 2u; }
    const size_t kstep = (size_t)(BK * 2);
    const size_t hstep = (size_t)HALF * K * 2;
    const size_t tstep = 2 * hstep;
    const unsigned ldsw = (unsigned)wid * 1024u;
    const int aoff = lds_byte(wr * 64 + fr, fq * 8), boff = lds_byte(wc * 32 + fr, fq * 8);
#define PG8_SA(b, h) (((b) * 2 + (h)) * HTB)
#define PG8_SB(b, h) ((4 + (b) * 2 + (h)) * HTB)
#define PG8_STAGE(bufoff, gbase, voff) do { _Pragma("unroll") for (int _i = 0; _i < 2; ++_i) \
        __builtin_amdgcn_global_load_lds((const unsigned*)((const char*)(gbase) + (voff)[_i]), (PG8_LAS unsigned*)(lds + (bufoff) + ldsw + _i * 8192), 16, 0, 0); } while (0)
#define PG8_LDA(dst, b, h) do { _Pragma("unroll") for (int m = 0; m < 4; ++m) _Pragma("unroll") for (int k = 0; k < 2; ++k) dst[m][k] = *(const PG8_LAS bf16x8*)(lds + PG8_SA(b, h) + aoff + m * 2048 + k * 1024); } while (0)
#define PG8_LDB(dst, b, h) do { _Pragma("unroll") for (int n = 0; n < 2; ++n) _Pragma("unroll") for (int k = 0; k < 2; ++k) dst[n][k] = *(const PG8_LAS bf16x8*)(lds + PG8_SB(b, h) + boff + n * 2048 + k * 1024); } while (0)
#define PG8_MMA(ai, bj, At, Bt) do { __builtin_amdgcn_s_setprio(1); _Pragma("unroll") for (int m = 0; m < 4; ++m) _Pragma("unroll") for (int n = 0; n < 2; ++n) _Pragma("unroll") for (int k = 0; k < 2; ++k) \
        acc[ai][bj][m][n] = __builtin_amdgcn_mfma_f32_16x16x32_bf16(Bt[n][k], At[m][k], acc[ai][bj][m][n], 0, 0, 0); __builtin_amdgcn_s_setprio(0); } while (0)
#define PG8_WAIT_V(n) asm volatile("s_waitcnt vmcnt(" #n ")" ::: "memory")
#define PG8_WAIT_L(n) asm volatile("s_waitcnt lgkmcnt(" #n ")" ::: "memory")
#define PG8_BAR __builtin_amdgcn_s_barrier()
#define PG8_SCHED __builtin_amdgcn_sched_barrier(0)
    Unit cur, nxt; int ui = 0;
    if (!S.next(0, cur)) return;
    f32x4 acc[2][2][4][2];
#pragma unroll
    for (int a = 0; a < 2; ++a)
#pragma unroll
        for (int b = 0; b < 2; ++b)
#pragma unroll
            for (int m = 0; m < 4; ++m)
#pragma unroll
                for (int n = 0; n < 2; ++n) acc[a][b][m][n] = (f32x4){0.f, 0.f, 0.f, 0.f};
    bf16x8 At[4][2], B0[2][2], B1[2][2];
    const char* cA = (const char*)g.A + (size_t)cur.pm * tstep; const char* cB = (const char*)g.Bt + (size_t)cur.e * g.estride + (size_t)cur.pn * tstep;
    S.a_ready(cur);
    if constexpr (SP2) {
        PG8_STAGE(PG8_SB(0, 0), cB, voffB); PG8_STAGE(PG8_SB(0, 1), cB + hstep, voffB); PG8_STAGE(PG8_SA(0, 0), cA, voffA); PG8_STAGE(PG8_SA(0, 1), cA + hstep, voffA);
        if (wr == 1) PG8_BAR;
        PG8_WAIT_V(2); PG8_BAR;
        PG8_STAGE(PG8_SB(1, 0), cB + kstep, voffB); PG8_STAGE(PG8_SA(1, 0), cA + kstep, voffA); PG8_STAGE(PG8_SB(1, 1), cB + hstep + kstep, voffB);
        PG8_WAIT_V(6); PG8_BAR;
    } else {
        PG8_STAGE(PG8_SB(0, 0), cB, voffB); PG8_STAGE(PG8_SA(0, 0), cA, voffA); PG8_STAGE(PG8_SB(0, 1), cB + hstep, voffB); PG8_STAGE(PG8_SA(0, 1), cA + hstep, voffA);
        if (wr == 1) PG8_BAR;
        PG8_WAIT_V(4); PG8_BAR;
        PG8_STAGE(PG8_SB(1, 0), cB + kstep, voffB); PG8_STAGE(PG8_SA(1, 0), cA + kstep, voffA); PG8_STAGE(PG8_SB(1, 1), cB + hstep + kstep, voffB);
        PG8_WAIT_V(6); PG8_BAR;
    }
    for (;;) {
        const bool has_next = S.next(ui + 1, nxt);
        const char* nA = has_next ? (const char*)g.A + (size_t)nxt.pm * tstep : cA; const char* nB = has_next ? (const char*)g.Bt + (size_t)nxt.e * g.estride + (size_t)nxt.pn * tstep : cB;
        for (int t = 0; t < nt; t += 2) {
            const bool last = (t == nt - 2);
            const char* a1 = cA + (size_t)(t + 1) * kstep;
            const char* a2 = last ? nA : cA + (size_t)(t + 2) * kstep; const char* b2 = last ? nB : cB + (size_t)(t + 2) * kstep;
            const char* a3 = a2 + kstep; const char* b3 = b2 + kstep;
            if (last && has_next) S.a_ready(nxt);
            if constexpr (SP2) {
            PG8_LDB(B0, 0, 0); PG8_LDB(B1, 0, 1); PG8_SCHED; PG8_LDA(At, 0, 0); PG8_STAGE(PG8_SA(1, 1), a1 + hstep, voffA);
            PG8_WAIT_V(8); PG8_WAIT_L(0); PG8_BAR; PG8_MMA(0, 0, At, B0); PG8_MMA(0, 1, At, B1); PG8_BAR; PG8_SCHED;
            PG8_LDA(At, 0, 1); PG8_STAGE(PG8_SB(0, 0), b2, voffB); PG8_STAGE(PG8_SB(0, 1), b2 + hstep, voffB); PG8_STAGE(PG8_SA(0, 0), a2, voffA);
            PG8_WAIT_V(8); PG8_WAIT_L(0); PG8_BAR; PG8_MMA(1, 0, At, B0); PG8_MMA(1, 1, At, B1); PG8_BAR; PG8_SCHED;
            PG8_LDB(B0, 1, 0); PG8_LDB(B1, 1, 1); PG8_SCHED; PG8_LDA(At, 1, 0); PG8_STAGE(PG8_SA(0, 1), a2 + hstep, voffA);
            PG8_WAIT_V(8); PG8_WAIT_L(0); PG8_BAR; PG8_MMA(0, 0, At, B0); PG8_MMA(0, 1, At, B1); PG8_BAR; PG8_SCHED;
            PG8_LDA(At, 1, 1); PG8_STAGE(PG8_SB(1, 0), b3, voffB); PG8_STAGE(PG8_SB(1, 1), b3 + hstep, voffB); PG8_STAGE(PG8_SA(1, 0), a3, voffA);
            PG8_WAIT_V(8); PG8_WAIT_L(0); PG8_BAR; PG8_MMA(1, 0, At, B0); PG8_MMA(1, 1, At, B1); PG8_BAR; PG8_SCHED;
            } else {
            PG8_LDB(B0, 0, 0); PG8_SCHED; PG8_LDA(At, 0, 0); PG8_STAGE(PG8_SA(1, 1), a1 + hstep, voffA);
            PG8_WAIT_L(8); PG8_BAR; PG8_WAIT_L(0); PG8_MMA(0, 0, At, B0); PG8_BAR; PG8_SCHED;
            PG8_LDB(B1, 0, 1); PG8_STAGE(PG8_SB(0, 0), b2, voffB);
            PG8_BAR; PG8_WAIT_L(0); PG8_MMA(0, 1, At, B1); PG8_BAR;
            PG8_LDA(At, 0, 1); PG8_STAGE(PG8_SA(0, 0), a2, voffA);
            PG8_BAR; PG8_WAIT_L(0); PG8_MMA(1, 0, At, B0); PG8_BAR; PG8_SCHED;
            PG8_STAGE(PG8_SB(0, 1), b2 + hstep, voffB);
            PG8_WAIT_V(6); PG8_BAR; PG8_MMA(1, 1, At, B1); PG8_BAR;
            PG8_LDB(B0, 1, 0); PG8_SCHED; PG8_LDA(At, 1, 0); PG8_STAGE(PG8_SA(0, 1), a2 + hstep, voffA);
            PG8_WAIT_L(8); PG8_BAR; PG8_WAIT_L(0); PG8_MMA(0, 0, At, B0); PG8_BAR; PG8_SCHED;
            PG8_LDB(B1, 1, 1); PG8_STAGE(PG8_SB(1, 0), b3, voffB);
            PG8_BAR; PG8_WAIT_L(0); PG8_MMA(0, 1, At, B1); PG8_BAR;
            PG8_LDA(At, 1, 1); PG8_STAGE(PG8_SA(1, 0), a3, voffA);
            PG8_BAR; PG8_WAIT_L(0); PG8_MMA(1, 0, At, B0); PG8_BAR; PG8_SCHED;
            PG8_STAGE(PG8_SB(1, 1), b3 + hstep, voffB);
            PG8_WAIT_V(6); PG8_BAR; PG8_MMA(1, 1, At, B1); PG8_BAR;
            }
        }
        if constexpr (ALIGN_EPI) { if (wr == 0) PG8_BAR; }
        if constexpr (!Epi::AFTER_DRAIN) { E(acc, cur, wr, wc, fr, fq); S.done(cur); }
        if (!has_next) break;
#pragma unroll
        for (int a = 0; a < 2; ++a)
#pragma unroll
            for (int b = 0; b < 2; ++b)
#pragma unroll
                for (int m = 0; m < 4; ++m)
#pragma unroll
                    for (int n = 0; n < 2; ++n) acc[a][b][m][n] = (f32x4){0.f, 0.f, 0.f, 0.f};
        cur = nxt; cA = nA; cB = nB; ++ui;
        if constexpr (ALIGN_EPI) { if (wr == 1) PG8_BAR; }
    }
    PG8_WAIT_V(0);
    if constexpr (!ALIGN_EPI) { if (wr == 0) PG8_BAR; }
    PG8_BAR;
    if constexpr (Epi::AFTER_DRAIN) { E.fused(acc, cur, wr, wc, fr, fq, lds, wid, lane); S.done(cur); }
#undef PG8_SA
#undef PG8_SB
#undef PG8_STAGE
#undef PG8_LDA
#undef PG8_LDB
#undef PG8_MMA
#undef PG8_WAIT_V
#undef PG8_WAIT_L
#undef PG8_BAR
#undef PG8_SCHED
}
}

namespace pg8 {
__device__ __forceinline__ u32x4 pack8(const f32x4 a, const f32x4 b) { u32x4 w; w.x = cvt_pk_bf16(a[0], a[1]); w.y = cvt_pk_bf16(a[2], a[3]); w.z = cvt_pk_bf16(b[0], b[1]); w.w = cvt_pk_bf16(b[2], b[3]); return w; }
__device__ __forceinline__ float silu_f(float x) { return x * __builtin_amdgcn_rcpf(1.0f + __builtin_amdgcn_exp2f(-1.4426950408889634f * x)); }

struct EpiRope {
    static constexpr bool PERM = true, AFTER_DRAIN = false;
    bf16_t* Q; bf16_t* Kb; bf16_t* Vb; const float* cs; const float* sn; float qscale; int seqmask;
    __device__ __forceinline__ void operator()(const f32x4 (&acc)[2][2][4][2], const Unit& u, int wr, int wc, int fr, int fq) const {
        const int row0 = u.pm * BM + wr * 64 + fr; const int part = u.pn >> 2, pn4 = u.pn & 3;
        if (part == 2) {
            const int col0 = pn4 * BM + wc * 32 + 8 * fq;
#pragma unroll
            for (int ai = 0; ai < 2; ++ai)
#pragma unroll
                for (int m = 0; m < 4; ++m) { bf16_t* rowp = Vb + (size_t)(row0 + ai * HALF + m * 16) * 1024 + col0;
#pragma unroll
                    for (int bj = 0; bj < 2; ++bj) *(u32x4*)(rowp + bj * HALF) = pack8(acc[ai][bj][m][0], acc[ai][bj][m][1]); }
        } else {
            bf16_t* base = part == 0 ? Q : Kb; const float sc = part == 0 ? qscale : 1.0f;
            const int hm = pn4 * 4 + wc, j0 = 8 * fq;
#pragma unroll
            for (int ai = 0; ai < 2; ++ai)
#pragma unroll
                for (int m = 0; m < 4; ++m) { const int row = row0 + ai * HALF + m * 16; const int pos = row & seqmask;
                    const f32x4 c0 = *(const f32x4*)(cs + pos * 32 + j0) * sc, c1 = *(const f32x4*)(cs + pos * 32 + j0 + 4) * sc;
                    const f32x4 s0 = *(const f32x4*)(sn + pos * 32 + j0) * sc, s1 = *(const f32x4*)(sn + pos * 32 + j0 + 4) * sc;
                    const f32x4 x1a = acc[ai][0][m][0], x1b = acc[ai][0][m][1], x2a = acc[ai][1][m][0], x2b = acc[ai][1][m][1];
                    const f32x4 o1a = x1a * c0 - x2a * s0, o1b = x1b * c1 - x2b * s1, o2a = x2a * c0 + x1a * s0, o2b = x2b * c1 + x1b * s1;
                    bf16_t* rowp = base + (size_t)row * 1024 + hm * 64 + j0;
                    *(u32x4*)(rowp) = pack8(o1a, o1b); *(u32x4*)(rowp + 32) = pack8(o2a, o2b); }
        }
    }
};
struct EpiSwiGLU {
    static constexpr bool PERM = true, AFTER_DRAIN = false;
    bf16_t* act;
    __device__ __forceinline__ void operator()(const f32x4 (&acc)[2][2][4][2], const Unit& u, int wr, int wc, int fr, int fq) const {
        const int row0 = u.pm * BM + wr * 64 + fr, col0 = u.pn * HALF + wc * 32 + 8 * fq;
#pragma unroll
        for (int ai = 0; ai < 2; ++ai)
#pragma unroll
            for (int m = 0; m < 4; ++m) { f32x4 v0, v1;
#pragma unroll
                for (int j = 0; j < 4; ++j) { v0[j] = silu_f(acc[ai][0][m][0][j]) * acc[ai][1][m][0][j]; v1[j] = silu_f(acc[ai][0][m][1][j]) * acc[ai][1][m][1][j]; }
                *(u32x4*)(act + (size_t)(row0 + ai * HALF + m * 16) * 512 + col0) = pack8(v0, v1); }
    }
};
struct EpiRowScale {
    static constexpr bool PERM = true, AFTER_DRAIN = false;
    bf16_t* O; const float* roww;
    __device__ __forceinline__ void operator()(const f32x4 (&acc)[2][2][4][2], const Unit& u, int wr, int wc, int fr, int fq) const {
        const int row0 = u.pm * BM + wr * 64 + fr, col0 = u.pn * BM + wc * 32 + 8 * fq;
#pragma unroll
        for (int ai = 0; ai < 2; ++ai)
#pragma unroll
            for (int m = 0; m < 4; ++m) { const int row = row0 + ai * HALF + m * 16; const float w = roww[row]; bf16_t* rowp = O + (size_t)row * 1024 + col0;
#pragma unroll
                for (int bj = 0; bj < 2; ++bj) *(u32x4*)(rowp + bj * HALF) = pack8(acc[ai][bj][m][0] * w, acc[ai][bj][m][1] * w); }
    }
};
struct MoeOrder : StaticOrder {
    const int* blk_e;
    __device__ __forceinline__ bool next(int i, Unit& u) const { if (!StaticOrder::next(i, u)) return false; u.e = __builtin_amdgcn_readfirstlane(blk_e[u.pm]); return true; }
};
}
#include <hip/hip_bf16.h>
#include <cmath>
namespace attn_body {
using bf16=__hip_bfloat16;
using bf16x8=__attribute__((ext_vector_type(8)))short;
using s16x4=__attribute__((ext_vector_type(4)))short;
using f32x16=__attribute__((ext_vector_type(16)))float;
using u32x4=__attribute__((ext_vector_type(4)))unsigned;
constexpr int BATCH=16,NHEAD=16,SEQ=4096,D=64,DM=NHEAD*D;
constexpr int NW=8,QBLK=32,QB=QBLK*NW,KVBLK=64,NQB=SEQ/QB;
constexpr int ATTN_PITCH=DM, ATTN_UNIT_ROWS=QB;
__device__ __forceinline__ int crow(int r,int hi){return (r&3)+8*(r>>2)+4*hi;}
#define SBAR() __builtin_amdgcn_sched_barrier(0)
__device__ __forceinline__ void cmask(f32x16&p0,f32x16&p1,int jb,int qrel,int hi){
  const float NEG=-INFINITY; int kb=64*jb+4*hi;
  #pragma unroll
  for(int r=0;r<16;++r){int kv=kb+(r&3)+8*(r>>2); if(kv>qrel)p0[r]=NEG; if(kv+32>qrel)p1[r]=NEG;}
}

constexpr int NSLOT=3, SLOTB=8192;
constexpr int LDS_K=0, LDS_V=NSLOT*SLOTB, LDS_WS=2*NSLOT*SLOTB, LDS_OST=LDS_WS+NW*64*4, LDS_BYTES=LDS_OST+NW*4096;
constexpr float C2=0.125f*1.4426950408889634f;
__device__ __forceinline__ void glds16(const void*gsrc,unsigned lds_dst){unsigned keep;
  asm volatile("s_mov_b32 %0, m0\n\ts_mov_b32 m0, %2\n\ts_nop 0\n\tglobal_load_lds_dwordx4 %1, off\n\ts_mov_b32 m0, %0":"=&s"(keep):"v"(gsrc),"s"(lds_dst):"memory");}
__device__ __forceinline__ float max3f(float a,float b,float c){float r;asm("v_max3_f32 %0, %1, %2, %3":"=v"(r):"v"(a),"v"(b),"v"(c));return r;}
__device__ __forceinline__ float max2f(float a,float b){float r;asm("v_max_f32_e32 %0, %1, %2":"=v"(r):"v"(a),"v"(b));return r;}
__device__ __forceinline__ float fadd_s(float a,float b){float r;asm("v_add_f32_e32 %0, %1, %2":"=v"(r):"v"(a),"v"(b));return r;}
__device__ __forceinline__ float fsub_s(float a,float b){float r;asm("v_sub_f32_e32 %0, %1, %2":"=v"(r):"v"(a),"v"(b));return r;}
typedef float f32x2_t __attribute__((ext_vector_type(2))); typedef __bf16 bf16x2_t __attribute__((ext_vector_type(2)));
__device__ __forceinline__ unsigned cvtpk_s(float lo,float hi){f32x2_t v={lo,hi};bf16x2_t b=__builtin_convertvector(v,bf16x2_t);return __builtin_bit_cast(unsigned,b);}
#define WAIT_BAR(N) asm volatile("s_waitcnt vmcnt(" #N ") lgkmcnt(0)\n\ts_barrier":::"memory")

__device__ __forceinline__ void qkt(f32x16&p0,f32x16&p1,const char*Kslot,const bf16x8*qr,const f32x16&negm,int r32,int hi){
  const char*kb=Kslot+hi*1024+r32*16;
  #pragma unroll
  for(int d0=0;d0<4;++d0){
    const bf16x8 b0=*reinterpret_cast<const bf16x8*>(kb+d0*2048);
    const bf16x8 b1=*reinterpret_cast<const bf16x8*>(kb+d0*2048+512);
    if(d0==0){p0=__builtin_amdgcn_mfma_f32_32x32x16_bf16(b0,qr[0],negm,0,0,0);p1=__builtin_amdgcn_mfma_f32_32x32x16_bf16(b1,qr[0],negm,0,0,0);}
    else{p0=__builtin_amdgcn_mfma_f32_32x32x16_bf16(b0,qr[d0],p0,0,0,0);p1=__builtin_amdgcn_mfma_f32_32x32x16_bf16(b1,qr[d0],p1,0,0,0);}}
}
typedef __attribute__((address_space(3))) const char* lds_cptr;
typedef short v4i16_t __attribute__((ext_vector_type(4)));
__device__ __forceinline__ void kload8(bf16x8*kf,lds_cptr kp){
  kf[0]=*(const __attribute__((address_space(3))) bf16x8*)(kp);      kf[1]=*(const __attribute__((address_space(3))) bf16x8*)(kp+512);
  kf[2]=*(const __attribute__((address_space(3))) bf16x8*)(kp+2048); kf[3]=*(const __attribute__((address_space(3))) bf16x8*)(kp+2560);
  kf[4]=*(const __attribute__((address_space(3))) bf16x8*)(kp+4096); kf[5]=*(const __attribute__((address_space(3))) bf16x8*)(kp+4608);
  kf[6]=*(const __attribute__((address_space(3))) bf16x8*)(kp+6144); kf[7]=*(const __attribute__((address_space(3))) bf16x8*)(kp+6656);
}
__device__ __forceinline__ void kload2(bf16x8*kf,lds_cptr kp,int j){ kf[2*j]=*(const __attribute__((address_space(3))) bf16x8*)(kp+j*2048); kf[2*j+1]=*(const __attribute__((address_space(3))) bf16x8*)(kp+j*2048+512); }
__device__ __forceinline__ s16x4 vtr(lds_cptr p){ return __builtin_bit_cast(s16x4,__builtin_amdgcn_ds_read_tr16_b64_v4i16((__attribute__((address_space(3))) v4i16_t*)p)); }
__device__ __forceinline__ float rowmax(const f32x16&p0,const f32x16&p1){
  float a=max3f(p0[0],p0[1],p1[0]),b=max3f(p0[2],p0[3],p1[1]);a=max3f(a,p1[2],p1[3]);
  #pragma unroll
  for(int r=4;r<16;r+=4){a=max3f(a,p0[r],p0[r+1]);b=max3f(b,p0[r+2],p0[r+3]);a=max3f(a,p1[r],p1[r+1]);b=max3f(b,p1[r+2],p1[r+3]);}
  const float m=max2f(a,b);
  auto rr=__builtin_amdgcn_permlane32_swap(__float_as_uint(m),__float_as_uint(m),false,false);
  return max2f(__uint_as_float(rr[0]),__uint_as_float(rr[1]));
}
__device__ __forceinline__ void pv(f32x16*o,int vb,bf16x8 pa0,bf16x8 pa1,bf16x8 pa2,bf16x8 pa3){
  #pragma unroll
  for(int d0=0;d0<2;++d0){s16x4 lo[4],hi[4];
    #pragma unroll
    for(int ks=0;ks<4;++ks){
      asm volatile("ds_read_b64_tr_b16 %0,%1 offset:%c2":"=&v"(lo[ks]):"v"(vb),"i"(d0*4096+ks*1024):"memory");
      asm volatile("ds_read_b64_tr_b16 %0,%1 offset:%c2":"=&v"(hi[ks]):"v"(vb),"i"(d0*4096+ks*1024+512):"memory");}
    asm volatile("s_waitcnt lgkmcnt(0)":::"memory");SBAR();
    #define PK(k) (bf16x8){lo[k][0],lo[k][1],lo[k][2],lo[k][3],hi[k][0],hi[k][1],hi[k][2],hi[k][3]}
    o[d0]=__builtin_amdgcn_mfma_f32_32x32x16_bf16(pa0,PK(0),o[d0],0,0,0);
    o[d0]=__builtin_amdgcn_mfma_f32_32x32x16_bf16(pa1,PK(1),o[d0],0,0,0);
    o[d0]=__builtin_amdgcn_mfma_f32_32x32x16_bf16(pa2,PK(2),o[d0],0,0,0);
    o[d0]=__builtin_amdgcn_mfma_f32_32x32x16_bf16(pa3,PK(3),o[d0],0,0,0);
    #undef PK
  }
}

#ifndef ATTN_STORE16
#define ATTN_STORE16(p,v) (*(u32x4*)(p)=(v))
#endif
template<int THRL> __device__ __forceinline__ void attn_unit(int b,int qcol,int kcol,int vcol,int ocol,int qb,const bf16*Q,const bf16* K,const bf16* V,bf16*O,char*shm,int tid){
  const int lane=tid&63,r32=lane&31,hi=lane>>5; const int wid=__builtin_amdgcn_readfirstlane(tid>>6);
  const long rowbase=(long)b*SEQ; const int q0=qb*QB;
  const bf16*Qw=Q+(rowbase+q0+wid*QBLK)*DM+qcol;
  const bf16*Kh=K+rowbase*DM+kcol,*Vh=V+rowbase*DM+vcol;
  const unsigned lds0=(unsigned)(uintptr_t)shm;
  float*wsf=(float*)(shm+LDS_WS)+wid*64;
  const bf16*ksrc=Kh+(long)lane*DM+wid*8;
  const bf16*vsrc=Vh+(long)(16*(wid&3)+(lane>>2))*DM+(wid>>2)*32+(lane&3)*8;
  const unsigned kdst=lds0+LDS_K+wid*1024, vdst=lds0+LDS_V+wid*1024;
  #define DMA_K(t,slot) glds16(ksrc+(long)(t)*KVBLK*DM,(unsigned)__builtin_amdgcn_readfirstlane(kdst+(slot)))
  #define DMA_V(t,slot) glds16(vsrc+(long)(t)*KVBLK*DM,(unsigned)__builtin_amdgcn_readfirstlane(vdst+(slot)))
  const int vb0=(int)(lds0+LDS_V)+((lane>>4)&1)*32+(lane&3)*8+(4*hi+((lane&15)>>2))*64;
  const char*Kbase=shm+LDS_K; bf16x8 kf[8];
  const lds_cptr shm3=(lds_cptr)shm; const lds_cptr kp0=shm3+LDS_K+hi*1024+r32*16; const lds_cptr vp0=shm3+LDS_V+((lane>>4)&1)*32+(lane&3)*8+(4*hi+((lane&15)>>2))*64;
  const int NT=(q0+QB)/KVBLK;
  DMA_K(0,0);DMA_V(0,0);DMA_K(1,SLOTB);
  bf16x8 qr[4];
  #pragma unroll
  for(int d0=0;d0<4;++d0)qr[d0]=*reinterpret_cast<const bf16x8*>(&Qw[(long)r32*DM+d0*16+hi*8]);
  float mhat=0.f,l_reg=0.f;f32x16 o[2];o[0]=f32x16{};o[1]=f32x16{};f32x16 negm=f32x16{};asm volatile("":"+v"(negm));
  const int qrel=wid*QBLK+r32;
  #define CMASK(P0,P1,t) do{int jb_=(t)-(NT-4); if(jb_>=0)cmask(P0,P1,jb_,qrel,hi);}while(0)
  bool resc=false;
  #define START(P0,P1) do{ const float rm=rowmax(P0,P1); resc=false; \
    { const float dl=rm; mhat=fadd_s(mhat,dl); \
      _Pragma("unroll") for(int r=0;r<16;++r){P0[r]=fsub_s(P0[r],dl);P1[r]=fsub_s(P1[r],dl);} \
      _Pragma("unroll") for(int r=0;r<16;++r)negm[r]=-mhat; asm volatile("":"+v"(negm)); } \
    _Pragma("unroll") for(int r=0;r<16;++r)P0[r]=__builtin_amdgcn_exp2f(P0[r]); }while(0)
  #define RESC() do{ if(resc){ asm volatile("s_waitcnt lgkmcnt(0)":::"memory"); \
      _Pragma("unroll") for(int d_=0;d_<2;++d_) _Pragma("unroll") for(int r=0;r<16;++r)o[d_][r]*=wsf[crow(r,hi)]; } }while(0)
  f32x16 pA0,pA1,pB0,pB1;
  int sl_prev=0,sl_cur=0,sl_next=SLOTB;
  #define ROT() do{sl_prev=sl_cur;sl_cur=sl_next;sl_next=(sl_next==(NSLOT-1)*SLOTB)?0:sl_next+SLOTB;}while(0)
  DMA_K(2,2*SLOTB);
  WAIT_BAR(3);
  qkt(pA0,pA1,Kbase,qr,negm,r32,hi);asm volatile("s_nop 15\n\ts_nop 7":"+v"(pA0),"+v"(pA1));CMASK(pA0,pA1,0);
  START(pA0,pA1);
  _Pragma("unroll") for(int r=0;r<16;++r)pA1[r]=__builtin_amdgcn_exp2f(pA1[r]);
  WAIT_BAR(0);
  DMA_K(3,0);DMA_V(1,SLOTB);
  ROT();
  kload8(kf,kp0+sl_cur);
  WAIT_BAR(2);
  s16x4 vlo[8],vhi[8]; u32x4 pw0,pw1,pw2,pw3;
  #define PKW(P,B) cvtpk_s(P[B],P[B+1])
  #define PAF(k) __builtin_bit_cast(bf16x8,pw##k)
  #define VFR(i) (bf16x8){vlo[i][0],vlo[i][1],vlo[i][2],vlo[i][3],vhi[i][0],vhi[i][1],vhi[i][2],vhi[i][3]}
  #define PIN(x) asm volatile("":"+v"(x))
  #define MX3(a,b,c) __builtin_fmaxf(__builtin_fmaxf((a),(b)),(c))
  #define GAPA(MF,A0,A1,A2,A3,W0,W1,PW) do{ MF; sacc+=A0; sacc+=A1; sacc+=A2; sacc+=A3; PIN(sacc); W0; W1; PIN(PW); SBAR(); }while(0)
  #define EX(v) __builtin_amdgcn_exp2f(v)
  #define GAPB(MF,X,B) do{ MF; X[B]=EX(X[B]); X[B+1]=EX(X[B+1]); X[B+2]=EX(X[B+2]); X[B+3]=EX(X[B+3]); PIN(X); SBAR(); }while(0)
  #define VRD(i) do{ vlo[i]=vtr(vp_+(((i)>>2)*4096+((i)&3)*1024)); vhi[i]=vtr(vp_+(((i)>>2)*4096+((i)&3)*1024+512)); }while(0)
  #define KRD(G,j) do{ if(G){ kload2(kf,kp0+sl_next,j); SBAR(); } }while(0)
  #define STEP(C0,C1,P0,P1,t,GK,GV,GL) do{ SBAR(); \
    const lds_cptr vp_=vp0+sl_prev; \
    VRD(0); SBAR(); float sacc=(P0[0]+P0[1]); \
    GAPA(C0=__builtin_amdgcn_mfma_f32_32x32x16_bf16(kf[0],qr[0],negm,0,0,0), P0[2],P0[3],P0[4],P0[5],     pw0[0]=PKW(P0,0), pw0[1]=PKW(P0,2), pw0); \
    VRD(4); SBAR(); GAPA(C1=__builtin_amdgcn_mfma_f32_32x32x16_bf16(kf[1],qr[0],negm,0,0,0), P0[6],P0[7],P0[8],P0[9],     pw0[2]=PKW(P0,4), pw0[3]=PKW(P0,6), pw0); \
    VRD(1); SBAR(); GAPA(C0=__builtin_amdgcn_mfma_f32_32x32x16_bf16(kf[2],qr[1],C0,0,0,0),   P0[10],P0[11],P0[12],P0[13], pw1[0]=PKW(P0,8), pw1[1]=PKW(P0,10), pw1); \
    VRD(5); SBAR(); GAPA(C1=__builtin_amdgcn_mfma_f32_32x32x16_bf16(kf[3],qr[1],C1,0,0,0),   P0[14],P0[15],P1[0],P1[1],   pw1[2]=PKW(P0,12),pw1[3]=PKW(P0,14), pw1); \
    VRD(2); SBAR(); GAPA(C0=__builtin_amdgcn_mfma_f32_32x32x16_bf16(kf[4],qr[2],C0,0,0,0),   P1[2],P1[3],P1[4],P1[5],     pw2[0]=PKW(P1,0), pw2[1]=PKW(P1,2), pw2); \
    VRD(6); SBAR(); GAPA(C1=__builtin_amdgcn_mfma_f32_32x32x16_bf16(kf[5],qr[2],C1,0,0,0),   P1[6],P1[7],P1[8],P1[9],     pw2[2]=PKW(P1,4), pw2[3]=PKW(P1,6), pw2); \
    VRD(3); SBAR(); GAPA(C0=__builtin_amdgcn_mfma_f32_32x32x16_bf16(kf[6],qr[3],C0,0,0,0),   P1[10],P1[11],P1[12],P1[13], pw3[0]=PKW(P1,8), pw3[1]=PKW(P1,10), pw3); \
    VRD(7); SBAR(); GAPA(C1=__builtin_amdgcn_mfma_f32_32x32x16_bf16(kf[7],qr[3],C1,0,0,0),   P1[14],P1[15],0.f,0.f,       pw3[2]=PKW(P1,12),pw3[3]=PKW(P1,14), pw3); \
    l_reg+=sacc; \
    if(GK){DMA_K((t)+3,sl_cur);} if(GV){DMA_V((t)+1,sl_next);} \
    CMASK(C0,C1,t); \
    { float a=MX3(C0[0],C0[1],C1[0]),b=MX3(C0[2],C0[3],C1[1]); a=MX3(a,C1[2],C1[3]); \
      _Pragma("unroll") for(int r=4;r<16;r+=4){a=MX3(a,C0[r],C0[r+1]);b=MX3(b,C0[r+2],C0[r+3]);a=MX3(a,C1[r],C1[r+1]);b=MX3(b,C1[r+2],C1[r+3]);} \
      float rm=__builtin_fmaxf(a,b); { auto rr=__builtin_amdgcn_permlane32_swap(__float_as_uint(rm),__float_as_uint(rm),false,false); rm=__builtin_fmaxf(__uint_as_float(rr[0]),__uint_as_float(rr[1])); } \
      resc=false; \
      if(__builtin_expect(__any(rm>(float)THRL),0)){ const float dl=__builtin_fmaxf(rm,0.f); mhat+=dl; \
        _Pragma("unroll") for(int r=0;r<16;++r){C0[r]-=dl;C1[r]-=dl;} \
        _Pragma("unroll") for(int r=0;r<16;++r)negm[r]=-mhat; asm volatile("":"+v"(negm)); \
        const float f=__builtin_amdgcn_exp2f(-dl); l_reg*=f; if(hi==0)wsf[r32]=f; resc=true; } } \
    SBAR(); \
    GAPB(o[0]=__builtin_amdgcn_mfma_f32_32x32x16_bf16(PAF(0),VFR(0),o[0],0,0,0), C0,0); \
    GAPB(o[1]=__builtin_amdgcn_mfma_f32_32x32x16_bf16(PAF(0),VFR(4),o[1],0,0,0), C0,4); \
    KRD(GL,0); GAPB(o[0]=__builtin_amdgcn_mfma_f32_32x32x16_bf16(PAF(1),VFR(1),o[0],0,0,0), C0,8); \
    KRD(GL,1); GAPB(o[1]=__builtin_amdgcn_mfma_f32_32x32x16_bf16(PAF(1),VFR(5),o[1],0,0,0), C0,12); \
    KRD(GL,2); GAPB(o[0]=__builtin_amdgcn_mfma_f32_32x32x16_bf16(PAF(2),VFR(2),o[0],0,0,0), C1,0); \
    KRD(GL,3); GAPB(o[1]=__builtin_amdgcn_mfma_f32_32x32x16_bf16(PAF(2),VFR(6),o[1],0,0,0), C1,4); \
    GAPB(o[0]=__builtin_amdgcn_mfma_f32_32x32x16_bf16(PAF(3),VFR(3),o[0],0,0,0), C1,8); \
    GAPB(o[1]=__builtin_amdgcn_mfma_f32_32x32x16_bf16(PAF(3),VFR(7),o[1],0,0,0), C1,12); \
    }while(0)
  int t=1;
  #undef CMASK
  #define CMASK(P0,P1,t) do{}while(0)
  for(;t+5<NT;t+=2){
    STEP(pB0,pB1,pA0,pA1,t,true,true,true);     WAIT_BAR(2); RESC(); ROT();
    STEP(pA0,pA1,pB0,pB1,t+1,true,true,true);   WAIT_BAR(2); RESC(); ROT();
  }
  #undef CMASK
  #define CMASK(P0,P1,t) do{int jb_=(t)-(NT-4); if(jb_>=0)cmask(P0,P1,jb_,qrel,hi);}while(0)
  #define ENDW(tt) do{ if((tt)+3<NT){WAIT_BAR(2);} else if((tt)+2<NT){WAIT_BAR(1);} else {WAIT_BAR(0);} }while(0)
  for(;t+1<NT;t+=2){
    STEP(pB0,pB1,pA0,pA1,t,(t+3<NT),(t+1<NT),(t+1<NT));       ENDW(t);   RESC(); ROT();
    STEP(pA0,pA1,pB0,pB1,t+1,(t+4<NT),(t+2<NT),(t+2<NT));     ENDW(t+1); RESC(); ROT();
  }
  STEP(pB0,pB1,pA0,pA1,NT-1,false,false,false); RESC();
  { float sacc=pB0[0]+pB0[1]; _Pragma("unroll") for(int r=2;r<16;++r)sacc+=pB0[r]; _Pragma("unroll") for(int r=0;r<16;++r)sacc+=pB1[r]; l_reg+=sacc;
    pw0=(u32x4){PKW(pB0,0),PKW(pB0,2),PKW(pB0,4),PKW(pB0,6)};pw1=(u32x4){PKW(pB0,8),PKW(pB0,10),PKW(pB0,12),PKW(pB0,14)};pw2=(u32x4){PKW(pB1,0),PKW(pB1,2),PKW(pB1,4),PKW(pB1,6)};pw3=(u32x4){PKW(pB1,8),PKW(pB1,10),PKW(pB1,12),PKW(pB1,14)};
    SBAR(); pv(o,vb0+sl_cur,PAF(0),PAF(1),PAF(2),PAF(3)); }
  #undef PKW
  #undef PAF
  #undef VFR
  #undef PIN
  #undef MX3
  #undef GAPA
  #undef GAPB
  #undef EX
  #undef VRD
  #undef KRD
  #undef STEP
  #undef ENDW
  {auto rr=__builtin_amdgcn_permlane32_swap(__float_as_uint(l_reg),__float_as_uint(l_reg),false,false);l_reg=__uint_as_float(rr[0])+__uint_as_float(rr[1]);}
  if(hi==0)wsf[32+r32]=l_reg;asm volatile("s_waitcnt lgkmcnt(0)":::"memory");
  float rli[16];
  #pragma unroll
  for(int r=0;r<16;++r)rli[r]=__builtin_amdgcn_rcpf(wsf[32+crow(r,hi)]);
  bf16*Ow=O+(rowbase+q0+wid*QBLK)*DM+ocol;
  { bf16*stg=(bf16*)(shm+LDS_OST)+wid*2048;
    #pragma unroll
    for(int r=0;r<16;++r){const int orow=crow(r,hi);
      #pragma unroll
      for(int d0=0;d0<2;++d0)stg[orow*64+d0*32+r32]=__float2bfloat16(o[d0][r]*rli[r]);}
    asm volatile("s_waitcnt lgkmcnt(0)":::"memory");
    #pragma unroll
    for(int i=0;i<4;++i){const int row=i*8+(lane>>3),ch=lane&7; const u32x4 v=*(const u32x4*)(stg+row*64+ch*8); ATTN_STORE16(Ow+(long)row*DM+ch*8,v);} }
  asm volatile("s_waitcnt lgkmcnt(0)\n\ts_barrier":::"memory");
  #undef DMA_K
  #undef DMA_V
  #undef CMASK
  #undef START
  #undef RESC
  #undef ROT
}
constexpr int ATTN_LDS_BYTES=LDS_BYTES;
struct AttnTensors { const bf16* Q; const bf16* K; const bf16* V; bf16* O0; bf16* O1; };
struct AttnUnit { int b, qcol, kcol, vcol, ocol, m, qb; };
struct StaticOrder {
  int vcu, G;
  __device__ __forceinline__ StaticOrder(int grid,int vcu_):vcu(vcu_),G(grid){}
  __device__ __forceinline__ bool next(int i,AttnUnit&u)const{ const int ci=vcu+G*(i>>4); if(ci>=BATCH*32)return false; const int vh=ci&31,h=vh>>2,m=(vh>>1)&1,vhalf=vh&1;
    u.b=ci>>5; u.qcol=(2*h+m)*64; u.kcol=u.qcol; u.vcol=h*128+vhalf*64; u.ocol=u.vcol; u.m=m; u.qb=15-(i&15); return true; }
  __device__ __forceinline__ void a_ready(const AttnUnit&)const{}
  __device__ __forceinline__ void done(const AttnUnit&)const{}
};
template<class Sched,int THRL=8> __device__ __forceinline__ void attn_phase(char*lds,const AttnTensors&T,const Sched&S,const int tid_){
  AttnUnit u;
  for(int i=0;S.next(i,u);++i){ S.a_ready(u); attn_unit<THRL>(u.b,u.qcol,u.kcol,u.vcol,u.ocol,u.qb,T.Q,T.K,T.V,u.m?T.O1:T.O0,lds,tid_); S.done(u); }
}
#undef SBAR
#undef WAIT_BAR
}

constexpr int NWAVES = 8;
constexpr int BATCH = 16, SEQ = 4096, D = 1024, M = BATCH * SEQ, DEPTH = 4;
constexpr int NEXP = 32, FF = 512;
constexpr int NSLOT_MAX = 2 * M + NEXP * 256, NBLK_MAX = NSLOT_MAX / 256;
constexpr float LN_EPS = 1e-5f;
constexpr float DN_ALPHA = 1.681792830507429f;
constexpr int HG_CHUNK = 32, HG_NCH = SEQ / HG_CHUNK;

constexpr size_t MiB = 1u << 20;
constexpr size_t WS_CTL = 0, CTL_ZERO_BYTES = 1 * MiB;
constexpr size_t WS_MOD = 1 * MiB;
constexpr size_t WS_ROPE_C = 3 * MiB, WS_ROPE_S = 3 * MiB + 512 * 1024;
constexpr size_t WS_RT = 4 * MiB;
constexpr size_t WS_EID = 5 * MiB;
constexpr size_t WS_WT = 5 * MiB + 512 * 1024;
constexpr size_t WS_TSLOT = 6 * MiB;
constexpr size_t WS_SLOTW = 6 * MiB + 512 * 1024;
constexpr size_t WS_BLKE = 7 * MiB + 128 * 1024;
constexpr size_t WS_HGD = 8 * MiB;
constexpr size_t WS_WHIN = 16 * MiB;
constexpr size_t WS_WAIN = 32 * MiB;
constexpr size_t WS_WHOUT = 44 * MiB;
constexpr size_t WS_WAOUT = 48 * MiB;
constexpr size_t WS_W13 = 52 * MiB;
constexpr size_t WS_W2 = 116 * MiB;
constexpr size_t WS_BUF0 = 148 * MiB, BUFSZ = 128 * MiB;
constexpr size_t WS_END = WS_BUF0 + 7 * BUFSZ;
constexpr int CW_TMO = 0, CW_CODE = 1;
constexpr int CW_BAR = 4096;
constexpr int CW_CNT = 8192;
static_assert((CW_CNT + 4 * 256) * 4 <= (int)CTL_ZERO_BYTES, "ctl");

constexpr int RING_OFF = 0, RING_BYTES = 147456;
constexpr int LDSCTL_OFF = RING_BYTES, MISC_OFF = LDSCTL_OFF + 512;
constexpr int LDS_BYTES = RING_BYTES + 1024;
static_assert(MISC_OFF + 128 <= LDS_BYTES, "LDS map");
#define GAS __attribute__((address_space(1)))
#define LAS __attribute__((address_space(3)))
typedef unsigned short bf16;
typedef unsigned v4u __attribute__((ext_vector_type(4)));
typedef float f32x4 __attribute__((ext_vector_type(4)));
typedef short bf16x8 __attribute__((ext_vector_type(8)));
typedef GAS unsigned gu32;
typedef GAS unsigned long long gu64;
#define RLX_AGENT __ATOMIC_RELAXED, __HIP_MEMORY_SCOPE_AGENT
#define LDS_WAIT() asm volatile("s_waitcnt lgkmcnt(0)" ::: "memory")
#define VM_WAIT() asm volatile("s_waitcnt vmcnt(0)" ::: "memory")
__device__ __forceinline__ unsigned long long rt() { return __builtin_amdgcn_s_memrealtime(); }
__device__ __forceinline__ unsigned f2bf(float f) { unsigned u = __builtin_bit_cast(unsigned, f); return (u + 0x7fffu + ((u >> 16) & 1u)) >> 16; }
__device__ __forceinline__ unsigned pk2(float lo, float hi) { return f2bf(lo) | (f2bf(hi) << 16); }

#define XB_TMO      128
#define XB_XCNT(j)  (256  + 64 * (j))
#define XB_XSUB(j)  (1280 + 64 * (j))
#define XB_XGEN(j)  (2304 + 64 * (j))
#define XB_TOP      3328
#define XB_TOPGEN   3392
#define XCD_BAR_WORDS 3456
#define XB_SPIN_CAP (1u << 18)

__device__ __forceinline__ unsigned xb_ld(unsigned* p)              { return __hip_atomic_load(p, __ATOMIC_RELAXED, __HIP_MEMORY_SCOPE_AGENT); }
__device__ __forceinline__ unsigned xb_add(unsigned* p, unsigned v) { return __hip_atomic_fetch_add(p, v, __ATOMIC_RELAXED, __HIP_MEMORY_SCOPE_AGENT); }
__device__ __forceinline__ unsigned xb_xcc_id() { return (unsigned)__builtin_amdgcn_s_getreg((3 << 11) | 20) & 0xFu; }
#define XB_SPIN(cond, bar) do { unsigned _sp = 0; while (cond) { __builtin_amdgcn_s_sleep(1); \
    if ((++_sp & 255u) == 0u) { if (xb_ld(&(bar)[XB_TMO])) break; if (_sp > XB_SPIN_CAP) { atomicAdd(&(bar)[XB_TMO], 1u); break; } } } } while (0)

struct XcdBarrier {
    unsigned* bar; unsigned x;
    volatile LAS unsigned* st;
};

__device__ __forceinline__ XcdBarrier xcd_barrier_post(unsigned* bar, volatile LAS unsigned* st) {
    XcdBarrier b; b.bar = bar; b.x = xb_xcc_id(); b.st = st;
    if (threadIdx.x == 0) (void)xb_add(&bar[XB_XCNT(b.x)], 1u);
    return b;
}
__device__ __forceinline__ void xcd_barrier_complete(unsigned* bar, unsigned x, unsigned& nloc, unsigned& nx) {
    const unsigned G = gridDim.x * gridDim.y * gridDim.z;
    unsigned sum, cnt, mine, sp = 0u;
    for (;;) {
        sum = 0u; cnt = 0u; mine = 0u;
#pragma unroll
        for (unsigned j = 0; j < 16; ++j) { const unsigned c = xb_ld(&bar[XB_XCNT(j)]); sum += c; cnt += (c > 0u) ? 1u : 0u; mine = (j == x) ? c : mine; }
        if (sum == G) break;
        __builtin_amdgcn_s_sleep(1);
        if ((++sp & 255u) == 0u) { if (xb_ld(&bar[XB_TMO])) break; if (sp > XB_SPIN_CAP) { atomicAdd(&bar[XB_TMO], 1u); break; } }
    }
    nloc = mine > 0u ? mine : 1u; nx = cnt > 0u ? cnt : 1u;
}

__device__ __forceinline__ void xcd_barrier(const XcdBarrier& b, const int wave_s) {
    asm volatile("s_waitcnt vmcnt(0)" ::: "memory");
    __syncthreads();
    if (wave_s == 0 && __builtin_amdgcn_mbcnt_hi(~0u, __builtin_amdgcn_mbcnt_lo(~0u, 0u)) == 0u) {
        unsigned* bar = b.bar;
        __builtin_amdgcn_s_waitcnt(0);
        unsigned nloc = b.st[0], nx = b.st[1];
        if (nloc == 0u) { xcd_barrier_complete(bar, b.x, nloc, nx); b.st[0] = nloc; b.st[1] = nx; }
        const unsigned old = xb_add(&bar[XB_XSUB(b.x)], 1u);
        const unsigned gen = old / nloc;
        if (old + 1u == (gen + 1u) * nloc) {
            __builtin_amdgcn_fence(__ATOMIC_RELEASE, "agent");
            asm volatile("s_waitcnt vmcnt(0)" ::: "memory");
            const unsigned og = xb_add(&bar[XB_TOP], 1u);
            const unsigned tg = og / nx;
            if (og + 1u == (tg + 1u) * nx) xb_add(&bar[XB_TOPGEN], 1u);
            else XB_SPIN(xb_ld(&bar[XB_TOPGEN]) == tg, bar);
            __builtin_amdgcn_fence(__ATOMIC_ACQUIRE, "agent");
            xb_add(&bar[XB_XGEN(b.x)], 1u);
            asm volatile("s_waitcnt vmcnt(0)" ::: "memory");
        } else {
            XB_SPIN(xb_ld(&bar[XB_XGEN(b.x)]) == gen, bar);
            __builtin_amdgcn_fence(__ATOMIC_ACQUIRE, "agent");
            asm volatile("s_waitcnt vmcnt(0)" ::: "memory");
        }
    }
    __syncthreads();
}

struct Args { const float* in[21]; float* out; unsigned char* ws; int ph_lo, ph_hi; };
#define CAS __attribute__((address_space(4)))
struct KA { const CAS char* p;
    __device__ __forceinline__ const float* in(int k) const { return *(const float* const CAS*)(p + 8 * k); }
    __device__ __forceinline__ float* out() const { return *(float* const CAS*)(p + 8 * 21); }
    __device__ __forceinline__ unsigned char* ws() const { return *(unsigned char* const CAS*)(p + 8 * 22); }
    __device__ __forceinline__ int ph_lo() const { return *(const CAS int*)(p + 8 * 23); }
    __device__ __forceinline__ int ph_hi() const { return *(const CAS int*)(p + 8 * 23 + 4); }
};
__device__ __forceinline__ KA karg_fresh() { const CAS char* q = (const CAS char*)__builtin_amdgcn_kernarg_segment_ptr(); asm volatile("" : "+s"(q)); KA k; k.p = q; return k; }
struct Frame {
    LAS unsigned char* lds; volatile LAS unsigned* MISC; gu32* ctl;
    int tid, lane, wave, vcu, G, bx;
};
typedef unsigned long long u64;
typedef float f32x16 __attribute__((ext_vector_type(16)));
__device__ __forceinline__ float lane_xor(float v, int lane, int o) { return __builtin_bit_cast(float, __builtin_amdgcn_ds_bpermute((lane ^ o) << 2, __builtin_bit_cast(int, v))); }
__device__ __forceinline__ float wave_sum(float v, int lane) {
#pragma unroll
    for (int o = 1; o < 64; o <<= 1) v += lane_xor(v, lane, o);
    return v;
}
__device__ __forceinline__ float bf2f(unsigned b) { return __uint_as_float(b << 16); }
__device__ __forceinline__ float bflo(unsigned w) { return __uint_as_float(w << 16); }
__device__ __forceinline__ float bfhi(unsigned w) { return __uint_as_float(w & 0xffff0000u); }
__device__ __forceinline__ float fexp(float x) { return __builtin_amdgcn_exp2f(1.4426950408889634f * x); }
__device__ __forceinline__ float sigmoid_f(float x) { return __builtin_amdgcn_rcpf(1.0f + fexp(-x)); }
__device__ __forceinline__ unsigned pkbf(float lo, float hi) { return pg8::cvt_pk_bf16(lo, hi); }
__device__ __forceinline__ int swap23(int p) { return (p & ~12) | ((p & 4) << 1) | ((p & 8) >> 1); }
__device__ __forceinline__ int crow16(int i, int hh) { return (i & 3) + 8 * (i >> 2) + 4 * hh; }

struct MapId { __device__ __forceinline__ int operator()(int n) const { return n; } };
struct MapW13 { int add; __device__ __forceinline__ int operator()(int u) const { return ((u >> 7) << 8) + add + (u & 127); } };
struct MapHgrnIn { __device__ __forceinline__ int operator()(int n) const { return (n < 2048) ? ((n & ~1023) | swap23(n & 1023)) : n; } };
struct MapAttnIn { __device__ __forceinline__ int operator()(int n) const { if (n >= 2048) return n; const int part = n >> 10, c = n & 1023, hm = c >> 6, dim = c & 63;
    return part * 1024 + (hm >> 2) * 256 + (dim >> 5) * 128 + (hm & 3) * 32 + (dim & 31); } };
template <class MapF>
__device__ __forceinline__ void transpose_item(const float* W, int K, int N, bf16* WT, LAS float* scr, int item, int lane, MapF map) {
    const int nblk = N / 32, kb = item / nblk, nb = item % nblk, k0 = 64 * kb, n0 = 32 * nb;
#pragma unroll 8
    for (int i = 0; i < 32; ++i) { const int kk = 2 * i + (lane >> 5); scr[kk * 33 + (lane & 31)] = W[(size_t)(k0 + kk) * N + n0 + (lane & 31)]; }
    LDS_WAIT(); asm volatile("" ::: "memory");
    const int c = lane & 7;
#pragma unroll
    for (int j = 0; j < 4; ++j) { const int n = (lane >> 3) + 8 * j; const LAS float* s = scr + (8 * c) * 33 + n;
        v4u o; o.x = pkbf(s[0 * 33], s[1 * 33]); o.y = pkbf(s[2 * 33], s[3 * 33]); o.z = pkbf(s[4 * 33], s[5 * 33]); o.w = pkbf(s[6 * 33], s[7 * 33]);
        *(GAS v4u*)(WT + (size_t)map(n0 + n) * K + k0 + 8 * c) = o; }
    LDS_WAIT(); asm volatile("" ::: "memory");
}
__device__ __forceinline__ void convert_moe(Frame& F, const KA a, int L) {
    LAS float* scr = (LAS float*)(F.lds + RING_OFF + F.wave * 16384);
    const int gw = F.vcu * NWAVES + F.wave, NGW = F.G * NWAVES;
    bf16* W13 = (bf16*)(a.ws() + WS_W13); bf16* W2 = (bf16*)(a.ws() + WS_W2);
    for (int it = gw; it < 32 * 768; it += NGW) {
        const int e = it / 768, r = it % 768; const size_t eo = (size_t)(L * 32 + e) * 1024 * 512;
        if (r < 256) transpose_item(a.in(18) + eo, 1024, 512, W13 + (size_t)e * 1024 * 1024, scr, r, F.lane, MapW13{0});
        else if (r < 512) transpose_item(a.in(19) + eo, 1024, 512, W13 + (size_t)e * 1024 * 1024, scr, r - 256, F.lane, MapW13{128});
        else transpose_item(a.in(20) + eo, 512, 1024, W2 + (size_t)e * 1024 * 512, scr, r - 512, F.lane, MapId{});
    }
}

__device__ __forceinline__ void phase_p0a(Frame& F, const KA a) {
    const int gw = F.vcu * NWAVES + F.wave, NGW = F.G * NWAVES;
    const float* c = a.in(1); const float* ada_w = a.in(2); const float* ada_b = a.in(3);
    float* mod = (float*)(a.ws() + WS_MOD);
    for (int it = F.vcu; it < 4 * 24; it += F.G) {
        const int i = it / 24, nb = it % 24;
        f32x4 acc[16];
#pragma unroll
        for (int b = 0; b < 16; ++b) acc[b] = (f32x4){0.f, 0.f, 0.f, 0.f};
        const float* wp = ada_w + ((size_t)i * 1024 + F.wave * 128) * 6144 + nb * 256 + 4 * F.lane;
        for (int k = 0; k < 128; ++k) {
            const f32x4 w4 = *(const f32x4*)(wp + (size_t)k * 6144);
#pragma unroll
            for (int b = 0; b < 16; ++b) { const float cv = c[b * 1024 + F.wave * 128 + k]; const float s = cv * sigmoid_f(cv); acc[b] += w4 * s; }
        }
        LAS float* red = (LAS float*)(F.lds + RING_OFF);
#pragma unroll
        for (int b = 0; b < 16; ++b) *(LAS f32x4*)(red + (F.wave * 16 + b) * 256 + 4 * F.lane) = acc[b];
        __syncthreads();
        for (int r = 0; r < 8; ++r) { const int idx = F.tid + 512 * r, b = idx >> 8, col = idx & 255; float s = ada_b[i * 6144 + nb * 256 + col];
#pragma unroll
            for (int w = 0; w < 8; ++w) s += red[(w * 16 + b) * 256 + col];
            mod[((size_t)i * 16 + b) * 6144 + nb * 256 + col] = s; }
        __syncthreads();
    }
    {
        float* cs = (float*)(a.ws() + WS_ROPE_C); float* sn = (float*)(a.ws() + WS_ROPE_S);
        for (int idx = gw * 64 + F.lane; idx < SEQ * 32; idx += NGW * 64) {
            const int pos = idx >> 5, j = idx & 31;
            double f = 1.0; const double r1 = 0.74989420933245582730;
            double p = r1;
#pragma unroll
            for (int bit = 0; bit < 5; ++bit) { if (j & (1 << bit)) f *= p; p *= p; }
            const double ang = (double)pos * f;
            const double kq = __builtin_rint(ang * 0.63661977236758134308);
            const double rr = (ang - kq * 1.57079632679489655800e+00) - kq * 6.12323399573676603587e-17;
            const double r2 = rr * rr;
            const double sp = rr * (1.0 + r2 * (-1.0 / 6 + r2 * (1.0 / 120 + r2 * (-1.0 / 5040 + r2 * (1.0 / 362880 + r2 * (-1.0 / 39916800 + r2 * (1.0 / 6227020800.0)))))));
            const double cp = 1.0 + r2 * (-0.5 + r2 * (1.0 / 24 + r2 * (-1.0 / 720 + r2 * (1.0 / 40320 + r2 * (-1.0 / 3628800 + r2 * (1.0 / 479001600.0 + r2 * (-1.0 / 87178291200.0)))))));
            const int q = ((int)kq) & 3;
            const double sv = (q == 0) ? sp : (q == 1) ? cp : (q == 2) ? -sp : -cp;
            const double cv = (q == 0) ? cp : (q == 1) ? -sp : (q == 2) ? -cp : sp;
            cs[idx] = (float)cv; sn[idx] = (float)sv;
        }
    }
    {
        float* rt = (float*)(a.ws() + WS_RT); const float* rgw = a.in(14); const float* rew = a.in(16);
        for (int idx = gw * 64 + F.lane; idx < 4 * 36 * 1024; idx += NGW * 64) {
            const int l = idx / 36864, e = (idx >> 10) % 36, k = idx & 1023;
            rt[idx] = (e < 4) ? rgw[((size_t)l * 1024 + k) * 4 + e] : rew[((size_t)l * 1024 + k) * 32 + (e - 4)];
        }
    }
    {
        LAS float* scr = (LAS float*)(F.lds + RING_OFF + F.wave * 16384);
        bf16* whin = (bf16*)(a.ws() + WS_WHIN); bf16* wain = (bf16*)(a.ws() + WS_WAIN); bf16* whout = (bf16*)(a.ws() + WS_WHOUT); bf16* waout = (bf16*)(a.ws() + WS_WAOUT);
        constexpr int I_HIN = 16 * 128, I_OUT = 16 * 32, I_AIN = 16 * 96, I_PER = I_HIN + I_OUT + I_AIN + I_OUT;
        for (int it = gw; it < 2 * I_PER; it += NGW) {
            const int j = it / I_PER; int r = it % I_PER;
            if (r < I_HIN) { transpose_item(a.in(6) + (size_t)j * 1024 * 4096, 1024, 4096, whin + (size_t)j * 4096 * 1024, scr, r, F.lane, MapHgrnIn{}); continue; } r -= I_HIN;
            if (r < I_OUT) { transpose_item(a.in(7) + (size_t)j * 1024 * 1024, 1024, 1024, whout + (size_t)j * 1024 * 1024, scr, r, F.lane, MapId{}); continue; } r -= I_OUT;
            if (r < I_AIN) { transpose_item(a.in(10) + (size_t)j * 1024 * 3072, 1024, 3072, wain + (size_t)j * 3072 * 1024, scr, r, F.lane, MapAttnIn{}); continue; } r -= I_AIN;
            transpose_item(a.in(11) + (size_t)j * 1024 * 1024, 1024, 1024, waout + (size_t)j * 1024 * 1024, scr, r, F.lane, MapId{});
        }
    }
    convert_moe(F, a, 0);
}

__device__ __forceinline__ void phase_p0b(Frame& F, const KA a) {
    const int gw = F.vcu * NWAVES + F.wave, NGW = F.G * NWAVES;
    const float* x = a.in(0); const float* mod = (const float*)(a.ws() + WS_MOD); bf16* h = (bf16*)(a.ws() + WS_BUF0);
    for (int tok = gw; tok < M; tok += NGW) {
        const int b = tok >> 12; const float* mb = mod + (size_t)b * 6144;
#pragma unroll
        for (int j = 0; j < 4; ++j) { const int col = 4 * F.lane + 256 * j;
            const f32x4 xv = *(const f32x4*)(x + (size_t)tok * D + col), sh = *(const f32x4*)(mb + col), sc = *(const f32x4*)(mb + 1024 + col);
            const f32x4 hv = xv * (sc + 1.0f) + sh;
            *(u64*)(h + (size_t)tok * D + col) = (u64)pkbf(hv[0], hv[1]) | ((u64)pkbf(hv[2], hv[3]) << 32); }
    }
}

__device__ __forceinline__ void phase_hgrn_prep(Frame& F, const KA a, int j) {
    bf16* Qb = (bf16*)(a.ws() + WS_BUF0 + 1 * BUFSZ); bf16* Zb = (bf16*)(a.ws() + WS_BUF0 + 2 * BUFSZ); const bf16* Vb = (const bf16*)(a.ws() + WS_BUF0 + 3 * BUFSZ);
    bf16* KhT = (bf16*)(a.ws() + WS_BUF0); bf16* VT = (bf16*)(a.ws() + WS_BUF0 + 5 * BUFSZ); float* dd = (float*)(a.ws() + WS_HGD);
    const float* lb = a.in(8);
    for (int it = F.vcu; it < BATCH * HG_NCH * 2; it += F.G) {
        const int half = it & 1, chunk = (it >> 1) & (HG_NCH - 1), b = it >> 8;
        const int col = half * 512 + F.tid, h = col >> 7, pos = col & 127, ch = swap23(pos);
        float lbv = 0.f; if (j == 1) lbv = sigmoid_f(lb[1024 + h * 128 + ch] - lb[h * 128 + ch]);
        const float oml = 1.0f - lbv;
        const size_t tok0 = (size_t)b * SEQ + chunk * HG_CHUNK;
        float bs[32], kv[32]; float bsum = 0.f;
#pragma unroll
        for (int t = 0; t < 32; ++t) { const float z = bf2f(Zb[(tok0 + t) * D + col]); const float k = oml * sigmoid_f(-z); const float f = 1.0f - k;
            const float g = (k < 0.05f) ? -k * (1.0f + k * (0.5f + k * (0.33333333f + k * 0.25f))) : 0.69314718056f * __builtin_amdgcn_logf(f);
            bsum += g; bs[t] = bsum; kv[t] = k; }
        const float bl = bsum;
#pragma unroll
        for (int t = 0; t < 32; ++t) { const float q = bf2f(Qb[(tok0 + t) * D + col]);
            Qb[(tok0 + t) * D + col] = (bf16)(pkbf(q * fexp(bs[t]), 0.f) & 0xffffu);
            Zb[(tok0 + t) * D + col] = (bf16)(pkbf(kv[t] * fexp(fminf(-bs[t], 80.0f)), 0.f) & 0xffffu); }
        const size_t rowbase = ((size_t)(b * 8 + h) * HG_NCH + chunk) * 128;
        { v4u w[4];
#pragma unroll
          for (int p2 = 0; p2 < 16; ++p2) { const int t0 = swap23(2 * p2), t1 = swap23(2 * p2 + 1);
              const unsigned pk = pkbf(kv[t0] * fexp(bl - bs[t0]), kv[t1] * fexp(bl - bs[t1])); w[p2 >> 2][p2 & 3] = pk; }
          v4u* dst = (v4u*)(KhT + (rowbase + ch) * 32);
#pragma unroll
          for (int i = 0; i < 4; ++i) dst[i] = w[i]; }
        dd[rowbase + ch] = fexp(bl);
        { unsigned vv[32];
#pragma unroll
          for (int t = 0; t < 32; ++t) vv[t] = Vb[(tok0 + t) * D + col];
          v4u w[4];
#pragma unroll
          for (int p2 = 0; p2 < 16; ++p2) { const int t0 = swap23(2 * p2), t1 = swap23(2 * p2 + 1); w[p2 >> 2][p2 & 3] = vv[t0] | (vv[t1] << 16); }
          v4u* dst = (v4u*)(VT + (rowbase + pos) * 32);
#pragma unroll
          for (int i = 0; i < 4; ++i) dst[i] = w[i]; }
    }
}

#define MFMA32(a_, b_, c_) __builtin_amdgcn_mfma_f32_32x32x16_bf16((a_), (b_), (c_), 0, 0, 0)
__device__ __forceinline__ bf16x8 pack_half(const f32x16& x, int s) {
    v4u p; p.x = pkbf(x[8 * s + 0], x[8 * s + 1]); p.y = pkbf(x[8 * s + 2], x[8 * s + 3]); p.z = pkbf(x[8 * s + 4], x[8 * s + 5]); p.w = pkbf(x[8 * s + 6], x[8 * s + 7]);
    return __builtin_bit_cast(bf16x8, p);
}
__device__ __forceinline__ void phase_hgrn_scan(Frame& F, const KA a) {
    const bf16* Qt = (const bf16*)(a.ws() + WS_BUF0 + 1 * BUFSZ); const bf16* Kt = (const bf16*)(a.ws() + WS_BUF0 + 2 * BUFSZ);
    const bf16* KhT = (const bf16*)(a.ws() + WS_BUF0); const bf16* VT = (const bf16*)(a.ws() + WS_BUF0 + 5 * BUFSZ); const float* dd = (const float*)(a.ws() + WS_HGD);
    bf16* O = (bf16*)(a.ws() + WS_BUF0 + 6 * BUFSZ);
    if (F.wave >= 2) return;
    for (int u = F.vcu; u < BATCH * 8 * 2; u += F.G) {
        const int bh = u >> 1, vt = (u & 1) * 2 + F.wave, b = bh >> 3, h = bh & 7;
        const int r = F.lane & 31, hh = F.lane >> 5;
        f32x16 S[4];
#pragma unroll
        for (int kt = 0; kt < 4; ++kt)
#pragma unroll
            for (int i = 0; i < 16; ++i) S[kt][i] = 0.f;
        const bf16* Qp = Qt + ((size_t)b * SEQ + r) * D + h * 128 + 8 * hh;
        const bf16* Kp = Kt + ((size_t)b * SEQ + r) * D + h * 128 + 8 * hh;
        const bf16* KhP = KhT + ((size_t)bh * HG_NCH * 128 + r) * 32 + 8 * hh;
        const bf16* Vp = VT + ((size_t)bh * HG_NCH * 128 + 32 * vt + r) * 32 + 8 * hh;
        const float* dp = dd + (size_t)bh * HG_NCH * 128 + 4 * hh;
        bf16* op = O + (size_t)b * SEQ * D + h * 128 + 32 * vt + r;
        for (int c = 0; c < HG_NCH; ++c) {
            bf16x8 Qf[8], Kf[8], Vf[2];
#pragma unroll
            for (int ks = 0; ks < 8; ++ks) { Qf[ks] = *(const bf16x8*)(Qp + (size_t)c * 32 * D + 16 * ks); Kf[ks] = *(const bf16x8*)(Kp + (size_t)c * 32 * D + 16 * ks); }
#pragma unroll
            for (int st = 0; st < 2; ++st) Vf[st] = *(const bf16x8*)(Vp + (size_t)c * 128 * 32 + 16 * st);
            f32x16 sc;
#pragma unroll
            for (int i = 0; i < 16; ++i) sc[i] = 0.f;
#pragma unroll
            for (int ks = 0; ks < 8; ++ks) sc = MFMA32(Kf[ks], Qf[ks], sc);
#pragma unroll
            for (int i = 0; i < 16; ++i) sc[i] = (crow16(i, hh) > r) ? 0.f : sc[i];
            f32x16 o;
#pragma unroll
            for (int i = 0; i < 16; ++i) o[i] = 0.f;
            o = MFMA32(pack_half(sc, 0), Vf[0], o); o = MFMA32(pack_half(sc, 1), Vf[1], o);
#pragma unroll
            for (int kt = 0; kt < 4; ++kt)
#pragma unroll
                for (int st = 0; st < 2; ++st) o = MFMA32(Qf[2 * kt + st], pack_half(S[kt], st), o);
#pragma unroll
            for (int kt = 0; kt < 4; ++kt) {
#pragma unroll
                for (int g = 0; g < 4; ++g) { const f32x4 dv = *(const f32x4*)(dp + (size_t)c * 128 + 32 * kt + 8 * g);
#pragma unroll
                    for (int i = 0; i < 4; ++i) S[kt][4 * g + i] *= dv[i]; }
#pragma unroll
                for (int st = 0; st < 2; ++st) { const bf16x8 kh = *(const bf16x8*)(KhP + (size_t)c * 128 * 32 + (size_t)(32 * kt) * 32 + 16 * st); S[kt] = MFMA32(kh, Vf[st], S[kt]); }
            }
#pragma unroll
            for (int i = 0; i < 16; ++i) op[(size_t)(c * 32 + crow16(i, hh)) * D] = (bf16)(pkbf(o[i], 0.f) & 0xffffu);
        }
    }
}

template <int MODE>
__device__ __forceinline__ void phase_normgate(Frame& F, const bf16* P0, const bf16* P1, bf16* out, const float* w, float lam, float mul) {
    const int gw = F.vcu * NWAVES + F.wave, NGW = F.G * NWAVES;
    float wv[16];
#pragma unroll
    for (int i = 0; i < 16; ++i) wv[i] = w[((16 * F.lane) & 127) + i] * mul;
    for (int tok = gw; tok < M; tok += NGW) {
        const size_t off = (size_t)tok * D + 16 * F.lane;
        const v4u a0 = *(const v4u*)(P0 + off), a1 = *(const v4u*)(P0 + off + 8), b0 = *(const v4u*)(P1 + off), b1 = *(const v4u*)(P1 + off + 8);
        float av[16], bv[16];
#pragma unroll
        for (int i = 0; i < 4; ++i) { av[2 * i] = bflo(a0[i]); av[2 * i + 1] = bfhi(a0[i]); av[8 + 2 * i] = bflo(a1[i]); av[8 + 2 * i + 1] = bfhi(a1[i]);
                                      bv[2 * i] = bflo(b0[i]); bv[2 * i + 1] = bfhi(b0[i]); bv[8 + 2 * i] = bflo(b1[i]); bv[8 + 2 * i + 1] = bfhi(b1[i]); }
        float ss = 0.f;
#pragma unroll
        for (int i = 0; i < 16; ++i) { if (MODE == 1) av[i] = av[i] - lam * bv[i]; ss += av[i] * av[i]; }
        ss += lane_xor(ss, F.lane, 1); ss += lane_xor(ss, F.lane, 2); ss += lane_xor(ss, F.lane, 4);
        const float rs = 1.0f / sqrtf(ss * (1.0f / 128.0f) + LN_EPS);
        float ov[16];
#pragma unroll
        for (int i = 0; i < 16; ++i) { float v = av[i] * rs * wv[i]; if (MODE == 0) v *= bv[i] * sigmoid_f(bv[i]); ov[i] = v; }
        v4u o0, o1;
#pragma unroll
        for (int i = 0; i < 4; ++i) { o0[i] = pkbf(ov[2 * i], ov[2 * i + 1]); o1[i] = pkbf(ov[8 + 2 * i], ov[8 + 2 * i + 1]); }
        *(v4u*)(out + off) = o0; *(v4u*)(out + off + 8) = o1;
    }
}

__device__ __forceinline__ void phase_l1(Frame& F, const KA a, int layer, const float* xin) {
    const int gw = F.vcu * NWAVES + F.wave, NGW = F.G * NWAVES;
    LAS float* Wr = (LAS float*)(F.lds + RING_OFF);
    LAS unsigned* hist = (LAS unsigned*)(F.lds + LDSCTL_OFF);
    { const f32x4* src = (const f32x4*)((const float*)(a.ws() + WS_RT) + (size_t)layer * 36 * 1024);
      for (int i = F.tid; i < 36 * 256; i += NWAVES * 64) *(LAS f32x4*)(Wr + 4 * i) = src[i];
      if (F.tid < 32) hist[F.tid] = 0u; }
    __syncthreads();
    const float* mod = (const float*)(a.ws() + WS_MOD) + (size_t)layer * 16 * 6144;
    const bf16* yb = (const bf16*)(a.ws() + WS_BUF0 + 1 * BUFSZ);
    bf16* h2 = (bf16*)(a.ws() + WS_BUF0);
    const float* lng = a.in(4) + (size_t)(layer * 2 + 0) * D; const float* lnb = a.in(5) + (size_t)(layer * 2 + 0) * D;
    const float* bg = a.in(15) + layer * 4; const float* be = a.in(17) + layer * 32;
    int* eid = (int*)(a.ws() + WS_EID); float* wt = (float*)(a.ws() + WS_WT);
    float* xout = a.out();
    for (int tok = gw; tok < M; tok += NGW) {
        const int b = tok >> 12; const float* mb = mod + (size_t)b * 6144;
        f32x4 hv[4];
        {
            const size_t ro = (size_t)tok * D;
            f32x4 v[4]; float s = 0.f;
#pragma unroll
            for (int j = 0; j < 4; ++j) { const int col = 4 * F.lane + 256 * j;
                const f32x4 xv = *(const f32x4*)(xin + ro + col); const u64 yw = *(const u64*)(yb + ro + col); const f32x4 g1 = *(const f32x4*)(mb + 2048 + col);
                f32x4 yv; yv[0] = bflo((unsigned)yw); yv[1] = bfhi((unsigned)yw); yv[2] = bflo((unsigned)(yw >> 32)); yv[3] = bfhi((unsigned)(yw >> 32));
                v[j] = xv * DN_ALPHA + g1 * yv; s += (v[j][0] + v[j][1]) + (v[j][2] + v[j][3]); }
            const float mean = wave_sum(s, F.lane) * (1.0f / D); float s2 = 0.f;
#pragma unroll
            for (int j = 0; j < 4; ++j) { v[j] = v[j] - mean; s2 += (v[j][0] * v[j][0] + v[j][1] * v[j][1]) + (v[j][2] * v[j][2] + v[j][3] * v[j][3]); }
            const float rstd = 1.0f / sqrtf(wave_sum(s2, F.lane) * (1.0f / D) + LN_EPS);
#pragma unroll
            for (int j = 0; j < 4; ++j) { const int col = 4 * F.lane + 256 * j;
                const f32x4 xo = v[j] * rstd * *(const f32x4*)(lng + col) + *(const f32x4*)(lnb + col);
                *(f32x4*)(xout + ro + col) = xo;
                const f32x4 hh2 = xo * (*(const f32x4*)(mb + 4096 + col) + 1.0f) + *(const f32x4*)(mb + 3072 + col);
                hv[j] = hh2;
                *(u64*)(h2 + ro + col) = (u64)pkbf(hh2[0], hh2[1]) | ((u64)pkbf(hh2[2], hh2[3]) << 32); }
        }
        float gl[4];
#pragma unroll
        for (int g = 0; g < 4; ++g) { float s0 = 0.f;
#pragma unroll
            for (int j = 0; j < 4; ++j) { const f32x4 w4 = *(const LAS f32x4*)(Wr + g * 1024 + 4 * F.lane + 256 * j);
                s0 += (hv[j][0] * w4[0] + hv[j][1] * w4[1]) + (hv[j][2] * w4[2] + hv[j][3] * w4[3]); }
            gl[g] = wave_sum(s0, F.lane) + bg[g]; }
        int gi = 0; float gm = gl[0];
#pragma unroll
        for (int g = 1; g < 4; ++g) if (gl[g] > gm) { gm = gl[g]; gi = g; }
        float gs = 0.f;
#pragma unroll
        for (int g = 0; g < 4; ++g) gs += fexp(gl[g] - gm);
        const float gw_ = 1.0f / gs;
        gi = __builtin_amdgcn_readfirstlane(gi);
        float el[8];
#pragma unroll
        for (int q = 0; q < 8; ++q) { float s0 = 0.f; const LAS float* wrow = Wr + (4 + gi * 8 + q) * 1024 + 4 * F.lane;
#pragma unroll
            for (int j = 0; j < 4; ++j) { const f32x4 w4 = *(const LAS f32x4*)(wrow + 256 * j);
                s0 += (hv[j][0] * w4[0] + hv[j][1] * w4[1]) + (hv[j][2] * w4[2] + hv[j][3] * w4[3]); }
            el[q] = wave_sum(s0, F.lane) + be[gi * 8 + q]; }
        int i0 = 0; float m0 = el[0];
#pragma unroll
        for (int q = 1; q < 8; ++q) if (el[q] > m0) { m0 = el[q]; i0 = q; }
        int i1 = -1; float m1 = -INFINITY;
#pragma unroll
        for (int q = 0; q < 8; ++q) if (q != i0 && el[q] > m1) { m1 = el[q]; i1 = q; }
        const float p1 = fexp(m1 - m0); const float w0 = gw_ / (1.0f + p1), w1 = gw_ * p1 / (1.0f + p1);
        if (F.lane == 0) { const int e0 = gi * 8 + i0, e1 = gi * 8 + i1;
            *(int2*)(eid + 2 * tok) = make_int2(e0, e1); *(float2*)(wt + 2 * tok) = make_float2(w0, w1);
            __hip_atomic_fetch_add(&hist[e0], 1u, __ATOMIC_RELAXED, __HIP_MEMORY_SCOPE_WORKGROUP); __hip_atomic_fetch_add(&hist[e1], 1u, __ATOMIC_RELAXED, __HIP_MEMORY_SCOPE_WORKGROUP); }
    }
    __syncthreads();
    if (F.tid < 32) { const unsigned c = hist[F.tid]; if (c) __hip_atomic_fetch_add(F.ctl + CW_CNT + 256 * layer + F.tid, c, RLX_AGENT); }
}

__device__ __forceinline__ void phase_m2(Frame& F, const KA a, int layer) {
    LAS int* pstart = (LAS int*)(F.lds + RING_OFF);
    LAS unsigned* lhist = (LAS unsigned*)(F.lds + RING_OFF + 256);
    LAS int* lbase = (LAS int*)(F.lds + RING_OFF + 512);
    LAS int* lslot = (LAS int*)(F.lds + RING_OFF + 1024);
    int* blk_e = (int*)(a.ws() + WS_BLKE) + layer * 1024;
    if (F.tid == 0) { int off = 0;
#pragma unroll 1
        for (int e = 0; e < 32; ++e) { const int c = (int)__hip_atomic_load(F.ctl + CW_CNT + 256 * layer + e, RLX_AGENT); pstart[e] = off; off += ((c + 255) >> 8) << 8; }
        pstart[32] = off;
        if (F.bx == 0) __hip_atomic_store(F.ctl + CW_CNT + 256 * layer + 128, (unsigned)(off >> 8), RLX_AGENT); }
    __syncthreads();
    if (F.bx == 0) { const int nblk = pstart[32] >> 8;
        for (int blk = F.tid; blk < nblk; blk += NWAVES * 64) { int e = 0;
#pragma unroll 1
            for (int k = 1; k < 32; ++k) e = (pstart[k] <= blk * 256) ? k : e;
            blk_e[blk] = e; } }
    const int* eid = (const int*)(a.ws() + WS_EID); const float* wt = (const float*)(a.ws() + WS_WT);
    int* tslot = (int*)(a.ws() + WS_TSLOT); float* slotw = (float*)(a.ws() + WS_SLOTW);
    const bf16* h2 = (const bf16*)(a.ws() + WS_BUF0); bf16* xbuf = (bf16*)(a.ws() + WS_BUF0 + 2 * BUFSZ);
    for (int chunk = F.vcu; chunk < M / 256; chunk += F.G) {
        if (F.tid < 32) lhist[F.tid] = 0u;
        __syncthreads();
        const int pi = chunk * 512 + F.tid;
        const int e = eid[pi];
        const unsigned rank = __hip_atomic_fetch_add(&lhist[e], 1u, __ATOMIC_RELAXED, __HIP_MEMORY_SCOPE_WORKGROUP);
        __syncthreads();
        if (F.tid < 32) { const unsigned c = lhist[F.tid]; lbase[F.tid] = pstart[F.tid] + (c ? (int)__hip_atomic_fetch_add(F.ctl + CW_CNT + 256 * layer + 64 + F.tid, c, RLX_AGENT) : 0); }
        __syncthreads();
        const int slot = lbase[e] + (int)rank;
        tslot[pi] = slot; slotw[slot] = wt[pi]; lslot[F.tid] = slot;
        __syncthreads();
        for (int q = 0; q < 64; ++q) { const int lp = F.wave * 64 + q; const int tok = chunk * 256 + (lp >> 1); const int sl = lslot[lp];
            const v4u* src = (const v4u*)(h2 + (size_t)tok * D); v4u* dst = (v4u*)(xbuf + (size_t)sl * D);
            dst[F.lane] = src[F.lane]; dst[64 + F.lane] = src[64 + F.lane]; }
        __syncthreads();
    }
}

__device__ __forceinline__ void phase_l2(Frame& F, const KA a, int layer) {
    const int gw = F.vcu * NWAVES + F.wave, NGW = F.G * NWAVES;
    const float* mod = (const float*)(a.ws() + WS_MOD) + (size_t)layer * 16 * 6144;
    const bf16* ys = (const bf16*)(a.ws() + WS_BUF0 + 2 * BUFSZ); const int* tslot = (const int*)(a.ws() + WS_TSLOT);
    bf16* hn = (bf16*)(a.ws() + WS_BUF0);
    const float* lng = a.in(4) + (size_t)(layer * 2 + 1) * D; const float* lnb = a.in(5) + (size_t)(layer * 2 + 1) * D;
    float* x = a.out();
    for (int tok = gw; tok < M; tok += NGW) {
        const int b = tok >> 12; const float* mb = mod + (size_t)b * 6144; const float* mn = mb + 16 * 6144;
        const int2 sl = *(const int2*)(tslot + 2 * tok);
        const size_t ro = (size_t)tok * D;
        f32x4 v[4]; float s = 0.f;
#pragma unroll
        for (int j = 0; j < 4; ++j) { const int col = 4 * F.lane + 256 * j;
            const f32x4 xv = *(const f32x4*)(x + ro + col); const u64 y0 = *(const u64*)(ys + (size_t)sl.x * D + col), y1 = *(const u64*)(ys + (size_t)sl.y * D + col);
            const f32x4 g2 = *(const f32x4*)(mb + 5120 + col);
            f32x4 yv; yv[0] = bflo((unsigned)y0) + bflo((unsigned)y1); yv[1] = bfhi((unsigned)y0) + bfhi((unsigned)y1);
            yv[2] = bflo((unsigned)(y0 >> 32)) + bflo((unsigned)(y1 >> 32)); yv[3] = bfhi((unsigned)(y0 >> 32)) + bfhi((unsigned)(y1 >> 32));
            v[j] = xv * DN_ALPHA + g2 * yv; s += (v[j][0] + v[j][1]) + (v[j][2] + v[j][3]); }
        const float mean = wave_sum(s, F.lane) * (1.0f / D); float s2 = 0.f;
#pragma unroll
        for (int j = 0; j < 4; ++j) { v[j] = v[j] - mean; s2 += (v[j][0] * v[j][0] + v[j][1] * v[j][1]) + (v[j][2] * v[j][2] + v[j][3] * v[j][3]); }
        const float rstd = 1.0f / sqrtf(wave_sum(s2, F.lane) * (1.0f / D) + LN_EPS);
#pragma unroll
        for (int j = 0; j < 4; ++j) { const int col = 4 * F.lane + 256 * j;
            const f32x4 xo = v[j] * rstd * *(const f32x4*)(lng + col) + *(const f32x4*)(lnb + col);
            *(f32x4*)(x + ro + col) = xo;
            if (layer < DEPTH - 1) { const f32x4 hv = xo * (*(const f32x4*)(mn + 1024 + col) + 1.0f) + *(const f32x4*)(mn + col);
                *(u64*)(hn + ro + col) = (u64)pkbf(hv[0], hv[1]) | ((u64)pkbf(hv[2], hv[3]) << 32); } }
    }
    if (layer < DEPTH - 1) { __syncthreads(); convert_moe(F, a, layer + 1); }
}

#ifndef MK_SEPARATE
#define MK_SEPARATE 1
#endif
constexpr int N_PHASES = 2 + 10 * DEPTH;
#ifndef PH_MASK
#define PH_MASK 0xFFFFF
#endif
#define PH_ON(n) (((PH_MASK) >> (n)) & 1)
__global__ void __launch_bounds__(NWAVES * 64, 2) fwd_kernel(Args args) {
    extern __shared__ __attribute__((aligned(16))) unsigned char lds[];
    const int wave_s = __builtin_amdgcn_readfirstlane((int)threadIdx.x >> 6);
    gu32* const ctl0 = (gu32*)(karg_fresh().ws() + WS_CTL);
    for (int u = threadIdx.x; u < (LDS_BYTES - LDSCTL_OFF) / 4; u += NWAVES * 64) ((LAS unsigned*)((LAS unsigned char*)lds + LDSCTL_OFF))[u] = 0u;
    __syncthreads();
    XcdBarrier bar; bar.bar = (unsigned*)(ctl0 + CW_BAR); bar.x = 0; bar.st = nullptr;
    if (!MK_SEPARATE) bar = xcd_barrier_post((unsigned*)(ctl0 + CW_BAR), (volatile LAS unsigned*)((LAS unsigned char*)lds + MISC_OFF) + 8);
    const int lo = karg_fresh().ph_lo(), hi = karg_fresh().ph_hi();
#define IN(k) (lo <= (k) && (k) < hi)
#define FRESH() const KA ka = karg_fresh(); unsigned char* const ws = ka.ws(); (void)ws; Frame F; { int t_, g_ = gridDim.x, bx_ = blockIdx.x; asm volatile("v_mbcnt_lo_u32_b32 %0, -1, 0\n\tv_mbcnt_hi_u32_b32 %0, -1, %0" : "=v"(t_)); asm volatile("" : "+s"(g_), "+s"(bx_)); t_ |= wave_s << 6; \
        F.lds = (LAS unsigned char*)lds; F.MISC = (volatile LAS unsigned*)(F.lds + MISC_OFF); F.ctl = (gu32*)(ws + WS_CTL); F.tid = t_; F.lane = t_ & 63; F.wave = __builtin_amdgcn_readfirstlane(t_ >> 6); \
        F.G = g_; F.bx = bx_; F.vcu = (g_ % 8 == 0) ? (bx_ % 8) * (g_ / 8) + bx_ / 8 : bx_; }
#define SEAM(k) do { if (IN(k) && IN((k) + 1)) { if (MK_SEPARATE) { } else xcd_barrier(bar, wave_s); } } while (0)
#define BUF(i) ((bf16*)(ws + WS_BUF0 + (size_t)(i) * BUFSZ))

    if (PH_ON(0) && IN(0)) { FRESH(); phase_p0a(F, ka); }
    SEAM(0);
    if (PH_ON(1) && IN(1)) { FRESH(); phase_p0b(F, ka); }
    SEAM(1);
    for (int i = 0; i < DEPTH; ++i) {
        const int pb = 2 + 10 * i, j = i >> 1;
        if ((i & 1) == 0) {
            if (PH_ON(2) && IN(pb)) { FRESH();
                pg8::Gemm g{BUF(0), (const bf16*)(ws + WS_WHIN) + (size_t)j * 4096 * 1024, M, 4096, D, 0}; pg8::StaticOrder S; S.init(M, 4096, F.G, F.bx);
                pg8::EpiBf16<0> E{BUF(1), D, nullptr, D, BUFSZ / 2, 1.0f};
                pg8::gemm_phase<pg8::EpiBf16<0>, pg8::StaticOrder, true, true>(F.lds + RING_OFF, g, S, E, F.tid);
            }
            SEAM(pb);
            if (PH_ON(3) && IN(pb + 1)) { FRESH(); phase_hgrn_prep(F, ka, j); }
            SEAM(pb + 1);
            if (PH_ON(4) && IN(pb + 2)) { FRESH(); phase_hgrn_scan(F, ka); }
            SEAM(pb + 2);
            if (PH_ON(5) && IN(pb + 3)) { FRESH(); phase_normgate<0>(F, BUF(6), BUF(4), BUF(4), ka.in(9) + j * 128, 0.f, 1.0f); }
            SEAM(pb + 3);
        } else {
            if (PH_ON(6) && IN(pb)) { FRESH();
                pg8::Gemm g{BUF(0), (const bf16*)(ws + WS_WAIN) + (size_t)j * 3072 * 1024, M, 3072, D, 0}; pg8::StaticOrder S; S.init(M, 3072, F.G, F.bx);
                pg8::EpiRope E{BUF(1), BUF(2), BUF(3), (const float*)(ws + WS_ROPE_C), (const float*)(ws + WS_ROPE_S), attn_body::C2, SEQ - 1};
                pg8::gemm_phase<pg8::EpiRope, pg8::StaticOrder, true, true>(F.lds + RING_OFF, g, S, E, F.tid);
            }
            SEAM(pb);
            if (PH_ON(7) && IN(pb + 1)) { FRESH();
                const attn_body::AttnTensors AT{(const attn_body::bf16*)BUF(1), (const attn_body::bf16*)BUF(2), (const attn_body::bf16*)BUF(3), (attn_body::bf16*)BUF(4), (attn_body::bf16*)BUF(5)};
                const attn_body::StaticOrder S((int)F.G, F.vcu);
                attn_body::attn_phase<attn_body::StaticOrder>((char*)lds + RING_OFF, AT, S, F.tid);
            }
            SEAM(pb + 1);
            if (PH_ON(8) && IN(pb + 2)) { FRESH();
                const float* lp = ka.in(12) + j * 256;
                const float d1 = wave_sum(lp[F.lane] * lp[64 + F.lane], F.lane), d2 = wave_sum(lp[128 + F.lane] * lp[192 + F.lane], F.lane);
                const float linit = (j == 0) ? 0.35550906759f : 0.55605820415f;
                const float lam = fexp(d1) - fexp(d2) + linit;
                phase_normgate<1>(F, BUF(4), BUF(5), BUF(6), ka.in(13) + j * 128, lam, 1.0f - linit);
            }
            if (IN(pb + 2) && IN(pb + 4)) { if (!MK_SEPARATE) xcd_barrier(bar, wave_s); }
        }
        if (PH_ON(9) && IN(pb + 4)) { FRESH();
            const bf16* A = (i & 1) ? BUF(6) : BUF(4);
            const bf16* W = (i & 1) ? (const bf16*)(ws + WS_WAOUT) + (size_t)j * 1024 * 1024 : (const bf16*)(ws + WS_WHOUT) + (size_t)j * 1024 * 1024;
            pg8::Gemm g{A, W, M, D, D, 0}; pg8::StaticOrder S; S.init(M, D, F.G, F.bx);
            pg8::EpiBf16<0> E{BUF(1), D, nullptr, 0, 0, 1.0f};
            pg8::gemm_phase<pg8::EpiBf16<0>, pg8::StaticOrder, true, true>(F.lds + RING_OFF, g, S, E, F.tid);
        }
        SEAM(pb + 4);
        if (PH_ON(10) && IN(pb + 5)) { FRESH(); phase_l1(F, ka, i, i == 0 ? ka.in(0) : (const float*)ka.out()); }
        SEAM(pb + 5);
        if (PH_ON(11) && IN(pb + 6)) { FRESH(); phase_m2(F, ka, i); }
        SEAM(pb + 6);
        if (PH_ON(12) && IN(pb + 7)) { FRESH();
            const int nblk = (int)__hip_atomic_load(F.ctl + CW_CNT + 256 * i + 128, RLX_AGENT);
            pg8::Gemm g{BUF(2), (const bf16*)(ws + WS_W13), nblk * 256, 1024, D, (size_t)1024 * 1024 * 2};
            pg8::MoeOrder S; S.init(nblk * 256, 1024, F.G, F.bx); S.blk_e = (const int*)(ws + WS_BLKE) + i * 1024;
            pg8::EpiSwiGLU E{BUF(5)};
            pg8::gemm_phase<pg8::EpiSwiGLU, pg8::MoeOrder, true, true>(F.lds + RING_OFF, g, S, E, F.tid);
        }
        SEAM(pb + 7);
        if (PH_ON(13) && IN(pb + 8)) { FRESH();
            const int nblk = (int)__hip_atomic_load(F.ctl + CW_CNT + 256 * i + 128, RLX_AGENT);
            pg8::Gemm g{BUF(5), (const bf16*)(ws + WS_W2), nblk * 256, 1024, FF, (size_t)1024 * 512 * 2};
            pg8::MoeOrder S; S.init(nblk * 256, 1024, F.G, F.bx); S.blk_e = (const int*)(ws + WS_BLKE) + i * 1024;
            pg8::EpiRowScale E{BUF(2), (const float*)(ws + WS_SLOTW)};
            pg8::gemm_phase<pg8::EpiRowScale, pg8::MoeOrder, true, true>(F.lds + RING_OFF, g, S, E, F.tid);
        }
        SEAM(pb + 8);
        if (PH_ON(14) && IN(pb + 9)) { FRESH(); phase_l2(F, ka, i); }
        SEAM(pb + 9);
    }
#undef IN
#undef SEAM
}

extern "C" void kernel_launch(void* const* d_in, const int* in_sizes, int n_in, void* d_out, int out_size, void* d_ws, size_t ws_size, hipStream_t stream) {
    static int grid = 0;
    if (grid == 0) {
        if (n_in != 21 || in_sizes[0] != M * D || out_size != M * D || ws_size < WS_END) { fprintf(stderr, "kernel_launch: unexpected shapes / workspace (n_in %d, ws %zu, need %zu)\n", n_in, ws_size, (size_t)WS_END); grid = -1; return; }
        int dev = 0, cus = 0, per_cu = 0;
        if (hipGetDevice(&dev) != hipSuccess || hipDeviceGetAttribute(&cus, hipDeviceAttributeMultiprocessorCount, dev) != hipSuccess) { grid = -1; return; }
        if (hipFuncSetAttribute((const void*)fwd_kernel, hipFuncAttributeMaxDynamicSharedMemorySize, LDS_BYTES) != hipSuccess) { fprintf(stderr, "kernel_launch: hipFuncSetAttribute failed\n"); grid = -1; return; }
        if (hipOccupancyMaxActiveBlocksPerMultiprocessor(&per_cu, (const void*)fwd_kernel, NWAVES * 64, LDS_BYTES) != hipSuccess || per_cu < 1) fprintf(stderr, "kernel_launch: occupancy query says %d\n", per_cu);
        (void)hipGetLastError();
        grid = cus;
    }
    if (grid < 0) return;
    if (hipMemsetAsync((char*)d_ws + WS_CTL, 0, CTL_ZERO_BYTES, stream) != hipSuccess) return;
    Args a{};
    for (int i = 0; i < 21; ++i) a.in[i] = (const float*)d_in[i];
    a.out = (float*)d_out; a.ws = (unsigned char*)d_ws;
#if MK_SEPARATE
    for (int p = 0; p < N_PHASES; ++p) {
        if (p >= 2 && (((p - 2) / 10) & 1) == 1 && ((p - 2) % 10) == 3) continue;
        a.ph_lo = p; a.ph_hi = p + 1;
        hipLaunchKernelGGL(fwd_kernel, dim3(grid), dim3(NWAVES * 64), LDS_BYTES, stream, a);
    }
#else
    a.ph_lo = 0; a.ph_hi = N_PHASES;
    hipLaunchKernelGGL(fwd_kernel, dim3(grid), dim3(NWAVES * 64), LDS_BYTES, stream, a);
#endif
}
```

```cpp
#include <hip/hip_runtime.h>
#include <cstdio>
#include <cstdint>
namespace pg8 {
#define PG8_LAS __attribute__((address_space(3)))
typedef unsigned short bf16_t;
typedef short bf16x8 __attribute__((ext_vector_type(8)));
typedef float f32x4 __attribute__((ext_vector_type(4)));
typedef unsigned u32x4 __attribute__((ext_vector_type(4)));
constexpr int BM = 256, BK = 64, HALF = 128, HTB = HALF * BK * 2  , STAGE_BYTES = 8 * HTB, NXCD = 8, WGM = 8;

__host__ __device__ __forceinline__ int lds_byte(int r, int c) { const int st = (r >> 4) * 2 + (c >> 5), rr = r & 15, cc = c & 31, ob = rr * 64 + cc * 2; return st * 1024 + (ob ^ (((ob >> 9) & 1) << 5)); }
__host__ __device__ __forceinline__ void stage_rc(int b, int& R, int& C) { const int st = b / 1024, sb = b % 1024, swz = sb ^ (((sb >> 9) & 1) << 5); R = (st >> 1) * 16 + swz / 64; C = (st & 1) * 32 + (swz % 64) / 2; }
__host__ __device__ __forceinline__ int perm32(int rho) { const int n = rho >> 4, i = rho & 15; return 8 * (i >> 2) + 4 * n + (i & 3); }

struct Unit { int pm, pn, e; };
struct Gemm { const bf16_t* A; const bf16_t* Bt; int M, N, K; size_t estride; const int* arow; };

struct StaticOrder {
    int nM, nN, nwg, G, c;
    __host__ __device__ void init(int M, int N, int G_, int c_) { nM = M / BM; nN = N / BM; nwg = nM * nN; G = G_; c = c_; }
    __host__ __device__ bool next(int i, Unit& u) const {
        const long L = (long)i * G + c; if (L >= nwg) return false;
        int wgid = (int)L; { const int q = nwg / NXCD, r = nwg % NXCD, xcd = wgid % NXCD, off = wgid / NXCD; wgid = (xcd < r ? xcd * (q + 1) : r * (q + 1) + (xcd - r) * q) + off; }
        const int nig = WGM * nN, gid = wgid / nig, fm = gid * WGM, gsz = (nM - fm) < WGM ? (nM - fm) : WGM;
        u.pm = fm + ((wgid % nig) % gsz); u.pn = (wgid % nig) / gsz; u.e = 0; return true;
    }
    __device__ __forceinline__ void a_ready(const Unit&) const {}
    __device__ __forceinline__ void done(const Unit&) const {}
};

__device__ __forceinline__ unsigned cvt_pk_bf16(float lo, float hi) { unsigned r; asm volatile("v_cvt_pk_bf16_f32 %0, %1, %2" : "=v"(r) : "v"(lo), "v"(hi)); return r; }
typedef float f32x2 __attribute__((ext_vector_type(2)));
__device__ __forceinline__ f32x2 gelu_pk(f32x2 v) {
    const f32x2 av = __builtin_elementwise_abs(v), d = av * 0.2316418882f + 1.0f;
    f32x2 t; t.x = __builtin_amdgcn_rcpf(d.x); t.y = __builtin_amdgcn_rcpf(d.y);
    f32x2 q = t * 0.5307027145f + (-0.7265760135f); q = q * t + 0.7107068705f; q = q * t + (-0.142248368f); q = q * t + 0.127414796f; q = q * t;
    const f32x2 s = (v * v) * (-0.72134752044f);
    f32x2 e; e.x = __builtin_amdgcn_exp2f(s.x); e.y = __builtin_amdgcn_exp2f(s.y);
    const f32x2 m = v * (q * e), r = v - m;
    f32x2 o; o.x = v.x < 0.f ? m.x : r.x; o.y = v.y < 0.f ? m.y : r.y; return o;
}

template <int ACT  > struct EpiBf16 {
    static constexpr bool PERM = true, AFTER_DRAIN = false; static_assert(ACT == 0 || ACT == 1, "EpiBf16: ACT is 0 (none) or 1 (gelu_pk)");
    bf16_t* O; int ldc; const float* bias; int split_cols; size_t split_stride; float scale0;
    __device__ __forceinline__ void operator()(const f32x4 (&acc)[2][2][4][2], const Unit& u, int wr, int wc, int fr, int fq) const {
        const int row0 = u.pm * BM + wr * 64 + fr; int colt = u.pn * BM; bf16_t* base = O;
        float sc = 1.f; if (split_cols) { const int t = colt / split_cols; base += (size_t)t * split_stride; colt -= t * split_cols; if (t == 0) sc = scale0; }
        const int col0 = colt + wc * 32 + 8 * fq, bcol0 = u.pn * BM + wc * 32 + 8 * fq;
        f32x4 bv[2][2];
#pragma unroll
        for (int bj = 0; bj < 2; ++bj)
#pragma unroll
            for (int n = 0; n < 2; ++n) bv[bj][n] = bias ? *(const f32x4*)(bias + bcol0 + bj * HALF + 4 * n) : (f32x4){0.f, 0.f, 0.f, 0.f};
#pragma unroll
        for (int ai = 0; ai < 2; ++ai)
#pragma unroll
            for (int m = 0; m < 4; ++m) { bf16_t* rowp = base + (size_t)(row0 + ai * HALF + m * 16) * ldc + col0;
#pragma unroll
                for (int bj = 0; bj < 2; ++bj) { f32x4 v0 = acc[ai][bj][m][0] + bv[bj][0], v1 = acc[ai][bj][m][1] + bv[bj][1];
                    if (ACT == 1) { f32x2 a = gelu_pk((f32x2){v0[0], v0[1]}), b = gelu_pk((f32x2){v0[2], v0[3]}), c = gelu_pk((f32x2){v1[0], v1[1]}), d = gelu_pk((f32x2){v1[2], v1[3]});
                        v0 = (f32x4){a.x, a.y, b.x, b.y}; v1 = (f32x4){c.x, c.y, d.x, d.y}; }
                    v0 = v0 * sc; v1 = v1 * sc; u32x4 w; w.x = cvt_pk_bf16(v0[0], v0[1]); w.y = cvt_pk_bf16(v0[2], v0[3]); w.z = cvt_pk_bf16(v1[0], v1[1]); w.w = cvt_pk_bf16(v1[2], v1[3]);
                    *(u32x4*)(rowp + bj * HALF) = w; } }
    }
};

template <class Epi, class Sched, bool ALIGN_EPI = false, bool SP2 = false, bool GATHER = false>
__device__ __forceinline__ void gemm_phase(PG8_LAS unsigned char* lds, const Gemm g, const Sched& S, const Epi& E, const int tid) {
        const int wid = __builtin_amdgcn_readfirstlane(tid >> 6), lane = tid & 63, wr = wid >> 2, wc = wid & 3, fr = lane & 15, fq = lane >> 4;
    const int K = g.K, nt = K / BK;
    unsigned voffA[2], voffB[2], gcolb[2];
#pragma unroll
    for (int i = 0; i < 2; ++i) { int R, C; stage_rc(tid * 16 + i * 8192, R, C); const int Rb = Epi::PERM ? ((R & ~31) + perm32(R & 31)) : R;
        voffA[i] = GATHER ? (unsigned)R * 4u   : (unsigned)(R * K + C) * 2u; voffB[i] = (unsigned)(Rb * K + C) * 2u; gcolb[i] = (unsigned)C * 2u; }
    unsigned gA[2][2] = {{0u, 0u}, {0u, 0u}}, gN[2][2] = {{0u, 0u}, {0u, 0u}};
#define PG8_ROWS(dst, u_) do { const char* rb_ = (const char*)(g.arow + (size_t)(u_).pm * BM); unsigned raw_[2][2];        \
        _Pragma("unroll") for (int _h = 0; _h < 2; ++_h) _Pragma("unroll") for (int _i = 0; _i < 2; ++_i) raw_[_h][_i] = (unsigned)*(const int*)(rb_ + voffA[_i] + _h * HALF * 4); \
        _Pragma("unroll") for (int _h = 0; _h < 2; ++_h) _Pragma("unroll") for (int _i = 0; _i < 2; ++_i) dst[_h][_i] = raw_[_h][_i] * (unsigned)(K * 2) + gcolb[_i]; } while (0)
    const size_t kstep = (size_t)(BK * 2);
    const size_t hstep = (size_t)HALF * K * 2;
    const size_t tstep = 2 * hstep;
    const unsigned ldsw = (unsigned)wid * 1024u;
    const int aoff = lds_byte(wr * 64 + fr, fq * 8), boff = lds_byte(wc * 32 + fr, fq * 8);
#define PG8_SA(b, h) (((b) * 2 + (h)) * HTB)
#define PG8_SB(b, h) ((4 + (b) * 2 + (h)) * HTB)
#define PG8_STAGE(bufoff, gbase, voff) do { _Pragma("unroll") for (int _i = 0; _i < 2; ++_i) \
        __builtin_amdgcn_global_load_lds((const unsigned*)((const char*)(gbase) + (voff)[_i]), (PG8_LAS unsigned*)(lds + (bufoff) + ldsw + _i * 8192), 16, 0, 0); } while (0)
#define PG8_STAGEA(bufoff, gbase, h_, nx_) do { if constexpr (GATHER) { _Pragma("unroll") for (int _i = 0; _i < 2; ++_i) \
        __builtin_amdgcn_global_load_lds((const unsigned*)((const char*)(gbase) + ((nx_) ? gN[h_][_i] : gA[h_][_i])), (PG8_LAS unsigned*)(lds + (bufoff) + ldsw + _i * 8192), 16, 0, 0); } \
        else { PG8_STAGE(bufoff, (gbase) + ((h_) ? hstep : (size_t)0), voffA); } } while (0)
#define PG8_LDA(dst, b, h) do { _Pragma("unroll") for (int m = 0; m < 4; ++m) _Pragma("unroll") for (int k = 0; k < 2; ++k) dst[m][k] = *(const PG8_LAS bf16x8*)(lds + PG8_SA(b, h) + aoff + m * 2048 + k * 1024); } while (0)
#define PG8_LDB(dst, b, h) do { _Pragma("unroll") for (int n = 0; n < 2; ++n) _Pragma("unroll") for (int k = 0; k < 2; ++k) dst[n][k] = *(const PG8_LAS bf16x8*)(lds + PG8_SB(b, h) + boff + n * 2048 + k * 1024); } while (0)
#define PG8_MMA(ai, bj, At, Bt) do { __builtin_amdgcn_s_setprio(1); _Pragma("unroll") for (int m = 0; m < 4; ++m) _Pragma("unroll") for (int n = 0; n < 2; ++n) _Pragma("unroll") for (int k = 0; k < 2; ++k) \
        acc[ai][bj][m][n] = __builtin_amdgcn_mfma_f32_16x16x32_bf16(Bt[n][k], At[m][k], acc[ai][bj][m][n], 0, 0, 0); __builtin_amdgcn_s_setprio(0); } while (0)
#define PG8_WAIT_V(n) asm volatile("s_waitcnt vmcnt(" #n ")" ::: "memory")
#define PG8_WAIT_L(n) asm volatile("s_waitcnt lgkmcnt(" #n ")" ::: "memory")
#define PG8_BAR __builtin_amdgcn_s_barrier()
#define PG8_SCHED __builtin_amdgcn_sched_barrier(0)
    Unit cur, nxt; int ui = 0;
    if (!S.next(0, cur)) return;
    f32x4 acc[2][2][4][2];
#pragma unroll
    for (int a = 0; a < 2; ++a)
#pragma unroll
        for (int b = 0; b < 2; ++b)
#pragma unroll
            for (int m = 0; m < 4; ++m)
#pragma unroll
                for (int n = 0; n < 2; ++n) acc[a][b][m][n] = (f32x4){0.f, 0.f, 0.f, 0.f};
    bf16x8 At[4][2], B0[2][2], B1[2][2];
    const char* cA = (const char*)g.A + (GATHER ? (size_t)0 : (size_t)cur.pm * tstep); const char* cB = (const char*)g.Bt + (size_t)cur.e * g.estride + (size_t)cur.pn * tstep;
    S.a_ready(cur);
    if constexpr (GATHER) PG8_ROWS(gA, cur);
    if constexpr (SP2) {
        PG8_STAGE(PG8_SB(0, 0), cB, voffB); PG8_STAGE(PG8_SB(0, 1), cB + hstep, voffB); PG8_STAGEA(PG8_SA(0, 0), cA, 0, false); PG8_STAGEA(PG8_SA(0, 1), cA, 1, false);
        if (wr == 1) PG8_BAR;
        PG8_WAIT_V(2); PG8_BAR;
        PG8_STAGE(PG8_SB(1, 0), cB + kstep, voffB); PG8_STAGEA(PG8_SA(1, 0), cA + kstep, 0, false); PG8_STAGE(PG8_SB(1, 1), cB + hstep + kstep, voffB);
        PG8_WAIT_V(6); PG8_BAR;
    } else {
        PG8_STAGE(PG8_SB(0, 0), cB, voffB); PG8_STAGEA(PG8_SA(0, 0), cA, 0, false); PG8_STAGE(PG8_SB(0, 1), cB + hstep, voffB); PG8_STAGEA(PG8_SA(0, 1), cA, 1, false);
        if (wr == 1) PG8_BAR;
        PG8_WAIT_V(4); PG8_BAR;
        PG8_STAGE(PG8_SB(1, 0), cB + kstep, voffB); PG8_STAGEA(PG8_SA(1, 0), cA + kstep, 0, false); PG8_STAGE(PG8_SB(1, 1), cB + hstep + kstep, voffB);
        PG8_WAIT_V(6); PG8_BAR;
    }
    for (;;) {
        const bool has_next = S.next(ui + 1, nxt);
        const char* nA = has_next ? (const char*)g.A + (GATHER ? (size_t)0 : (size_t)nxt.pm * tstep) : cA;
        if constexpr (GATHER) { if (has_next) PG8_ROWS(gN, nxt); else { _Pragma("unroll") for (int _h = 0; _h < 2; ++_h) _Pragma("unroll") for (int _i = 0; _i < 2; ++_i) gN[_h][_i] = gA[_h][_i]; } } const char* nB = has_next ? (const char*)g.Bt + (size_t)nxt.e * g.estride + (size_t)nxt.pn * tstep : cB;
        for (int t = 0; t < nt; t += 2) {
            const bool last = (t == nt - 2);
            const char* a1 = cA + (size_t)(t + 1) * kstep;
            const char* a2 = last ? nA : cA + (size_t)(t + 2) * kstep; const char* b2 = last ? nB : cB + (size_t)(t + 2) * kstep;
            const char* a3 = a2 + kstep; const char* b3 = b2 + kstep;
            if (last && has_next) S.a_ready(nxt);
            if constexpr (SP2) {
            PG8_LDB(B0, 0, 0); PG8_LDB(B1, 0, 1); PG8_SCHED; PG8_LDA(At, 0, 0); PG8_STAGEA(PG8_SA(1, 1), a1, 1, false);
            PG8_WAIT_V(8); PG8_WAIT_L(0); PG8_BAR; PG8_MMA(0, 0, At, B0); PG8_MMA(0, 1, At, B1); PG8_BAR; PG8_SCHED;
            PG8_LDA(At, 0, 1); PG8_STAGE(PG8_SB(0, 0), b2, voffB); PG8_STAGE(PG8_SB(0, 1), b2 + hstep, voffB); PG8_STAGEA(PG8_SA(0, 0), a2, 0, last);
            PG8_WAIT_V(8); PG8_WAIT_L(0); PG8_BAR; PG8_MMA(1, 0, At, B0); PG8_MMA(1, 1, At, B1); PG8_BAR; PG8_SCHED;
            PG8_LDB(B0, 1, 0); PG8_LDB(B1, 1, 1); PG8_SCHED; PG8_LDA(At, 1, 0); PG8_STAGEA(PG8_SA(0, 1), a2, 1, last);
            PG8_WAIT_V(8); PG8_WAIT_L(0); PG8_BAR; PG8_MMA(0, 0, At, B0); PG8_MMA(0, 1, At, B1); PG8_BAR; PG8_SCHED;
            PG8_LDA(At, 1, 1); PG8_STAGE(PG8_SB(1, 0), b3, voffB); PG8_STAGE(PG8_SB(1, 1), b3 + hstep, voffB); PG8_STAGEA(PG8_SA(1, 0), a3, 0, last);
            PG8_WAIT_V(8); PG8_WAIT_L(0); PG8_BAR; PG8_MMA(1, 0, At, B0); PG8_MMA(1, 1, At, B1); PG8_BAR; PG8_SCHED;
            } else {
            PG8_LDB(B0, 0, 0); PG8_SCHED; PG8_LDA(At, 0, 0); PG8_STAGEA(PG8_SA(1, 1), a1, 1, false);
            PG8_WAIT_L(8); PG8_BAR; PG8_WAIT_L(0); PG8_MMA(0, 0, At, B0); PG8_BAR; PG8_SCHED;
            PG8_LDB(B1, 0, 1); PG8_STAGE(PG8_SB(0, 0), b2, voffB);
            PG8_BAR; PG8_WAIT_L(0); PG8_MMA(0, 1, At, B1); PG8_BAR;
            PG8_LDA(At, 0, 1); PG8_STAGEA(PG8_SA(0, 0), a2, 0, last);
            PG8_BAR; PG8_WAIT_L(0); PG8_MMA(1, 0, At, B0); PG8_BAR; PG8_SCHED;
            PG8_STAGE(PG8_SB(0, 1), b2 + hstep, voffB);
            PG8_WAIT_V(6); PG8_BAR; PG8_MMA(1, 1, At, B1); PG8_BAR;
            PG8_LDB(B0, 1, 0); PG8_SCHED; PG8_LDA(At, 1, 0); PG8_STAGEA(PG8_SA(0, 1), a2, 1, last);
            PG8_WAIT_L(8); PG8_BAR; PG8_WAIT_L(0); PG8_MMA(0, 0, At, B0); PG8_BAR; PG8_SCHED;
            PG8_LDB(B1, 1, 1); PG8_STAGE(PG8_SB(1, 0), b3, voffB);
            PG8_BAR; PG8_WAIT_L(0); PG8_MMA(0, 1, At, B1); PG8_BAR;
            PG8_LDA(At, 1, 1); PG8_STAGEA(PG8_SA(1, 0), a3, 0, last);
            PG8_BAR; PG8_WAIT_L(0); PG8_MMA(1, 0, At, B0); PG8_BAR; PG8_SCHED;
            PG8_STAGE(PG8_SB(1, 1), b3 + hstep, voffB);
            PG8_WAIT_V(6); PG8_BAR; PG8_MMA(1, 1, At, B1); PG8_BAR;
            }
        }
        if constexpr (ALIGN_EPI) { if (wr == 0) PG8_BAR; }
        if constexpr (!Epi::AFTER_DRAIN) { E(acc, cur, wr, wc, fr, fq); S.done(cur); }
        if (!has_next) break;
#pragma unroll
        for (int a = 0; a < 2; ++a)
#pragma unroll
            for (int b = 0; b < 2; ++b)
#pragma unroll
                for (int m = 0; m < 4; ++m)
#pragma unroll
                    for (int n = 0; n < 2; ++n) acc[a][b][m][n] = (f32x4){0.f, 0.f, 0.f, 0.f};
        cur = nxt; cA = nA; cB = nB; ++ui;
        if constexpr (GATHER) { _Pragma("unroll") for (int _h = 0; _h < 2; ++_h) _Pragma("unroll") for (int _i = 0; _i < 2; ++_i) gA[_h][_i] = gN[_h][_i]; }
        if constexpr (ALIGN_EPI) { if (wr == 1) PG8_BAR; }
    }
    PG8_WAIT_V(0);
    if constexpr (!ALIGN_EPI) { if (wr == 0) PG8_BAR; }
    PG8_BAR;
    if constexpr (Epi::AFTER_DRAIN) { E.fused(acc, cur, wr, wc, fr, fq, lds, wid, lane); S.done(cur); }
#undef PG8_SA
#undef PG8_SB
#undef PG8_STAGE
#undef PG8_STAGEA
#undef PG8_ROWS
#undef PG8_LDA
#undef PG8_LDB
#undef PG8_MMA
#undef PG8_WAIT_V
#undef PG8_WAIT_L
#undef PG8_BAR
#undef PG8_SCHED
}
}

namespace pg8 {
__device__ __forceinline__ u32x4 pack8(const f32x4 a, const f32x4 b) { u32x4 w; w.x = cvt_pk_bf16(a[0], a[1]); w.y = cvt_pk_bf16(a[2], a[3]); w.z = cvt_pk_bf16(b[0], b[1]); w.w = cvt_pk_bf16(b[2], b[3]); return w; }
__device__ __forceinline__ float silu_f(float x) { return x * __builtin_amdgcn_rcpf(1.0f + __builtin_amdgcn_exp2f(-1.4426950408889634f * x)); }

struct EpiRope {
    static constexpr bool PERM = true, AFTER_DRAIN = false;
    bf16_t* Q; bf16_t* Kb; bf16_t* Vb; const float* cs; const float* sn; float qscale; int seqmask;
    __device__ __forceinline__ void operator()(const f32x4 (&acc)[2][2][4][2], const Unit& u, int wr, int wc, int fr, int fq) const {
        const int row0 = u.pm * BM + wr * 64 + fr; const int part = u.pn >> 2, pn4 = u.pn & 3;
        if (part == 2) {
            const int col0 = pn4 * BM + wc * 32 + 8 * fq;
#pragma unroll
            for (int ai = 0; ai < 2; ++ai)
#pragma unroll
                for (int m = 0; m < 4; ++m) { bf16_t* rowp = Vb + (size_t)(row0 + ai * HALF + m * 16) * 1024 + col0;
#pragma unroll
                    for (int bj = 0; bj < 2; ++bj) *(u32x4*)(rowp + bj * HALF) = pack8(acc[ai][bj][m][0], acc[ai][bj][m][1]); }
        } else {
            bf16_t* base = part == 0 ? Q : Kb; const float sc = part == 0 ? qscale : 1.0f;
            const int hm = pn4 * 4 + wc, j0 = 8 * fq;
#pragma unroll
            for (int q = 0; q < 4; ++q) {
                const int ai = q >> 1, mb = (q & 1) * 2;
                f32x4 c0[2], c1[2], s0[2], s1[2];
#pragma unroll
                for (int mm = 0; mm < 2; ++mm) { const int pos = (row0 + ai * HALF + (mb + mm) * 16) & seqmask;
                    c0[mm] = *(const f32x4*)(cs + pos * 32 + j0); c1[mm] = *(const f32x4*)(cs + pos * 32 + j0 + 4); s0[mm] = *(const f32x4*)(sn + pos * 32 + j0); s1[mm] = *(const f32x4*)(sn + pos * 32 + j0 + 4); }
#pragma unroll
                for (int mm = 0; mm < 2; ++mm) { const int m = mb + mm; const int row = row0 + ai * HALF + m * 16;
                    const f32x4 x1a = acc[ai][0][m][0] * sc, x1b = acc[ai][0][m][1] * sc, x2a = acc[ai][1][m][0] * sc, x2b = acc[ai][1][m][1] * sc;
                    const f32x4 o1a = x1a * c0[mm] - x2a * s0[mm], o1b = x1b * c1[mm] - x2b * s1[mm], o2a = x2a * c0[mm] + x1a * s0[mm], o2b = x2b * c1[mm] + x1b * s1[mm];
                    bf16_t* rowp = base + (size_t)row * 1024 + hm * 64 + j0;
                    *(u32x4*)(rowp) = pack8(o1a, o1b); *(u32x4*)(rowp + 32) = pack8(o2a, o2b); }
            }
        }
    }
};
struct EpiSwiGLU {
    static constexpr bool PERM = true, AFTER_DRAIN = false;
    bf16_t* act;
    __device__ __forceinline__ void operator()(const f32x4 (&acc)[2][2][4][2], const Unit& u, int wr, int wc, int fr, int fq) const {
        const int row0 = u.pm * BM + wr * 64 + fr, col0 = u.pn * HALF + wc * 32 + 8 * fq;
#pragma unroll
        for (int ai = 0; ai < 2; ++ai)
#pragma unroll
            for (int m = 0; m < 4; ++m) { f32x4 v0, v1;
#pragma unroll
                for (int j = 0; j < 4; ++j) { v0[j] = silu_f(acc[ai][0][m][0][j]) * acc[ai][1][m][0][j]; v1[j] = silu_f(acc[ai][0][m][1][j]) * acc[ai][1][m][1][j]; }
                *(u32x4*)(act + (size_t)(row0 + ai * HALF + m * 16) * 512 + col0) = pack8(v0, v1); }
    }
};
struct EpiRowScale {
    static constexpr bool PERM = true, AFTER_DRAIN = false;
    bf16_t* O; const float* roww;
    __device__ __forceinline__ void operator()(const f32x4 (&acc)[2][2][4][2], const Unit& u, int wr, int wc, int fr, int fq) const {
        const int row0 = u.pm * BM + wr * 64 + fr, col0 = u.pn * BM + wc * 32 + 8 * fq;
        float w8[8];
#pragma unroll
        for (int q = 0; q < 8; ++q) w8[q] = roww[row0 + (q >> 2) * HALF + (q & 3) * 16];
#pragma unroll
        for (int ai = 0; ai < 2; ++ai)
#pragma unroll
            for (int m = 0; m < 4; ++m) { const int row = row0 + ai * HALF + m * 16; const float w = w8[ai * 4 + m]; bf16_t* rowp = O + (size_t)row * 1024 + col0;
#pragma unroll
                for (int bj = 0; bj < 2; ++bj) *(u32x4*)(rowp + bj * HALF) = pack8(acc[ai][bj][m][0] * w, acc[ai][bj][m][1] * w); }
    }
};
struct PanelOrder {
    int pm, nN;
    __device__ __forceinline__ bool next(int i, Unit& u) const { if (i >= nN) return false; u.pm = pm; u.pn = i; u.e = 0; return true; }
    __device__ __forceinline__ void a_ready(const Unit&) const {}
    __device__ __forceinline__ void done(const Unit&) const {}
};
struct MoeOrder : StaticOrder {
    const int* blk_e;
    __device__ __forceinline__ bool next(int i, Unit& u) const { if (!StaticOrder::next(i, u)) return false; u.e = ((const __attribute__((address_space(4))) int*)blk_e)[u.pm]; return true; }
};
}
#include <hip/hip_bf16.h>
#include <cmath>
namespace attn_body {
using bf16=__hip_bfloat16;
using bf16x8=__attribute__((ext_vector_type(8)))short;
using s16x4=__attribute__((ext_vector_type(4)))short;
using f32x16=__attribute__((ext_vector_type(16)))float;
using u32x4=__attribute__((ext_vector_type(4)))unsigned;
constexpr int BATCH=16,NHEAD=16,SEQ=4096,D=64,DM=NHEAD*D;
constexpr int NW=8,QBLK=32,QB=QBLK*NW,KVBLK=64,NQB=SEQ/QB;
constexpr int ATTN_PITCH=DM, ATTN_UNIT_ROWS=QB;
__device__ __forceinline__ int crow(int r,int hi){return (r&3)+8*(r>>2)+4*hi;}
#define SBAR() __builtin_amdgcn_sched_barrier(0)
__device__ __forceinline__ void cmask(f32x16&p0,f32x16&p1,int jb,int qrel,int hi){
  const float NEG=-INFINITY; int kb=64*jb+4*hi;
  #pragma unroll
  for(int r=0;r<16;++r){int kv=kb+(r&3)+8*(r>>2); if(kv>qrel)p0[r]=NEG; if(kv+32>qrel)p1[r]=NEG;}
}

constexpr int NSLOT=3, SLOTB=8192;
constexpr int LDS_K=0, LDS_V=NSLOT*SLOTB, LDS_WS=2*NSLOT*SLOTB, LDS_OST=LDS_WS+NW*64*4, LDS_BYTES=LDS_OST+NW*4096;
constexpr float C2=0.125f*1.4426950408889634f;
__device__ __forceinline__ void glds16(const void*gsrc,unsigned lds_dst){unsigned keep;
  asm volatile("s_mov_b32 %0, m0\n\ts_mov_b32 m0, %2\n\ts_nop 0\n\tglobal_load_lds_dwordx4 %1, off\n\ts_mov_b32 m0, %0":"=&s"(keep):"v"(gsrc),"s"(lds_dst):"memory");}
__device__ __forceinline__ float max3f(float a,float b,float c){float r;asm("v_max3_f32 %0, %1, %2, %3":"=v"(r):"v"(a),"v"(b),"v"(c));return r;}
__device__ __forceinline__ float max2f(float a,float b){float r;asm("v_max_f32_e32 %0, %1, %2":"=v"(r):"v"(a),"v"(b));return r;}
__device__ __forceinline__ float fadd_s(float a,float b){float r;asm("v_add_f32_e32 %0, %1, %2":"=v"(r):"v"(a),"v"(b));return r;}
__device__ __forceinline__ float fsub_s(float a,float b){float r;asm("v_sub_f32_e32 %0, %1, %2":"=v"(r):"v"(a),"v"(b));return r;}
typedef float f32x2_t __attribute__((ext_vector_type(2))); typedef __bf16 bf16x2_t __attribute__((ext_vector_type(2)));
__device__ __forceinline__ unsigned cvtpk_s(float lo,float hi){f32x2_t v={lo,hi};bf16x2_t b=__builtin_convertvector(v,bf16x2_t);return __builtin_bit_cast(unsigned,b);}
#define WAIT_BAR(N) asm volatile("s_waitcnt vmcnt(" #N ") lgkmcnt(0)\n\ts_barrier":::"memory")

__device__ __forceinline__ void qkt(f32x16&p0,f32x16&p1,const char*Kslot,const bf16x8*qr,const f32x16&negm,int r32,int hi){
  const char*kb=Kslot+hi*1024+r32*16;
  #pragma unroll
  for(int d0=0;d0<4;++d0){
    const bf16x8 b0=*reinterpret_cast<const bf16x8*>(kb+d0*2048);
    const bf16x8 b1=*reinterpret_cast<const bf16x8*>(kb+d0*2048+512);
    if(d0==0){p0=__builtin_amdgcn_mfma_f32_32x32x16_bf16(b0,qr[0],negm,0,0,0);p1=__builtin_amdgcn_mfma_f32_32x32x16_bf16(b1,qr[0],negm,0,0,0);}
    else{p0=__builtin_amdgcn_mfma_f32_32x32x16_bf16(b0,qr[d0],p0,0,0,0);p1=__builtin_amdgcn_mfma_f32_32x32x16_bf16(b1,qr[d0],p1,0,0,0);}}
}
typedef __attribute__((address_space(3))) const char* lds_cptr;
typedef short v4i16_t __attribute__((ext_vector_type(4)));
__device__ __forceinline__ void kload8(bf16x8*kf,lds_cptr kp){
  kf[0]=*(const __attribute__((address_space(3))) bf16x8*)(kp);      kf[1]=*(const __attribute__((address_space(3))) bf16x8*)(kp+512);
  kf[2]=*(const __attribute__((address_space(3))) bf16x8*)(kp+2048); kf[3]=*(const __attribute__((address_space(3))) bf16x8*)(kp+2560);
  kf[4]=*(const __attribute__((address_space(3))) bf16x8*)(kp+4096); kf[5]=*(const __attribute__((address_space(3))) bf16x8*)(kp+4608);
  kf[6]=*(const __attribute__((address_space(3))) bf16x8*)(kp+6144); kf[7]=*(const __attribute__((address_space(3))) bf16x8*)(kp+6656);
}
__device__ __forceinline__ void kload2(bf16x8*kf,lds_cptr kp,int j){ kf[2*j]=*(const __attribute__((address_space(3))) bf16x8*)(kp+j*2048); kf[2*j+1]=*(const __attribute__((address_space(3))) bf16x8*)(kp+j*2048+512); }
__device__ __forceinline__ s16x4 vtr(lds_cptr p){ return __builtin_bit_cast(s16x4,__builtin_amdgcn_ds_read_tr16_b64_v4i16((__attribute__((address_space(3))) v4i16_t*)p)); }
__device__ __forceinline__ float rowmax(const f32x16&p0,const f32x16&p1){
  float a=max3f(p0[0],p0[1],p1[0]),b=max3f(p0[2],p0[3],p1[1]);a=max3f(a,p1[2],p1[3]);
  #pragma unroll
  for(int r=4;r<16;r+=4){a=max3f(a,p0[r],p0[r+1]);b=max3f(b,p0[r+2],p0[r+3]);a=max3f(a,p1[r],p1[r+1]);b=max3f(b,p1[r+2],p1[r+3]);}
  const float m=max2f(a,b);
  auto rr=__builtin_amdgcn_permlane32_swap(__float_as_uint(m),__float_as_uint(m),false,false);
  return max2f(__uint_as_float(rr[0]),__uint_as_float(rr[1]));
}
__device__ __forceinline__ void pv(f32x16*o,int vb,bf16x8 pa0,bf16x8 pa1,bf16x8 pa2,bf16x8 pa3){
  #pragma unroll
  for(int d0=0;d0<2;++d0){s16x4 lo[4],hi[4];
    #pragma unroll
    for(int ks=0;ks<4;++ks){
      asm volatile("ds_read_b64_tr_b16 %0,%1 offset:%c2":"=&v"(lo[ks]):"v"(vb),"i"(d0*4096+ks*1024):"memory");
      asm volatile("ds_read_b64_tr_b16 %0,%1 offset:%c2":"=&v"(hi[ks]):"v"(vb),"i"(d0*4096+ks*1024+512):"memory");}
    asm volatile("s_waitcnt lgkmcnt(0)":::"memory");SBAR();
    #define PK(k) (bf16x8){lo[k][0],lo[k][1],lo[k][2],lo[k][3],hi[k][0],hi[k][1],hi[k][2],hi[k][3]}
    o[d0]=__builtin_amdgcn_mfma_f32_32x32x16_bf16(pa0,PK(0),o[d0],0,0,0);
    o[d0]=__builtin_amdgcn_mfma_f32_32x32x16_bf16(pa1,PK(1),o[d0],0,0,0);
    o[d0]=__builtin_amdgcn_mfma_f32_32x32x16_bf16(pa2,PK(2),o[d0],0,0,0);
    o[d0]=__builtin_amdgcn_mfma_f32_32x32x16_bf16(pa3,PK(3),o[d0],0,0,0);
    #undef PK
  }
}

#ifndef ATTN_STORE16
#define ATTN_STORE16(p,v) (*(u32x4*)(p)=(v))
#endif
template<int THRL> __device__ __forceinline__ void attn_unit(int b,int qcol,int kcol,int vcol,int ocol,int qb,const bf16*Q,const bf16* K,const bf16* V,bf16*O,char*shm,int tid){
  const int lane=tid&63,r32=lane&31,hi=lane>>5; const int wid=__builtin_amdgcn_readfirstlane(tid>>6);
  const long rowbase=(long)b*SEQ; const int q0=qb*QB;
  const bf16*Qw=Q+(rowbase+q0+wid*QBLK)*DM+qcol;
  const bf16*Kh=K+rowbase*DM+kcol,*Vh=V+rowbase*DM+vcol;
  const unsigned lds0=(unsigned)(uintptr_t)shm;
  float*wsf=(float*)(shm+LDS_WS)+wid*64;
  const bf16*ksrc=Kh+(long)lane*DM+wid*8;
  const bf16*vsrc=Vh+(long)(16*(wid&3)+(lane>>2))*DM+(wid>>2)*32+(lane&3)*8;
  const unsigned kdst=lds0+LDS_K+wid*1024, vdst=lds0+LDS_V+wid*1024;
  #define DMA_K(t,slot) glds16(ksrc+(long)(t)*KVBLK*DM,(unsigned)__builtin_amdgcn_readfirstlane(kdst+(slot)))
  #define DMA_V(t,slot) glds16(vsrc+(long)(t)*KVBLK*DM,(unsigned)__builtin_amdgcn_readfirstlane(vdst+(slot)))
  const int vb0=(int)(lds0+LDS_V)+((lane>>4)&1)*32+(lane&3)*8+(4*hi+((lane&15)>>2))*64;
  const char*Kbase=shm+LDS_K; bf16x8 kf[8];
  const lds_cptr shm3=(lds_cptr)shm; const lds_cptr kp0=shm3+LDS_K+hi*1024+r32*16; const lds_cptr vp0=shm3+LDS_V+((lane>>4)&1)*32+(lane&3)*8+(4*hi+((lane&15)>>2))*64;
  const int NT=(q0+QB)/KVBLK;
  DMA_K(0,0);DMA_V(0,0);DMA_K(1,SLOTB);
  bf16x8 qr[4];
  #pragma unroll
  for(int d0=0;d0<4;++d0)qr[d0]=*reinterpret_cast<const bf16x8*>(&Qw[(long)r32*DM+d0*16+hi*8]);
  float mhat=0.f,l_reg=0.f;f32x16 o[2];o[0]=f32x16{};o[1]=f32x16{};f32x16 negm=f32x16{};asm volatile("":"+v"(negm));
  const int qrel=wid*QBLK+r32;
  #define CMASK(P0,P1,t) do{int jb_=(t)-(NT-4); if(jb_>=0)cmask(P0,P1,jb_,qrel,hi);}while(0)
  bool resc=false;
  #define START(P0,P1) do{ const float rm=rowmax(P0,P1); resc=false; \
    { const float dl=rm; mhat=fadd_s(mhat,dl); \
      _Pragma("unroll") for(int r=0;r<16;++r){P0[r]=fsub_s(P0[r],dl);P1[r]=fsub_s(P1[r],dl);} \
      _Pragma("unroll") for(int r=0;r<16;++r)negm[r]=-mhat; asm volatile("":"+v"(negm)); } \
    _Pragma("unroll") for(int r=0;r<16;++r)P0[r]=__builtin_amdgcn_exp2f(P0[r]); }while(0)
  #define RESC() do{ if(resc){ asm volatile("s_waitcnt lgkmcnt(0)":::"memory"); \
      _Pragma("unroll") for(int d_=0;d_<2;++d_) _Pragma("unroll") for(int r=0;r<16;++r)o[d_][r]*=wsf[crow(r,hi)]; } }while(0)
  f32x16 pA0,pA1,pB0,pB1;
  int sl_prev=0,sl_cur=0,sl_next=SLOTB;
  #define ROT() do{sl_prev=sl_cur;sl_cur=sl_next;sl_next=(sl_next==(NSLOT-1)*SLOTB)?0:sl_next+SLOTB;}while(0)
  DMA_K(2,2*SLOTB);
  WAIT_BAR(3);
  qkt(pA0,pA1,Kbase,qr,negm,r32,hi);asm volatile("s_nop 15\n\ts_nop 7":"+v"(pA0),"+v"(pA1));CMASK(pA0,pA1,0);
  START(pA0,pA1);
  _Pragma("unroll") for(int r=0;r<16;++r)pA1[r]=__builtin_amdgcn_exp2f(pA1[r]);
  WAIT_BAR(0);
  DMA_K(3,0);DMA_V(1,SLOTB);
  ROT();
  kload8(kf,kp0+sl_cur);
  WAIT_BAR(2);
  s16x4 vlo[8],vhi[8]; u32x4 pw0,pw1,pw2,pw3;
  #define PKW(P,B) cvtpk_s(P[B],P[B+1])
  #define PAF(k) __builtin_bit_cast(bf16x8,pw##k)
  #define VFR(i) (bf16x8){vlo[i][0],vlo[i][1],vlo[i][2],vlo[i][3],vhi[i][0],vhi[i][1],vhi[i][2],vhi[i][3]}
  #define PIN(x) asm volatile("":"+v"(x))
  #define MX3(a,b,c) __builtin_fmaxf(__builtin_fmaxf((a),(b)),(c))
  #define GAPA(MF,A0,A1,A2,A3,W0,W1,PW) do{ MF; sacc+=A0; sacc+=A1; sacc+=A2; sacc+=A3; PIN(sacc); W0; W1; PIN(PW); SBAR(); }while(0)
  #define EX(v) __builtin_amdgcn_exp2f(v)
  #define GAPB(MF,X,B) do{ MF; X[B]=EX(X[B]); X[B+1]=EX(X[B+1]); X[B+2]=EX(X[B+2]); X[B+3]=EX(X[B+3]); PIN(X); SBAR(); }while(0)
  #define VRD(i) do{ vlo[i]=vtr(vp_+(((i)>>2)*4096+((i)&3)*1024)); vhi[i]=vtr(vp_+(((i)>>2)*4096+((i)&3)*1024+512)); }while(0)
  #define KRD(G,j) do{ if(G){ kload2(kf,kp0+sl_next,j); SBAR(); } }while(0)
  #define STEP(C0,C1,P0,P1,t,GK,GV,GL) do{ SBAR(); \
    const lds_cptr vp_=vp0+sl_prev; \
    VRD(0); SBAR(); float sacc=(P0[0]+P0[1]); \
    GAPA(C0=__builtin_amdgcn_mfma_f32_32x32x16_bf16(kf[0],qr[0],negm,0,0,0), P0[2],P0[3],P0[4],P0[5],     pw0[0]=PKW(P0,0), pw0[1]=PKW(P0,2), pw0); \
    VRD(4); SBAR(); GAPA(C1=__builtin_amdgcn_mfma_f32_32x32x16_bf16(kf[1],qr[0],negm,0,0,0), P0[6],P0[7],P0[8],P0[9],     pw0[2]=PKW(P0,4), pw0[3]=PKW(P0,6), pw0); \
    VRD(1); SBAR(); GAPA(C0=__builtin_amdgcn_mfma_f32_32x32x16_bf16(kf[2],qr[1],C0,0,0,0),   P0[10],P0[11],P0[12],P0[13], pw1[0]=PKW(P0,8), pw1[1]=PKW(P0,10), pw1); \
    VRD(5); SBAR(); GAPA(C1=__builtin_amdgcn_mfma_f32_32x32x16_bf16(kf[3],qr[1],C1,0,0,0),   P0[14],P0[15],P1[0],P1[1],   pw1[2]=PKW(P0,12),pw1[3]=PKW(P0,14), pw1); \
    VRD(2); SBAR(); GAPA(C0=__builtin_amdgcn_mfma_f32_32x32x16_bf16(kf[4],qr[2],C0,0,0,0),   P1[2],P1[3],P1[4],P1[5],     pw2[0]=PKW(P1,0), pw2[1]=PKW(P1,2), pw2); \
    VRD(6); SBAR(); GAPA(C1=__builtin_amdgcn_mfma_f32_32x32x16_bf16(kf[5],qr[2],C1,0,0,0),   P1[6],P1[7],P1[8],P1[9],     pw2[2]=PKW(P1,4), pw2[3]=PKW(P1,6), pw2); \
    VRD(3); SBAR(); GAPA(C0=__builtin_amdgcn_mfma_f32_32x32x16_bf16(kf[6],qr[3],C0,0,0,0),   P1[10],P1[11],P1[12],P1[13], pw3[0]=PKW(P1,8), pw3[1]=PKW(P1,10), pw3); \
    VRD(7); SBAR(); GAPA(C1=__builtin_amdgcn_mfma_f32_32x32x16_bf16(kf[7],qr[3],C1,0,0,0),   P1[14],P1[15],0.f,0.f,       pw3[2]=PKW(P1,12),pw3[3]=PKW(P1,14), pw3); \
    l_reg+=sacc; \
    if(GK){DMA_K((t)+3,sl_cur);} if(GV){DMA_V((t)+1,sl_next);} \
    CMASK(C0,C1,t); \
    { float a=MX3(C0[0],C0[1],C1[0]),b=MX3(C0[2],C0[3],C1[1]); a=MX3(a,C1[2],C1[3]); \
      _Pragma("unroll") for(int r=4;r<16;r+=4){a=MX3(a,C0[r],C0[r+1]);b=MX3(b,C0[r+2],C0[r+3]);a=MX3(a,C1[r],C1[r+1]);b=MX3(b,C1[r+2],C1[r+3]);} \
      float rm=__builtin_fmaxf(a,b); { auto rr=__builtin_amdgcn_permlane32_swap(__float_as_uint(rm),__float_as_uint(rm),false,false); rm=__builtin_fmaxf(__uint_as_float(rr[0]),__uint_as_float(rr[1])); } \
      resc=false; \
      if(__builtin_expect(__any(rm>(float)THRL),0)){ const float dl=__builtin_fmaxf(rm,0.f); mhat+=dl; \
        _Pragma("unroll") for(int r=0;r<16;++r){C0[r]-=dl;C1[r]-=dl;} \
        _Pragma("unroll") for(int r=0;r<16;++r)negm[r]=-mhat; asm volatile("":"+v"(negm)); \
        const float f=__builtin_amdgcn_exp2f(-dl); l_reg*=f; if(hi==0)wsf[r32]=f; resc=true; } } \
    SBAR(); \
    GAPB(o[0]=__builtin_amdgcn_mfma_f32_32x32x16_bf16(PAF(0),VFR(0),o[0],0,0,0), C0,0); \
    GAPB(o[1]=__builtin_amdgcn_mfma_f32_32x32x16_bf16(PAF(0),VFR(4),o[1],0,0,0), C0,4); \
    KRD(GL,0); GAPB(o[0]=__builtin_amdgcn_mfma_f32_32x32x16_bf16(PAF(1),VFR(1),o[0],0,0,0), C0,8); \
    KRD(GL,1); GAPB(o[1]=__builtin_amdgcn_mfma_f32_32x32x16_bf16(PAF(1),VFR(5),o[1],0,0,0), C0,12); \
    KRD(GL,2); GAPB(o[0]=__builtin_amdgcn_mfma_f32_32x32x16_bf16(PAF(2),VFR(2),o[0],0,0,0), C1,0); \
    KRD(GL,3); GAPB(o[1]=__builtin_amdgcn_mfma_f32_32x32x16_bf16(PAF(2),VFR(6),o[1],0,0,0), C1,4); \
    GAPB(o[0]=__builtin_amdgcn_mfma_f32_32x32x16_bf16(PAF(3),VFR(3),o[0],0,0,0), C1,8); \
    GAPB(o[1]=__builtin_amdgcn_mfma_f32_32x32x16_bf16(PAF(3),VFR(7),o[1],0,0,0), C1,12); \
    }while(0)
  int t=1;
  #undef CMASK
  #define CMASK(P0,P1,t) do{}while(0)
  for(;t+5<NT;t+=2){
    STEP(pB0,pB1,pA0,pA1,t,true,true,true);     WAIT_BAR(2); RESC(); ROT();
    STEP(pA0,pA1,pB0,pB1,t+1,true,true,true);   WAIT_BAR(2); RESC(); ROT();
  }
  #undef CMASK
  #define CMASK(P0,P1,t) do{int jb_=(t)-(NT-4); if(jb_>=0)cmask(P0,P1,jb_,qrel,hi);}while(0)
  #define ENDW(tt) do{ if((tt)+3<NT){WAIT_BAR(2);} else if((tt)+2<NT){WAIT_BAR(1);} else {WAIT_BAR(0);} }while(0)
  for(;t+1<NT;t+=2){
    STEP(pB0,pB1,pA0,pA1,t,(t+3<NT),(t+1<NT),(t+1<NT));       ENDW(t);   RESC(); ROT();
    STEP(pA0,pA1,pB0,pB1,t+1,(t+4<NT),(t+2<NT),(t+2<NT));     ENDW(t+1); RESC(); ROT();
  }
  STEP(pB0,pB1,pA0,pA1,NT-1,false,false,false); RESC();
  { float sacc=pB0[0]+pB0[1]; _Pragma("unroll") for(int r=2;r<16;++r)sacc+=pB0[r]; _Pragma("unroll") for(int r=0;r<16;++r)sacc+=pB1[r]; l_reg+=sacc;
    pw0=(u32x4){PKW(pB0,0),PKW(pB0,2),PKW(pB0,4),PKW(pB0,6)};pw1=(u32x4){PKW(pB0,8),PKW(pB0,10),PKW(pB0,12),PKW(pB0,14)};pw2=(u32x4){PKW(pB1,0),PKW(pB1,2),PKW(pB1,4),PKW(pB1,6)};pw3=(u32x4){PKW(pB1,8),PKW(pB1,10),PKW(pB1,12),PKW(pB1,14)};
    SBAR(); pv(o,vb0+sl_cur,PAF(0),PAF(1),PAF(2),PAF(3)); }
  #undef PKW
  #undef PAF
  #undef VFR
  #undef PIN
  #undef MX3
  #undef GAPA
  #undef GAPB
  #undef EX
  #undef VRD
  #undef KRD
  #undef STEP
  #undef ENDW
  {auto rr=__builtin_amdgcn_permlane32_swap(__float_as_uint(l_reg),__float_as_uint(l_reg),false,false);l_reg=__uint_as_float(rr[0])+__uint_as_float(rr[1]);}
  if(hi==0)wsf[32+r32]=l_reg;asm volatile("s_waitcnt lgkmcnt(0)":::"memory");
  float rli[16];
  #pragma unroll
  for(int r=0;r<16;++r)rli[r]=__builtin_amdgcn_rcpf(wsf[32+crow(r,hi)]);
  bf16*Ow=O+(rowbase+q0+wid*QBLK)*DM+ocol;
  { bf16*stg=(bf16*)(shm+LDS_OST)+wid*2048;
    #pragma unroll
    for(int r=0;r<16;++r){const int orow=crow(r,hi);
      #pragma unroll
      for(int d0=0;d0<2;++d0)stg[orow*64+d0*32+r32]=__float2bfloat16(o[d0][r]*rli[r]);}
    asm volatile("s_waitcnt lgkmcnt(0)":::"memory");
    #pragma unroll
    for(int i=0;i<4;++i){const int row=i*8+(lane>>3),ch=lane&7; const u32x4 v=*(const u32x4*)(stg+row*64+ch*8); ATTN_STORE16(Ow+(long)row*DM+ch*8,v);} }
  asm volatile("s_waitcnt lgkmcnt(0)\n\ts_barrier":::"memory");
  #undef DMA_K
  #undef DMA_V
  #undef CMASK
  #undef START
  #undef RESC
  #undef ROT
}
constexpr int ATTN_LDS_BYTES=LDS_BYTES;
struct AttnTensors { const bf16* Q; const bf16* K; const bf16* V; bf16* O0; bf16* O1; };
struct AttnUnit { int b, qcol, kcol, vcol, ocol, m, qb; };
struct StaticOrder {
  int vcu, G;
  __device__ __forceinline__ StaticOrder(int grid,int vcu_):vcu(vcu_),G(grid){}
  __device__ __forceinline__ bool next(int i,AttnUnit&u)const{
    int b,h,m,vhalf,qb;
    if(G==256){ if(i>=32)return false; const int xcd=vcu>>5,l=vcu&31,vh=l&3,qs=l>>2,bh=xcd*16+(i>>1); b=bh>>3; h=bh&7; m=(vh>>1)&1; vhalf=vh&1; qb=(i&1)?qs:15-qs; }
    else { const int ci=vcu+G*(i>>4); if(ci>=BATCH*32)return false; const int vh=ci&31; h=vh>>2; m=(vh>>1)&1; vhalf=vh&1; b=ci>>5; qb=15-(i&15); }
    u.b=b; u.qcol=(2*h+m)*64; u.kcol=u.qcol; u.vcol=h*128+vhalf*64; u.ocol=u.vcol; u.m=m; u.qb=qb; return true; }
  __device__ __forceinline__ void a_ready(const AttnUnit&)const{}
  __device__ __forceinline__ void done(const AttnUnit&)const{}
};
template<class Sched,int THRL=8> __device__ __forceinline__ void attn_phase(char*lds,const AttnTensors&T,const Sched&S,const int tid_){
  AttnUnit u;
  for(int i=0;S.next(i,u);++i){ S.a_ready(u); attn_unit<THRL>(u.b,u.qcol,u.kcol,u.vcol,u.ocol,u.qb,T.Q,T.K,T.V,u.m?T.O1:T.O0,lds,tid_); S.done(u); }
}
constexpr int VSLOTB=16384;
constexpr int WL_K=0, WL_V=NSLOT*SLOTB, WL_WS=WL_V+NSLOT*VSLOTB, WL_Q=WL_WS+NW*64*4, WL_OST=WL_Q+NW*4096, WL_BYTES=WL_OST+NW*4096;
__device__ __forceinline__ void cmask2(f32x16&p0,f32x16&p1,int jb,int qrel,int hi){
  const float NEG=-INFINITY; const int qq=qrel-64*jb-4*hi;
  #pragma unroll
  for(int r=0;r<16;++r){const int c=(r&3)+8*(r>>2); if(c>qq)p0[r]=NEG; if(c+32>qq)p1[r]=NEG;}
}
__device__ __forceinline__ void pv4(f32x16*o,int vb,bf16x8 pa0,bf16x8 pa1,bf16x8 pa2,bf16x8 pa3){
  #pragma unroll
  for(int d0=0;d0<4;++d0){s16x4 lo[4],hi[4];
    #pragma unroll
    for(int ks=0;ks<4;++ks){
      asm volatile("ds_read_b64_tr_b16 %0,%1 offset:%c2":"=&v"(lo[ks]):"v"(vb),"i"(d0*4096+ks*1024):"memory");
      asm volatile("ds_read_b64_tr_b16 %0,%1 offset:%c2":"=&v"(hi[ks]):"v"(vb),"i"(d0*4096+ks*1024+512):"memory");}
    asm volatile("s_waitcnt lgkmcnt(0)":::"memory");SBAR();
    #define PK(k) (bf16x8){lo[k][0],lo[k][1],lo[k][2],lo[k][3],hi[k][0],hi[k][1],hi[k][2],hi[k][3]}
    o[d0]=__builtin_amdgcn_mfma_f32_32x32x16_bf16(pa0,PK(0),o[d0],0,0,0);
    o[d0]=__builtin_amdgcn_mfma_f32_32x32x16_bf16(pa1,PK(1),o[d0],0,0,0);
    o[d0]=__builtin_amdgcn_mfma_f32_32x32x16_bf16(pa2,PK(2),o[d0],0,0,0);
    o[d0]=__builtin_amdgcn_mfma_f32_32x32x16_bf16(pa3,PK(3),o[d0],0,0,0);
    #undef PK
  }
}
using f32x4_t=__attribute__((ext_vector_type(4)))float;
struct CombineW { const bf16* O0; bf16* A2; const float* w; float lam, mul; };
template<int THRL> __device__ __forceinline__ void attn_unit_w(int b,int qcol,int vcol,int qb,int m,const bf16*Q,const bf16* K,const bf16* V,bf16*O,const CombineW&CB,char*shm,int tid){
  const int lane=tid&63,r32=lane&31,hi=lane>>5; const int wid=__builtin_amdgcn_readfirstlane(tid>>6);
  const long rowbase=(long)b*SEQ; const int q0=qb*QB;
  int hi4=4*hi; asm volatile("":"+v"(hi4));
  #define CROWO(r) (((r)&3)+8*((r)>>2)+hi4)
  const bf16*Qw=Q+(rowbase+q0+wid*QBLK)*DM+qcol;
  const bf16*Kh=K+rowbase*DM+qcol,*Vh=V+rowbase*DM+vcol;
  const unsigned lds0=(unsigned)(uintptr_t)shm;
  float*wsf=(float*)(shm+WL_WS)+wid*64;
  const bf16*ksrc=Kh+(long)lane*DM+wid*8;
  const bf16*vsrc=Vh+(long)(16*(wid&3)+(lane>>2))*DM+(wid>>2)*32+(lane&3)*8;
  const unsigned kdst=lds0+WL_K+wid*1024, vdst=lds0+WL_V+wid*1024;
  #define DMA_K(t,slot) glds16(ksrc+(long)(t)*KVBLK*DM,(unsigned)__builtin_amdgcn_readfirstlane(kdst+(slot)))
  #define DMA_V(t,slot) do{ glds16(vsrc+(long)(t)*KVBLK*DM,(unsigned)__builtin_amdgcn_readfirstlane(vdst+2*(slot))); glds16(vsrc+(long)(t)*KVBLK*DM+64,(unsigned)__builtin_amdgcn_readfirstlane(vdst+2*(slot)+8192)); }while(0)
  const int vb0=(int)(lds0+WL_V)+((lane>>4)&1)*32+(lane&3)*8+(4*hi+((lane&15)>>2))*64;
  const char*Kbase=shm+WL_K; bf16x8 kf[8];
  const lds_cptr shm3=(lds_cptr)shm; const lds_cptr kp0=shm3+WL_K+hi*1024+r32*16; const lds_cptr vp0=shm3+WL_V+((lane>>4)&1)*32+(lane&3)*8+(4*hi+((lane&15)>>2))*64;
  const lds_cptr qp=shm3+WL_Q+wid*4096+lane*16;
  const int NT=(q0+QB)/KVBLK;
  DMA_K(0,0);DMA_V(0,0);DMA_K(1,SLOTB);
  bf16x8 qr[4];
  #pragma unroll
  for(int d0=0;d0<4;++d0)qr[d0]=*reinterpret_cast<const bf16x8*>(&Qw[(long)r32*DM+d0*16+hi*8]);
  #pragma unroll
  for(int d0=0;d0<4;++d0)*(__attribute__((address_space(3))) bf16x8*)(qp+d0*1024)=qr[d0];
  float mhat=0.f,l_reg=0.f;f32x16 o[4];o[0]=f32x16{};o[1]=f32x16{};o[2]=f32x16{};o[3]=f32x16{};
  const f32x16 zero16=f32x16{};
  const int qrel=wid*QBLK+r32;
  #define CMASK(P0,P1,t) do{int jb_=(t)-(NT-4); if(jb_>=0)cmask2(P0,P1,jb_,qrel,hi);}while(0)
  bool resc=false;
  #define START(P0,P1) do{ const float rm=rowmax(P0,P1); resc=false; \
    { const float dl=rm; mhat=fadd_s(mhat,dl); \
      _Pragma("unroll") for(int r=0;r<16;++r){P0[r]=fsub_s(P0[r],dl);P1[r]=fsub_s(P1[r],dl);} } \
    _Pragma("unroll") for(int r=0;r<16;++r)P0[r]=__builtin_amdgcn_exp2f(P0[r]); }while(0)
  #define RESC() do{ if(resc){ asm volatile("s_waitcnt lgkmcnt(0)":::"memory"); \
      _Pragma("unroll") for(int d_=0;d_<4;++d_) _Pragma("unroll") for(int r=0;r<16;++r)o[d_][r]*=wsf[CROWO(r)]; } }while(0)
  f32x16 pA0,pA1,pB0,pB1;
  int sl_prev=0,sl_cur=0,sl_next=SLOTB;
  #define ROT() do{sl_prev=sl_cur;sl_cur=sl_next;sl_next=(sl_next==(NSLOT-1)*SLOTB)?0:sl_next+SLOTB;}while(0)
  DMA_K(2,2*SLOTB);
  WAIT_BAR(3);
  qkt(pA0,pA1,Kbase,qr,zero16,r32,hi);asm volatile("s_nop 15\n\ts_nop 7":"+v"(pA0),"+v"(pA1));CMASK(pA0,pA1,0);
  START(pA0,pA1);
  _Pragma("unroll") for(int r=0;r<16;++r)pA1[r]=__builtin_amdgcn_exp2f(pA1[r]);
  WAIT_BAR(0);
  DMA_K(3,0);DMA_V(1,SLOTB);
  ROT();
  kload8(kf,kp0+sl_cur);
  WAIT_BAR(3);
  s16x4 vlo[16],vhi[16]; u32x4 pw0,pw1,pw2,pw3;
  #define PKW(P,B) cvtpk_s(P[B],P[B+1])
  #define PAF(k) __builtin_bit_cast(bf16x8,pw##k)
  #define VFR(i) (bf16x8){vlo[i][0],vlo[i][1],vlo[i][2],vlo[i][3],vhi[i][0],vhi[i][1],vhi[i][2],vhi[i][3]}
  #define PIN(x) asm volatile("":"+v"(x))
  #define MX3(a,b,c) __builtin_fmaxf(__builtin_fmaxf((a),(b)),(c))
  #define GAPA(MF,A0,A1,A2,A3,W0,W1,PW) do{ MF; sacc+=A0; sacc+=A1; sacc+=A2; sacc+=A3; PIN(sacc); W0; W1; PIN(PW); SBAR(); }while(0)
  #define EX(v) __builtin_amdgcn_exp2f(v)
  #define GAPB(MF,X,B) do{ MF; X[B]=EX(X[B]); X[B+1]=EX(X[B+1]); PIN(X); SBAR(); }while(0)
  #define VRD(i) do{ vlo[i]=vtr(vp_+(((i)>>2)*4096+((i)&3)*1024)); vhi[i]=vtr(vp_+(((i)>>2)*4096+((i)&3)*1024+512)); }while(0)
  #define KRD(G,j) do{ if(G){ kload2(kf,kp0+sl_next,j); SBAR(); } }while(0)
  #define QRD(d) (*(const __attribute__((address_space(3))) bf16x8*)(qp+(d)*1024))
  #define MF32(a_,b_,c_) __builtin_amdgcn_mfma_f32_32x32x16_bf16(a_,b_,c_,0,0,0)
  #define STEP(C0,C1,P0,P1,t,GK,GV,GL) do{ SBAR(); \
    const lds_cptr vp_=vp0+2*sl_prev; bf16x8 q0_,q1_,q2_,q3_; \
    q0_=QRD(0); VRD(0); SBAR(); float sacc=(P0[0]+P0[1]); \
    GAPA(C0=MF32(kf[0],q0_,zero16), P0[2],P0[3],P0[4],P0[5],     pw0[0]=PKW(P0,0), pw0[1]=PKW(P0,2), pw0); \
    q1_=QRD(1); SBAR(); GAPA(C1=MF32(kf[1],q0_,zero16), P0[6],P0[7],P0[8],P0[9],     pw0[2]=PKW(P0,4), pw0[3]=PKW(P0,6), pw0); \
    VRD(4); SBAR(); GAPA(C0=MF32(kf[2],q1_,C0),   P0[10],P0[11],P0[12],P0[13], pw1[0]=PKW(P0,8), pw1[1]=PKW(P0,10), pw1); \
    q2_=QRD(2); SBAR(); GAPA(C1=MF32(kf[3],q1_,C1),   P0[14],P0[15],P1[0],P1[1],   pw1[2]=PKW(P0,12),pw1[3]=PKW(P0,14), pw1); \
    VRD(8); SBAR(); GAPA(C0=MF32(kf[4],q2_,C0),   P1[2],P1[3],P1[4],P1[5],     pw2[0]=PKW(P1,0), pw2[1]=PKW(P1,2), pw2); \
    q3_=QRD(3); SBAR(); GAPA(C1=MF32(kf[5],q2_,C1),   P1[6],P1[7],P1[8],P1[9],     pw2[2]=PKW(P1,4), pw2[3]=PKW(P1,6), pw2); \
    VRD(12); SBAR(); GAPA(C0=MF32(kf[6],q3_,C0),   P1[10],P1[11],P1[12],P1[13], pw3[0]=PKW(P1,8), pw3[1]=PKW(P1,10), pw3); \
    GAPA(C1=MF32(kf[7],q3_,C1),   P1[14],P1[15],0.f,0.f,       pw3[2]=PKW(P1,12),pw3[3]=PKW(P1,14), pw3); \
    l_reg+=sacc; \
    if(GK){DMA_K((t)+3,sl_cur);} if(GV){DMA_V((t)+1,sl_next);} \
    CMASK(C0,C1,t); \
    { float a=MX3(C0[0],C0[1],C1[0]),b=MX3(C0[2],C0[3],C1[1]); a=MX3(a,C1[2],C1[3]); \
      _Pragma("unroll") for(int r=4;r<16;r+=4){a=MX3(a,C0[r],C0[r+1]);b=MX3(b,C0[r+2],C0[r+3]);a=MX3(a,C1[r],C1[r+1]);b=MX3(b,C1[r+2],C1[r+3]);} \
      float rm=__builtin_fmaxf(a,b); { auto rr=__builtin_amdgcn_permlane32_swap(__float_as_uint(rm),__float_as_uint(rm),false,false); rm=__builtin_fmaxf(__uint_as_float(rr[0]),__uint_as_float(rr[1])); } \
      rm-=mhat; resc=false; \
      if(__builtin_expect(__any(rm>(float)THRL),0)){ const float dl=__builtin_fmaxf(rm,0.f); mhat+=dl; \
        const float f=__builtin_amdgcn_exp2f(-dl); l_reg*=f; if(hi==0)wsf[r32]=f; resc=true; } \
      _Pragma("unroll") for(int r=0;r<16;++r){C0[r]-=mhat;C1[r]-=mhat;} } \
    SBAR(); \
    VRD(1);  GAPB(o[0]=MF32(PAF(0),VFR(0), o[0]), C0,0); \
    VRD(5);  GAPB(o[1]=MF32(PAF(0),VFR(4), o[1]), C0,2); \
    VRD(9);  GAPB(o[2]=MF32(PAF(0),VFR(8), o[2]), C0,4); \
    VRD(13); GAPB(o[3]=MF32(PAF(0),VFR(12),o[3]), C0,6); \
    VRD(2);  KRD(GL,0); GAPB(o[0]=MF32(PAF(1),VFR(1), o[0]), C0,8); \
    VRD(6);  GAPB(o[1]=MF32(PAF(1),VFR(5), o[1]), C0,10); \
    VRD(10); KRD(GL,1); GAPB(o[2]=MF32(PAF(1),VFR(9), o[2]), C0,12); \
    VRD(14); GAPB(o[3]=MF32(PAF(1),VFR(13),o[3]), C0,14); \
    VRD(3);  KRD(GL,2); GAPB(o[0]=MF32(PAF(2),VFR(2), o[0]), C1,0); \
    VRD(7);  GAPB(o[1]=MF32(PAF(2),VFR(6), o[1]), C1,2); \
    VRD(11); KRD(GL,3); GAPB(o[2]=MF32(PAF(2),VFR(10),o[2]), C1,4); \
    VRD(15); GAPB(o[3]=MF32(PAF(2),VFR(14),o[3]), C1,6); \
    GAPB(o[0]=MF32(PAF(3),VFR(3), o[0]), C1,8); \
    GAPB(o[1]=MF32(PAF(3),VFR(7), o[1]), C1,10); \
    GAPB(o[2]=MF32(PAF(3),VFR(11),o[2]), C1,12); \
    GAPB(o[3]=MF32(PAF(3),VFR(15),o[3]), C1,14); \
    }while(0)
  int t=1;
  #undef CMASK
  #define CMASK(P0,P1,t) do{}while(0)
  for(;t+5<NT;t+=2){
    STEP(pB0,pB1,pA0,pA1,t,true,true,true);     WAIT_BAR(3); RESC(); ROT();
    STEP(pA0,pA1,pB0,pB1,t+1,true,true,true);   WAIT_BAR(3); RESC(); ROT();
  }
  #undef CMASK
  #define CMASK(P0,P1,t) do{int jb_=(t)-(NT-4); if(jb_>=0)cmask2(P0,P1,jb_,qrel,hi);}while(0)
  #define ENDW(tt) do{ if((tt)+3<NT){WAIT_BAR(3);} else if((tt)+2<NT){WAIT_BAR(2);} else {WAIT_BAR(0);} }while(0)
  for(;t+1<NT;t+=2){
    STEP(pB0,pB1,pA0,pA1,t,(t+3<NT),(t+1<NT),(t+1<NT));       ENDW(t);   RESC(); ROT();
    STEP(pA0,pA1,pB0,pB1,t+1,(t+4<NT),(t+2<NT),(t+2<NT));     ENDW(t+1); RESC(); ROT();
  }
  STEP(pB0,pB1,pA0,pA1,NT-1,false,false,false); RESC();
  { float sacc=pB0[0]+pB0[1]; _Pragma("unroll") for(int r=2;r<16;++r)sacc+=pB0[r]; _Pragma("unroll") for(int r=0;r<16;++r)sacc+=pB1[r]; l_reg+=sacc;
    pw0=(u32x4){PKW(pB0,0),PKW(pB0,2),PKW(pB0,4),PKW(pB0,6)};pw1=(u32x4){PKW(pB0,8),PKW(pB0,10),PKW(pB0,12),PKW(pB0,14)};pw2=(u32x4){PKW(pB1,0),PKW(pB1,2),PKW(pB1,4),PKW(pB1,6)};pw3=(u32x4){PKW(pB1,8),PKW(pB1,10),PKW(pB1,12),PKW(pB1,14)};
    SBAR(); pv4(o,vb0+2*sl_cur,PAF(0),PAF(1),PAF(2),PAF(3)); }
  #undef PKW
  #undef PAF
  #undef VFR
  #undef PIN
  #undef MX3
  #undef GAPA
  #undef GAPB
  #undef EX
  #undef VRD
  #undef KRD
  #undef QRD
  #undef MF32
  #undef STEP
  #undef ENDW
  {auto rr=__builtin_amdgcn_permlane32_swap(__float_as_uint(l_reg),__float_as_uint(l_reg),false,false);l_reg=__uint_as_float(rr[0])+__uint_as_float(rr[1]);}
  if(hi==0)wsf[32+r32]=l_reg;asm volatile("s_waitcnt lgkmcnt(0)":::"memory");
  float rli[16];
  #pragma unroll
  for(int r=0;r<16;++r)rli[r]=__builtin_amdgcn_rcpf(wsf[32+CROWO(r)]);
  const long obase=(rowbase+q0+wid*QBLK)*DM+vcol;
  bf16*stg=(bf16*)(shm+WL_OST)+wid*2048;
  if(m==0){ bf16*Ow=O+obase;
    #pragma unroll
    for(int half=0;half<2;++half){
      #pragma unroll
      for(int r=0;r<16;++r){const int orow=CROWO(r);
        #pragma unroll
        for(int d0=0;d0<2;++d0)stg[orow*64+d0*32+r32]=__float2bfloat16(o[2*half+d0][r]*rli[r]);}
      asm volatile("s_waitcnt lgkmcnt(0)":::"memory");
      #pragma unroll
      for(int i=0;i<4;++i){const int row=i*8+(lane>>3),ch=lane&7; const u32x4 v=*(const u32x4*)(stg+row*64+ch*8); ATTN_STORE16(Ow+(long)row*DM+half*64+ch*8,v);}
      asm volatile("s_waitcnt lgkmcnt(0)":::"memory"); }
  } else {
    const bf16*O0w=CB.O0+obase; bf16*Aw=CB.A2+obase; const float lam=CB.lam;
    float df[2][4][8]; float ssq[4]={0.f,0.f,0.f,0.f};
    #pragma unroll
    for(int half=0;half<2;++half){
      u32x4 a[4];
      #pragma unroll
      for(int i=0;i<4;++i){const int row=i*8+(lane>>3),ch=lane&7; a[i]=*(const u32x4*)(O0w+(long)row*DM+half*64+ch*8);}
      #pragma unroll
      for(int r=0;r<16;++r){const int orow=CROWO(r);
        #pragma unroll
        for(int d0=0;d0<2;++d0)stg[orow*64+d0*32+r32]=__float2bfloat16(o[2*half+d0][r]*rli[r]);}
      asm volatile("s_waitcnt lgkmcnt(0)":::"memory");
      #pragma unroll
      for(int i=0;i<4;++i){const int row=i*8+(lane>>3),ch=lane&7; const u32x4 v=*(const u32x4*)(stg+row*64+ch*8);
        #pragma unroll
        for(int k=0;k<4;++k){ const float d0_=__uint_as_float(a[i][k]<<16)-lam*__uint_as_float(v[k]<<16), d1_=__uint_as_float(a[i][k]&0xffff0000u)-lam*__uint_as_float(v[k]&0xffff0000u);
          df[half][i][2*k]=d0_; df[half][i][2*k+1]=d1_; ssq[i]+=d0_*d0_; ssq[i]+=d1_*d1_; } }
      asm volatile("s_waitcnt lgkmcnt(0)":::"memory"); }
    #pragma unroll
    for(int i=0;i<4;++i){ float ss=ssq[i];
      ss+=__builtin_bit_cast(float,__builtin_amdgcn_update_dpp(0,__builtin_bit_cast(int,ss),0xB1,0xF,0xF,true));
      ss+=__builtin_bit_cast(float,__builtin_amdgcn_update_dpp(0,__builtin_bit_cast(int,ss),0x4E,0xF,0xF,true));
      ss+=__builtin_bit_cast(float,__builtin_amdgcn_update_dpp(0,__builtin_bit_cast(int,ss),0x141,0xF,0xF,true));
      ssq[i]=1.0f/sqrtf(ss*(1.0f/128.0f)+1e-5f); }
    #pragma unroll
    for(int half=0;half<2;++half){ const int ch=lane&7;
      const f32x4_t w0=*(const f32x4_t*)(CB.w+half*64+ch*8),w1=*(const f32x4_t*)(CB.w+half*64+ch*8+4);
      #pragma unroll
      for(int i=0;i<4;++i){const int row=i*8+(lane>>3); const float rs=ssq[i]; u32x4 ov;
        #pragma unroll
        for(int k=0;k<4;++k){ const float wa=(k<2?w0[2*k]:w1[2*k-4])*CB.mul, wb=(k<2?w0[2*k+1]:w1[2*k-3])*CB.mul; ov[k]=cvtpk_s(df[half][i][2*k]*rs*wa,df[half][i][2*k+1]*rs*wb); }
        ATTN_STORE16(Aw+(long)row*DM+half*64+ch*8,ov);} }
  }
  asm volatile("s_waitcnt lgkmcnt(0)\n\ts_barrier":::"memory");
  #undef DMA_K
  #undef DMA_V
  #undef CMASK
  #undef START
  #undef RESC
  #undef ROT
  #undef CROWO
}
constexpr int ATTNW_LDS_BYTES=WL_BYTES;
struct AttnUnitW { int b, qcol, vcol, m, qb; };
struct StaticOrderW {
  int vcu, G;
  __device__ __forceinline__ StaticOrderW(int grid,int vcu_):vcu(vcu_),G(grid){}
  __device__ __forceinline__ bool next(int i,AttnUnitW&u)const{
    int b,h,m,qb;
    if(G==256){ if(i>=16)return false; const int xcd=vcu>>5,l=vcu&31,s=l>>1,ip=i>>1,bh=xcd*16+8*(l&1)+ip; m=i&1; b=bh>>3; h=bh&7; qb=(ip&1)?s:15-s; }
    else { const int i2=i>>1,ci=vcu+G*(i2>>4); if(ci>=BATCH*8)return false; h=ci&7; m=i&1; b=ci>>3; qb=15-(i2&15); }
    u.b=b; u.qcol=(2*h+m)*64; u.vcol=h*128; u.m=m; u.qb=qb; return true; }
};
template<int THRL=8> __device__ __forceinline__ void attn_phase_w(char*lds,const AttnTensors&T,const StaticOrderW&S,const CombineW&CB,const int tid_){
  AttnUnitW u;
  for(int i=0;S.next(i,u);++i){ attn_unit_w<THRL>(u.b,u.qcol,u.vcol,u.qb,u.m,T.Q,T.K,T.V,T.O0,CB,lds,tid_); }
}
#undef SBAR
#undef WAIT_BAR
}

constexpr int NWAVES = 8;
constexpr int BATCH = 16, SEQ = 4096, D = 1024, M = BATCH * SEQ, DEPTH = 4;
constexpr int NEXP = 32, FF = 512;
constexpr int NSLOT_MAX = 2 * M + NEXP * 256, NBLK_MAX = NSLOT_MAX / 256;
constexpr float LN_EPS = 1e-5f;
constexpr float DN_ALPHA = 1.681792830507429f;
constexpr int HG_CHUNK = 32, HG_NCH = SEQ / HG_CHUNK;

constexpr size_t MiB = 1u << 20;
constexpr size_t WS_CTL = 0, CTL_ZERO_BYTES = 1 * MiB;
constexpr size_t WS_MOD = 1 * MiB;
constexpr size_t WS_ROPE_C = 3 * MiB, WS_ROPE_S = 3 * MiB + 512 * 1024;
constexpr size_t WS_RT = 4 * MiB;
constexpr size_t WS_EID = 5 * MiB;
constexpr size_t WS_WT = 5 * MiB + 512 * 1024;
constexpr size_t WS_TSLOT = 6 * MiB;
constexpr size_t WS_SLOTW = 6 * MiB + 512 * 1024;
constexpr size_t WS_BLKE = 7 * MiB + 128 * 1024;
constexpr size_t WS_STOK = 7 * MiB + 256 * 1024;
constexpr size_t WS_HGD = 8 * MiB;
constexpr size_t WS_WHIN = 16 * MiB;
constexpr size_t WS_WAIN = 32 * MiB;
constexpr size_t WS_WHOUT = 44 * MiB;
constexpr size_t WS_WAOUT = 48 * MiB;
constexpr size_t WS_W13 = 52 * MiB;
constexpr size_t WS_W2 = 116 * MiB;
constexpr size_t WS_BUF0 = 148 * MiB, BUFSZ = 128 * MiB;
constexpr size_t WS_WB2 = WS_BUF0 + 7 * BUFSZ;
constexpr size_t WS_END = WS_WB2 + 96 * MiB;
constexpr int CW_TMO = 0, CW_CODE = 1;
constexpr int CW_BAR = 4096;
constexpr int CW_CNT = 8192;
static_assert((CW_CNT + 4 * 256) * 4 <= (int)CTL_ZERO_BYTES, "ctl");

constexpr int RING_OFF = 0, RING_BYTES = 147456;
constexpr int LDSCTL_OFF = RING_BYTES, MISC_OFF = LDSCTL_OFF + 512;
constexpr int LDS_BYTES = RING_BYTES + 1024;
static_assert(MISC_OFF + 128 <= LDS_BYTES, "LDS map");
#define GAS __attribute__((address_space(1)))
#define LAS __attribute__((address_space(3)))
typedef unsigned short bf16;
typedef unsigned v4u __attribute__((ext_vector_type(4)));
typedef float f32x4 __attribute__((ext_vector_type(4)));
typedef short bf16x8 __attribute__((ext_vector_type(8)));
typedef GAS unsigned gu32;
typedef GAS unsigned long long gu64;
#define RLX_AGENT __ATOMIC_RELAXED, __HIP_MEMORY_SCOPE_AGENT
#define LDS_WAIT() asm volatile("s_waitcnt lgkmcnt(0)" ::: "memory")
#define VM_WAIT() asm volatile("s_waitcnt vmcnt(0)" ::: "memory")
__device__ __forceinline__ unsigned long long rt() { return __builtin_amdgcn_s_memrealtime(); }
__device__ __forceinline__ unsigned f2bf(float f) { unsigned u = __builtin_bit_cast(unsigned, f); return (u + 0x7fffu + ((u >> 16) & 1u)) >> 16; }
__device__ __forceinline__ unsigned pk2(float lo, float hi) { return f2bf(lo) | (f2bf(hi) << 16); }

#define XB_TMO      128
#define XB_XCNT(j)  (256  + 64 * (j))
#define XB_XSUB(j)  (1280 + 64 * (j))
#define XB_XGEN(j)  (2304 + 64 * (j))
#define XB_TOP      3328
#define XB_TOPGEN   3392
#define XCD_BAR_WORDS 3456
#define XB_SPIN_CAP (1u << 18)

__device__ __forceinline__ unsigned xb_ld(unsigned* p)              { return __hip_atomic_load(p, __ATOMIC_RELAXED, __HIP_MEMORY_SCOPE_AGENT); }
__device__ __forceinline__ unsigned xb_add(unsigned* p, unsigned v) { return __hip_atomic_fetch_add(p, v, __ATOMIC_RELAXED, __HIP_MEMORY_SCOPE_AGENT); }
__device__ __forceinline__ unsigned xb_xcc_id() { return (unsigned)__builtin_amdgcn_s_getreg((3 << 11) | 20) & 0xFu; }
#define XB_SPIN(cond, bar) do { unsigned _sp = 0; while (cond) { __builtin_amdgcn_s_sleep(1); \
    if ((++_sp & 255u) == 0u) { if (xb_ld(&(bar)[XB_TMO])) break; if (_sp > XB_SPIN_CAP) { atomicAdd(&(bar)[XB_TMO], 1u); break; } } } } while (0)

struct XcdBarrier {
    unsigned* bar; unsigned x;
    volatile LAS unsigned* st;
};

__device__ __forceinline__ XcdBarrier xcd_barrier_post(unsigned* bar, volatile LAS unsigned* st) {
    XcdBarrier b; b.bar = bar; b.x = xb_xcc_id(); b.st = st;
    if (threadIdx.x == 0) (void)xb_add(&bar[XB_XCNT(b.x)], 1u);
    return b;
}
__device__ __forceinline__ void xcd_barrier_complete(unsigned* bar, unsigned x, unsigned& nloc, unsigned& nx) {
    const unsigned G = gridDim.x * gridDim.y * gridDim.z;
    unsigned sum, cnt, mine, sp = 0u;
    for (;;) {
        sum = 0u; cnt = 0u; mine = 0u;
#pragma unroll
        for (unsigned j = 0; j < 16; ++j) { const unsigned c = xb_ld(&bar[XB_XCNT(j)]); sum += c; cnt += (c > 0u) ? 1u : 0u; mine = (j == x) ? c : mine; }
        if (sum == G) break;
        __builtin_amdgcn_s_sleep(1);
        if ((++sp & 255u) == 0u) { if (xb_ld(&bar[XB_TMO])) break; if (sp > XB_SPIN_CAP) { atomicAdd(&bar[XB_TMO], 1u); break; } }
    }
    nloc = mine > 0u ? mine : 1u; nx = cnt > 0u ? cnt : 1u;
}

__device__ __forceinline__ void xcd_barrier(const XcdBarrier& b, const int wave_s) {
    asm volatile("s_waitcnt vmcnt(0)" ::: "memory");
    __syncthreads();
    unsigned lane_; asm volatile("v_mbcnt_lo_u32_b32 %0, -1, 0\n\tv_mbcnt_hi_u32_b32 %0, -1, %0" : "=v"(lane_));
    if (wave_s == 0 && lane_ == 0u) {
        unsigned* bar = b.bar; asm volatile("" : "+s"(bar));
        __builtin_amdgcn_s_waitcnt(0);
        unsigned nloc = b.st[0], nx = b.st[1];
        if (nloc == 0u) { xcd_barrier_complete(bar, b.x, nloc, nx); b.st[0] = nloc; b.st[1] = nx; }
        const unsigned old = xb_add(&bar[XB_XSUB(b.x)], 1u);
        const unsigned gen = old / nloc;
        if (old + 1u == (gen + 1u) * nloc) {
            __builtin_amdgcn_fence(__ATOMIC_RELEASE, "agent");
            asm volatile("s_waitcnt vmcnt(0)" ::: "memory");
            const unsigned og = xb_add(&bar[XB_TOP], 1u);
            const unsigned tg = og / nx;
            if (og + 1u == (tg + 1u) * nx) xb_add(&bar[XB_TOPGEN], 1u);
            else XB_SPIN(xb_ld(&bar[XB_TOPGEN]) == tg, bar);
            __builtin_amdgcn_fence(__ATOMIC_ACQUIRE, "agent");
            xb_add(&bar[XB_XGEN(b.x)], 1u);
            asm volatile("s_waitcnt vmcnt(0)" ::: "memory");
        } else {
            XB_SPIN(xb_ld(&bar[XB_XGEN(b.x)]) == gen, bar);
            __builtin_amdgcn_fence(__ATOMIC_ACQUIRE, "agent");
            asm volatile("s_waitcnt vmcnt(0)" ::: "memory");
        }
    }
    __syncthreads();
}

struct Args { const float* in[21]; float* out; unsigned char* ws; int ph_lo, ph_hi; };
#define CAS __attribute__((address_space(4)))
struct KA { const CAS char* p;
    __device__ __forceinline__ const float* in(int k) const { return *(const float* const CAS*)(p + 8 * k); }
    __device__ __forceinline__ float* out() const { return *(float* const CAS*)(p + 8 * 21); }
    __device__ __forceinline__ unsigned char* ws() const { return *(unsigned char* const CAS*)(p + 8 * 22); }
    __device__ __forceinline__ int ph_lo() const { return *(const CAS int*)(p + 8 * 23); }
    __device__ __forceinline__ int ph_hi() const { return *(const CAS int*)(p + 8 * 23 + 4); }
};
__device__ __forceinline__ KA karg_fresh() { const CAS char* q = (const CAS char*)__builtin_amdgcn_kernarg_segment_ptr(); asm volatile("" : "+s"(q)); KA k; k.p = q; return k; }
struct Frame {
    LAS unsigned char* lds; volatile LAS unsigned* MISC; gu32* ctl;
    int tid, lane, wave, vcu, G, bx;
};
typedef unsigned long long u64;
typedef float f32x16 __attribute__((ext_vector_type(16)));
template <int CTRL> __device__ __forceinline__ float dpp_mov(float v) { return __builtin_bit_cast(float, __builtin_amdgcn_update_dpp(0, __builtin_bit_cast(int, v), CTRL, 0xF, 0xF, true)); }
__device__ __forceinline__ float row8_sum(float v) { v += dpp_mov<0xB1>(v); v += dpp_mov<0x4E>(v); v += dpp_mov<0x141>(v); return v; }
__device__ __forceinline__ float wave_sum(float v, int) { v = row8_sum(v); v += dpp_mov<0x140>(v);
    const float r0 = __builtin_bit_cast(float, __builtin_amdgcn_readlane(__builtin_bit_cast(int, v), 0)), r1 = __builtin_bit_cast(float, __builtin_amdgcn_readlane(__builtin_bit_cast(int, v), 16));
    const float r2 = __builtin_bit_cast(float, __builtin_amdgcn_readlane(__builtin_bit_cast(int, v), 32)), r3 = __builtin_bit_cast(float, __builtin_amdgcn_readlane(__builtin_bit_cast(int, v), 48));
    return (r0 + r1) + (r2 + r3); }
__device__ __forceinline__ float bf2f(unsigned b) { return __uint_as_float(b << 16); }
__device__ __forceinline__ float bflo(unsigned w) { return __uint_as_float(w << 16); }
__device__ __forceinline__ float bfhi(unsigned w) { return __uint_as_float(w & 0xffff0000u); }
__device__ __forceinline__ float fexp(float x) { return __builtin_amdgcn_exp2f(1.4426950408889634f * x); }
__device__ __forceinline__ float sigmoid_f(float x) { return __builtin_amdgcn_rcpf(1.0f + fexp(-x)); }
__device__ __forceinline__ unsigned pkbf(float lo, float hi) { return pg8::cvt_pk_bf16(lo, hi); }
typedef _Float16 f16x2_t __attribute__((ext_vector_type(2))); typedef float f32x2_t2 __attribute__((ext_vector_type(2)));
__device__ __forceinline__ unsigned pkh(float lo, float hi) { const f32x2_t2 v = {lo, hi}; return __builtin_bit_cast(unsigned, __builtin_convertvector(v, f16x2_t)); }
__device__ __forceinline__ f32x4 unpk_h4(u64 w) { const f16x2_t a = __builtin_bit_cast(f16x2_t, (unsigned)w), b = __builtin_bit_cast(f16x2_t, (unsigned)(w >> 32)); return (f32x4){(float)a[0], (float)a[1], (float)b[0], (float)b[1]}; }
__device__ __forceinline__ int swap23(int p) { return (p & ~12) | ((p & 4) << 1) | ((p & 8) >> 1); }
__device__ __forceinline__ int crow16(int i, int hh) { return (i & 3) + 8 * (i >> 2) + 4 * hh; }

struct MapId { __device__ __forceinline__ int operator()(int n) const { return n; } };
struct MapW13 { int add; __device__ __forceinline__ int operator()(int u) const { return ((u >> 7) << 8) + add + (u & 127); } };
struct MapHgrnIn { __device__ __forceinline__ int operator()(int n) const { return (n < 2048) ? ((n & ~1023) | swap23(n & 1023)) : n; } };
struct MapAttnIn { __device__ __forceinline__ int operator()(int n) const { if (n >= 2048) return n; const int part = n >> 10, c = n & 1023, hm = c >> 6, dim = c & 63;
    return part * 1024 + (hm >> 2) * 256 + (dim >> 5) * 128 + (hm & 3) * 32 + (dim & 31); } };
template <class MapF>
__device__ __forceinline__ void transpose_item(const float* W, int K, int N, bf16* WT, LAS float* scr, int item, int lane, MapF map) {
    const int nblk = N / 32, kb = item / nblk, nb = item % nblk, k0 = 64 * kb, n0 = 32 * nb;
#pragma unroll 8
    for (int i = 0; i < 32; ++i) { const int kk = 2 * i + (lane >> 5); scr[kk * 33 + (lane & 31)] = W[(size_t)(k0 + kk) * N + n0 + (lane & 31)]; }
    LDS_WAIT(); asm volatile("" ::: "memory");
    const int c = lane & 7;
#pragma unroll
    for (int j = 0; j < 4; ++j) { const int n = (lane >> 3) + 8 * j; const LAS float* s = scr + (8 * c) * 33 + n;
        v4u o; o.x = pkbf(s[0 * 33], s[1 * 33]); o.y = pkbf(s[2 * 33], s[3 * 33]); o.z = pkbf(s[4 * 33], s[5 * 33]); o.w = pkbf(s[6 * 33], s[7 * 33]);
        *(GAS v4u*)(WT + (size_t)map(n0 + n) * K + k0 + 8 * c) = o; }
    LDS_WAIT(); asm volatile("" ::: "memory");
}
__device__ __forceinline__ unsigned char* moe_wbuf(unsigned char* ws, int L) { return (L & 1) ? ws + WS_WB2 : ws + WS_W13; }
struct ConvItem { const float* W; bf16* WT; int K, N, k0, n0, add; };
__device__ __forceinline__ ConvItem conv_item(const KA a, int L, int it) {
    const int e = it / 768, r = it % 768; const size_t eo = (size_t)(L * 32 + e) * 1024 * 512; ConvItem c;
    bf16* W13 = (bf16*)moe_wbuf(a.ws(), L) + (size_t)e * 1024 * 1024; bf16* W2 = (bf16*)(moe_wbuf(a.ws(), L) + 64 * MiB) + (size_t)e * 1024 * 512;
    if (r < 512) { const int rr = r & 255; c.W = (r < 256 ? a.in(18) : a.in(19)) + eo; c.WT = W13; c.K = 1024; c.N = 512; c.k0 = 64 * (rr >> 4); c.n0 = 32 * (rr & 15); c.add = (r < 256) ? 0 : 128; }
    else { const int rr = r - 512; c.W = a.in(20) + eo; c.WT = W2; c.K = 512; c.N = 1024; c.k0 = 64 * (rr >> 5); c.n0 = 32 * (rr & 31); c.add = -1; }
    return c;
}
__device__ __forceinline__ void conv_load(const ConvItem& c, int lane, f32x4 (&v)[8]) {
#pragma unroll
    for (int i = 0; i < 8; ++i) v[i] = *(const f32x4*)(c.W + (size_t)(c.k0 + 8 * (lane >> 3) + i) * c.N + c.n0 + 4 * (lane & 7));
}
__device__ __forceinline__ void conv_store(const ConvItem& c, int lane, const f32x4 (&v)[8]) {
#pragma unroll
    for (int cc = 0; cc < 4; ++cc) { const int n = c.n0 + 4 * (lane & 7) + cc;
        const int row = (c.add == -1) ? n : (c.add == -2) ? MapHgrnIn{}(n) : (c.add == -3) ? MapAttnIn{}(n) : (((n >> 7) << 8) + c.add + (n & 127));
        v4u o; o.x = pkbf(v[0][cc], v[1][cc]); o.y = pkbf(v[2][cc], v[3][cc]); o.z = pkbf(v[4][cc], v[5][cc]); o.w = pkbf(v[6][cc], v[7][cc]);
        *(GAS v4u*)(c.WT + (size_t)row * c.K + c.k0 + 8 * (lane >> 3)) = o; }
}
constexpr int MIX_HIN = 16 * 128, MIX_OUT = 16 * 32, MIX_AIN = 16 * 96, MIX_PER = MIX_HIN + MIX_OUT + MIX_AIN + MIX_OUT, MIX_FIRST = MIX_HIN + MIX_OUT;
__device__ __forceinline__ ConvItem mix_item(const KA a, int it) {
    const int j = it / MIX_PER; int r = it % MIX_PER; ConvItem c; c.K = 1024;
    if (r < MIX_HIN) { c.W = a.in(6) + (size_t)j * 1024 * 4096; c.WT = (bf16*)(a.ws() + WS_WHIN) + (size_t)j * 4096 * 1024; c.N = 4096; c.add = -2; }
    else if ((r -= MIX_HIN) < MIX_OUT) { c.W = a.in(7) + (size_t)j * 1024 * 1024; c.WT = (bf16*)(a.ws() + WS_WHOUT) + (size_t)j * 1024 * 1024; c.N = 1024; c.add = -1; }
    else if ((r -= MIX_OUT) < MIX_AIN) { c.W = a.in(10) + (size_t)j * 1024 * 3072; c.WT = (bf16*)(a.ws() + WS_WAIN) + (size_t)j * 3072 * 1024; c.N = 3072; c.add = -3; }
    else { r -= MIX_AIN; c.W = a.in(11) + (size_t)j * 1024 * 1024; c.WT = (bf16*)(a.ws() + WS_WAOUT) + (size_t)j * 1024 * 1024; c.N = 1024; c.add = -1; }
    const int nblk = c.N / 32; c.k0 = 64 * (r / nblk); c.n0 = 32 * (r % nblk);
    return c;
}
__device__ __forceinline__ void convert_mixer(const KA a, int lane, int first, int last, int gw, int ngw) {
    for (int it = first + gw; it < last; it += ngw) { const ConvItem c = mix_item(a, it); f32x4 v[8]; conv_load(c, lane, v); conv_store(c, lane, v); }
}
__device__ __forceinline__ void convert_moe(Frame& F, const KA a, int L, int cw, int nconv) {
    const int gw = F.vcu * nconv + cw, NGW = F.G * nconv;
    if (gw >= 32 * 768) return;
    ConvItem cur = conv_item(a, L, gw); f32x4 v[8]; conv_load(cur, F.lane, v);
    for (int it = gw; it < 32 * 768; it += NGW) {
        const int nx = it + NGW; ConvItem nxt = cur; f32x4 vn[8];
        if (nx < 32 * 768) { nxt = conv_item(a, L, nx); conv_load(nxt, F.lane, vn); }
        conv_store(cur, F.lane, v);
        cur = nxt;
#pragma unroll
        for (int i = 0; i < 8; ++i) v[i] = vn[i];
    }
}

__device__ __forceinline__ void phase_p0a(Frame& F, const KA a) {
    const int gw = F.vcu * NWAVES + F.wave, NGW = F.G * NWAVES;
    const float* c = a.in(1); const float* ada_w = a.in(2); const float* ada_b = a.in(3);
    float* mod = (float*)(a.ws() + WS_MOD);
    if (F.vcu < 4 * 24) {
        LAS float* sl = (LAS float*)(F.lds + RING_OFF + 65536);
        for (int idx = F.tid; idx < 16 * 1024; idx += 512) { const int k = idx & 1023, b = idx >> 10; const float cv = c[idx]; sl[k * 16 + b] = cv * sigmoid_f(cv); }
        __syncthreads();
    }
    for (int it = F.vcu; it < 4 * 24; it += F.G) {
        const int i = it / 24, nb = it % 24;
        f32x4 acc[16];
#pragma unroll
        for (int b = 0; b < 16; ++b) acc[b] = (f32x4){0.f, 0.f, 0.f, 0.f};
        const float* wp = ada_w + ((size_t)i * 1024 + F.wave * 128) * 6144 + nb * 256 + 4 * F.lane;
        const LAS float* sw = (const LAS float*)(F.lds + RING_OFF + 65536) + F.wave * 128 * 16;
        for (int k0 = 0; k0 < 128; k0 += 8) {
            f32x4 w4[8];
#pragma unroll
            for (int kk = 0; kk < 8; ++kk) w4[kk] = *(const f32x4*)(wp + (size_t)(k0 + kk) * 6144);
#pragma unroll
            for (int kk = 0; kk < 8; ++kk) {
                const LAS f32x4* sp = (const LAS f32x4*)(sw + (k0 + kk) * 16);
                const f32x4 s0 = sp[0], s1 = sp[1], s2 = sp[2], s3 = sp[3];
#pragma unroll
                for (int b = 0; b < 4; ++b) { acc[b] += w4[kk] * s0[b]; acc[4 + b] += w4[kk] * s1[b]; acc[8 + b] += w4[kk] * s2[b]; acc[12 + b] += w4[kk] * s3[b]; }
            }
        }
        LAS float* red = (LAS float*)(F.lds + RING_OFF);
#pragma unroll
        for (int hb = 0; hb < 2; ++hb) {
#pragma unroll
            for (int b = 0; b < 8; ++b) *(LAS f32x4*)(red + (F.wave * 8 + b) * 256 + 4 * F.lane) = acc[8 * hb + b];
            __syncthreads();
            for (int r = 0; r < 4; ++r) { const int idx = F.tid + 512 * r, b = idx >> 8, col = idx & 255; float s = ada_b[i * 6144 + nb * 256 + col];
#pragma unroll
                for (int w = 0; w < 8; ++w) s += red[(w * 8 + b) * 256 + col];
                mod[((size_t)i * 16 + 8 * hb + b) * 6144 + nb * 256 + col] = s; }
            __syncthreads();
        }
    }
    {
        float* cs = (float*)(a.ws() + WS_ROPE_C); float* sn = (float*)(a.ws() + WS_ROPE_S);
        for (int idx = gw * 64 + F.lane; idx < SEQ * 32; idx += NGW * 64) {
            const int pos = idx >> 5, j = idx & 31;
            double f = 1.0; const double r1 = 0.74989420933245582730;
            double p = r1;
#pragma unroll
            for (int bit = 0; bit < 5; ++bit) { if (j & (1 << bit)) f *= p; p *= p; }
            const double ang = (double)pos * f;
            const double kq = __builtin_rint(ang * 0.63661977236758134308);
            const double rr = (ang - kq * 1.57079632679489655800e+00) - kq * 6.12323399573676603587e-17;
            const double r2 = rr * rr;
            const double sp = rr * (1.0 + r2 * (-1.0 / 6 + r2 * (1.0 / 120 + r2 * (-1.0 / 5040 + r2 * (1.0 / 362880 + r2 * (-1.0 / 39916800 + r2 * (1.0 / 6227020800.0)))))));
            const double cp = 1.0 + r2 * (-0.5 + r2 * (1.0 / 24 + r2 * (-1.0 / 720 + r2 * (1.0 / 40320 + r2 * (-1.0 / 3628800 + r2 * (1.0 / 479001600.0 + r2 * (-1.0 / 87178291200.0)))))));
            const int q = ((int)kq) & 3;
            const double sv = (q == 0) ? sp : (q == 1) ? cp : (q == 2) ? -sp : -cp;
            const double cv = (q == 0) ? cp : (q == 1) ? -sp : (q == 2) ? -cp : sp;
            cs[idx] = (float)cv; sn[idx] = (float)sv;
        }
    }
    {
        float* rt = (float*)(a.ws() + WS_RT); const float* rgw = a.in(14); const float* rew = a.in(16);
        for (int idx = gw * 64 + F.lane; idx < 4 * 36 * 1024; idx += NGW * 64) {
            const int l = idx / 36864, e = (idx >> 10) % 36, k = idx & 1023;
            rt[idx] = (e < 4) ? rgw[((size_t)l * 1024 + k) * 4 + e] : rew[((size_t)l * 1024 + k) * 32 + (e - 4)];
        }
    }
    convert_mixer(a, F.lane, 0, MIX_FIRST, gw, NGW);
}

__device__ __forceinline__ void phase_p0b(Frame& F, const KA a) {
    const int gw = F.vcu * NWAVES + F.wave, NGW = F.G * NWAVES;
    const float* x = a.in(0); const float* mod = (const float*)(a.ws() + WS_MOD); bf16* h = (bf16*)(a.ws() + WS_BUF0);
#define P0B_LOAD(X, t_) do { _Pragma("unroll") for (int tt = 0; tt < 4; ++tt) _Pragma("unroll") for (int j = 0; j < 4; ++j) X[tt][j] = *(const f32x4*)(x + (size_t)((t_) + tt) * D + 4 * F.lane + 256 * j); } while (0)
#define P0B_MOD(SH, SC, t_) do { const float* mb = mod + (size_t)((t_) >> 12) * 6144; \
        _Pragma("unroll") for (int j = 0; j < 4; ++j) { const int col = 4 * F.lane + 256 * j; SH[j] = *(const f32x4*)(mb + col); SC[j] = *(const f32x4*)(mb + 1024 + col); } } while (0)
#define P0B_PROC(X, SH, SC, t_) do { \
        _Pragma("unroll") for (int j = 0; j < 4; ++j) { const int col = 4 * F.lane + 256 * j; const f32x4 sh = SH[j], sc = SC[j] + 1.0f; \
            _Pragma("unroll") for (int tt = 0; tt < 4; ++tt) { const f32x4 hv = X[tt][j] * sc + sh; \
                *(u64*)(h + (size_t)((t_) + tt) * D + col) = (u64)pkbf(hv[0], hv[1]) | ((u64)pkbf(hv[2], hv[3]) << 32); } } } while (0)
    const int step = NGW * 4;
    f32x4 xa[4][4], xb[4][4];
    int t0 = gw * 4;
    if (t0 < M) P0B_LOAD(xa, t0);
    f32x4 shv[4], scv[4];
    for (; t0 < M; t0 += 2 * step) {
        const int t1 = t0 + step, t2 = t1 + step;
        P0B_MOD(shv, scv, t0);
        asm volatile("" :: "v"(xa[3][3]), "v"(scv[3]));
        if (t1 < M) P0B_LOAD(xb, t1);
        P0B_PROC(xa, shv, scv, t0);
        if (t1 < M) { P0B_MOD(shv, scv, t1); asm volatile("" :: "v"(xb[3][3]), "v"(scv[3])); }
        if (t2 < M) P0B_LOAD(xa, t2);
        if (t1 < M) P0B_PROC(xb, shv, scv, t1);
    }
#undef P0B_MOD
#undef P0B_LOAD
#undef P0B_PROC
}

__device__ __forceinline__ void phase_hgrn_prep(Frame& F, const KA a, int j) {
    bf16* Qb = (bf16*)(a.ws() + WS_BUF0 + 1 * BUFSZ); bf16* Zb = (bf16*)(a.ws() + WS_BUF0 + 2 * BUFSZ);
    float* dd = (float*)(a.ws() + WS_HGD);
    const float* lb = a.in(8);
    const int grp = F.tid >> 7, jt = F.tid & 127, col = 8 * jt, h = col >> 7, pos = col & 127;
    const int ch0 = swap23(pos), ch1 = swap23(pos + 4);
    float oml[8];
#pragma unroll
    for (int c = 0; c < 8; ++c) oml[c] = 1.0f;
    if (j == 1) {
#pragma unroll
        for (int c = 0; c < 4; ++c) { oml[c] = 1.0f - sigmoid_f(lb[1024 + h * 128 + ch0 + c] - lb[h * 128 + ch0 + c]); oml[4 + c] = 1.0f - sigmoid_f(lb[1024 + h * 128 + ch1 + c] - lb[h * 128 + ch1 + c]); } }
    constexpr int NIT = BATCH * HG_NCH;
    float bs[8];
#define HP_IT(s_) (F.vcu + F.G * (grp + 4 * ((s_) >> 2)))
#define HP_LOAD(Z, Q, s_) do { int it_ = HP_IT(s_); it_ = (it_ < NIT) ? it_ : 0;        \
        const size_t tk_ = (size_t)(it_ >> 7) * SEQ + (it_ & (HG_NCH - 1)) * HG_CHUNK + 8 * ((s_) & 3); \
        _Pragma("unroll") for (int t = 0; t < 8; ++t) { Z[t] = *(const v4u*)(Zb + (tk_ + t) * D + col); Q[t] = *(const v4u*)(Qb + (tk_ + t) * D + col); } } while (0)
#define HP_PROC(Z, Q, s_) do { const int it_ = HP_IT(s_); const int chunk_ = it_ & (HG_NCH - 1), b_ = it_ >> 7; const size_t tk_ = (size_t)b_ * SEQ + chunk_ * HG_CHUNK + 8 * ((s_) & 3); \
        if (((s_) & 3) == 0) { _Pragma("unroll") for (int c = 0; c < 8; ++c) bs[c] = 0.f; } \
        _Pragma("unroll") for (int t = 0; t < 8; ++t) { v4u qo, ko; \
            _Pragma("unroll") for (int i = 0; i < 4; ++i) { \
                const float k0 = oml[2 * i] * sigmoid_f(-bflo(Z[t][i])), k1 = oml[2 * i + 1] * sigmoid_f(-bfhi(Z[t][i])); \
                const float g0 = (k0 < 0.05f) ? -k0 * (1.0f + k0 * (0.5f + k0 * (0.33333333f + k0 * 0.25f))) : 0.69314718056f * __builtin_amdgcn_logf(1.0f - k0); \
                const float g1 = (k1 < 0.05f) ? -k1 * (1.0f + k1 * (0.5f + k1 * (0.33333333f + k1 * 0.25f))) : 0.69314718056f * __builtin_amdgcn_logf(1.0f - k1); \
                bs[2 * i] += g0; bs[2 * i + 1] += g1; \
                qo[i] = pkbf(bflo(Q[t][i]) * fexp(bs[2 * i]), bfhi(Q[t][i]) * fexp(bs[2 * i + 1])); \
                ko[i] = pkbf(k0 * fexp(fminf(-bs[2 * i], 80.0f)), k1 * fexp(fminf(-bs[2 * i + 1], 80.0f))); } \
            *(v4u*)(Qb + (tk_ + t) * D + col) = qo; *(v4u*)(Zb + (tk_ + t) * D + col) = ko; } \
        if (((s_) & 3) == 3) { const size_t rowbase_ = ((size_t)(b_ * 8 + h) * HG_NCH + chunk_) * 128; \
            *(f32x4*)(dd + rowbase_ + ch0) = (f32x4){fexp(bs[0]), fexp(bs[1]), fexp(bs[2]), fexp(bs[3])}; *(f32x4*)(dd + rowbase_ + ch1) = (f32x4){fexp(bs[4]), fexp(bs[5]), fexp(bs[6]), fexp(bs[7])}; } } while (0)
    v4u za[8], qa[8], zb[8], qb[8];
    int s = 0;
    HP_LOAD(za, qa, 0);
    for (; HP_IT(s) < NIT; s += 2) {
        asm volatile("" :: "v"(za[7]), "v"(qa[7]));
        HP_LOAD(zb, qb, s + 1);
        HP_PROC(za, qa, s);
        asm volatile("" :: "v"(zb[7]), "v"(qb[7]));
        HP_LOAD(za, qa, s + 2);
        HP_PROC(zb, qb, s + 1);
    }
#undef HP_IT
#undef HP_LOAD
#undef HP_PROC
}

#define MFMA32(a_, b_, c_) __builtin_amdgcn_mfma_f32_32x32x16_bf16((a_), (b_), (c_), 0, 0, 0)
typedef float f32x2_pk __attribute__((ext_vector_type(2))); typedef __bf16 bf16x2_pk __attribute__((ext_vector_type(2)));
__device__ __forceinline__ unsigned cvt2(float lo, float hi) { const f32x2_pk v = {lo, hi}; return __builtin_bit_cast(unsigned, __builtin_convertvector(v, bf16x2_pk)); }
__device__ __forceinline__ bf16x8 pack_half(const f32x16& x, int s) {
    v4u p; p.x = cvt2(x[8 * s + 0], x[8 * s + 1]); p.y = cvt2(x[8 * s + 2], x[8 * s + 3]); p.z = cvt2(x[8 * s + 4], x[8 * s + 5]); p.w = cvt2(x[8 * s + 6], x[8 * s + 7]);
    return __builtin_bit_cast(bf16x8, p);
}
constexpr int HS_Q = 0, HS_K = 8192, HS_V = 16384, HS_D = 18432, HS_BUF = 18944, HS_NBUF = 3, HS_WAVE = HS_NBUF * HS_BUF, HS_OST = 2 * HS_WAVE, HS_CONV = HS_OST + 4096, HS_NCONV = 6;
static_assert(HS_CONV <= RING_BYTES, "scan LDS map");
typedef short s16x4_t __attribute__((ext_vector_type(4)));
__device__ __forceinline__ void phase_hgrn_scan(Frame& F, const KA a, int layer) {
    const bf16* Qt = (const bf16*)(a.ws() + WS_BUF0 + 1 * BUFSZ); const bf16* Kt = (const bf16*)(a.ws() + WS_BUF0 + 2 * BUFSZ);
    const bf16* Vb = (const bf16*)(a.ws() + WS_BUF0 + 3 * BUFSZ); const float* dd = (const float*)(a.ws() + WS_HGD);
    bf16* O = (bf16*)(a.ws() + WS_BUF0 + 6 * BUFSZ);
    if (F.wave >= 2) {
        if (F.wave < 2 + HS_NCONV) { if (layer == 0) convert_mixer(a, F.lane, MIX_FIRST, 2 * MIX_PER, F.vcu * HS_NCONV + F.wave - 2, F.G * HS_NCONV);
            convert_moe(F, a, layer, F.wave - 2, HS_NCONV); convert_moe(F, a, layer + 1, F.wave - 2, HS_NCONV); }
        return; }
    LAS unsigned char* ring = F.lds + RING_OFF + F.wave * HS_WAVE;
    LAS unsigned char* ost = F.lds + RING_OFF + HS_OST + F.wave * 2048;
    for (int u = F.vcu; u < BATCH * 8 * 2; u += F.G) {
        const int bh = u >> 1, vt = (u & 1) * 2 + F.wave, b = bh >> 3, h = bh & 7;
        const int r = F.lane & 31, hh = F.lane >> 5;
        f32x16 S[4];
#pragma unroll
        for (int kt = 0; kt < 4; ++kt)
#pragma unroll
            for (int i = 0; i < 16; ++i) S[kt][i] = 0.f;
        const bf16* Qp = Qt + ((size_t)b * SEQ + r) * D + h * 128 + 8 * hh;
        const bf16* Kp = Kt + ((size_t)b * SEQ + r) * D + h * 128 + 8 * hh;
        const bf16* Vp = Vb + ((size_t)b * SEQ + (F.lane >> 2)) * D + h * 128 + 32 * vt + 8 * (F.lane & 3);
        const float* dp = dd + (size_t)bh * HG_NCH * 128 + F.lane;
        bf16* op2 = O + ((size_t)b * SEQ + 4 * hh) * D + h * 128 + 32 * vt + r;
        const int i16 = F.lane & 15, blk = (F.lane >> 4) & 1, tq = i16 >> 2, tp = i16 & 3, tpp = ((tp & 1) << 1) | (tp >> 1);
        const int trb = HS_K + blk * 1024 + (tpp >> 1) * 512 + (4 * hh + tq) * 16 + (tpp & 1) * 8;
        const int vtrb = HS_V + (4 * hh + tq) * 64 + 32 * blk + 8 * tp;
#define HS_DMA(c_, buf_) do { LAS unsigned char* bb_ = ring + (buf_) * HS_BUF; \
        _Pragma("unroll") for (int ks = 0; ks < 8; ++ks) { __builtin_amdgcn_global_load_lds((const unsigned*)(Qp + (size_t)(c_) * 32 * D + 16 * ks), (LAS unsigned*)(bb_ + HS_Q + ks * 1024), 16, 0, 0); \
                                                        __builtin_amdgcn_global_load_lds((const unsigned*)(Kp + (size_t)(c_) * 32 * D + 16 * ks), (LAS unsigned*)(bb_ + HS_K + ks * 1024), 16, 0, 0); } \
        _Pragma("unroll") for (int st = 0; st < 2; ++st) __builtin_amdgcn_global_load_lds((const unsigned*)(Vp + ((size_t)(c_) * 32 + 16 * st) * D), (LAS unsigned*)(bb_ + HS_V + st * 1024), 16, 0, 0); \
        _Pragma("unroll") for (int q_ = 0; q_ < 2; ++q_) __builtin_amdgcn_global_load_lds((const unsigned*)(dp + (size_t)(c_) * 128 + 64 * q_), (LAS unsigned*)(bb_ + HS_D + q_ * 256), 4, 0, 0); } while (0)
        asm volatile("s_waitcnt lgkmcnt(0)" ::: "memory");
        HS_DMA(0, 0); HS_DMA(1, 1);
        int bcur = 0, bnext = 2;
        for (int c = 0; c < HG_NCH; ++c) {
            const int cn = (c + 2 < HG_NCH) ? c + 2 : HG_NCH - 1;
            HS_DMA(cn, bnext);
            if (c == 0) asm volatile("s_waitcnt vmcnt(40)" ::: "memory");
            else asm volatile("s_waitcnt vmcnt(56)" ::: "memory");
            const LAS unsigned char* bbase = ring + bcur * HS_BUF;
            const LAS unsigned char* bb = bbase + F.lane * 16;
            bf16x8 Qf[8], Kf[8], Vf[2];
            { const unsigned vba = (unsigned)(uintptr_t)(bbase + vtrb); s16x4_t v0, v1, v2, v3;
              asm volatile("ds_read_b64_tr_b16 %0, %1 offset:0" : "=&v"(v0) : "v"(vba) : "memory"); asm volatile("ds_read_b64_tr_b16 %0, %1 offset:512" : "=&v"(v1) : "v"(vba) : "memory");
              asm volatile("ds_read_b64_tr_b16 %0, %1 offset:1024" : "=&v"(v2) : "v"(vba) : "memory"); asm volatile("ds_read_b64_tr_b16 %0, %1 offset:1536" : "=&v"(v3) : "v"(vba) : "memory");
#pragma unroll
              for (int ks = 0; ks < 8; ++ks) { Qf[ks] = *(const LAS bf16x8*)(bb + HS_Q + ks * 1024); Kf[ks] = *(const LAS bf16x8*)(bb + HS_K + ks * 1024); }
              asm volatile("s_waitcnt lgkmcnt(0)" : "+v"(v0), "+v"(v1), "+v"(v2), "+v"(v3) :: "memory");
              Vf[0] = (bf16x8){v0[0], v0[1], v0[2], v0[3], v1[0], v1[1], v1[2], v1[3]}; Vf[1] = (bf16x8){v2[0], v2[1], v2[2], v2[3], v3[0], v3[1], v3[2], v3[3]}; }
            f32x16 sc0, sc1;
#pragma unroll
            for (int i = 0; i < 16; ++i) { sc0[i] = 0.f; sc1[i] = 0.f; }
#pragma unroll
            for (int ks = 0; ks < 8; ks += 2) { sc0 = MFMA32(Kf[ks], Qf[ks], sc0); sc1 = MFMA32(Kf[ks + 1], Qf[ks + 1], sc1); }
#pragma unroll
            for (int i = 0; i < 16; ++i) sc0[i] = (crow16(i, hh) > r) ? 0.f : (sc0[i] + sc1[i]);
            f32x16 oA, oB;
#pragma unroll
            for (int i = 0; i < 16; ++i) { oA[i] = 0.f; oB[i] = 0.f; }
#pragma unroll
            for (int kt = 0; kt < 4; kt += 2)
#pragma unroll
                for (int st = 0; st < 2; ++st) { oA = MFMA32(Qf[2 * kt + st], pack_half(S[kt], st), oA); oB = MFMA32(Qf[2 * kt + 2 + st], pack_half(S[kt + 1], st), oB); }
            oA = MFMA32(pack_half(sc0, 0), Vf[0], oA); oB = MFMA32(pack_half(sc0, 1), Vf[1], oB);
            const LAS float* dl = (const LAS float*)(bbase + HS_D) + 4 * hh;
            const unsigned tba = (unsigned)(uintptr_t)(bbase + trb);
            s16x4_t klo[8], khi[8];
#pragma unroll
            for (int f = 0; f < 8; ++f) {
                asm volatile("ds_read_b64_tr_b16 %0, %1 offset:%c2" : "=&v"(klo[f]) : "v"(tba), "i"((f >> 1) * 2048 + (f & 1) * 256) : "memory");
                asm volatile("ds_read_b64_tr_b16 %0, %1 offset:%c2" : "=&v"(khi[f]) : "v"(tba), "i"((f >> 1) * 2048 + (f & 1) * 256 + 128) : "memory"); }
            asm volatile("s_waitcnt lgkmcnt(0)" : "+v"(klo[0]), "+v"(klo[1]), "+v"(klo[2]), "+v"(klo[3]), "+v"(klo[4]), "+v"(klo[5]), "+v"(klo[6]), "+v"(klo[7]) :: "memory");
            asm volatile("" : "+v"(khi[0]), "+v"(khi[1]), "+v"(khi[2]), "+v"(khi[3]), "+v"(khi[4]), "+v"(khi[5]), "+v"(khi[6]), "+v"(khi[7]) :: "memory");
#pragma unroll
            for (int kt = 0; kt < 4; ++kt) {
#pragma unroll
                for (int st = 0; st < 2; ++st) { const int f = kt * 2 + st;
                    const bf16x8 kh = (bf16x8){klo[f][0], klo[f][1], klo[f][2], klo[f][3], khi[f][0], khi[f][1], khi[f][2], khi[f][3]};
                    S[kt] = MFMA32(kh, Vf[st], S[kt]); }
#pragma unroll
                for (int g = 0; g < 4; ++g) { const f32x4 dv = *(const LAS f32x4*)(dl + 32 * kt + 8 * g);
#pragma unroll
                    for (int i = 0; i < 4; ++i) S[kt][4 * g + i] *= dv[i]; }
            }
#pragma unroll
            for (int i = 0; i < 16; ++i) *(unsigned short*)(op2 + ((size_t)c * 32 + crow16(i, 0)) * D) = (unsigned short)(pkbf(oA[i] + oB[i], 0.f) & 0xffffu);
            asm volatile("s_waitcnt lgkmcnt(0)" ::: "memory");
            bcur = (bcur == HS_NBUF - 1) ? 0 : bcur + 1; bnext = (bnext == HS_NBUF - 1) ? 0 : bnext + 1;
        }
        asm volatile("s_waitcnt vmcnt(0)" ::: "memory");
#undef HS_DMA
    }
}

template <int MODE>
__device__ __forceinline__ void phase_normgate(Frame& F, const bf16* P0, const bf16* P1, bf16* out, const float* w, float lam, float mul) {
    const int gw = F.vcu * NWAVES + F.wave, NGW = F.G * NWAVES;
    float wv[16];
#pragma unroll
    for (int i = 0; i < 16; ++i) wv[i] = w[((16 * F.lane) & 127) + i] * mul;
    const int tpw = ((M + NGW - 1) / NGW + 3) & ~3;
#define NG_LOAD(A0, A1, B0, B1, t_) do { _Pragma("unroll") for (int tt = 0; tt < 4; ++tt) { const size_t off = (size_t)((t_) + tt) * D + 16 * F.lane; \
        A0[tt] = *(const v4u*)(P0 + off); A1[tt] = *(const v4u*)(P0 + off + 8); B0[tt] = *(const v4u*)(P1 + off); B1[tt] = *(const v4u*)(P1 + off + 8); } } while (0)
#define NG_PROC(A0, A1, B0, B1, t_) do { _Pragma("unroll") for (int tt = 0; tt < 4; ++tt) { \
            float av[16], bv[16]; \
            _Pragma("unroll") for (int i = 0; i < 4; ++i) { av[2 * i] = bflo(A0[tt][i]); av[2 * i + 1] = bfhi(A0[tt][i]); av[8 + 2 * i] = bflo(A1[tt][i]); av[8 + 2 * i + 1] = bfhi(A1[tt][i]); \
                                          bv[2 * i] = bflo(B0[tt][i]); bv[2 * i + 1] = bfhi(B0[tt][i]); bv[8 + 2 * i] = bflo(B1[tt][i]); bv[8 + 2 * i + 1] = bfhi(B1[tt][i]); } \
            float ss = 0.f; \
            _Pragma("unroll") for (int i = 0; i < 16; ++i) { if (MODE == 1) av[i] = av[i] - lam * bv[i]; ss += av[i] * av[i]; } \
            ss = row8_sum(ss); \
            const float rs = 1.0f / sqrtf(ss * (1.0f / 128.0f) + LN_EPS); \
            v4u o0, o1; \
            _Pragma("unroll") for (int i = 0; i < 8; ++i) { float v0 = av[2 * i] * rs * wv[2 * i], v1 = av[2 * i + 1] * rs * wv[2 * i + 1]; \
                if (MODE == 0) { v0 *= bv[2 * i] * sigmoid_f(bv[2 * i]); v1 *= bv[2 * i + 1] * sigmoid_f(bv[2 * i + 1]); } \
                if (i < 4) o0[i] = pkbf(v0, v1); else o1[i - 4] = pkbf(v0, v1); } \
            const size_t off = (size_t)((t_) + tt) * D + 16 * F.lane; \
            *(v4u*)(out + off) = o0; *(v4u*)(out + off + 8) = o1; } } while (0)
    const int tend = ((gw + 1) * tpw < M) ? (gw + 1) * tpw : M;
    v4u a0[4], a1[4], b0[4], b1[4], c0[4], c1[4], e0[4], e1[4];
    int t0 = gw * tpw;
    if (t0 < tend) NG_LOAD(a0, a1, b0, b1, t0);
    for (; t0 < tend; t0 += 8) {
        asm volatile("" :: "v"(a1[3]), "v"(b1[3]));
        if (t0 + 4 < tend) NG_LOAD(c0, c1, e0, e1, t0 + 4);
        NG_PROC(a0, a1, b0, b1, t0);
        if (t0 + 4 < tend) asm volatile("" :: "v"(c1[3]), "v"(e1[3]));
        if (t0 + 8 < tend) NG_LOAD(a0, a1, b0, b1, t0 + 8);
        if (t0 + 4 < tend) NG_PROC(c0, c1, e0, e1, t0 + 4);
    }
#undef NG_LOAD
#undef NG_PROC
}

__device__ __forceinline__ void phase_l1(Frame& F, const KA a, int layer, const float* xin, const bool dry) {
    const int gw = F.vcu * NWAVES + F.wave, NGW = F.G * NWAVES;
    LAS float* Wr = (LAS float*)(F.lds + RING_OFF);
    LAS unsigned* hist = (LAS unsigned*)(F.lds + LDSCTL_OFF);
    { const f32x4* src = (const f32x4*)((const float*)(a.ws() + WS_RT) + (size_t)layer * 36 * 1024);
      f32x4 tmp[18];
#pragma unroll
      for (int k = 0; k < 18; ++k) tmp[k] = src[F.tid + 512 * k];
#pragma unroll
      for (int k = 0; k < 18; ++k) *(LAS f32x4*)(Wr + 4 * (F.tid + 512 * k)) = tmp[k];
      if (F.tid < 32) hist[F.tid] = 0u; }
    __syncthreads();
    const float* mod = (const float*)(a.ws() + WS_MOD) + (size_t)layer * 16 * 6144;
    const bf16* yb = (const bf16*)(a.ws() + WS_BUF0 + 1 * BUFSZ);
    bf16* h2 = (bf16*)(a.ws() + WS_BUF0);
    const float* lng = a.in(4) + (size_t)(layer * 2 + 0) * D; const float* lnb = a.in(5) + (size_t)(layer * 2 + 0) * D;
    const float* bg = a.in(15) + layer * 4; const float* be = a.in(17) + layer * 32;
    int* eid = (int*)(a.ws() + WS_EID); float* wt = (float*)(a.ws() + WS_WT);
    const unsigned short* xhin = (const unsigned short*)a.out();
    unsigned short* xhout = (unsigned short*)(a.ws() + WS_BUF0 + 1 * BUFSZ);
    const int tpw = ((M + NGW - 1) / NGW + 3) & ~3;
    int curb = -1; f32x4 g1v[4], lgv[4], lbv[4], scv[4], shv[4];
    for (int t0 = gw * tpw; t0 < (gw + 1) * tpw && t0 < M; t0 += 4) {
        const int b = t0 >> 12;
        if (b != curb) { curb = b; const float* mb = mod + (size_t)b * 6144;
#pragma unroll
            for (int j = 0; j < 4; ++j) { const int col = 4 * F.lane + 256 * j; g1v[j] = *(const f32x4*)(mb + 2048 + col); lgv[j] = *(const f32x4*)(lng + col); lbv[j] = *(const f32x4*)(lnb + col);
                scv[j] = *(const f32x4*)(mb + 4096 + col) + 1.0f; shv[j] = *(const f32x4*)(mb + 3072 + col); } }
        f32x4 hv[4][4];
        {
            f32x4 v[4][4]; float s[4] = {0.f, 0.f, 0.f, 0.f};
            u64 yw[4][4];
#pragma unroll
            for (int j = 0; j < 4; ++j)
#pragma unroll
                for (int tt = 0; tt < 4; ++tt) yw[tt][j] = *(const u64*)(yb + (size_t)(t0 + tt) * D + 4 * F.lane + 256 * j);
            if (layer == 0) {
#pragma unroll
                for (int j = 0; j < 4; ++j)
#pragma unroll
                    for (int tt = 0; tt < 4; ++tt) v[tt][j] = *(const f32x4*)(xin + (size_t)(t0 + tt) * D + 4 * F.lane + 256 * j);
            } else { u64 xr[4][4];
#pragma unroll
                for (int j = 0; j < 4; ++j)
#pragma unroll
                    for (int tt = 0; tt < 4; ++tt) xr[tt][j] = *(const u64*)(xhin + (size_t)(t0 + tt) * D + 4 * F.lane + 256 * j);
#pragma unroll
                for (int j = 0; j < 4; ++j)
#pragma unroll
                    for (int tt = 0; tt < 4; ++tt) v[tt][j] = unpk_h4(xr[tt][j]);
            }
#pragma unroll
            for (int j = 0; j < 4; ++j) { const f32x4 g1 = g1v[j];
#pragma unroll
                for (int tt = 0; tt < 4; ++tt) { const u64 y_ = yw[tt][j];
                    f32x4 yv; yv[0] = bflo((unsigned)y_); yv[1] = bfhi((unsigned)y_); yv[2] = bflo((unsigned)(y_ >> 32)); yv[3] = bfhi((unsigned)(y_ >> 32));
                    v[tt][j] = v[tt][j] * DN_ALPHA + g1 * yv; s[tt] += (v[tt][j][0] + v[tt][j][1]) + (v[tt][j][2] + v[tt][j][3]); } }
            float rstd[4];
#pragma unroll
            for (int tt = 0; tt < 4; ++tt) { const float mean = wave_sum(s[tt], F.lane) * (1.0f / D); float s2 = 0.f;
#pragma unroll
                for (int j = 0; j < 4; ++j) { v[tt][j] = v[tt][j] - mean; s2 += (v[tt][j][0] * v[tt][j][0] + v[tt][j][1] * v[tt][j][1]) + (v[tt][j][2] * v[tt][j][2] + v[tt][j][3] * v[tt][j][3]); }
                rstd[tt] = __builtin_amdgcn_rsqf(wave_sum(s2, F.lane) * (1.0f / D) + LN_EPS); }
#pragma unroll
            for (int j = 0; j < 4; ++j) { const int col = 4 * F.lane + 256 * j;
                const f32x4 lg_ = lgv[j], lb_ = lbv[j], sc2 = scv[j], sh2 = shv[j];
#pragma unroll
                for (int tt = 0; tt < 4; ++tt) { const size_t ro = (size_t)(t0 + tt) * D;
                    const f32x4 xo = v[tt][j] * rstd[tt] * lg_ + lb_;
                    *(u64*)(xhout + ro + col) = (u64)pkh(xo[0], xo[1]) | ((u64)pkh(xo[2], xo[3]) << 32);
                    const f32x4 hh2 = xo * sc2 + sh2; hv[tt][j] = hh2;
                    *(u64*)(h2 + ro + col) = (u64)pkbf(hh2[0], hh2[1]) | ((u64)pkbf(hh2[2], hh2[3]) << 32); } }
        }
        float gl[4][4];
        { f32x4 w[4][4];
#pragma unroll
          for (int g = 0; g < 4; ++g)
#pragma unroll
              for (int j = 0; j < 4; ++j) w[g][j] = *(const LAS f32x4*)(Wr + g * 1024 + 4 * F.lane + 256 * j);
#pragma unroll
          for (int tt = 0; tt < 4; ++tt)
#pragma unroll
              for (int g = 0; g < 4; ++g) { float s0 = 0.f;
#pragma unroll
                  for (int j = 0; j < 4; ++j) s0 += (hv[tt][j][0] * w[g][j][0] + hv[tt][j][1] * w[g][j][1]) + (hv[tt][j][2] * w[g][j][2] + hv[tt][j][3] * w[g][j][3]);
                  gl[tt][g] = wave_sum(s0, F.lane) + bg[g]; } }
#pragma unroll
        for (int tt = 0; tt < 4; ++tt) {
            int gi = 0; float gm = gl[tt][0];
#pragma unroll
            for (int g = 1; g < 4; ++g) if (gl[tt][g] > gm) { gm = gl[tt][g]; gi = g; }
            float gs = 0.f;
#pragma unroll
            for (int g = 0; g < 4; ++g) gs += fexp(gl[tt][g] - gm);
            const float gw_ = __builtin_amdgcn_rcpf(gs);
            gi = __builtin_amdgcn_readfirstlane(gi);
            float el[8];
#pragma unroll
            for (int half = 0; half < 2; ++half) { f32x4 w[4][4]; const LAS float* wrow = Wr + (4 + gi * 8 + half * 4) * 1024 + 4 * F.lane;
#pragma unroll
                for (int q = 0; q < 4; ++q)
#pragma unroll
                    for (int j = 0; j < 4; ++j) w[q][j] = *(const LAS f32x4*)(wrow + q * 1024 + 256 * j);
#pragma unroll
                for (int q = 0; q < 4; ++q) { float s0 = 0.f;
#pragma unroll
                    for (int j = 0; j < 4; ++j) s0 += (hv[tt][j][0] * w[q][j][0] + hv[tt][j][1] * w[q][j][1]) + (hv[tt][j][2] * w[q][j][2] + hv[tt][j][3] * w[q][j][3]);
                    el[half * 4 + q] = wave_sum(s0, F.lane) + be[gi * 8 + half * 4 + q]; } }
            int i0 = 0; float m0 = el[0];
#pragma unroll
            for (int q = 1; q < 8; ++q) if (el[q] > m0) { m0 = el[q]; i0 = q; }
            int i1 = -1; float m1 = -INFINITY;
#pragma unroll
            for (int q = 0; q < 8; ++q) if (q != i0 && el[q] > m1) { m1 = el[q]; i1 = q; }
            const float p1 = fexp(m1 - m0); const float rr_ = __builtin_amdgcn_rcpf(1.0f + p1); const float w0 = gw_ * rr_, w1 = gw_ * p1 * rr_;
            if (F.lane == 0) { const int e0 = gi * 8 + i0, e1 = gi * 8 + i1, tok = t0 + tt;
                *(int2*)(eid + 2 * tok) = make_int2(e0, e1); *(float2*)(wt + 2 * tok) = make_float2(w0, w1);
                __hip_atomic_fetch_add(&hist[e0], 1u, __ATOMIC_RELAXED, __HIP_MEMORY_SCOPE_WORKGROUP); __hip_atomic_fetch_add(&hist[e1], 1u, __ATOMIC_RELAXED, __HIP_MEMORY_SCOPE_WORKGROUP); }
        }
    }
    __syncthreads();
    if (F.tid < 32 && !dry) { const unsigned c = hist[F.tid]; if (c) __hip_atomic_fetch_add(F.ctl + CW_CNT + 256 * layer + F.tid, c, RLX_AGENT); }
}

__device__ __forceinline__ void phase_m2(Frame& F, const KA a, int layer) {
    LAS int* pstart = (LAS int*)(F.lds + RING_OFF);
    LAS unsigned* lhist = (LAS unsigned*)(F.lds + RING_OFF + 256);
    LAS int* lbase = (LAS int*)(F.lds + RING_OFF + 512);
    int* blk_e = (int*)(a.ws() + WS_BLKE) + layer * 1024;
    LAS int* cntl = (LAS int*)(F.lds + RING_OFF + 768);
    if (F.tid < 32) cntl[F.tid] = (int)__hip_atomic_load(F.ctl + CW_CNT + 256 * layer + F.tid, RLX_AGENT);
    __syncthreads();
    if (F.tid == 0) { int off = 0;
#pragma unroll 1
        for (int e = 0; e < 32; ++e) { pstart[e] = off; off += ((cntl[e] + 255) >> 8) << 8; }
        pstart[32] = off;
        if (F.bx == 0) __hip_atomic_store(F.ctl + CW_CNT + 256 * layer + 128, (unsigned)(off >> 8), RLX_AGENT); }
    __syncthreads();
    if (F.bx == 0) { const int nblk = pstart[32] >> 8;
        for (int blk = F.tid; blk < nblk; blk += NWAVES * 64) { int e = 0;
#pragma unroll 1
            for (int k = 1; k < 32; ++k) e = (pstart[k] <= blk * 256) ? k : e;
            blk_e[blk] = e; } }
    const int* eid = (const int*)(a.ws() + WS_EID); const float* wt = (const float*)(a.ws() + WS_WT);
    int* tslot = (int*)(a.ws() + WS_TSLOT); float* slotw = (float*)(a.ws() + WS_SLOTW);
    int* stok = (int*)(a.ws() + WS_STOK);
    for (int e = F.vcu; e < 32; e += F.G) { const int c = cntl[e];
        for (int s = pstart[e] + c + F.tid; s < pstart[e + 1]; s += NWAVES * 64) stok[s] = 0; }
    for (int chunk = F.vcu; chunk < M / 256; chunk += F.G) {
        if (F.tid < 32) lhist[F.tid] = 0u;
        __syncthreads();
        const int pi = chunk * 512 + F.tid;
        const int e = eid[pi];
        const unsigned rank = __hip_atomic_fetch_add(&lhist[e], 1u, __ATOMIC_RELAXED, __HIP_MEMORY_SCOPE_WORKGROUP);
        __syncthreads();
        if (F.tid < 32) { const unsigned c = lhist[F.tid]; lbase[F.tid] = pstart[F.tid] + (c ? (int)__hip_atomic_fetch_add(F.ctl + CW_CNT + 256 * layer + 64 + F.tid, c, RLX_AGENT) : 0); }
        __syncthreads();
        const int slot = lbase[e] + (int)rank;
        tslot[pi] = slot; slotw[slot] = wt[pi]; stok[slot] = pi >> 1;
        __syncthreads();
    }
}

__device__ __forceinline__ void phase_l2(Frame& F, const KA a, int layer) {
    const int gw = F.vcu * NWAVES + F.wave, NGW = F.G * NWAVES;
    const float* mod = (const float*)(a.ws() + WS_MOD) + (size_t)layer * 16 * 6144;
    const bf16* ys = (const bf16*)(a.ws() + WS_BUF0 + 2 * BUFSZ); const int* tslot = (const int*)(a.ws() + WS_TSLOT);
    bf16* hn = (bf16*)(a.ws() + WS_BUF0);
    const float* lng = a.in(4) + (size_t)(layer * 2 + 1) * D; const float* lnb = a.in(5) + (size_t)(layer * 2 + 1) * D;
    float* x = a.out(); unsigned short* xho = (unsigned short*)a.out(); const unsigned short* xh = (const unsigned short*)(a.ws() + WS_BUF0 + 1 * BUFSZ);
    const int mlay = (layer < DEPTH - 1) ? 16 * 6144 : 0;
    const int tpw = ((M + NGW - 1) / NGW + 3) & ~3;
    for (int t0 = gw * tpw; t0 < (gw + 1) * tpw && t0 < M; t0 += 4) {
        const int b = t0 >> 12; const float* mb = mod + (size_t)b * 6144;
        int sl[8];
        { const int4 s0 = *(const int4*)(tslot + 2 * t0), s1 = *(const int4*)(tslot + 2 * t0 + 4); sl[0] = s0.x; sl[1] = s0.y; sl[2] = s0.z; sl[3] = s0.w; sl[4] = s1.x; sl[5] = s1.y; sl[6] = s1.z; sl[7] = s1.w; }
        u64 xr[4][4], y0r[4][4], y1r[4][4];
#pragma unroll
        for (int j = 0; j < 4; ++j) { const int col = 4 * F.lane + 256 * j;
#pragma unroll
            for (int tt = 0; tt < 4; ++tt) { xr[tt][j] = *(const u64*)(xh + (size_t)(t0 + tt) * D + col);
                y0r[tt][j] = *(const u64*)(ys + (size_t)sl[2 * tt] * D + col); y1r[tt][j] = *(const u64*)(ys + (size_t)sl[2 * tt + 1] * D + col); } }
        f32x4 g2v[4];
#pragma unroll
        for (int j = 0; j < 4; ++j) g2v[j] = *(const f32x4*)(mb + 5120 + 4 * F.lane + 256 * j);
        asm volatile("" ::: "memory");
        f32x4 v[4][4]; float s[4] = {0.f, 0.f, 0.f, 0.f};
#pragma unroll
        for (int j = 0; j < 4; ++j) { const f32x4 g2 = g2v[j];
#pragma unroll
            for (int tt = 0; tt < 4; ++tt) {
                const f32x4 xv = unpk_h4(xr[tt][j]); const u64 y0 = y0r[tt][j], y1 = y1r[tt][j];
                f32x4 yv; yv[0] = bflo((unsigned)y0) + bflo((unsigned)y1); yv[1] = bfhi((unsigned)y0) + bfhi((unsigned)y1);
                yv[2] = bflo((unsigned)(y0 >> 32)) + bflo((unsigned)(y1 >> 32)); yv[3] = bfhi((unsigned)(y0 >> 32)) + bfhi((unsigned)(y1 >> 32));
                v[tt][j] = xv * DN_ALPHA + g2 * yv; s[tt] += (v[tt][j][0] + v[tt][j][1]) + (v[tt][j][2] + v[tt][j][3]); } }
        f32x4 lgv[4], lbv[4], scv[4], shv[4];
#pragma unroll
        for (int j = 0; j < 4; ++j) { const int col = 4 * F.lane + 256 * j; lgv[j] = *(const f32x4*)(lng + col); lbv[j] = *(const f32x4*)(lnb + col);
            scv[j] = *(const f32x4*)(mb + mlay + 1024 + col); shv[j] = *(const f32x4*)(mb + mlay + col); }
        asm volatile("" ::: "memory");
        float rstd[4];
#pragma unroll
        for (int tt = 0; tt < 4; ++tt) { const float mean = wave_sum(s[tt], F.lane) * (1.0f / D); float s2 = 0.f;
#pragma unroll
            for (int j = 0; j < 4; ++j) { v[tt][j] = v[tt][j] - mean; s2 += (v[tt][j][0] * v[tt][j][0] + v[tt][j][1] * v[tt][j][1]) + (v[tt][j][2] * v[tt][j][2] + v[tt][j][3] * v[tt][j][3]); }
            rstd[tt] = __builtin_amdgcn_rsqf(wave_sum(s2, F.lane) * (1.0f / D) + LN_EPS); }
        if (layer == DEPTH - 1) {
#pragma unroll
            for (int j = 0; j < 4; ++j) { const int col = 4 * F.lane + 256 * j;
#pragma unroll
                for (int tt = 0; tt < 4; ++tt) *(f32x4*)(x + (size_t)(t0 + tt) * D + col) = v[tt][j] * rstd[tt] * lgv[j] + lbv[j]; }
        } else {
#pragma unroll
            for (int j = 0; j < 4; ++j) { const int col = 4 * F.lane + 256 * j;
#pragma unroll
                for (int tt = 0; tt < 4; ++tt) { const size_t ro = (size_t)(t0 + tt) * D;
                    const f32x4 xo = v[tt][j] * rstd[tt] * lgv[j] + lbv[j];
                    *(u64*)(xho + ro + col) = (u64)pkh(xo[0], xo[1]) | ((u64)pkh(xo[2], xo[3]) << 32);
                    const f32x4 hv = xo * (scv[j] + 1.0f) + shv[j];
                    *(u64*)(hn + ro + col) = (u64)pkbf(hv[0], hv[1]) | ((u64)pkbf(hv[2], hv[3]) << 32); } }
        }
    }
}

#ifndef MK_SEPARATE
#define MK_SEPARATE 0
#endif
constexpr int N_PHASES = 2 + 10 * DEPTH;
#ifndef PH_MASK
#define PH_MASK 0xFFFFF
#endif
#define PH_ON(n) (((PH_MASK) >> (n)) & 1)
#ifndef DBL_MASK
#define DBL_MASK 0
#endif
#define DBL(n) for (int rep_ = 0; rep_ < 1 + (((DBL_MASK) >> (n)) & 1); ++rep_)
__global__ void __launch_bounds__(NWAVES * 64, 2) fwd_kernel(Args args) {
    extern __shared__ __attribute__((aligned(16))) unsigned char lds[];
    const int wave_s = __builtin_amdgcn_readfirstlane((int)threadIdx.x >> 6);
    gu32* const ctl0 = (gu32*)(karg_fresh().ws() + WS_CTL);
    for (int u = threadIdx.x; u < (LDS_BYTES - LDSCTL_OFF) / 4; u += NWAVES * 64) ((LAS unsigned*)((LAS unsigned char*)lds + LDSCTL_OFF))[u] = 0u;
    __syncthreads();
    XcdBarrier bar; bar.bar = (unsigned*)(ctl0 + CW_BAR); bar.x = 0; bar.st = nullptr;
    if (!MK_SEPARATE) bar = xcd_barrier_post((unsigned*)(ctl0 + CW_BAR), (volatile LAS unsigned*)((LAS unsigned char*)lds + MISC_OFF) + 8);
    const int lo = karg_fresh().ph_lo(), hi = karg_fresh().ph_hi();
    const bool PANEL = !MK_SEPARATE && gridDim.x == (unsigned)(M / 256);
#define IN(k) (lo <= (k) && (k) < hi)
#define FRESH() const KA ka = karg_fresh(); unsigned char* const ws = ka.ws(); (void)ws; Frame F; { int t_, g_ = gridDim.x, bx_ = blockIdx.x; asm volatile("v_mbcnt_lo_u32_b32 %0, -1, 0\n\tv_mbcnt_hi_u32_b32 %0, -1, %0" : "=v"(t_)); asm volatile("" : "+s"(g_), "+s"(bx_)); t_ |= wave_s << 6; \
        F.lds = (LAS unsigned char*)lds; F.MISC = (volatile LAS unsigned*)(F.lds + MISC_OFF); F.ctl = (gu32*)(ws + WS_CTL); F.tid = t_; F.lane = t_ & 63; F.wave = __builtin_amdgcn_readfirstlane(t_ >> 6); \
        F.G = g_; F.bx = bx_; F.vcu = (g_ % 8 == 0) ? (bx_ % 8) * (g_ / 8) + bx_ / 8 : bx_; }
#ifndef DBL_BARRIER
#define DBL_BARRIER 0
#endif
#define SEAM(k) do { if (IN(k) && IN((k) + 1)) { if (MK_SEPARATE) { } else { xcd_barrier(bar, wave_s); if (DBL_BARRIER) xcd_barrier(bar, wave_s); } } } while (0)
#define BUF(i) ((bf16*)(ws + WS_BUF0 + (size_t)(i) * BUFSZ))

    if (PH_ON(0) && IN(0)) { FRESH(); DBL(0) phase_p0a(F, ka); }
    SEAM(0);
    if (PH_ON(1) && IN(1)) { FRESH(); DBL(1) phase_p0b(F, ka); }
    SEAM(1);
    for (int i = 0; i < DEPTH; ++i) {
        const int pb = 2 + 10 * i, j = i >> 1;
        if ((i & 1) == 0) {
            if (PH_ON(2) && IN(pb)) { FRESH();
                pg8::Gemm g{BUF(0), (const bf16*)(ws + WS_WHIN) + (size_t)j * 4096 * 1024, M, 4096, D, 0, nullptr}; pg8::StaticOrder S; S.init(M, 4096, F.G, F.bx);
                pg8::EpiBf16<0> E{BUF(1), D, nullptr, D, BUFSZ / 2, 1.0f};
                DBL(2) pg8::gemm_phase<pg8::EpiBf16<0>, pg8::StaticOrder, true, true>(F.lds + RING_OFF, g, S, E, F.tid);
            }
            SEAM(pb);
            if (PH_ON(3) && IN(pb + 1)) { FRESH(); phase_hgrn_prep(F, ka, j); }
            SEAM(pb + 1);
            if (PH_ON(4) && IN(pb + 2)) { FRESH(); DBL(4) phase_hgrn_scan(F, ka, i); }
            SEAM(pb + 2);
            if (PH_ON(5) && IN(pb + 3)) { FRESH(); phase_normgate<0>(F, BUF(6), BUF(4), BUF(4), ka.in(9) + j * 128, 0.f, 1.0f); }
            if (!PANEL) SEAM(pb + 3);
        } else {
            if (PH_ON(6) && IN(pb)) { FRESH();
                pg8::Gemm g{BUF(0), (const bf16*)(ws + WS_WAIN) + (size_t)j * 3072 * 1024, M, 3072, D, 0, nullptr}; pg8::StaticOrder S; S.init(M, 3072, F.G, F.bx);
                pg8::EpiRope E{BUF(1), BUF(2), BUF(3), (const float*)(ws + WS_ROPE_C), (const float*)(ws + WS_ROPE_S), attn_body::C2, SEQ - 1};
                DBL(6) pg8::gemm_phase<pg8::EpiRope, pg8::StaticOrder, true, true>(F.lds + RING_OFF, g, S, E, F.tid);
            }
            SEAM(pb);
            if (PH_ON(7) && IN(pb + 1)) { FRESH();
                const attn_body::AttnTensors AT{(const attn_body::bf16*)BUF(1), (const attn_body::bf16*)BUF(2), (const attn_body::bf16*)BUF(3), (attn_body::bf16*)BUF(4), (attn_body::bf16*)BUF(5)};
                static_assert(attn_body::ATTNW_LDS_BYTES <= RING_BYTES, "attention LDS");
                const attn_body::StaticOrderW S((int)F.G, F.vcu);
                const float* lp = ka.in(12) + j * 256;
                const float d1 = wave_sum(lp[F.lane] * lp[64 + F.lane], F.lane), d2 = wave_sum(lp[128 + F.lane] * lp[192 + F.lane], F.lane);
                const float linit = (j == 0) ? 0.35550906759f : 0.55605820415f;
                const float lam = fexp(d1) - fexp(d2) + linit;
                const attn_body::CombineW CB{(const attn_body::bf16*)BUF(4), (attn_body::bf16*)BUF(6), ka.in(13) + j * 128, lam, 1.0f - linit};
                DBL(7) attn_body::attn_phase_w<8>((char*)lds + RING_OFF, AT, S, CB, F.tid);
            }
            SEAM(pb + 1);
        }
        if (PH_ON(9) && IN(pb + 4)) { FRESH();
            const bf16* A = (i & 1) ? BUF(6) : BUF(4);
            const bf16* W = (i & 1) ? (const bf16*)(ws + WS_WAOUT) + (size_t)j * 1024 * 1024 : (const bf16*)(ws + WS_WHOUT) + (size_t)j * 1024 * 1024;
            pg8::Gemm g{A, W, M, D, D, 0, nullptr};
            pg8::EpiBf16<0> E{BUF(1), D, nullptr, 0, 0, 1.0f};
            if (PANEL) {
                __syncthreads();
                pg8::PanelOrder S{F.vcu, D / 256};
                pg8::gemm_phase<pg8::EpiBf16<0>, pg8::PanelOrder, true, true>(F.lds + RING_OFF, g, S, E, F.tid);
                __syncthreads();
            } else {
                pg8::StaticOrder S; S.init(M, D, F.G, F.bx);
                DBL(9) pg8::gemm_phase<pg8::EpiBf16<0>, pg8::StaticOrder, true, true>(F.lds + RING_OFF, g, S, E, F.tid);
            }
        }
        if (!PANEL) SEAM(pb + 4);
        if (PH_ON(10) && IN(pb + 5)) { FRESH(); phase_l1(F, ka, i, i == 0 ? ka.in(0) : (const float*)ka.out(), false);
            if ((((DBL_MASK) >> 10) & 1) && i == 0) { __syncthreads(); phase_l1(F, ka, i, ka.in(0), true); } }
        SEAM(pb + 5);
        if (PH_ON(11) && IN(pb + 6)) { FRESH(); phase_m2(F, ka, i); }
        SEAM(pb + 6);
        if (PH_ON(12) && IN(pb + 7)) { FRESH();
            const int nblk = (int)__hip_atomic_load(F.ctl + CW_CNT + 256 * i + 128, RLX_AGENT);
            pg8::Gemm g{BUF(0), (const bf16*)moe_wbuf(ws, i), nblk * 256, 1024, D, (size_t)1024 * 1024 * 2, (const int*)(ws + WS_STOK)};
            pg8::MoeOrder S; S.init(nblk * 256, 1024, F.G, F.bx); S.blk_e = (const int*)(ws + WS_BLKE) + i * 1024;
            pg8::EpiSwiGLU E{BUF(5)};
            DBL(12) pg8::gemm_phase<pg8::EpiSwiGLU, pg8::MoeOrder, true, true, true>(F.lds + RING_OFF, g, S, E, F.tid);
        }
        SEAM(pb + 7);
        if (PH_ON(13) && IN(pb + 8)) { FRESH();
            const int nblk = (int)__hip_atomic_load(F.ctl + CW_CNT + 256 * i + 128, RLX_AGENT);
            pg8::Gemm g{BUF(5), (const bf16*)(moe_wbuf(ws, i) + 64 * MiB), nblk * 256, 1024, FF, (size_t)1024 * 512 * 2, nullptr};
            pg8::MoeOrder S; S.init(nblk * 256, 1024, F.G, F.bx); S.blk_e = (const int*)(ws + WS_BLKE) + i * 1024;
            pg8::EpiRowScale E{BUF(2), (const float*)(ws + WS_SLOTW)};
            DBL(13) pg8::gemm_phase<pg8::EpiRowScale, pg8::MoeOrder, true, true>(F.lds + RING_OFF, g, S, E, F.tid);
        }
        SEAM(pb + 8);
        if (PH_ON(14) && IN(pb + 9)) { FRESH(); DBL(14) phase_l2(F, ka, i); }
        SEAM(pb + 9);
    }
#undef IN
#undef SEAM
}

extern "C" void kernel_launch(void* const* d_in, const int* in_sizes, int n_in, void* d_out, int out_size, void* d_ws, size_t ws_size, hipStream_t stream) {
    static int grid = 0;
    if (grid == 0) {
        if (n_in != 21 || in_sizes[0] != M * D || out_size != M * D || ws_size < WS_END) { fprintf(stderr, "kernel_launch: unexpected shapes / workspace (n_in %d, ws %zu, need %zu)\n", n_in, ws_size, (size_t)WS_END); grid = -1; return; }
        int dev = 0, cus = 0, per_cu = 0;
        if (hipGetDevice(&dev) != hipSuccess || hipDeviceGetAttribute(&cus, hipDeviceAttributeMultiprocessorCount, dev) != hipSuccess) { grid = -1; return; }
        if (hipFuncSetAttribute((const void*)fwd_kernel, hipFuncAttributeMaxDynamicSharedMemorySize, LDS_BYTES) != hipSuccess) { fprintf(stderr, "kernel_launch: hipFuncSetAttribute failed\n"); grid = -1; return; }
        if (hipOccupancyMaxActiveBlocksPerMultiprocessor(&per_cu, (const void*)fwd_kernel, NWAVES * 64, LDS_BYTES) != hipSuccess || per_cu < 1) fprintf(stderr, "kernel_launch: occupancy query says %d\n", per_cu);
        (void)hipGetLastError();
        grid = cus;
    }
    if (grid < 0) return;
    if (hipMemsetAsync((char*)d_ws + WS_CTL, 0, CTL_ZERO_BYTES, stream) != hipSuccess) return;
    Args a{};
    for (int i = 0; i < 21; ++i) a.in[i] = (const float*)d_in[i];
    a.out = (float*)d_out; a.ws = (unsigned char*)d_ws;
#if MK_SEPARATE
    for (int p = 0; p < N_PHASES; ++p) {
        if (p >= 2 && (((p - 2) / 10) & 1) == 1 && ((p - 2) % 10) == 3) continue;
        a.ph_lo = p; a.ph_hi = p + 1;
        hipLaunchKernelGGL(fwd_kernel, dim3(grid), dim3(NWAVES * 64), LDS_BYTES, stream, a);
    }
#else
    a.ph_lo = 0; a.ph_hi = N_PHASES;
    hipLaunchKernelGGL(fwd_kernel, dim3(grid), dim3(NWAVES * 64), LDS_BYTES, stream, a);
#endif
}
```

```cpp
#include <hip/hip_runtime.h>
#include <cstdio>
#include <cstdint>
namespace pg8 {
#define PG8_LAS __attribute__((address_space(3)))
typedef unsigned short bf16_t;
typedef short bf16x8 __attribute__((ext_vector_type(8)));
typedef float f32x4 __attribute__((ext_vector_type(4)));
typedef unsigned u32x4 __attribute__((ext_vector_type(4)));
constexpr int BM = 256, BK = 64, HALF = 128, HTB = HALF * BK * 2  , STAGE_BYTES = 8 * HTB, NXCD = 8, WGM = 8;

__host__ __device__ __forceinline__ int lds_byte(int r, int c) { const int st = (r >> 4) * 2 + (c >> 5), rr = r & 15, cc = c & 31, ob = rr * 64 + cc * 2; return st * 1024 + (ob ^ (((ob >> 9) & 1) << 5)); }
__host__ __device__ __forceinline__ void stage_rc(int b, int& R, int& C) { const int st = b / 1024, sb = b % 1024, swz = sb ^ (((sb >> 9) & 1) << 5); R = (st >> 1) * 16 + swz / 64; C = (st & 1) * 32 + (swz % 64) / 2; }
__host__ __device__ __forceinline__ int perm32(int rho) { const int n = rho >> 4, i = rho & 15; return 8 * (i >> 2) + 4 * n + (i & 3); }

struct Unit { int pm, pn, e; };
struct Gemm { const bf16_t* A; const bf16_t* Bt; int M, N, K; size_t estride; const int* arow; };

struct StaticOrder {
    int nM, nN, nwg, G, c;
    __host__ __device__ void init(int M, int N, int G_, int c_) { nM = M / BM; nN = N / BM; nwg = nM * nN; G = G_; c = c_; }
    __host__ __device__ bool next(int i, Unit& u) const {
        const long L = (long)i * G + c; if (L >= nwg) return false;
        int wgid = (int)L; { const int q = nwg / NXCD, r = nwg % NXCD, xcd = wgid % NXCD, off = wgid / NXCD; wgid = (xcd < r ? xcd * (q + 1) : r * (q + 1) + (xcd - r) * q) + off; }
        const int nig = WGM * nN, gid = wgid / nig, fm = gid * WGM, gsz = (nM - fm) < WGM ? (nM - fm) : WGM;
        u.pm = fm + ((wgid % nig) % gsz); u.pn = (wgid % nig) / gsz; u.e = 0; return true;
    }
    __device__ __forceinline__ void a_ready(const Unit&) const {}
    __device__ __forceinline__ void done(const Unit&) const {}
};

__device__ __forceinline__ unsigned cvt_pk_bf16(float lo, float hi) { unsigned r; asm volatile("v_cvt_pk_bf16_f32 %0, %1, %2" : "=v"(r) : "v"(lo), "v"(hi)); return r; }
typedef float f32x2 __attribute__((ext_vector_type(2)));
__device__ __forceinline__ f32x2 gelu_pk(f32x2 v) {
    const f32x2 av = __builtin_elementwise_abs(v), d = av * 0.2316418882f + 1.0f;
    f32x2 t; t.x = __builtin_amdgcn_rcpf(d.x); t.y = __builtin_amdgcn_rcpf(d.y);
    f32x2 q = t * 0.5307027145f + (-0.7265760135f); q = q * t + 0.7107068705f; q = q * t + (-0.142248368f); q = q * t + 0.127414796f; q = q * t;
    const f32x2 s = (v * v) * (-0.72134752044f);
    f32x2 e; e.x = __builtin_amdgcn_exp2f(s.x); e.y = __builtin_amdgcn_exp2f(s.y);
    const f32x2 m = v * (q * e), r = v - m;
    f32x2 o; o.x = v.x < 0.f ? m.x : r.x; o.y = v.y < 0.f ? m.y : r.y; return o;
}

template <int ACT  > struct EpiBf16 {
    static constexpr bool PERM = true, AFTER_DRAIN = false; static_assert(ACT == 0 || ACT == 1, "EpiBf16: ACT is 0 (none) or 1 (gelu_pk)");
    bf16_t* O; int ldc; const float* bias; int split_cols; size_t split_stride; float scale0;
    __device__ __forceinline__ void operator()(const f32x4 (&acc)[2][2][4][2], const Unit& u, int wr, int wc, int fr, int fq) const {
        const int row0 = u.pm * BM + wr * 64 + fr; int colt = u.pn * BM; bf16_t* base = O;
        float sc = 1.f; if (split_cols) { const int t = colt / split_cols; base += (size_t)t * split_stride; colt -= t * split_cols; if (t == 0) sc = scale0; }
        const int col0 = colt + wc * 32 + 8 * fq, bcol0 = u.pn * BM + wc * 32 + 8 * fq;
        f32x4 bv[2][2];
#pragma unroll
        for (int bj = 0; bj < 2; ++bj)
#pragma unroll
            for (int n = 0; n < 2; ++n) bv[bj][n] = bias ? *(const f32x4*)(bias + bcol0 + bj * HALF + 4 * n) : (f32x4){0.f, 0.f, 0.f, 0.f};
#pragma unroll
        for (int ai = 0; ai < 2; ++ai)
#pragma unroll
            for (int m = 0; m < 4; ++m) { bf16_t* rowp = base + (size_t)(row0 + ai * HALF + m * 16) * ldc + col0;
#pragma unroll
                for (int bj = 0; bj < 2; ++bj) { f32x4 v0 = acc[ai][bj][m][0] + bv[bj][0], v1 = acc[ai][bj][m][1] + bv[bj][1];
                    if (ACT == 1) { f32x2 a = gelu_pk((f32x2){v0[0], v0[1]}), b = gelu_pk((f32x2){v0[2], v0[3]}), c = gelu_pk((f32x2){v1[0], v1[1]}), d = gelu_pk((f32x2){v1[2], v1[3]});
                        v0 = (f32x4){a.x, a.y, b.x, b.y}; v1 = (f32x4){c.x, c.y, d.x, d.y}; }
                    v0 = v0 * sc; v1 = v1 * sc; u32x4 w; w.x = cvt_pk_bf16(v0[0], v0[1]); w.y = cvt_pk_bf16(v0[2], v0[3]); w.z = cvt_pk_bf16(v1[0], v1[1]); w.w = cvt_pk_bf16(v1[2], v1[3]);
                    *(u32x4*)(rowp + bj * HALF) = w; } }
    }
};

template <class Epi, class Sched, bool ALIGN_EPI = false, bool SP2 = false, bool GATHER = false>
__device__ __forceinline__ void gemm_phase(PG8_LAS unsigned char* lds, const Gemm g, const Sched& S, const Epi& E, const int tid) {
        const int wid = __builtin_amdgcn_readfirstlane(tid >> 6), lane = tid & 63, wr = wid >> 2, wc = wid & 3, fr = lane & 15, fq = lane >> 4;
    const int K = g.K, nt = K / BK;
    unsigned voffA[2], voffB[2], gcolb[2];
#pragma unroll
    for (int i = 0; i < 2; ++i) { int R, C; stage_rc(tid * 16 + i * 8192, R, C); const int Rb = Epi::PERM ? ((R & ~31) + perm32(R & 31)) : R;
        voffA[i] = GATHER ? (unsigned)R * 4u   : (unsigned)(R * K + C) * 2u; voffB[i] = (unsigned)(Rb * K + C) * 2u; gcolb[i] = (unsigned)C * 2u; }
    unsigned gA[2][2] = {{0u, 0u}, {0u, 0u}}, gN[2][2] = {{0u, 0u}, {0u, 0u}};
#define PG8_ROWS(dst, u_) do { const char* rb_ = (const char*)(g.arow + (size_t)(u_).pm * BM); unsigned raw_[2][2];        \
        _Pragma("unroll") for (int _h = 0; _h < 2; ++_h) _Pragma("unroll") for (int _i = 0; _i < 2; ++_i) raw_[_h][_i] = (unsigned)*(const int*)(rb_ + voffA[_i] + _h * HALF * 4); \
        _Pragma("unroll") for (int _h = 0; _h < 2; ++_h) _Pragma("unroll") for (int _i = 0; _i < 2; ++_i) dst[_h][_i] = raw_[_h][_i] * (unsigned)(K * 2) + gcolb[_i]; } while (0)
    const size_t kstep = (size_t)(BK * 2);
    const size_t hstep = (size_t)HALF * K * 2;
    const size_t tstep = 2 * hstep;
    const unsigned ldsw = (unsigned)wid * 1024u;
    const int aoff = lds_byte(wr * 64 + fr, fq * 8), boff = lds_byte(wc * 32 + fr, fq * 8);
#define PG8_SA(b, h) (((b) * 2 + (h)) * HTB)
#define PG8_SB(b, h) ((4 + (b) * 2 + (h)) * HTB)
#define PG8_STAGE(bufoff, gbase, voff) do { _Pragma("unroll") for (int _i = 0; _i < 2; ++_i) \
        __builtin_amdgcn_global_load_lds((const unsigned*)((const char*)(gbase) + (voff)[_i]), (PG8_LAS unsigned*)(lds + (bufoff) + ldsw + _i * 8192), 16, 0, 0); } while (0)
#define PG8_STAGEA(bufoff, gbase, h_, nx_) do { if constexpr (GATHER) { _Pragma("unroll") for (int _i = 0; _i < 2; ++_i) \
        __builtin_amdgcn_global_load_lds((const unsigned*)((const char*)(gbase) + ((nx_) ? gN[h_][_i] : gA[h_][_i])), (PG8_LAS unsigned*)(lds + (bufoff) + ldsw + _i * 8192), 16, 0, 0); } \
        else { PG8_STAGE(bufoff, (gbase) + ((h_) ? hstep : (size_t)0), voffA); } } while (0)
#define PG8_LDA(dst, b, h) do { _Pragma("unroll") for (int m = 0; m < 4; ++m) _Pragma("unroll") for (int k = 0; k < 2; ++k) dst[m][k] = *(const PG8_LAS bf16x8*)(lds + PG8_SA(b, h) + aoff + m * 2048 + k * 1024); } while (0)
#define PG8_LDB(dst, b, h) do { _Pragma("unroll") for (int n = 0; n < 2; ++n) _Pragma("unroll") for (int k = 0; k < 2; ++k) dst[n][k] = *(const PG8_LAS bf16x8*)(lds + PG8_SB(b, h) + boff + n * 2048 + k * 1024); } while (0)
#define PG8_MMA(ai, bj, At, Bt) do { __builtin_amdgcn_s_setprio(1); _Pragma("unroll") for (int m = 0; m < 4; ++m) _Pragma("unroll") for (int n = 0; n < 2; ++n) _Pragma("unroll") for (int k = 0; k < 2; ++k) \
        acc[ai][bj][m][n] = __builtin_amdgcn_mfma_f32_16x16x32_bf16(Bt[n][k], At[m][k], acc[ai][bj][m][n], 0, 0, 0); __builtin_amdgcn_s_setprio(0); } while (0)
#define PG8_WAIT_V(n) asm volatile("s_waitcnt vmcnt(" #n ")" ::: "memory")
#define PG8_WAIT_L(n) asm volatile("s_waitcnt lgkmcnt(" #n ")" ::: "memory")
#define PG8_BAR __builtin_amdgcn_s_barrier()
#define PG8_SCHED __builtin_amdgcn_sched_barrier(0)
    Unit cur, nxt; int ui = 0;
    if (!S.next(0, cur)) return;
    f32x4 acc[2][2][4][2];
#pragma unroll
    for (int a = 0; a < 2; ++a)
#pragma unroll
        for (int b = 0; b < 2; ++b)
#pragma unroll
            for (int m = 0; m < 4; ++m)
#pragma unroll
                for (int n = 0; n < 2; ++n) acc[a][b][m][n] = (f32x4){0.f, 0.f, 0.f, 0.f};
    bf16x8 At[4][2], B0[2][2], B1[2][2];
    const char* cA = (const char*)g.A + (GATHER ? (size_t)0 : (size_t)cur.pm * tstep); const char* cB = (const char*)g.Bt + (size_t)cur.e * g.estride + (size_t)cur.pn * tstep;
    S.a_ready(cur);
    if constexpr (GATHER) PG8_ROWS(gA, cur);
    if constexpr (SP2) {
        PG8_STAGE(PG8_SB(0, 0), cB, voffB); PG8_STAGE(PG8_SB(0, 1), cB + hstep, voffB); PG8_STAGEA(PG8_SA(0, 0), cA, 0, false); PG8_STAGEA(PG8_SA(0, 1), cA, 1, false);
        if (wr == 1) PG8_BAR;
        PG8_WAIT_V(2); PG8_BAR;
        PG8_STAGE(PG8_SB(1, 0), cB + kstep, voffB); PG8_STAGEA(PG8_SA(1, 0), cA + kstep, 0, false); PG8_STAGE(PG8_SB(1, 1), cB + hstep + kstep, voffB);
        PG8_WAIT_V(6); PG8_BAR;
    } else {
        PG8_STAGE(PG8_SB(0, 0), cB, voffB); PG8_STAGEA(PG8_SA(0, 0), cA, 0, false); PG8_STAGE(PG8_SB(0, 1), cB + hstep, voffB); PG8_STAGEA(PG8_SA(0, 1), cA, 1, false);
        if (wr == 1) PG8_BAR;
        PG8_WAIT_V(4); PG8_BAR;
        PG8_STAGE(PG8_SB(1, 0), cB + kstep, voffB); PG8_STAGEA(PG8_SA(1, 0), cA + kstep, 0, false); PG8_STAGE(PG8_SB(1, 1), cB + hstep + kstep, voffB);
        PG8_WAIT_V(6); PG8_BAR;
    }
    for (;;) {
        const bool has_next = S.next(ui + 1, nxt);
        const char* nA = has_next ? (const char*)g.A + (GATHER ? (size_t)0 : (size_t)nxt.pm * tstep) : cA;
        if constexpr (GATHER) { if (has_next) PG8_ROWS(gN, nxt); else { _Pragma("unroll") for (int _h = 0; _h < 2; ++_h) _Pragma("unroll") for (int _i = 0; _i < 2; ++_i) gN[_h][_i] = gA[_h][_i]; } } const char* nB = has_next ? (const char*)g.Bt + (size_t)nxt.e * g.estride + (size_t)nxt.pn * tstep : cB;
        for (int t = 0; t < nt; t += 2) {
            const bool last = (t == nt - 2);
            const char* a1 = cA + (size_t)(t + 1) * kstep;
            const char* a2 = last ? nA : cA + (size_t)(t + 2) * kstep; const char* b2 = last ? nB : cB + (size_t)(t + 2) * kstep;
            const char* a3 = a2 + kstep; const char* b3 = b2 + kstep;
            if (last && has_next) S.a_ready(nxt);
            if constexpr (SP2) {
            PG8_LDB(B0, 0, 0); PG8_LDB(B1, 0, 1); PG8_SCHED; PG8_LDA(At, 0, 0); PG8_STAGEA(PG8_SA(1, 1), a1, 1, false);
            PG8_WAIT_V(8); PG8_WAIT_L(0); PG8_BAR; PG8_MMA(0, 0, At, B0); PG8_MMA(0, 1, At, B1); PG8_BAR; PG8_SCHED;
            PG8_LDA(At, 0, 1); PG8_STAGE(PG8_SB(0, 0), b2, voffB); PG8_STAGE(PG8_SB(0, 1), b2 + hstep, voffB); PG8_STAGEA(PG8_SA(0, 0), a2, 0, last);
            PG8_WAIT_V(8); PG8_WAIT_L(0); PG8_BAR; PG8_MMA(1, 0, At, B0); PG8_MMA(1, 1, At, B1); PG8_BAR; PG8_SCHED;
            PG8_LDB(B0, 1, 0); PG8_LDB(B1, 1, 1); PG8_SCHED; PG8_LDA(At, 1, 0); PG8_STAGEA(PG8_SA(0, 1), a2, 1, last);
            PG8_WAIT_V(8); PG8_WAIT_L(0); PG8_BAR; PG8_MMA(0, 0, At, B0); PG8_MMA(0, 1, At, B1); PG8_BAR; PG8_SCHED;
            PG8_LDA(At, 1, 1); PG8_STAGE(PG8_SB(1, 0), b3, voffB); PG8_STAGE(PG8_SB(1, 1), b3 + hstep, voffB); PG8_STAGEA(PG8_SA(1, 0), a3, 0, last);
            PG8_WAIT_V(8); PG8_WAIT_L(0); PG8_BAR; PG8_MMA(1, 0, At, B0); PG8_MMA(1, 1, At, B1); PG8_BAR; PG8_SCHED;
            } else {
            PG8_LDB(B0, 0, 0); PG8_SCHED; PG8_LDA(At, 0, 0); PG8_STAGEA(PG8_SA(1, 1), a1, 1, false);
            PG8_WAIT_L(8); PG8_BAR; PG8_WAIT_L(0); PG8_MMA(0, 0, At, B0); PG8_BAR; PG8_SCHED;
            PG8_LDB(B1, 0, 1); PG8_STAGE(PG8_SB(0, 0), b2, voffB);
            PG8_BAR; PG8_WAIT_L(0); PG8_MMA(0, 1, At, B1); PG8_BAR;
            PG8_LDA(At, 0, 1); PG8_STAGEA(PG8_SA(0, 0), a2, 0, last);
            PG8_BAR; PG8_WAIT_L(0); PG8_MMA(1, 0, At, B0); PG8_BAR; PG8_SCHED;
            PG8_STAGE(PG8_SB(0, 1), b2 + hstep, voffB);
            PG8_WAIT_V(6); PG8_BAR; PG8_MMA(1, 1, At, B1); PG8_BAR;
            PG8_LDB(B0, 1, 0); PG8_SCHED; PG8_LDA(At, 1, 0); PG8_STAGEA(PG8_SA(0, 1), a2, 1, last);
            PG8_WAIT_L(8); PG8_BAR; PG8_WAIT_L(0); PG8_MMA(0, 0, At, B0); PG8_BAR; PG8_SCHED;
            PG8_LDB(B1, 1, 1); PG8_STAGE(PG8_SB(1, 0), b3, voffB);
            PG8_BAR; PG8_WAIT_L(0); PG8_MMA(0, 1, At, B1); PG8_BAR;
            PG8_LDA(At, 1, 1); PG8_STAGEA(PG8_SA(1, 0), a3, 0, last);
            PG8_BAR; PG8_WAIT_L(0); PG8_MMA(1, 0, At, B0); PG8_BAR; PG8_SCHED;
            PG8_STAGE(PG8_SB(1, 1), b3 + hstep, voffB);
            PG8_WAIT_V(6); PG8_BAR; PG8_MMA(1, 1, At, B1); PG8_BAR;
            }
        }
        if constexpr (ALIGN_EPI) { if (wr == 0) PG8_BAR; }
        if constexpr (!Epi::AFTER_DRAIN) { E(acc, cur, wr, wc, fr, fq); S.done(cur); }
        if (!has_next) break;
#pragma unroll
        for (int a = 0; a < 2; ++a)
#pragma unroll
            for (int b = 0; b < 2; ++b)
#pragma unroll
                for (int m = 0; m < 4; ++m)
#pragma unroll
                    for (int n = 0; n < 2; ++n) acc[a][b][m][n] = (f32x4){0.f, 0.f, 0.f, 0.f};
        cur = nxt; cA = nA; cB = nB; ++ui;
        if constexpr (GATHER) { _Pragma("unroll") for (int _h = 0; _h < 2; ++_h) _Pragma("unroll") for (int _i = 0; _i < 2; ++_i) gA[_h][_i] = gN[_h][_i]; }
        if constexpr (ALIGN_EPI) { if (wr == 1) PG8_BAR; }
    }
    PG8_WAIT_V(0);
    if constexpr (!ALIGN_EPI) { if (wr == 0) PG8_BAR; }
    PG8_BAR;
    if constexpr (Epi::AFTER_DRAIN) { E.fused(acc, cur, wr, wc, fr, fq, lds, wid, lane); S.done(cur); }
#undef PG8_SA
#undef PG8_SB
#undef PG8_STAGE
#undef PG8_STAGEA
#undef PG8_ROWS
#undef PG8_LDA
#undef PG8_LDB
#undef PG8_MMA
#undef PG8_WAIT_V
#undef PG8_WAIT_L
#undef PG8_BAR
#undef PG8_SCHED
}
}

namespace pg8 {
__device__ __forceinline__ u32x4 pack8(const f32x4 a, const f32x4 b) { u32x4 w; w.x = cvt_pk_bf16(a[0], a[1]); w.y = cvt_pk_bf16(a[2], a[3]); w.z = cvt_pk_bf16(b[0], b[1]); w.w = cvt_pk_bf16(b[2], b[3]); return w; }
__device__ __forceinline__ float silu_f(float x) { return x * __builtin_amdgcn_rcpf(1.0f + __builtin_amdgcn_exp2f(-1.4426950408889634f * x)); }

struct EpiRope {
    static constexpr bool PERM = true, AFTER_DRAIN = false;
    bf16_t* Q; bf16_t* Kb; bf16_t* Vb; const float* cs; const float* sn; float qscale; int seqmask;
    __device__ __forceinline__ void operator()(const f32x4 (&acc)[2][2][4][2], const Unit& u, int wr, int wc, int fr, int fq) const {
        const int row0 = u.pm * BM + wr * 64 + fr; const int part = u.pn >> 2, pn4 = u.pn & 3;
        if (part == 2) {
            const int col0 = pn4 * BM + wc * 32 + 8 * fq;
#pragma unroll
            for (int ai = 0; ai < 2; ++ai)
#pragma unroll
                for (int m = 0; m < 4; ++m) { bf16_t* rowp = Vb + (size_t)(row0 + ai * HALF + m * 16) * 1024 + col0;
#pragma unroll
                    for (int bj = 0; bj < 2; ++bj) *(u32x4*)(rowp + bj * HALF) = pack8(acc[ai][bj][m][0], acc[ai][bj][m][1]); }
        } else {
            bf16_t* base = part == 0 ? Q : Kb; const float sc = part == 0 ? qscale : 1.0f;
            const int hm = pn4 * 4 + wc, j0 = 8 * fq;
#pragma unroll
            for (int q = 0; q < 4; ++q) {
                const int ai = q >> 1, mb = (q & 1) * 2;
                f32x4 c0[2], c1[2], s0[2], s1[2];
#pragma unroll
                for (int mm = 0; mm < 2; ++mm) { const int pos = (row0 + ai * HALF + (mb + mm) * 16) & seqmask;
                    c0[mm] = *(const f32x4*)(cs + pos * 32 + j0); c1[mm] = *(const f32x4*)(cs + pos * 32 + j0 + 4); s0[mm] = *(const f32x4*)(sn + pos * 32 + j0); s1[mm] = *(const f32x4*)(sn + pos * 32 + j0 + 4); }
#pragma unroll
                for (int mm = 0; mm < 2; ++mm) { const int m = mb + mm; const int row = row0 + ai * HALF + m * 16;
                    const f32x4 x1a = acc[ai][0][m][0] * sc, x1b = acc[ai][0][m][1] * sc, x2a = acc[ai][1][m][0] * sc, x2b = acc[ai][1][m][1] * sc;
                    const f32x4 o1a = x1a * c0[mm] - x2a * s0[mm], o1b = x1b * c1[mm] - x2b * s1[mm], o2a = x2a * c0[mm] + x1a * s0[mm], o2b = x2b * c1[mm] + x1b * s1[mm];
                    bf16_t* rowp = base + (size_t)row * 1024 + hm * 64 + j0;
                    *(u32x4*)(rowp) = pack8(o1a, o1b); *(u32x4*)(rowp + 32) = pack8(o2a, o2b); }
            }
        }
    }
};
struct EpiSwiGLU {
    static constexpr bool PERM = true, AFTER_DRAIN = false;
    bf16_t* act;
    __device__ __forceinline__ void operator()(const f32x4 (&acc)[2][2][4][2], const Unit& u, int wr, int wc, int fr, int fq) const {
        const int row0 = u.pm * BM + wr * 64 + fr, col0 = u.pn * HALF + wc * 32 + 8 * fq;
#pragma unroll
        for (int ai = 0; ai < 2; ++ai)
#pragma unroll
            for (int m = 0; m < 4; ++m) { f32x4 v0, v1;
#pragma unroll
                for (int j = 0; j < 4; ++j) { v0[j] = silu_f(acc[ai][0][m][0][j]) * acc[ai][1][m][0][j]; v1[j] = silu_f(acc[ai][0][m][1][j]) * acc[ai][1][m][1][j]; }
                *(u32x4*)(act + (size_t)(row0 + ai * HALF + m * 16) * 512 + col0) = pack8(v0, v1); }
    }
};
struct EpiRowScale {
    static constexpr bool PERM = true, AFTER_DRAIN = false;
    bf16_t* O; const float* roww;
    __device__ __forceinline__ void operator()(const f32x4 (&acc)[2][2][4][2], const Unit& u, int wr, int wc, int fr, int fq) const {
        const int row0 = u.pm * BM + wr * 64 + fr, col0 = u.pn * BM + wc * 32 + 8 * fq;
        float w8[8];
#pragma unroll
        for (int q = 0; q < 8; ++q) w8[q] = roww[row0 + (q >> 2) * HALF + (q & 3) * 16];
#pragma unroll
        for (int ai = 0; ai < 2; ++ai)
#pragma unroll
            for (int m = 0; m < 4; ++m) { const int row = row0 + ai * HALF + m * 16; const float w = w8[ai * 4 + m]; bf16_t* rowp = O + (size_t)row * 1024 + col0;
#pragma unroll
                for (int bj = 0; bj < 2; ++bj) *(u32x4*)(rowp + bj * HALF) = pack8(acc[ai][bj][m][0] * w, acc[ai][bj][m][1] * w); }
    }
};
struct PanelOrder {
    int pm, nN;
    __device__ __forceinline__ bool next(int i, Unit& u) const { if (i >= nN) return false; u.pm = pm; u.pn = i; u.e = 0; return true; }
    __device__ __forceinline__ void a_ready(const Unit&) const {}
    __device__ __forceinline__ void done(const Unit&) const {}
};
struct MoeOrder : StaticOrder {
    const int* blk_e;
    __device__ __forceinline__ bool next(int i, Unit& u) const { if (!StaticOrder::next(i, u)) return false; u.e = ((const __attribute__((address_space(4))) int*)blk_e)[u.pm]; return true; }
};
}
#include <hip/hip_bf16.h>
#include <cmath>
namespace attn_body {
using bf16=__hip_bfloat16;
using bf16x8=__attribute__((ext_vector_type(8)))short;
using s16x4=__attribute__((ext_vector_type(4)))short;
using f32x16=__attribute__((ext_vector_type(16)))float;
using u32x4=__attribute__((ext_vector_type(4)))unsigned;
constexpr int BATCH=16,NHEAD=16,SEQ=4096,D=64,DM=NHEAD*D;
constexpr int NW=8,QBLK=32,QB=QBLK*NW,KVBLK=64,NQB=SEQ/QB;
constexpr int ATTN_PITCH=DM, ATTN_UNIT_ROWS=QB;
__device__ __forceinline__ int crow(int r,int hi){return (r&3)+8*(r>>2)+4*hi;}
#define SBAR() __builtin_amdgcn_sched_barrier(0)
__device__ __forceinline__ void cmask(f32x16&p0,f32x16&p1,int jb,int qrel,int hi){
  const float NEG=-INFINITY; int kb=64*jb+4*hi;
  #pragma unroll
  for(int r=0;r<16;++r){int kv=kb+(r&3)+8*(r>>2); if(kv>qrel)p0[r]=NEG; if(kv+32>qrel)p1[r]=NEG;}
}

constexpr int NSLOT=3, SLOTB=8192;
constexpr int LDS_K=0, LDS_V=NSLOT*SLOTB, LDS_WS=2*NSLOT*SLOTB, LDS_OST=LDS_WS+NW*64*4, LDS_BYTES=LDS_OST+NW*4096;
constexpr float C2=0.125f*1.4426950408889634f;
__device__ __forceinline__ void glds16(const void*gsrc,unsigned lds_dst){unsigned keep;
  asm volatile("s_mov_b32 %0, m0\n\ts_mov_b32 m0, %2\n\ts_nop 0\n\tglobal_load_lds_dwordx4 %1, off\n\ts_mov_b32 m0, %0":"=&s"(keep):"v"(gsrc),"s"(lds_dst):"memory");}
__device__ __forceinline__ float max3f(float a,float b,float c){float r;asm("v_max3_f32 %0, %1, %2, %3":"=v"(r):"v"(a),"v"(b),"v"(c));return r;}
__device__ __forceinline__ float max2f(float a,float b){float r;asm("v_max_f32_e32 %0, %1, %2":"=v"(r):"v"(a),"v"(b));return r;}
__device__ __forceinline__ float fadd_s(float a,float b){float r;asm("v_add_f32_e32 %0, %1, %2":"=v"(r):"v"(a),"v"(b));return r;}
__device__ __forceinline__ float fsub_s(float a,float b){float r;asm("v_sub_f32_e32 %0, %1, %2":"=v"(r):"v"(a),"v"(b));return r;}
typedef float f32x2_t __attribute__((ext_vector_type(2))); typedef __bf16 bf16x2_t __attribute__((ext_vector_type(2)));
__device__ __forceinline__ unsigned cvtpk_s(float lo,float hi){f32x2_t v={lo,hi};bf16x2_t b=__builtin_convertvector(v,bf16x2_t);return __builtin_bit_cast(unsigned,b);}
#define WAIT_BAR(N) asm volatile("s_waitcnt vmcnt(" #N ") lgkmcnt(0)\n\ts_barrier":::"memory")

__device__ __forceinline__ void qkt(f32x16&p0,f32x16&p1,const char*Kslot,const bf16x8*qr,const f32x16&negm,int r32,int hi){
  const char*kb=Kslot+hi*1024+r32*16;
  #pragma unroll
  for(int d0=0;d0<4;++d0){
    const bf16x8 b0=*reinterpret_cast<const bf16x8*>(kb+d0*2048);
    const bf16x8 b1=*reinterpret_cast<const bf16x8*>(kb+d0*2048+512);
    if(d0==0){p0=__builtin_amdgcn_mfma_f32_32x32x16_bf16(b0,qr[0],negm,0,0,0);p1=__builtin_amdgcn_mfma_f32_32x32x16_bf16(b1,qr[0],negm,0,0,0);}
    else{p0=__builtin_amdgcn_mfma_f32_32x32x16_bf16(b0,qr[d0],p0,0,0,0);p1=__builtin_amdgcn_mfma_f32_32x32x16_bf16(b1,qr[d0],p1,0,0,0);}}
}
typedef __attribute__((address_space(3))) const char* lds_cptr;
typedef short v4i16_t __attribute__((ext_vector_type(4)));
__device__ __forceinline__ void kload8(bf16x8*kf,lds_cptr kp){
  kf[0]=*(const __attribute__((address_space(3))) bf16x8*)(kp);      kf[1]=*(const __attribute__((address_space(3))) bf16x8*)(kp+512);
  kf[2]=*(const __attribute__((address_space(3))) bf16x8*)(kp+2048); kf[3]=*(const __attribute__((address_space(3))) bf16x8*)(kp+2560);
  kf[4]=*(const __attribute__((address_space(3))) bf16x8*)(kp+4096); kf[5]=*(const __attribute__((address_space(3))) bf16x8*)(kp+4608);
  kf[6]=*(const __attribute__((address_space(3))) bf16x8*)(kp+6144); kf[7]=*(const __attribute__((address_space(3))) bf16x8*)(kp+6656);
}
__device__ __forceinline__ void kload2(bf16x8*kf,lds_cptr kp,int j){ kf[2*j]=*(const __attribute__((address_space(3))) bf16x8*)(kp+j*2048); kf[2*j+1]=*(const __attribute__((address_space(3))) bf16x8*)(kp+j*2048+512); }
__device__ __forceinline__ s16x4 vtr(lds_cptr p){ return __builtin_bit_cast(s16x4,__builtin_amdgcn_ds_read_tr16_b64_v4i16((__attribute__((address_space(3))) v4i16_t*)p)); }
__device__ __forceinline__ float rowmax(const f32x16&p0,const f32x16&p1){
  float a=max3f(p0[0],p0[1],p1[0]),b=max3f(p0[2],p0[3],p1[1]);a=max3f(a,p1[2],p1[3]);
  #pragma unroll
  for(int r=4;r<16;r+=4){a=max3f(a,p0[r],p0[r+1]);b=max3f(b,p0[r+2],p0[r+3]);a=max3f(a,p1[r],p1[r+1]);b=max3f(b,p1[r+2],p1[r+3]);}
  const float m=max2f(a,b);
  auto rr=__builtin_amdgcn_permlane32_swap(__float_as_uint(m),__float_as_uint(m),false,false);
  return max2f(__uint_as_float(rr[0]),__uint_as_float(rr[1]));
}
__device__ __forceinline__ void pv(f32x16*o,int vb,bf16x8 pa0,bf16x8 pa1,bf16x8 pa2,bf16x8 pa3){
  #pragma unroll
  for(int d0=0;d0<2;++d0){s16x4 lo[4],hi[4];
    #pragma unroll
    for(int ks=0;ks<4;++ks){
      asm volatile("ds_read_b64_tr_b16 %0,%1 offset:%c2":"=&v"(lo[ks]):"v"(vb),"i"(d0*4096+ks*1024):"memory");
      asm volatile("ds_read_b64_tr_b16 %0,%1 offset:%c2":"=&v"(hi[ks]):"v"(vb),"i"(d0*4096+ks*1024+512):"memory");}
    asm volatile("s_waitcnt lgkmcnt(0)":::"memory");SBAR();
    #define PK(k) (bf16x8){lo[k][0],lo[k][1],lo[k][2],lo[k][3],hi[k][0],hi[k][1],hi[k][2],hi[k][3]}
    o[d0]=__builtin_amdgcn_mfma_f32_32x32x16_bf16(pa0,PK(0),o[d0],0,0,0);
    o[d0]=__builtin_amdgcn_mfma_f32_32x32x16_bf16(pa1,PK(1),o[d0],0,0,0);
    o[d0]=__builtin_amdgcn_mfma_f32_32x32x16_bf16(pa2,PK(2),o[d0],0,0,0);
    o[d0]=__builtin_amdgcn_mfma_f32_32x32x16_bf16(pa3,PK(3),o[d0],0,0,0);
    #undef PK
  }
}

#ifndef ATTN_STORE16
#define ATTN_STORE16(p,v) (*(u32x4*)(p)=(v))
#endif
template<int THRL> __device__ __forceinline__ void attn_unit(int b,int qcol,int kcol,int vcol,int ocol,int qb,const bf16*Q,const bf16* K,const bf16* V,bf16*O,char*shm,int tid){
  const int lane=tid&63,r32=lane&31,hi=lane>>5; const int wid=__builtin_amdgcn_readfirstlane(tid>>6);
  const long rowbase=(long)b*SEQ; const int q0=qb*QB;
  const bf16*Qw=Q+(rowbase+q0+wid*QBLK)*DM+qcol;
  const bf16*Kh=K+rowbase*DM+kcol,*Vh=V+rowbase*DM+vcol;
  const unsigned lds0=(unsigned)(uintptr_t)shm;
  float*wsf=(float*)(shm+LDS_WS)+wid*64;
  const bf16*ksrc=Kh+(long)lane*DM+wid*8;
  const bf16*vsrc=Vh+(long)(16*(wid&3)+(lane>>2))*DM+(wid>>2)*32+(lane&3)*8;
  const unsigned kdst=lds0+LDS_K+wid*1024, vdst=lds0+LDS_V+wid*1024;
  #define DMA_K(t,slot) glds16(ksrc+(long)(t)*KVBLK*DM,(unsigned)__builtin_amdgcn_readfirstlane(kdst+(slot)))
  #define DMA_V(t,slot) glds16(vsrc+(long)(t)*KVBLK*DM,(unsigned)__builtin_amdgcn_readfirstlane(vdst+(slot)))
  const int vb0=(int)(lds0+LDS_V)+((lane>>4)&1)*32+(lane&3)*8+(4*hi+((lane&15)>>2))*64;
  const char*Kbase=shm+LDS_K; bf16x8 kf[8];
  const lds_cptr shm3=(lds_cptr)shm; const lds_cptr kp0=shm3+LDS_K+hi*1024+r32*16; const lds_cptr vp0=shm3+LDS_V+((lane>>4)&1)*32+(lane&3)*8+(4*hi+((lane&15)>>2))*64;
  const int NT=(q0+QB)/KVBLK;
  DMA_K(0,0);DMA_V(0,0);DMA_K(1,SLOTB);
  bf16x8 qr[4];
  #pragma unroll
  for(int d0=0;d0<4;++d0)qr[d0]=*reinterpret_cast<const bf16x8*>(&Qw[(long)r32*DM+d0*16+hi*8]);
  float mhat=0.f,l_reg=0.f;f32x16 o[2];o[0]=f32x16{};o[1]=f32x16{};f32x16 negm=f32x16{};asm volatile("":"+v"(negm));
  const int qrel=wid*QBLK+r32;
  #define CMASK(P0,P1,t) do{int jb_=(t)-(NT-4); if(jb_>=0)cmask(P0,P1,jb_,qrel,hi);}while(0)
  bool resc=false;
  #define START(P0,P1) do{ const float rm=rowmax(P0,P1); resc=false; \
    { const float dl=rm; mhat=fadd_s(mhat,dl); \
      _Pragma("unroll") for(int r=0;r<16;++r){P0[r]=fsub_s(P0[r],dl);P1[r]=fsub_s(P1[r],dl);} \
      _Pragma("unroll") for(int r=0;r<16;++r)negm[r]=-mhat; asm volatile("":"+v"(negm)); } \
    _Pragma("unroll") for(int r=0;r<16;++r)P0[r]=__builtin_amdgcn_exp2f(P0[r]); }while(0)
  #define RESC() do{ if(resc){ asm volatile("s_waitcnt lgkmcnt(0)":::"memory"); \
      _Pragma("unroll") for(int d_=0;d_<2;++d_) _Pragma("unroll") for(int r=0;r<16;++r)o[d_][r]*=wsf[crow(r,hi)]; } }while(0)
  f32x16 pA0,pA1,pB0,pB1;
  int sl_prev=0,sl_cur=0,sl_next=SLOTB;
  #define ROT() do{sl_prev=sl_cur;sl_cur=sl_next;sl_next=(sl_next==(NSLOT-1)*SLOTB)?0:sl_next+SLOTB;}while(0)
  DMA_K(2,2*SLOTB);
  WAIT_BAR(3);
  qkt(pA0,pA1,Kbase,qr,negm,r32,hi);asm volatile("s_nop 15\n\ts_nop 7":"+v"(pA0),"+v"(pA1));CMASK(pA0,pA1,0);
  START(pA0,pA1);
  _Pragma("unroll") for(int r=0;r<16;++r)pA1[r]=__builtin_amdgcn_exp2f(pA1[r]);
  WAIT_BAR(0);
  DMA_K(3,0);DMA_V(1,SLOTB);
  ROT();
  kload8(kf,kp0+sl_cur);
  WAIT_BAR(2);
  s16x4 vlo[8],vhi[8]; u32x4 pw0,pw1,pw2,pw3;
  #define PKW(P,B) cvtpk_s(P[B],P[B+1])
  #define PAF(k) __builtin_bit_cast(bf16x8,pw##k)
  #define VFR(i) (bf16x8){vlo[i][0],vlo[i][1],vlo[i][2],vlo[i][3],vhi[i][0],vhi[i][1],vhi[i][2],vhi[i][3]}
  #define PIN(x) asm volatile("":"+v"(x))
  #define MX3(a,b,c) __builtin_fmaxf(__builtin_fmaxf((a),(b)),(c))
  #define GAPA(MF,A0,A1,A2,A3,W0,W1,PW) do{ MF; sacc+=A0; sacc+=A1; sacc+=A2; sacc+=A3; PIN(sacc); W0; W1; PIN(PW); SBAR(); }while(0)
  #define EX(v) __builtin_amdgcn_exp2f(v)
  #define GAPB(MF,X,B) do{ MF; X[B]=EX(X[B]); X[B+1]=EX(X[B+1]); X[B+2]=EX(X[B+2]); X[B+3]=EX(X[B+3]); PIN(X); SBAR(); }while(0)
  #define VRD(i) do{ vlo[i]=vtr(vp_+(((i)>>2)*4096+((i)&3)*1024)); vhi[i]=vtr(vp_+(((i)>>2)*4096+((i)&3)*1024+512)); }while(0)
  #define KRD(G,j) do{ if(G){ kload2(kf,kp0+sl_next,j); SBAR(); } }while(0)
  #define STEP(C0,C1,P0,P1,t,GK,GV,GL) do{ SBAR(); \
    const lds_cptr vp_=vp0+sl_prev; \
    VRD(0); SBAR(); float sacc=(P0[0]+P0[1]); \
    GAPA(C0=__builtin_amdgcn_mfma_f32_32x32x16_bf16(kf[0],qr[0],negm,0,0,0), P0[2],P0[3],P0[4],P0[5],     pw0[0]=PKW(P0,0), pw0[1]=PKW(P0,2), pw0); \
    VRD(4); SBAR(); GAPA(C1=__builtin_amdgcn_mfma_f32_32x32x16_bf16(kf[1],qr[0],negm,0,0,0), P0[6],P0[7],P0[8],P0[9],     pw0[2]=PKW(P0,4), pw0[3]=PKW(P0,6), pw0); \
    VRD(1); SBAR(); GAPA(C0=__builtin_amdgcn_mfma_f32_32x32x16_bf16(kf[2],qr[1],C0,0,0,0),   P0[10],P0[11],P0[12],P0[13], pw1[0]=PKW(P0,8), pw1[1]=PKW(P0,10), pw1); \
    VRD(5); SBAR(); GAPA(C1=__builtin_amdgcn_mfma_f32_32x32x16_bf16(kf[3],qr[1],C1,0,0,0),   P0[14],P0[15],P1[0],P1[1],   pw1[2]=PKW(P0,12),pw1[3]=PKW(P0,14), pw1); \
    VRD(2); SBAR(); GAPA(C0=__builtin_amdgcn_mfma_f32_32x32x16_bf16(kf[4],qr[2],C0,0,0,0),   P1[2],P1[3],P1[4],P1[5],     pw2[0]=PKW(P1,0), pw2[1]=PKW(P1,2), pw2); \
    VRD(6); SBAR(); GAPA(C1=__builtin_amdgcn_mfma_f32_32x32x16_bf16(kf[5],qr[2],C1,0,0,0),   P1[6],P1[7],P1[8],P1[9],     pw2[2]=PKW(P1,4), pw2[3]=PKW(P1,6), pw2); \
    VRD(3); SBAR(); GAPA(C0=__builtin_amdgcn_mfma_f32_32x32x16_bf16(kf[6],qr[3],C0,0,0,0),   P1[10],P1[11],P1[12],P1[13], pw3[0]=PKW(P1,8), pw3[1]=PKW(P1,10), pw3); \
    VRD(7); SBAR(); GAPA(C1=__builtin_amdgcn_mfma_f32_32x32x16_bf16(kf[7],qr[3],C1,0,0,0),   P1[14],P1[15],0.f,0.f,       pw3[2]=PKW(P1,12),pw3[3]=PKW(P1,14), pw3); \
    l_reg+=sacc; \
    if(GK){DMA_K((t)+3,sl_cur);} if(GV){DMA_V((t)+1,sl_next);} \
    CMASK(C0,C1,t); \
    { float a=MX3(C0[0],C0[1],C1[0]),b=MX3(C0[2],C0[3],C1[1]); a=MX3(a,C1[2],C1[3]); \
      _Pragma("unroll") for(int r=4;r<16;r+=4){a=MX3(a,C0[r],C0[r+1]);b=MX3(b,C0[r+2],C0[r+3]);a=MX3(a,C1[r],C1[r+1]);b=MX3(b,C1[r+2],C1[r+3]);} \
      float rm=__builtin_fmaxf(a,b); { auto rr=__builtin_amdgcn_permlane32_swap(__float_as_uint(rm),__float_as_uint(rm),false,false); rm=__builtin_fmaxf(__uint_as_float(rr[0]),__uint_as_float(rr[1])); } \
      resc=false; \
      if(__builtin_expect(__any(rm>(float)THRL),0)){ const float dl=__builtin_fmaxf(rm,0.f); mhat+=dl; \
        _Pragma("unroll") for(int r=0;r<16;++r){C0[r]-=dl;C1[r]-=dl;} \
        _Pragma("unroll") for(int r=0;r<16;++r)negm[r]=-mhat; asm volatile("":"+v"(negm)); \
        const float f=__builtin_amdgcn_exp2f(-dl); l_reg*=f; if(hi==0)wsf[r32]=f; resc=true; } } \
    SBAR(); \
    GAPB(o[0]=__builtin_amdgcn_mfma_f32_32x32x16_bf16(PAF(0),VFR(0),o[0],0,0,0), C0,0); \
    GAPB(o[1]=__builtin_amdgcn_mfma_f32_32x32x16_bf16(PAF(0),VFR(4),o[1],0,0,0), C0,4); \
    KRD(GL,0); GAPB(o[0]=__builtin_amdgcn_mfma_f32_32x32x16_bf16(PAF(1),VFR(1),o[0],0,0,0), C0,8); \
    KRD(GL,1); GAPB(o[1]=__builtin_amdgcn_mfma_f32_32x32x16_bf16(PAF(1),VFR(5),o[1],0,0,0), C0,12); \
    KRD(GL,2); GAPB(o[0]=__builtin_amdgcn_mfma_f32_32x32x16_bf16(PAF(2),VFR(2),o[0],0,0,0), C1,0); \
    KRD(GL,3); GAPB(o[1]=__builtin_amdgcn_mfma_f32_32x32x16_bf16(PAF(2),VFR(6),o[1],0,0,0), C1,4); \
    GAPB(o[0]=__builtin_amdgcn_mfma_f32_32x32x16_bf16(PAF(3),VFR(3),o[0],0,0,0), C1,8); \
    GAPB(o[1]=__builtin_amdgcn_mfma_f32_32x32x16_bf16(PAF(3),VFR(7),o[1],0,0,0), C1,12); \
    }while(0)
  int t=1;
  #undef CMASK
  #define CMASK(P0,P1,t) do{}while(0)
  for(;t+5<NT;t+=2){
    STEP(pB0,pB1,pA0,pA1,t,true,true,true);     WAIT_BAR(2); RESC(); ROT();
    STEP(pA0,pA1,pB0,pB1,t+1,true,true,true);   WAIT_BAR(2); RESC(); ROT();
  }
  #undef CMASK
  #define CMASK(P0,P1,t) do{int jb_=(t)-(NT-4); if(jb_>=0)cmask(P0,P1,jb_,qrel,hi);}while(0)
  #define ENDW(tt) do{ if((tt)+3<NT){WAIT_BAR(2);} else if((tt)+2<NT){WAIT_BAR(1);} else {WAIT_BAR(0);} }while(0)
  for(;t+1<NT;t+=2){
    STEP(pB0,pB1,pA0,pA1,t,(t+3<NT),(t+1<NT),(t+1<NT));       ENDW(t);   RESC(); ROT();
    STEP(pA0,pA1,pB0,pB1,t+1,(t+4<NT),(t+2<NT),(t+2<NT));     ENDW(t+1); RESC(); ROT();
  }
  STEP(pB0,pB1,pA0,pA1,NT-1,false,false,false); RESC();
  { float sacc=pB0[0]+pB0[1]; _Pragma("unroll") for(int r=2;r<16;++r)sacc+=pB0[r]; _Pragma("unroll") for(int r=0;r<16;++r)sacc+=pB1[r]; l_reg+=sacc;
    pw0=(u32x4){PKW(pB0,0),PKW(pB0,2),PKW(pB0,4),PKW(pB0,6)};pw1=(u32x4){PKW(pB0,8),PKW(pB0,10),PKW(pB0,12),PKW(pB0,14)};pw2=(u32x4){PKW(pB1,0),PKW(pB1,2),PKW(pB1,4),PKW(pB1,6)};pw3=(u32x4){PKW(pB1,8),PKW(pB1,10),PKW(pB1,12),PKW(pB1,14)};
    SBAR(); pv(o,vb0+sl_cur,PAF(0),PAF(1),PAF(2),PAF(3)); }
  #undef PKW
  #undef PAF
  #undef VFR
  #undef PIN
  #undef MX3
  #undef GAPA
  #undef GAPB
  #undef EX
  #undef VRD
  #undef KRD
  #undef STEP
  #undef ENDW
  {auto rr=__builtin_amdgcn_permlane32_swap(__float_as_uint(l_reg),__float_as_uint(l_reg),false,false);l_reg=__uint_as_float(rr[0])+__uint_as_float(rr[1]);}
  if(hi==0)wsf[32+r32]=l_reg;asm volatile("s_waitcnt lgkmcnt(0)":::"memory");
  float rli[16];
  #pragma unroll
  for(int r=0;r<16;++r)rli[r]=__builtin_amdgcn_rcpf(wsf[32+crow(r,hi)]);
  bf16*Ow=O+(rowbase+q0+wid*QBLK)*DM+ocol;
  { bf16*stg=(bf16*)(shm+LDS_OST)+wid*2048;
    #pragma unroll
    for(int r=0;r<16;++r){const int orow=crow(r,hi);
      #pragma unroll
      for(int d0=0;d0<2;++d0)stg[orow*64+d0*32+r32]=__float2bfloat16(o[d0][r]*rli[r]);}
    asm volatile("s_waitcnt lgkmcnt(0)":::"memory");
    #pragma unroll
    for(int i=0;i<4;++i){const int row=i*8+(lane>>3),ch=lane&7; const u32x4 v=*(const u32x4*)(stg+row*64+ch*8); ATTN_STORE16(Ow+(long)row*DM+ch*8,v);} }
  asm volatile("s_waitcnt lgkmcnt(0)\n\ts_barrier":::"memory");
  #undef DMA_K
  #undef DMA_V
  #undef CMASK
  #undef START
  #undef RESC
  #undef ROT
}
constexpr int ATTN_LDS_BYTES=LDS_BYTES;
struct AttnTensors { const bf16* Q; const bf16* K; const bf16* V; bf16* O0; bf16* O1; };
struct AttnUnit { int b, qcol, kcol, vcol, ocol, m, qb; };
struct StaticOrder {
  int vcu, G;
  __device__ __forceinline__ StaticOrder(int grid,int vcu_):vcu(vcu_),G(grid){}
  __device__ __forceinline__ bool next(int i,AttnUnit&u)const{
    int b,h,m,vhalf,qb;
    if(G==256){ if(i>=32)return false; const int xcd=vcu>>5,l=vcu&31,vh=l&3,qs=l>>2,bh=xcd*16+(i>>1); b=bh>>3; h=bh&7; m=(vh>>1)&1; vhalf=vh&1; qb=(i&1)?qs:15-qs; }
    else { const int ci=vcu+G*(i>>4); if(ci>=BATCH*32)return false; const int vh=ci&31; h=vh>>2; m=(vh>>1)&1; vhalf=vh&1; b=ci>>5; qb=15-(i&15); }
    u.b=b; u.qcol=(2*h+m)*64; u.kcol=u.qcol; u.vcol=h*128+vhalf*64; u.ocol=u.vcol; u.m=m; u.qb=qb; return true; }
  __device__ __forceinline__ void a_ready(const AttnUnit&)const{}
  __device__ __forceinline__ void done(const AttnUnit&)const{}
};
template<class Sched,int THRL=8> __device__ __forceinline__ void attn_phase(char*lds,const AttnTensors&T,const Sched&S,const int tid_){
  AttnUnit u;
  for(int i=0;S.next(i,u);++i){ S.a_ready(u); attn_unit<THRL>(u.b,u.qcol,u.kcol,u.vcol,u.ocol,u.qb,T.Q,T.K,T.V,u.m?T.O1:T.O0,lds,tid_); S.done(u); }
}
constexpr int VSLOTB=16384;
constexpr int WL_K=0, WL_V=NSLOT*SLOTB, WL_WS=WL_V+NSLOT*VSLOTB, WL_Q=WL_WS+NW*64*4, WL_OST=WL_Q+NW*4096, WL_BYTES=WL_OST+NW*4096;
__device__ __forceinline__ void cmask2(f32x16&p0,f32x16&p1,int jb,int qrel,int hi){
  const float NEG=-INFINITY; const int qq=qrel-64*jb-4*hi;
  #pragma unroll
  for(int r=0;r<16;++r){const int c=(r&3)+8*(r>>2); if(c>qq)p0[r]=NEG; if(c+32>qq)p1[r]=NEG;}
}
__device__ __forceinline__ void pv4(f32x16*o,int vb,bf16x8 pa0,bf16x8 pa1,bf16x8 pa2,bf16x8 pa3){
  #pragma unroll
  for(int d0=0;d0<4;++d0){s16x4 lo[4],hi[4];
    #pragma unroll
    for(int ks=0;ks<4;++ks){
      asm volatile("ds_read_b64_tr_b16 %0,%1 offset:%c2":"=&v"(lo[ks]):"v"(vb),"i"(d0*4096+ks*1024):"memory");
      asm volatile("ds_read_b64_tr_b16 %0,%1 offset:%c2":"=&v"(hi[ks]):"v"(vb),"i"(d0*4096+ks*1024+512):"memory");}
    asm volatile("s_waitcnt lgkmcnt(0)":::"memory");SBAR();
    #define PK(k) (bf16x8){lo[k][0],lo[k][1],lo[k][2],lo[k][3],hi[k][0],hi[k][1],hi[k][2],hi[k][3]}
    o[d0]=__builtin_amdgcn_mfma_f32_32x32x16_bf16(pa0,PK(0),o[d0],0,0,0);
    o[d0]=__builtin_amdgcn_mfma_f32_32x32x16_bf16(pa1,PK(1),o[d0],0,0,0);
    o[d0]=__builtin_amdgcn_mfma_f32_32x32x16_bf16(pa2,PK(2),o[d0],0,0,0);
    o[d0]=__builtin_amdgcn_mfma_f32_32x32x16_bf16(pa3,PK(3),o[d0],0,0,0);
    #undef PK
  }
}
using f32x4_t=__attribute__((ext_vector_type(4)))float;
struct CombineW { const bf16* O0; bf16* A2; const float* w; float lam, mul; };
template<int THRL> __device__ __forceinline__ void attn_unit_w(int b,int qcol,int vcol,int qb,int m,const bf16*Q,const bf16* K,const bf16* V,bf16*O,const CombineW&CB,char*shm,int tid){
  const int lane=tid&63,r32=lane&31,hi=lane>>5; const int wid=__builtin_amdgcn_readfirstlane(tid>>6);
  const long rowbase=(long)b*SEQ; const int q0=qb*QB;
  int hi4=4*hi; asm volatile("":"+v"(hi4));
  #define CROWO(r) (((r)&3)+8*((r)>>2)+hi4)
  const bf16*Qw=Q+(rowbase+q0+wid*QBLK)*DM+qcol;
  const bf16*Kh=K+rowbase*DM+qcol,*Vh=V+rowbase*DM+vcol;
  const unsigned lds0=(unsigned)(uintptr_t)shm;
  float*wsf=(float*)(shm+WL_WS)+wid*64;
  const bf16*ksrc=Kh+(long)lane*DM+wid*8;
  const bf16*vsrc=Vh+(long)(16*(wid&3)+(lane>>2))*DM+(wid>>2)*32+(lane&3)*8;
  const unsigned kdst=lds0+WL_K+wid*1024, vdst=lds0+WL_V+wid*1024;
  #define DMA_K(t,slot) glds16(ksrc+(long)(t)*KVBLK*DM,(unsigned)__builtin_amdgcn_readfirstlane(kdst+(slot)))
  #define DMA_V(t,slot) do{ glds16(vsrc+(long)(t)*KVBLK*DM,(unsigned)__builtin_amdgcn_readfirstlane(vdst+2*(slot))); glds16(vsrc+(long)(t)*KVBLK*DM+64,(unsigned)__builtin_amdgcn_readfirstlane(vdst+2*(slot)+8192)); }while(0)
  const int vb0=(int)(lds0+WL_V)+((lane>>4)&1)*32+(lane&3)*8+(4*hi+((lane&15)>>2))*64;
  const char*Kbase=shm+WL_K; bf16x8 kf[8];
  const lds_cptr shm3=(lds_cptr)shm; const lds_cptr kp0=shm3+WL_K+hi*1024+r32*16; const lds_cptr vp0=shm3+WL_V+((lane>>4)&1)*32+(lane&3)*8+(4*hi+((lane&15)>>2))*64;
  const lds_cptr qp=shm3+WL_Q+wid*4096+lane*16;
  const int NT=(q0+QB)/KVBLK;
  DMA_K(0,0);DMA_V(0,0);DMA_K(1,SLOTB);
  bf16x8 qr[4];
  #pragma unroll
  for(int d0=0;d0<4;++d0)qr[d0]=*reinterpret_cast<const bf16x8*>(&Qw[(long)r32*DM+d0*16+hi*8]);
  #pragma unroll
  for(int d0=0;d0<4;++d0)*(__attribute__((address_space(3))) bf16x8*)(qp+d0*1024)=qr[d0];
  float mhat=0.f,l_reg=0.f;f32x16 o[4];o[0]=f32x16{};o[1]=f32x16{};o[2]=f32x16{};o[3]=f32x16{};
  const f32x16 zero16=f32x16{};
  const int qrel=wid*QBLK+r32;
  #define CMASK(P0,P1,t) do{int jb_=(t)-(NT-4); if(jb_>=0)cmask2(P0,P1,jb_,qrel,hi);}while(0)
  bool resc=false;
  #define START(P0,P1) do{ const float rm=rowmax(P0,P1); resc=false; \
    { const float dl=rm; mhat=fadd_s(mhat,dl); \
      _Pragma("unroll") for(int r=0;r<16;++r){P0[r]=fsub_s(P0[r],dl);P1[r]=fsub_s(P1[r],dl);} } \
    _Pragma("unroll") for(int r=0;r<16;++r)P0[r]=__builtin_amdgcn_exp2f(P0[r]); }while(0)
  #define RESC() do{ if(resc){ asm volatile("s_waitcnt lgkmcnt(0)":::"memory"); \
      _Pragma("unroll") for(int d_=0;d_<4;++d_) _Pragma("unroll") for(int r=0;r<16;++r)o[d_][r]*=wsf[CROWO(r)]; } }while(0)
  f32x16 pA0,pA1,pB0,pB1;
  int sl_prev=0,sl_cur=0,sl_next=SLOTB;
  #define ROT() do{sl_prev=sl_cur;sl_cur=sl_next;sl_next=(sl_next==(NSLOT-1)*SLOTB)?0:sl_next+SLOTB;}while(0)
  DMA_K(2,2*SLOTB);
  WAIT_BAR(3);
  qkt(pA0,pA1,Kbase,qr,zero16,r32,hi);asm volatile("s_nop 15\n\ts_nop 7":"+v"(pA0),"+v"(pA1));CMASK(pA0,pA1,0);
  START(pA0,pA1);
  _Pragma("unroll") for(int r=0;r<16;++r)pA1[r]=__builtin_amdgcn_exp2f(pA1[r]);
  WAIT_BAR(0);
  DMA_K(3,0);DMA_V(1,SLOTB);
  ROT();
  kload8(kf,kp0+sl_cur);
  WAIT_BAR(3);
  s16x4 vlo[16],vhi[16]; u32x4 pw0,pw1,pw2,pw3;
  #define PKW(P,B) cvtpk_s(P[B],P[B+1])
  #define PAF(k) __builtin_bit_cast(bf16x8,pw##k)
  #define VFR(i) (bf16x8){vlo[i][0],vlo[i][1],vlo[i][2],vlo[i][3],vhi[i][0],vhi[i][1],vhi[i][2],vhi[i][3]}
  #define PIN(x) asm volatile("":"+v"(x))
  #define MX3(a,b,c) __builtin_fmaxf(__builtin_fmaxf((a),(b)),(c))
  #define GAPA(MF,A0,A1,A2,A3,W0,W1,PW) do{ MF; sacc+=A0; sacc+=A1; sacc+=A2; sacc+=A3; PIN(sacc); W0; W1; PIN(PW); SBAR(); }while(0)
  #define EX(v) __builtin_amdgcn_exp2f(v)
  #define GAPB(MF,X,B) do{ MF; X[B]=EX(X[B]); X[B+1]=EX(X[B+1]); PIN(X); SBAR(); }while(0)
  #define VRD(i) do{ vlo[i]=vtr(vp_+(((i)>>2)*4096+((i)&3)*1024)); vhi[i]=vtr(vp_+(((i)>>2)*4096+((i)&3)*1024+512)); }while(0)
  #define KRD(G,j) do{ if(G){ kload2(kf,kp0+sl_next,j); SBAR(); } }while(0)
  #define QRD(d) (*(const __attribute__((address_space(3))) bf16x8*)(qp+(d)*1024))
  #define MF32(a_,b_,c_) __builtin_amdgcn_mfma_f32_32x32x16_bf16(a_,b_,c_,0,0,0)
  #define STEP(C0,C1,P0,P1,t,GK,GV,GL) do{ SBAR(); \
    const lds_cptr vp_=vp0+2*sl_prev; bf16x8 q0_,q1_,q2_,q3_; \
    q0_=QRD(0); VRD(0); SBAR(); float sacc=(P0[0]+P0[1]); \
    GAPA(C0=MF32(kf[0],q0_,zero16), P0[2],P0[3],P0[4],P0[5],     pw0[0]=PKW(P0,0), pw0[1]=PKW(P0,2), pw0); \
    q1_=QRD(1); SBAR(); GAPA(C1=MF32(kf[1],q0_,zero16), P0[6],P0[7],P0[8],P0[9],     pw0[2]=PKW(P0,4), pw0[3]=PKW(P0,6), pw0); \
    VRD(4); SBAR(); GAPA(C0=MF32(kf[2],q1_,C0),   P0[10],P0[11],P0[12],P0[13], pw1[0]=PKW(P0,8), pw1[1]=PKW(P0,10), pw1); \
    q2_=QRD(2); SBAR(); GAPA(C1=MF32(kf[3],q1_,C1),   P0[14],P0[15],P1[0],P1[1],   pw1[2]=PKW(P0,12),pw1[3]=PKW(P0,14), pw1); \
    VRD(8); SBAR(); GAPA(C0=MF32(kf[4],q2_,C0),   P1[2],P1[3],P1[4],P1[5],     pw2[0]=PKW(P1,0), pw2[1]=PKW(P1,2), pw2); \
    q3_=QRD(3); SBAR(); GAPA(C1=MF32(kf[5],q2_,C1),   P1[6],P1[7],P1[8],P1[9],     pw2[2]=PKW(P1,4), pw2[3]=PKW(P1,6), pw2); \
    VRD(12); SBAR(); GAPA(C0=MF32(kf[6],q3_,C0),   P1[10],P1[11],P1[12],P1[13], pw3[0]=PKW(P1,8), pw3[1]=PKW(P1,10), pw3); \
    GAPA(C1=MF32(kf[7],q3_,C1),   P1[14],P1[15],0.f,0.f,       pw3[2]=PKW(P1,12),pw3[3]=PKW(P1,14), pw3); \
    l_reg+=sacc; \
    if(GK){DMA_K((t)+3,sl_cur);} if(GV){DMA_V((t)+1,sl_next);} \
    CMASK(C0,C1,t); \
    { float a=MX3(C0[0],C0[1],C1[0]),b=MX3(C0[2],C0[3],C1[1]); a=MX3(a,C1[2],C1[3]); \
      _Pragma("unroll") for(int r=4;r<16;r+=4){a=MX3(a,C0[r],C0[r+1]);b=MX3(b,C0[r+2],C0[r+3]);a=MX3(a,C1[r],C1[r+1]);b=MX3(b,C1[r+2],C1[r+3]);} \
      float rm=__builtin_fmaxf(a,b); { auto rr=__builtin_amdgcn_permlane32_swap(__float_as_uint(rm),__float_as_uint(rm),false,false); rm=__builtin_fmaxf(__uint_as_float(rr[0]),__uint_as_float(rr[1])); } \
      rm-=mhat; resc=false; \
      if(__builtin_expect(__any(rm>(float)THRL),0)){ const float dl=__builtin_fmaxf(rm,0.f); mhat+=dl; \
        const float f=__builtin_amdgcn_exp2f(-dl); l_reg*=f; if(hi==0)wsf[r32]=f; resc=true; } \
      _Pragma("unroll") for(int r=0;r<16;++r){C0[r]-=mhat;C1[r]-=mhat;} } \
    SBAR(); \
    VRD(1);  GAPB(o[0]=MF32(PAF(0),VFR(0), o[0]), C0,0); \
    VRD(5);  GAPB(o[1]=MF32(PAF(0),VFR(4), o[1]), C0,2); \
    VRD(9);  GAPB(o[2]=MF32(PAF(0),VFR(8), o[2]), C0,4); \
    VRD(13); GAPB(o[3]=MF32(PAF(0),VFR(12),o[3]), C0,6); \
    VRD(2);  KRD(GL,0); GAPB(o[0]=MF32(PAF(1),VFR(1), o[0]), C0,8); \
    VRD(6);  GAPB(o[1]=MF32(PAF(1),VFR(5), o[1]), C0,10); \
    VRD(10); KRD(GL,1); GAPB(o[2]=MF32(PAF(1),VFR(9), o[2]), C0,12); \
    VRD(14); GAPB(o[3]=MF32(PAF(1),VFR(13),o[3]), C0,14); \
    VRD(3);  KRD(GL,2); GAPB(o[0]=MF32(PAF(2),VFR(2), o[0]), C1,0); \
    VRD(7);  GAPB(o[1]=MF32(PAF(2),VFR(6), o[1]), C1,2); \
    VRD(11); KRD(GL,3); GAPB(o[2]=MF32(PAF(2),VFR(10),o[2]), C1,4); \
    VRD(15); GAPB(o[3]=MF32(PAF(2),VFR(14),o[3]), C1,6); \
    GAPB(o[0]=MF32(PAF(3),VFR(3), o[0]), C1,8); \
    GAPB(o[1]=MF32(PAF(3),VFR(7), o[1]), C1,10); \
    GAPB(o[2]=MF32(PAF(3),VFR(11),o[2]), C1,12); \
    GAPB(o[3]=MF32(PAF(3),VFR(15),o[3]), C1,14); \
    }while(0)
  int t=1;
  #undef CMASK
  #define CMASK(P0,P1,t) do{}while(0)
  for(;t+5<NT;t+=2){
    STEP(pB0,pB1,pA0,pA1,t,true,true,true);     WAIT_BAR(3); RESC(); ROT();
    STEP(pA0,pA1,pB0,pB1,t+1,true,true,true);   WAIT_BAR(3); RESC(); ROT();
  }
  #undef CMASK
  #define CMASK(P0,P1,t) do{int jb_=(t)-(NT-4); if(jb_>=0)cmask2(P0,P1,jb_,qrel,hi);}while(0)
  #define ENDW(tt) do{ if((tt)+3<NT){WAIT_BAR(3);} else if((tt)+2<NT){WAIT_BAR(2);} else {WAIT_BAR(0);} }while(0)
  for(;t+1<NT;t+=2){
    STEP(pB0,pB1,pA0,pA1,t,(t+3<NT),(t+1<NT),(t+1<NT));       ENDW(t);   RESC(); ROT();
    STEP(pA0,pA1,pB0,pB1,t+1,(t+4<NT),(t+2<NT),(t+2<NT));     ENDW(t+1); RESC(); ROT();
  }
  STEP(pB0,pB1,pA0,pA1,NT-1,false,false,false); RESC();
  { float sacc=pB0[0]+pB0[1]; _Pragma("unroll") for(int r=2;r<16;++r)sacc+=pB0[r]; _Pragma("unroll") for(int r=0;r<16;++r)sacc+=pB1[r]; l_reg+=sacc;
    pw0=(u32x4){PKW(pB0,0),PKW(pB0,2),PKW(pB0,4),PKW(pB0,6)};pw1=(u32x4){PKW(pB0,8),PKW(pB0,10),PKW(pB0,12),PKW(pB0,14)};pw2=(u32x4){PKW(pB1,0),PKW(pB1,2),PKW(pB1,4),PKW(pB1,6)};pw3=(u32x4){PKW(pB1,8),PKW(pB1,10),PKW(pB1,12),PKW(pB1,14)};
    SBAR(); pv4(o,vb0+2*sl_cur,PAF(0),PAF(1),PAF(2),PAF(3)); }
  #undef PKW
  #undef PAF
  #undef VFR
  #undef PIN
  #undef MX3
  #undef GAPA
  #undef GAPB
  #undef EX
  #undef VRD
  #undef KRD
  #undef QRD
  #undef MF32
  #undef STEP
  #undef ENDW
  {auto rr=__builtin_amdgcn_permlane32_swap(__float_as_uint(l_reg),__float_as_uint(l_reg),false,false);l_reg=__uint_as_float(rr[0])+__uint_as_float(rr[1]);}
  if(hi==0)wsf[32+r32]=l_reg;asm volatile("s_waitcnt lgkmcnt(0)":::"memory");
  float rli[16];
  #pragma unroll
  for(int r=0;r<16;++r)rli[r]=__builtin_amdgcn_rcpf(wsf[32+CROWO(r)]);
  const long obase=(rowbase+q0+wid*QBLK)*DM+vcol;
  bf16*stg=(bf16*)(shm+WL_OST)+wid*2048;
  if(m==0){ bf16*Ow=O+obase;
    #pragma unroll
    for(int half=0;half<2;++half){
      #pragma unroll
      for(int r=0;r<16;++r){const int orow=CROWO(r);
        #pragma unroll
        for(int d0=0;d0<2;++d0)stg[orow*64+d0*32+r32]=__float2bfloat16(o[2*half+d0][r]*rli[r]);}
      asm volatile("s_waitcnt lgkmcnt(0)":::"memory");
      #pragma unroll
      for(int i=0;i<4;++i){const int row=i*8+(lane>>3),ch=lane&7; const u32x4 v=*(const u32x4*)(stg+row*64+ch*8); ATTN_STORE16(Ow+(long)row*DM+half*64+ch*8,v);}
      asm volatile("s_waitcnt lgkmcnt(0)":::"memory"); }
  } else {
    const bf16*O0w=CB.O0+obase; bf16*Aw=CB.A2+obase; const float lam=CB.lam;
    float df[2][4][8]; float ssq[4]={0.f,0.f,0.f,0.f};
    #pragma unroll
    for(int half=0;half<2;++half){
      u32x4 a[4];
      #pragma unroll
      for(int i=0;i<4;++i){const int row=i*8+(lane>>3),ch=lane&7; a[i]=*(const u32x4*)(O0w+(long)row*DM+half*64+ch*8);}
      #pragma unroll
      for(int r=0;r<16;++r){const int orow=CROWO(r);
        #pragma unroll
        for(int d0=0;d0<2;++d0)stg[orow*64+d0*32+r32]=__float2bfloat16(o[2*half+d0][r]*rli[r]);}
      asm volatile("s_waitcnt lgkmcnt(0)":::"memory");
      #pragma unroll
      for(int i=0;i<4;++i){const int row=i*8+(lane>>3),ch=lane&7; const u32x4 v=*(const u32x4*)(stg+row*64+ch*8);
        #pragma unroll
        for(int k=0;k<4;++k){ const float d0_=__uint_as_float(a[i][k]<<16)-lam*__uint_as_float(v[k]<<16), d1_=__uint_as_float(a[i][k]&0xffff0000u)-lam*__uint_as_float(v[k]&0xffff0000u);
          df[half][i][2*k]=d0_; df[half][i][2*k+1]=d1_; ssq[i]+=d0_*d0_; ssq[i]+=d1_*d1_; } }
      asm volatile("s_waitcnt lgkmcnt(0)":::"memory"); }
    #pragma unroll
    for(int i=0;i<4;++i){ float ss=ssq[i];
      ss+=__builtin_bit_cast(float,__builtin_amdgcn_update_dpp(0,__builtin_bit_cast(int,ss),0xB1,0xF,0xF,true));
      ss+=__builtin_bit_cast(float,__builtin_amdgcn_update_dpp(0,__builtin_bit_cast(int,ss),0x4E,0xF,0xF,true));
      ss+=__builtin_bit_cast(float,__builtin_amdgcn_update_dpp(0,__builtin_bit_cast(int,ss),0x141,0xF,0xF,true));
      ssq[i]=1.0f/sqrtf(ss*(1.0f/128.0f)+1e-5f); }
    #pragma unroll
    for(int half=0;half<2;++half){ const int ch=lane&7;
      const f32x4_t w0=*(const f32x4_t*)(CB.w+half*64+ch*8),w1=*(const f32x4_t*)(CB.w+half*64+ch*8+4);
      #pragma unroll
      for(int i=0;i<4;++i){const int row=i*8+(lane>>3); const float rs=ssq[i]; u32x4 ov;
        #pragma unroll
        for(int k=0;k<4;++k){ const float wa=(k<2?w0[2*k]:w1[2*k-4])*CB.mul, wb=(k<2?w0[2*k+1]:w1[2*k-3])*CB.mul; ov[k]=cvtpk_s(df[half][i][2*k]*rs*wa,df[half][i][2*k+1]*rs*wb); }
        ATTN_STORE16(Aw+(long)row*DM+half*64+ch*8,ov);} }
  }
  asm volatile("s_waitcnt lgkmcnt(0)\n\ts_barrier":::"memory");
  #undef DMA_K
  #undef DMA_V
  #undef CMASK
  #undef START
  #undef RESC
  #undef ROT
  #undef CROWO
}
constexpr int ATTNW_LDS_BYTES=WL_BYTES;
struct AttnUnitW { int b, qcol, vcol, m, qb; };
struct StaticOrderW {
  int vcu, G;
  __device__ __forceinline__ StaticOrderW(int grid,int vcu_):vcu(vcu_),G(grid){}
  __device__ __forceinline__ bool next(int i,AttnUnitW&u)const{
    int b,h,m,qb;
    if(G==256){ if(i>=16)return false; const int xcd=vcu>>5,l=vcu&31,s=l>>1,ip=i>>1,bh=xcd*16+8*(l&1)+ip; m=i&1; b=bh>>3; h=bh&7; qb=(ip&1)?s:15-s; }
    else { const int i2=i>>1,ci=vcu+G*(i2>>4); if(ci>=BATCH*8)return false; h=ci&7; m=i&1; b=ci>>3; qb=15-(i2&15); }
    u.b=b; u.qcol=(2*h+m)*64; u.vcol=h*128; u.m=m; u.qb=qb; return true; }
};
template<int THRL=8> __device__ __forceinline__ void attn_phase_w(char*lds,const AttnTensors&T,const StaticOrderW&S,const CombineW&CB,const int tid_){
  AttnUnitW u;
  for(int i=0;S.next(i,u);++i){ attn_unit_w<THRL>(u.b,u.qcol,u.vcol,u.qb,u.m,T.Q,T.K,T.V,T.O0,CB,lds,tid_); }
}
#undef SBAR
#undef WAIT_BAR
}

constexpr int NWAVES = 8;
constexpr int BATCH = 16, SEQ = 4096, D = 1024, M = BATCH * SEQ, DEPTH = 4;
constexpr int NEXP = 32, FF = 512;
constexpr int NSLOT_MAX = 2 * M + NEXP * 256, NBLK_MAX = NSLOT_MAX / 256;
constexpr float LN_EPS = 1e-5f;
constexpr float DN_ALPHA = 1.681792830507429f;
constexpr int HG_CHUNK = 32, HG_NCH = SEQ / HG_CHUNK;

constexpr size_t MiB = 1u << 20;
constexpr size_t WS_CTL = 0, CTL_ZERO_BYTES = 1 * MiB;
constexpr size_t WS_MOD = 1 * MiB;
constexpr size_t WS_ROPE_C = 3 * MiB, WS_ROPE_S = 3 * MiB + 512 * 1024;
constexpr size_t WS_RT = 4 * MiB;
constexpr size_t WS_EID = 5 * MiB;
constexpr size_t WS_WT = 5 * MiB + 512 * 1024;
constexpr size_t WS_TSLOT = 6 * MiB;
constexpr size_t WS_SLOTW = 6 * MiB + 512 * 1024;
constexpr size_t WS_BLKE = 7 * MiB + 128 * 1024;
constexpr size_t WS_STOK = 7 * MiB + 256 * 1024;
constexpr size_t WS_HGD = 8 * MiB;
constexpr size_t WS_WHIN = 16 * MiB;
constexpr size_t WS_WAIN = 32 * MiB;
constexpr size_t WS_WHOUT = 44 * MiB;
constexpr size_t WS_WAOUT = 48 * MiB;
constexpr size_t WS_W13 = 52 * MiB;
constexpr size_t WS_W2 = 116 * MiB;
constexpr size_t WS_BUF0 = 148 * MiB, BUFSZ = 128 * MiB;
constexpr size_t WS_WB2 = WS_BUF0 + 7 * BUFSZ;
constexpr size_t WS_END = WS_WB2 + 96 * MiB;
constexpr int CW_TMO = 0, CW_CODE = 1;
constexpr int CW_BAR = 4096;
constexpr int CW_CNT = 8192;
static_assert((CW_CNT + 4 * 256) * 4 <= (int)CTL_ZERO_BYTES, "ctl");

constexpr int RING_OFF = 0, RING_BYTES = 147456;
constexpr int LDSCTL_OFF = RING_BYTES, MISC_OFF = LDSCTL_OFF + 512;
constexpr int LDS_BYTES = RING_BYTES + 1024;
static_assert(MISC_OFF + 128 <= LDS_BYTES, "LDS map");
#define GAS __attribute__((address_space(1)))
#define LAS __attribute__((address_space(3)))
typedef unsigned short bf16;
typedef unsigned v4u __attribute__((ext_vector_type(4)));
typedef float f32x4 __attribute__((ext_vector_type(4)));
typedef short bf16x8 __attribute__((ext_vector_type(8)));
typedef GAS unsigned gu32;
typedef GAS unsigned long long gu64;
#define RLX_AGENT __ATOMIC_RELAXED, __HIP_MEMORY_SCOPE_AGENT
#define LDS_WAIT() asm volatile("s_waitcnt lgkmcnt(0)" ::: "memory")
#define VM_WAIT() asm volatile("s_waitcnt vmcnt(0)" ::: "memory")
__device__ __forceinline__ unsigned long long rt() { return __builtin_amdgcn_s_memrealtime(); }
__device__ __forceinline__ unsigned f2bf(float f) { unsigned u = __builtin_bit_cast(unsigned, f); return (u + 0x7fffu + ((u >> 16) & 1u)) >> 16; }
__device__ __forceinline__ unsigned pk2(float lo, float hi) { return f2bf(lo) | (f2bf(hi) << 16); }

#define XB_TMO      128
#define XB_XCNT(j)  (256  + 64 * (j))
#define XB_XSUB(j)  (1280 + 64 * (j))
#define XB_XGEN(j)  (2304 + 64 * (j))
#define XB_TOP      3328
#define XB_TOPGEN   3392
#define XCD_BAR_WORDS 3456
#define XB_SPIN_CAP (1u << 18)

__device__ __forceinline__ unsigned xb_ld(unsigned* p)              { return __hip_atomic_load(p, __ATOMIC_RELAXED, __HIP_MEMORY_SCOPE_AGENT); }
__device__ __forceinline__ unsigned xb_add(unsigned* p, unsigned v) { return __hip_atomic_fetch_add(p, v, __ATOMIC_RELAXED, __HIP_MEMORY_SCOPE_AGENT); }
__device__ __forceinline__ unsigned xb_xcc_id() { return (unsigned)__builtin_amdgcn_s_getreg((3 << 11) | 20) & 0xFu; }
#define XB_SPIN(cond, bar) do { unsigned _sp = 0; while (cond) { __builtin_amdgcn_s_sleep(1); \
    if ((++_sp & 255u) == 0u) { if (xb_ld(&(bar)[XB_TMO])) break; if (_sp > XB_SPIN_CAP) { atomicAdd(&(bar)[XB_TMO], 1u); break; } } } } while (0)

struct XcdBarrier {
    unsigned* bar; unsigned x;
    volatile LAS unsigned* st;
};

__device__ __forceinline__ XcdBarrier xcd_barrier_post(unsigned* bar, volatile LAS unsigned* st) {
    XcdBarrier b; b.bar = bar; b.x = xb_xcc_id(); b.st = st;
    if (threadIdx.x == 0) (void)xb_add(&bar[XB_XCNT(b.x)], 1u);
    return b;
}
__device__ __forceinline__ void xcd_barrier_complete(unsigned* bar, unsigned x, unsigned& nloc, unsigned& nx) {
    const unsigned G = gridDim.x * gridDim.y * gridDim.z;
    unsigned sum, cnt, mine, sp = 0u;
    for (;;) {
        sum = 0u; cnt = 0u; mine = 0u;
#pragma unroll
        for (unsigned j = 0; j < 16; ++j) { const unsigned c = xb_ld(&bar[XB_XCNT(j)]); sum += c; cnt += (c > 0u) ? 1u : 0u; mine = (j == x) ? c : mine; }
        if (sum == G) break;
        __builtin_amdgcn_s_sleep(1);
        if ((++sp & 255u) == 0u) { if (xb_ld(&bar[XB_TMO])) break; if (sp > XB_SPIN_CAP) { atomicAdd(&bar[XB_TMO], 1u); break; } }
    }
    nloc = mine > 0u ? mine : 1u; nx = cnt > 0u ? cnt : 1u;
}

__device__ __forceinline__ void xcd_barrier(const XcdBarrier& b, const int wave_s) {
    asm volatile("s_waitcnt vmcnt(0)" ::: "memory");
    __syncthreads();
    unsigned lane_; asm volatile("v_mbcnt_lo_u32_b32 %0, -1, 0\n\tv_mbcnt_hi_u32_b32 %0, -1, %0" : "=v"(lane_));
    if (wave_s == 0 && lane_ == 0u) {
        unsigned* bar = b.bar; asm volatile("" : "+s"(bar));
        __builtin_amdgcn_s_waitcnt(0);
        unsigned nloc = b.st[0], nx = b.st[1];
        if (nloc == 0u) { xcd_barrier_complete(bar, b.x, nloc, nx); b.st[0] = nloc; b.st[1] = nx; }
        const unsigned old = xb_add(&bar[XB_XSUB(b.x)], 1u);
        const unsigned gen = old / nloc;
        if (old + 1u == (gen + 1u) * nloc) {
            __builtin_amdgcn_fence(__ATOMIC_RELEASE, "agent");
            asm volatile("s_waitcnt vmcnt(0)" ::: "memory");
            const unsigned og = xb_add(&bar[XB_TOP], 1u);
            const unsigned tg = og / nx;
            if (og + 1u == (tg + 1u) * nx) xb_add(&bar[XB_TOPGEN], 1u);
            else XB_SPIN(xb_ld(&bar[XB_TOPGEN]) == tg, bar);
            __builtin_amdgcn_fence(__ATOMIC_ACQUIRE, "agent");
            xb_add(&bar[XB_XGEN(b.x)], 1u);
            asm volatile("s_waitcnt vmcnt(0)" ::: "memory");
        } else {
            XB_SPIN(xb_ld(&bar[XB_XGEN(b.x)]) == gen, bar);
            __builtin_amdgcn_fence(__ATOMIC_ACQUIRE, "agent");
            asm volatile("s_waitcnt vmcnt(0)" ::: "memory");
        }
    }
    __syncthreads();
}

struct Args { const float* in[21]; float* out; unsigned char* ws; int ph_lo, ph_hi; };
#define CAS __attribute__((address_space(4)))
struct KA { const CAS char* p;
    __device__ __forceinline__ const float* in(int k) const { return *(const float* const CAS*)(p + 8 * k); }
    __device__ __forceinline__ float* out() const { return *(float* const CAS*)(p + 8 * 21); }
    __device__ __forceinline__ unsigned char* ws() const { return *(unsigned char* const CAS*)(p + 8 * 22); }
    __device__ __forceinline__ int ph_lo() const { return *(const CAS int*)(p + 8 * 23); }
    __device__ __forceinline__ int ph_hi() const { return *(const CAS int*)(p + 8 * 23 + 4); }
};
__device__ __forceinline__ KA karg_fresh() { const CAS char* q = (const CAS char*)__builtin_amdgcn_kernarg_segment_ptr(); asm volatile("" : "+s"(q)); KA k; k.p = q; return k; }
struct Frame {
    LAS unsigned char* lds; volatile LAS unsigned* MISC; gu32* ctl;
    int tid, lane, wave, vcu, G, bx;
};
typedef unsigned long long u64;
typedef float f32x16 __attribute__((ext_vector_type(16)));
template <int CTRL> __device__ __forceinline__ float dpp_mov(float v) { return __builtin_bit_cast(float, __builtin_amdgcn_update_dpp(0, __builtin_bit_cast(int, v), CTRL, 0xF, 0xF, true)); }
__device__ __forceinline__ float row8_sum(float v) { v += dpp_mov<0xB1>(v); v += dpp_mov<0x4E>(v); v += dpp_mov<0x141>(v); return v; }
__device__ __forceinline__ float wave_sum(float v, int) { v = row8_sum(v); v += dpp_mov<0x140>(v);
    const float r0 = __builtin_bit_cast(float, __builtin_amdgcn_readlane(__builtin_bit_cast(int, v), 0)), r1 = __builtin_bit_cast(float, __builtin_amdgcn_readlane(__builtin_bit_cast(int, v), 16));
    const float r2 = __builtin_bit_cast(float, __builtin_amdgcn_readlane(__builtin_bit_cast(int, v), 32)), r3 = __builtin_bit_cast(float, __builtin_amdgcn_readlane(__builtin_bit_cast(int, v), 48));
    return (r0 + r1) + (r2 + r3); }
__device__ __forceinline__ float bf2f(unsigned b) { return __uint_as_float(b << 16); }
__device__ __forceinline__ float bflo(unsigned w) { return __uint_as_float(w << 16); }
__device__ __forceinline__ float bfhi(unsigned w) { return __uint_as_float(w & 0xffff0000u); }
__device__ __forceinline__ float fexp(float x) { return __builtin_amdgcn_exp2f(1.4426950408889634f * x); }
__device__ __forceinline__ float sigmoid_f(float x) { return __builtin_amdgcn_rcpf(1.0f + fexp(-x)); }
__device__ __forceinline__ unsigned pkbf(float lo, float hi) { return pg8::cvt_pk_bf16(lo, hi); }
typedef _Float16 f16x2_t __attribute__((ext_vector_type(2))); typedef float f32x2_t2 __attribute__((ext_vector_type(2)));
__device__ __forceinline__ unsigned pkh(float lo, float hi) { const f32x2_t2 v = {lo, hi}; return __builtin_bit_cast(unsigned, __builtin_convertvector(v, f16x2_t)); }
__device__ __forceinline__ f32x4 unpk_h4(u64 w) { const f16x2_t a = __builtin_bit_cast(f16x2_t, (unsigned)w), b = __builtin_bit_cast(f16x2_t, (unsigned)(w >> 32)); return (f32x4){(float)a[0], (float)a[1], (float)b[0], (float)b[1]}; }
__device__ __forceinline__ int swap23(int p) { return (p & ~12) | ((p & 4) << 1) | ((p & 8) >> 1); }
__device__ __forceinline__ int crow16(int i, int hh) { return (i & 3) + 8 * (i >> 2) + 4 * hh; }

struct MapId { __device__ __forceinline__ int operator()(int n) const { return n; } };
struct MapW13 { int add; __device__ __forceinline__ int operator()(int u) const { return ((u >> 7) << 8) + add + (u & 127); } };
struct MapHgrnIn { __device__ __forceinline__ int operator()(int n) const { return (n < 2048) ? ((n & ~1023) | swap23(n & 1023)) : n; } };
struct MapAttnIn { __device__ __forceinline__ int operator()(int n) const { if (n >= 2048) return n; const int part = n >> 10, c = n & 1023, hm = c >> 6, dim = c & 63;
    return part * 1024 + (hm >> 2) * 256 + (dim >> 5) * 128 + (hm & 3) * 32 + (dim & 31); } };
template <class MapF>
__device__ __forceinline__ void transpose_item(const float* W, int K, int N, bf16* WT, LAS float* scr, int item, int lane, MapF map) {
    const int nblk = N / 32, kb = item / nblk, nb = item % nblk, k0 = 64 * kb, n0 = 32 * nb;
#pragma unroll 8
    for (int i = 0; i < 32; ++i) { const int kk = 2 * i + (lane >> 5); scr[kk * 33 + (lane & 31)] = W[(size_t)(k0 + kk) * N + n0 + (lane & 31)]; }
    LDS_WAIT(); asm volatile("" ::: "memory");
    const int c = lane & 7;
#pragma unroll
    for (int j = 0; j < 4; ++j) { const int n = (lane >> 3) + 8 * j; const LAS float* s = scr + (8 * c) * 33 + n;
        v4u o; o.x = pkbf(s[0 * 33], s[1 * 33]); o.y = pkbf(s[2 * 33], s[3 * 33]); o.z = pkbf(s[4 * 33], s[5 * 33]); o.w = pkbf(s[6 * 33], s[7 * 33]);
        *(GAS v4u*)(WT + (size_t)map(n0 + n) * K + k0 + 8 * c) = o; }
    LDS_WAIT(); asm volatile("" ::: "memory");
}
__device__ __forceinline__ unsigned char* moe_wbuf(unsigned char* ws, int L) { return (L & 1) ? ws + WS_WB2 : ws + WS_W13; }
struct ConvItem { const float* W; bf16* WT; int K, N, k0, n0, add; };
__device__ __forceinline__ ConvItem conv_item(const KA a, int L, int it) {
    const int e = it / 768, r = it % 768; const size_t eo = (size_t)(L * 32 + e) * 1024 * 512; ConvItem c;
    bf16* W13 = (bf16*)moe_wbuf(a.ws(), L) + (size_t)e * 1024 * 1024; bf16* W2 = (bf16*)(moe_wbuf(a.ws(), L) + 64 * MiB) + (size_t)e * 1024 * 512;
    if (r < 512) { const int rr = r & 255; c.W = (r < 256 ? a.in(18) : a.in(19)) + eo; c.WT = W13; c.K = 1024; c.N = 512; c.k0 = 64 * (rr >> 4); c.n0 = 32 * (rr & 15); c.add = (r < 256) ? 0 : 128; }
    else { const int rr = r - 512; c.W = a.in(20) + eo; c.WT = W2; c.K = 512; c.N = 1024; c.k0 = 64 * (rr >> 5); c.n0 = 32 * (rr & 31); c.add = -1; }
    return c;
}
__device__ __forceinline__ void conv_load(const ConvItem& c, int lane, f32x4 (&v)[8]) {
#pragma unroll
    for (int i = 0; i < 8; ++i) v[i] = *(const f32x4*)(c.W + (size_t)(c.k0 + 8 * (lane >> 3) + i) * c.N + c.n0 + 4 * (lane & 7));
}
__device__ __forceinline__ void conv_store(const ConvItem& c, int lane, const f32x4 (&v)[8]) {
#pragma unroll
    for (int cc = 0; cc < 4; ++cc) { const int n = c.n0 + 4 * (lane & 7) + cc;
        const int row = (c.add == -1) ? n : (c.add == -2) ? MapHgrnIn{}(n) : (c.add == -3) ? MapAttnIn{}(n) : (((n >> 7) << 8) + c.add + (n & 127));
        v4u o; o.x = pkbf(v[0][cc], v[1][cc]); o.y = pkbf(v[2][cc], v[3][cc]); o.z = pkbf(v[4][cc], v[5][cc]); o.w = pkbf(v[6][cc], v[7][cc]);
        *(GAS v4u*)(c.WT + (size_t)row * c.K + c.k0 + 8 * (lane >> 3)) = o; }
}
constexpr int MIX_HIN = 16 * 128, MIX_OUT = 16 * 32, MIX_AIN = 16 * 96, MIX_PER = MIX_HIN + MIX_OUT + MIX_AIN + MIX_OUT, MIX_FIRST = MIX_HIN + MIX_OUT;
__device__ __forceinline__ ConvItem mix_item(const KA a, int it) {
    const int j = it / MIX_PER; int r = it % MIX_PER; ConvItem c; c.K = 1024;
    if (r < MIX_HIN) { c.W = a.in(6) + (size_t)j * 1024 * 4096; c.WT = (bf16*)(a.ws() + WS_WHIN) + (size_t)j * 4096 * 1024; c.N = 4096; c.add = -2; }
    else if ((r -= MIX_HIN) < MIX_OUT) { c.W = a.in(7) + (size_t)j * 1024 * 1024; c.WT = (bf16*)(a.ws() + WS_WHOUT) + (size_t)j * 1024 * 1024; c.N = 1024; c.add = -1; }
    else if ((r -= MIX_OUT) < MIX_AIN) { c.W = a.in(10) + (size_t)j * 1024 * 3072; c.WT = (bf16*)(a.ws() + WS_WAIN) + (size_t)j * 3072 * 1024; c.N = 3072; c.add = -3; }
    else { r -= MIX_AIN; c.W = a.in(11) + (size_t)j * 1024 * 1024; c.WT = (bf16*)(a.ws() + WS_WAOUT) + (size_t)j * 1024 * 1024; c.N = 1024; c.add = -1; }
    const int nblk = c.N / 32; c.k0 = 64 * (r / nblk); c.n0 = 32 * (r % nblk);
    return c;
}
__device__ __forceinline__ void convert_mixer(const KA a, int lane, int first, int last, int gw, int ngw) {
    for (int it = first + gw; it < last; it += ngw) { const ConvItem c = mix_item(a, it); f32x4 v[8]; conv_load(c, lane, v); conv_store(c, lane, v); }
}
__device__ __forceinline__ void convert_moe(Frame& F, const KA a, int L, int cw, int nconv) {
    const int gw = F.vcu * nconv + cw, NGW = F.G * nconv;
    if (gw >= 32 * 768) return;
    ConvItem cur = conv_item(a, L, gw); f32x4 v[8]; conv_load(cur, F.lane, v);
    for (int it = gw; it < 32 * 768; it += NGW) {
        const int nx = it + NGW; ConvItem nxt = cur; f32x4 vn[8];
        if (nx < 32 * 768) { nxt = conv_item(a, L, nx); conv_load(nxt, F.lane, vn); }
        conv_store(cur, F.lane, v);
        cur = nxt;
#pragma unroll
        for (int i = 0; i < 8; ++i) v[i] = vn[i];
    }
}

__device__ __forceinline__ void phase_p0a(Frame& F, const KA a) {
    const int gw = F.vcu * NWAVES + F.wave, NGW = F.G * NWAVES;
    const float* c = a.in(1); const float* ada_w = a.in(2); const float* ada_b = a.in(3);
    float* mod = (float*)(a.ws() + WS_MOD);
    if (F.vcu < 4 * 24) {
        LAS float* sl = (LAS float*)(F.lds + RING_OFF + 65536);
        for (int idx = F.tid; idx < 16 * 1024; idx += 512) { const int k = idx & 1023, b = idx >> 10; const float cv = c[idx]; sl[k * 16 + b] = cv * sigmoid_f(cv); }
        __syncthreads();
    }
    for (int it = F.vcu; it < 4 * 24; it += F.G) {
        const int i = it / 24, nb = it % 24;
        f32x4 acc[16];
#pragma unroll
        for (int b = 0; b < 16; ++b) acc[b] = (f32x4){0.f, 0.f, 0.f, 0.f};
        const float* wp = ada_w + ((size_t)i * 1024 + F.wave * 128) * 6144 + nb * 256 + 4 * F.lane;
        const LAS float* sw = (const LAS float*)(F.lds + RING_OFF + 65536) + F.wave * 128 * 16;
        for (int k0 = 0; k0 < 128; k0 += 8) {
            f32x4 w4[8];
#pragma unroll
            for (int kk = 0; kk < 8; ++kk) w4[kk] = *(const f32x4*)(wp + (size_t)(k0 + kk) * 6144);
#pragma unroll
            for (int kk = 0; kk < 8; ++kk) {
                const LAS f32x4* sp = (const LAS f32x4*)(sw + (k0 + kk) * 16);
                const f32x4 s0 = sp[0], s1 = sp[1], s2 = sp[2], s3 = sp[3];
#pragma unroll
                for (int b = 0; b < 4; ++b) { acc[b] += w4[kk] * s0[b]; acc[4 + b] += w4[kk] * s1[b]; acc[8 + b] += w4[kk] * s2[b]; acc[12 + b] += w4[kk] * s3[b]; }
            }
        }
        LAS float* red = (LAS float*)(F.lds + RING_OFF);
#pragma unroll
        for (int hb = 0; hb < 2; ++hb) {
#pragma unroll
            for (int b = 0; b < 8; ++b) *(LAS f32x4*)(red + (F.wave * 8 + b) * 256 + 4 * F.lane) = acc[8 * hb + b];
            __syncthreads();
            for (int r = 0; r < 4; ++r) { const int idx = F.tid + 512 * r, b = idx >> 8, col = idx & 255; float s = ada_b[i * 6144 + nb * 256 + col];
#pragma unroll
                for (int w = 0; w < 8; ++w) s += red[(w * 8 + b) * 256 + col];
                mod[((size_t)i * 16 + 8 * hb + b) * 6144 + nb * 256 + col] = s; }
            __syncthreads();
        }
    }
    {
        float* cs = (float*)(a.ws() + WS_ROPE_C); float* sn = (float*)(a.ws() + WS_ROPE_S);
        for (int idx = gw * 64 + F.lane; idx < SEQ * 32; idx += NGW * 64) {
            const int pos = idx >> 5, j = idx & 31;
            double f = 1.0; const double r1 = 0.74989420933245582730;
            double p = r1;
#pragma unroll
            for (int bit = 0; bit < 5; ++bit) { if (j & (1 << bit)) f *= p; p *= p; }
            const double ang = (double)pos * f;
            const double kq = __builtin_rint(ang * 0.63661977236758134308);
            const double rr = (ang - kq * 1.57079632679489655800e+00) - kq * 6.12323399573676603587e-17;
            const double r2 = rr * rr;
            const double sp = rr * (1.0 + r2 * (-1.0 / 6 + r2 * (1.0 / 120 + r2 * (-1.0 / 5040 + r2 * (1.0 / 362880 + r2 * (-1.0 / 39916800 + r2 * (1.0 / 6227020800.0)))))));
            const double cp = 1.0 + r2 * (-0.5 + r2 * (1.0 / 24 + r2 * (-1.0 / 720 + r2 * (1.0 / 40320 + r2 * (-1.0 / 3628800 + r2 * (1.0 / 479001600.0 + r2 * (-1.0 / 87178291200.0)))))));
            const int q = ((int)kq) & 3;
            const double sv = (q == 0) ? sp : (q == 1) ? cp : (q == 2) ? -sp : -cp;
            const double cv = (q == 0) ? cp : (q == 1) ? -sp : (q == 2) ? -cp : sp;
            cs[idx] = (float)cv; sn[idx] = (float)sv;
        }
    }
    {
        float* rt = (float*)(a.ws() + WS_RT); const float* rgw = a.in(14); const float* rew = a.in(16);
        for (int idx = gw * 64 + F.lane; idx < 4 * 36 * 1024; idx += NGW * 64) {
            const int l = idx / 36864, e = (idx >> 10) % 36, k = idx & 1023;
            rt[idx] = (e < 4) ? rgw[((size_t)l * 1024 + k) * 4 + e] : rew[((size_t)l * 1024 + k) * 32 + (e - 4)];
        }
    }
    convert_mixer(a, F.lane, 0, MIX_FIRST, gw, NGW);
}

__device__ __forceinline__ void phase_p0b(Frame& F, const KA a) {
    const int gw = F.vcu * NWAVES + F.wave, NGW = F.G * NWAVES;
    const float* x = a.in(0); const float* mod = (const float*)(a.ws() + WS_MOD); bf16* h = (bf16*)(a.ws() + WS_BUF0);
#define P0B_LOAD(X, t_) do { _Pragma("unroll") for (int tt = 0; tt < 4; ++tt) _Pragma("unroll") for (int j = 0; j < 4; ++j) X[tt][j] = *(const f32x4*)(x + (size_t)((t_) + tt) * D + 4 * F.lane + 256 * j); } while (0)
#define P0B_PROC(X, t_) do { const float* mb = mod + (size_t)((t_) >> 12) * 6144; \
        _Pragma("unroll") for (int j = 0; j < 4; ++j) { const int col = 4 * F.lane + 256 * j; const f32x4 sh = *(const f32x4*)(mb + col), sc = *(const f32x4*)(mb + 1024 + col) + 1.0f; \
            _Pragma("unroll") for (int tt = 0; tt < 4; ++tt) { const f32x4 hv = X[tt][j] * sc + sh; \
                *(u64*)(h + (size_t)((t_) + tt) * D + col) = (u64)pkbf(hv[0], hv[1]) | ((u64)pkbf(hv[2], hv[3]) << 32); } } } while (0)
    const int step = NGW * 4;
    f32x4 xa[4][4], xb[4][4];
    int t0 = gw * 4;
    if (t0 < M) P0B_LOAD(xa, t0);
    for (; t0 < M; t0 += 2 * step) {
        const int t1 = t0 + step, t2 = t1 + step;
        if (t1 < M) P0B_LOAD(xb, t1);
        P0B_PROC(xa, t0);
        if (t2 < M) P0B_LOAD(xa, t2);
        if (t1 < M) P0B_PROC(xb, t1);
    }
#undef P0B_LOAD
#undef P0B_PROC
}

__device__ __forceinline__ void phase_hgrn_prep(Frame& F, const KA a, int j) {
    bf16* Qb = (bf16*)(a.ws() + WS_BUF0 + 1 * BUFSZ); bf16* Zb = (bf16*)(a.ws() + WS_BUF0 + 2 * BUFSZ);
    float* dd = (float*)(a.ws() + WS_HGD);
    const float* lb = a.in(8);
    const int grp = F.tid >> 7, jt = F.tid & 127, col = 8 * jt, h = col >> 7, pos = col & 127;
    const int ch0 = swap23(pos), ch1 = swap23(pos + 4);
    float oml[8];
#pragma unroll
    for (int c = 0; c < 8; ++c) oml[c] = 1.0f;
    if (j == 1) {
#pragma unroll
        for (int c = 0; c < 4; ++c) { oml[c] = 1.0f - sigmoid_f(lb[1024 + h * 128 + ch0 + c] - lb[h * 128 + ch0 + c]); oml[4 + c] = 1.0f - sigmoid_f(lb[1024 + h * 128 + ch1 + c] - lb[h * 128 + ch1 + c]); } }
    constexpr int NIT = BATCH * HG_NCH;
    float bs[8];
#define HP_IT(s_) (F.vcu + F.G * (grp + 4 * ((s_) >> 2)))
#define HP_LOAD(Z, Q, s_) do { int it_ = HP_IT(s_); it_ = (it_ < NIT) ? it_ : 0;        \
        const size_t tk_ = (size_t)(it_ >> 7) * SEQ + (it_ & (HG_NCH - 1)) * HG_CHUNK + 8 * ((s_) & 3); \
        _Pragma("unroll") for (int t = 0; t < 8; ++t) { Z[t] = *(const v4u*)(Zb + (tk_ + t) * D + col); Q[t] = *(const v4u*)(Qb + (tk_ + t) * D + col); } } while (0)
#define HP_PROC(Z, Q, s_) do { const int it_ = HP_IT(s_); const int chunk_ = it_ & (HG_NCH - 1), b_ = it_ >> 7; const size_t tk_ = (size_t)b_ * SEQ + chunk_ * HG_CHUNK + 8 * ((s_) & 3); \
        if (((s_) & 3) == 0) { _Pragma("unroll") for (int c = 0; c < 8; ++c) bs[c] = 0.f; } \
        _Pragma("unroll") for (int t = 0; t < 8; ++t) { v4u qo, ko; \
            _Pragma("unroll") for (int i = 0; i < 4; ++i) { \
                const float k0 = oml[2 * i] * sigmoid_f(-bflo(Z[t][i])), k1 = oml[2 * i + 1] * sigmoid_f(-bfhi(Z[t][i])); \
                const float g0 = (k0 < 0.05f) ? -k0 * (1.0f + k0 * (0.5f + k0 * (0.33333333f + k0 * 0.25f))) : 0.69314718056f * __builtin_amdgcn_logf(1.0f - k0); \
                const float g1 = (k1 < 0.05f) ? -k1 * (1.0f + k1 * (0.5f + k1 * (0.33333333f + k1 * 0.25f))) : 0.69314718056f * __builtin_amdgcn_logf(1.0f - k1); \
                bs[2 * i] += g0; bs[2 * i + 1] += g1; \
                qo[i] = pkbf(bflo(Q[t][i]) * fexp(bs[2 * i]), bfhi(Q[t][i]) * fexp(bs[2 * i + 1])); \
                ko[i] = pkbf(k0 * fexp(fminf(-bs[2 * i], 80.0f)), k1 * fexp(fminf(-bs[2 * i + 1], 80.0f))); } \
            *(v4u*)(Qb + (tk_ + t) * D + col) = qo; *(v4u*)(Zb + (tk_ + t) * D + col) = ko; } \
        if (((s_) & 3) == 3) { const size_t rowbase_ = ((size_t)(b_ * 8 + h) * HG_NCH + chunk_) * 128; \
            *(f32x4*)(dd + rowbase_ + ch0) = (f32x4){fexp(bs[0]), fexp(bs[1]), fexp(bs[2]), fexp(bs[3])}; *(f32x4*)(dd + rowbase_ + ch1) = (f32x4){fexp(bs[4]), fexp(bs[5]), fexp(bs[6]), fexp(bs[7])}; } } while (0)
    v4u za[8], qa[8], zb[8], qb[8];
    int s = 0;
    HP_LOAD(za, qa, 0);
    for (; HP_IT(s) < NIT; s += 2) {
        HP_LOAD(zb, qb, s + 1);
        HP_PROC(za, qa, s);
        HP_LOAD(za, qa, s + 2);
        HP_PROC(zb, qb, s + 1);
    }
#undef HP_IT
#undef HP_LOAD
#undef HP_PROC
}

#define MFMA32(a_, b_, c_) __builtin_amdgcn_mfma_f32_32x32x16_bf16((a_), (b_), (c_), 0, 0, 0)
typedef float f32x2_pk __attribute__((ext_vector_type(2))); typedef __bf16 bf16x2_pk __attribute__((ext_vector_type(2)));
__device__ __forceinline__ unsigned cvt2(float lo, float hi) { const f32x2_pk v = {lo, hi}; return __builtin_bit_cast(unsigned, __builtin_convertvector(v, bf16x2_pk)); }
__device__ __forceinline__ bf16x8 pack_half(const f32x16& x, int s) {
    v4u p; p.x = cvt2(x[8 * s + 0], x[8 * s + 1]); p.y = cvt2(x[8 * s + 2], x[8 * s + 3]); p.z = cvt2(x[8 * s + 4], x[8 * s + 5]); p.w = cvt2(x[8 * s + 6], x[8 * s + 7]);
    return __builtin_bit_cast(bf16x8, p);
}
constexpr int HS_Q = 0, HS_K = 8192, HS_V = 16384, HS_D = 18432, HS_BUF = 18944, HS_NBUF = 3, HS_WAVE = HS_NBUF * HS_BUF, HS_OST = 2 * HS_WAVE, HS_CONV = HS_OST + 4096, HS_NCONV = 6;
static_assert(HS_CONV <= RING_BYTES, "scan LDS map");
typedef short s16x4_t __attribute__((ext_vector_type(4)));
__device__ __forceinline__ void phase_hgrn_scan(Frame& F, const KA a, int layer) {
    const bf16* Qt = (const bf16*)(a.ws() + WS_BUF0 + 1 * BUFSZ); const bf16* Kt = (const bf16*)(a.ws() + WS_BUF0 + 2 * BUFSZ);
    const bf16* Vb = (const bf16*)(a.ws() + WS_BUF0 + 3 * BUFSZ); const float* dd = (const float*)(a.ws() + WS_HGD);
    bf16* O = (bf16*)(a.ws() + WS_BUF0 + 6 * BUFSZ);
    if (F.wave >= 2) {
        if (F.wave < 2 + HS_NCONV) { if (layer == 0) convert_mixer(a, F.lane, MIX_FIRST, 2 * MIX_PER, F.vcu * HS_NCONV + F.wave - 2, F.G * HS_NCONV);
            convert_moe(F, a, layer, F.wave - 2, HS_NCONV); convert_moe(F, a, layer + 1, F.wave - 2, HS_NCONV); }
        return; }
    LAS unsigned char* ring = F.lds + RING_OFF + F.wave * HS_WAVE;
    LAS unsigned char* ost = F.lds + RING_OFF + HS_OST + F.wave * 2048;
    for (int u = F.vcu; u < BATCH * 8 * 2; u += F.G) {
        const int bh = u >> 1, vt = (u & 1) * 2 + F.wave, b = bh >> 3, h = bh & 7;
        const int r = F.lane & 31, hh = F.lane >> 5;
        f32x16 S[4];
#pragma unroll
        for (int kt = 0; kt < 4; ++kt)
#pragma unroll
            for (int i = 0; i < 16; ++i) S[kt][i] = 0.f;
        const bf16* Qp = Qt + ((size_t)b * SEQ + r) * D + h * 128 + 8 * hh;
        const bf16* Kp = Kt + ((size_t)b * SEQ + r) * D + h * 128 + 8 * hh;
        const bf16* Vp = Vb + ((size_t)b * SEQ + (F.lane >> 2)) * D + h * 128 + 32 * vt + 8 * (F.lane & 3);
        const float* dp = dd + (size_t)bh * HG_NCH * 128 + F.lane;
        bf16* op2 = O + ((size_t)b * SEQ + 4 * hh) * D + h * 128 + 32 * vt + r;
        const int i16 = F.lane & 15, blk = (F.lane >> 4) & 1, tq = i16 >> 2, tp = i16 & 3, tpp = ((tp & 1) << 1) | (tp >> 1);
        const int trb = HS_K + blk * 1024 + (tpp >> 1) * 512 + (4 * hh + tq) * 16 + (tpp & 1) * 8;
        const int vtrb = HS_V + (4 * hh + tq) * 64 + 32 * blk + 8 * tp;
#define HS_DMA(c_, buf_) do { LAS unsigned char* bb_ = ring + (buf_) * HS_BUF; \
        _Pragma("unroll") for (int ks = 0; ks < 8; ++ks) { __builtin_amdgcn_global_load_lds((const unsigned*)(Qp + (size_t)(c_) * 32 * D + 16 * ks), (LAS unsigned*)(bb_ + HS_Q + ks * 1024), 16, 0, 0); \
                                                        __builtin_amdgcn_global_load_lds((const unsigned*)(Kp + (size_t)(c_) * 32 * D + 16 * ks), (LAS unsigned*)(bb_ + HS_K + ks * 1024), 16, 0, 0); } \
        _Pragma("unroll") for (int st = 0; st < 2; ++st) __builtin_amdgcn_global_load_lds((const unsigned*)(Vp + ((size_t)(c_) * 32 + 16 * st) * D), (LAS unsigned*)(bb_ + HS_V + st * 1024), 16, 0, 0); \
        _Pragma("unroll") for (int q_ = 0; q_ < 2; ++q_) __builtin_amdgcn_global_load_lds((const unsigned*)(dp + (size_t)(c_) * 128 + 64 * q_), (LAS unsigned*)(bb_ + HS_D + q_ * 256), 4, 0, 0); } while (0)
        asm volatile("s_waitcnt lgkmcnt(0)" ::: "memory");
        HS_DMA(0, 0); HS_DMA(1, 1);
        int bcur = 0, bnext = 2;
        for (int c = 0; c < HG_NCH; ++c) {
            const int cn = (c + 2 < HG_NCH) ? c + 2 : HG_NCH - 1;
            HS_DMA(cn, bnext);
            if (c == 0) asm volatile("s_waitcnt vmcnt(40)" ::: "memory");
            else asm volatile("s_waitcnt vmcnt(56)" ::: "memory");
            const LAS unsigned char* bbase = ring + bcur * HS_BUF;
            const LAS unsigned char* bb = bbase + F.lane * 16;
            bf16x8 Qf[8], Kf[8], Vf[2];
            { const unsigned vba = (unsigned)(uintptr_t)(bbase + vtrb); s16x4_t v0, v1, v2, v3;
              asm volatile("ds_read_b64_tr_b16 %0, %1 offset:0" : "=&v"(v0) : "v"(vba) : "memory"); asm volatile("ds_read_b64_tr_b16 %0, %1 offset:512" : "=&v"(v1) : "v"(vba) : "memory");
              asm volatile("ds_read_b64_tr_b16 %0, %1 offset:1024" : "=&v"(v2) : "v"(vba) : "memory"); asm volatile("ds_read_b64_tr_b16 %0, %1 offset:1536" : "=&v"(v3) : "v"(vba) : "memory");
#pragma unroll
              for (int ks = 0; ks < 8; ++ks) { Qf[ks] = *(const LAS bf16x8*)(bb + HS_Q + ks * 1024); Kf[ks] = *(const LAS bf16x8*)(bb + HS_K + ks * 1024); }
              asm volatile("s_waitcnt lgkmcnt(0)" : "+v"(v0), "+v"(v1), "+v"(v2), "+v"(v3) :: "memory");
              Vf[0] = (bf16x8){v0[0], v0[1], v0[2], v0[3], v1[0], v1[1], v1[2], v1[3]}; Vf[1] = (bf16x8){v2[0], v2[1], v2[2], v2[3], v3[0], v3[1], v3[2], v3[3]}; }
            f32x16 sc0, sc1;
#pragma unroll
            for (int i = 0; i < 16; ++i) { sc0[i] = 0.f; sc1[i] = 0.f; }
#pragma unroll
            for (int ks = 0; ks < 8; ks += 2) { sc0 = MFMA32(Kf[ks], Qf[ks], sc0); sc1 = MFMA32(Kf[ks + 1], Qf[ks + 1], sc1); }
#pragma unroll
            for (int i = 0; i < 16; ++i) sc0[i] = (crow16(i, hh) > r) ? 0.f : (sc0[i] + sc1[i]);
            f32x16 oA, oB;
#pragma unroll
            for (int i = 0; i < 16; ++i) { oA[i] = 0.f; oB[i] = 0.f; }
#pragma unroll
            for (int kt = 0; kt < 4; kt += 2)
#pragma unroll
                for (int st = 0; st < 2; ++st) { oA = MFMA32(Qf[2 * kt + st], pack_half(S[kt], st), oA); oB = MFMA32(Qf[2 * kt + 2 + st], pack_half(S[kt + 1], st), oB); }
            oA = MFMA32(pack_half(sc0, 0), Vf[0], oA); oB = MFMA32(pack_half(sc0, 1), Vf[1], oB);
            const LAS float* dl = (const LAS float*)(bbase + HS_D) + 4 * hh;
            const unsigned tba = (unsigned)(uintptr_t)(bbase + trb);
            s16x4_t klo[8], khi[8];
#pragma unroll
            for (int f = 0; f < 8; ++f) {
                asm volatile("ds_read_b64_tr_b16 %0, %1 offset:%c2" : "=&v"(klo[f]) : "v"(tba), "i"((f >> 1) * 2048 + (f & 1) * 256) : "memory");
                asm volatile("ds_read_b64_tr_b16 %0, %1 offset:%c2" : "=&v"(khi[f]) : "v"(tba), "i"((f >> 1) * 2048 + (f & 1) * 256 + 128) : "memory"); }
            asm volatile("s_waitcnt lgkmcnt(0)" : "+v"(klo[0]), "+v"(klo[1]), "+v"(klo[2]), "+v"(klo[3]), "+v"(klo[4]), "+v"(klo[5]), "+v"(klo[6]), "+v"(klo[7]) :: "memory");
            asm volatile("" : "+v"(khi[0]), "+v"(khi[1]), "+v"(khi[2]), "+v"(khi[3]), "+v"(khi[4]), "+v"(khi[5]), "+v"(khi[6]), "+v"(khi[7]) :: "memory");
#pragma unroll
            for (int kt = 0; kt < 4; ++kt) {
#pragma unroll
                for (int st = 0; st < 2; ++st) { const int f = kt * 2 + st;
                    const bf16x8 kh = (bf16x8){klo[f][0], klo[f][1], klo[f][2], klo[f][3], khi[f][0], khi[f][1], khi[f][2], khi[f][3]};
                    S[kt] = MFMA32(kh, Vf[st], S[kt]); }
#pragma unroll
                for (int g = 0; g < 4; ++g) { const f32x4 dv = *(const LAS f32x4*)(dl + 32 * kt + 8 * g);
#pragma unroll
                    for (int i = 0; i < 4; ++i) S[kt][4 * g + i] *= dv[i]; }
            }
#pragma unroll
            for (int i = 0; i < 16; ++i) *(unsigned short*)(op2 + ((size_t)c * 32 + crow16(i, 0)) * D) = (unsigned short)(pkbf(oA[i] + oB[i], 0.f) & 0xffffu);
            asm volatile("s_waitcnt lgkmcnt(0)" ::: "memory");
            bcur = (bcur == HS_NBUF - 1) ? 0 : bcur + 1; bnext = (bnext == HS_NBUF - 1) ? 0 : bnext + 1;
        }
        asm volatile("s_waitcnt vmcnt(0)" ::: "memory");
#undef HS_DMA
    }
}

template <int MODE>
__device__ __forceinline__ void phase_normgate(Frame& F, const bf16* P0, const bf16* P1, bf16* out, const float* w, float lam, float mul) {
    const int gw = F.vcu * NWAVES + F.wave, NGW = F.G * NWAVES;
    float wv[16];
#pragma unroll
    for (int i = 0; i < 16; ++i) wv[i] = w[((16 * F.lane) & 127) + i] * mul;
    const int tpw = ((M + NGW - 1) / NGW + 3) & ~3;
#define NG_LOAD(A0, A1, B0, B1, t_) do { _Pragma("unroll") for (int tt = 0; tt < 4; ++tt) { const size_t off = (size_t)((t_) + tt) * D + 16 * F.lane; \
        A0[tt] = *(const v4u*)(P0 + off); A1[tt] = *(const v4u*)(P0 + off + 8); B0[tt] = *(const v4u*)(P1 + off); B1[tt] = *(const v4u*)(P1 + off + 8); } } while (0)
#define NG_PROC(A0, A1, B0, B1, t_) do { _Pragma("unroll") for (int tt = 0; tt < 4; ++tt) { \
            float av[16], bv[16]; \
            _Pragma("unroll") for (int i = 0; i < 4; ++i) { av[2 * i] = bflo(A0[tt][i]); av[2 * i + 1] = bfhi(A0[tt][i]); av[8 + 2 * i] = bflo(A1[tt][i]); av[8 + 2 * i + 1] = bfhi(A1[tt][i]); \
                                          bv[2 * i] = bflo(B0[tt][i]); bv[2 * i + 1] = bfhi(B0[tt][i]); bv[8 + 2 * i] = bflo(B1[tt][i]); bv[8 + 2 * i + 1] = bfhi(B1[tt][i]); } \
            float ss = 0.f; \
            _Pragma("unroll") for (int i = 0; i < 16; ++i) { if (MODE == 1) av[i] = av[i] - lam * bv[i]; ss += av[i] * av[i]; } \
            ss = row8_sum(ss); \
            const float rs = 1.0f / sqrtf(ss * (1.0f / 128.0f) + LN_EPS); \
            v4u o0, o1; \
            _Pragma("unroll") for (int i = 0; i < 8; ++i) { float v0 = av[2 * i] * rs * wv[2 * i], v1 = av[2 * i + 1] * rs * wv[2 * i + 1]; \
                if (MODE == 0) { v0 *= bv[2 * i] * sigmoid_f(bv[2 * i]); v1 *= bv[2 * i + 1] * sigmoid_f(bv[2 * i + 1]); } \
                if (i < 4) o0[i] = pkbf(v0, v1); else o1[i - 4] = pkbf(v0, v1); } \
            const size_t off = (size_t)((t_) + tt) * D + 16 * F.lane; \
            *(v4u*)(out + off) = o0; *(v4u*)(out + off + 8) = o1; } } while (0)
    const int tend = ((gw + 1) * tpw < M) ? (gw + 1) * tpw : M;
    v4u a0[4], a1[4], b0[4], b1[4], c0[4], c1[4], e0[4], e1[4];
    int t0 = gw * tpw;
    if (t0 < tend) NG_LOAD(a0, a1, b0, b1, t0);
    for (; t0 < tend; t0 += 8) {
        if (t0 + 4 < tend) NG_LOAD(c0, c1, e0, e1, t0 + 4);
        NG_PROC(a0, a1, b0, b1, t0);
        if (t0 + 8 < tend) NG_LOAD(a0, a1, b0, b1, t0 + 8);
        if (t0 + 4 < tend) NG_PROC(c0, c1, e0, e1, t0 + 4);
    }
#undef NG_LOAD
#undef NG_PROC
}

__device__ __forceinline__ void phase_l1(Frame& F, const KA a, int layer, const float* xin, const bool dry) {
    const int gw = F.vcu * NWAVES + F.wave, NGW = F.G * NWAVES;
    LAS float* Wr = (LAS float*)(F.lds + RING_OFF);
    LAS unsigned* hist = (LAS unsigned*)(F.lds + LDSCTL_OFF);
    { const f32x4* src = (const f32x4*)((const float*)(a.ws() + WS_RT) + (size_t)layer * 36 * 1024);
      f32x4 tmp[18];
#pragma unroll
      for (int k = 0; k < 18; ++k) tmp[k] = src[F.tid + 512 * k];
#pragma unroll
      for (int k = 0; k < 18; ++k) *(LAS f32x4*)(Wr + 4 * (F.tid + 512 * k)) = tmp[k];
      if (F.tid < 32) hist[F.tid] = 0u; }
    __syncthreads();
    const float* mod = (const float*)(a.ws() + WS_MOD) + (size_t)layer * 16 * 6144;
    const bf16* yb = (const bf16*)(a.ws() + WS_BUF0 + 1 * BUFSZ);
    bf16* h2 = (bf16*)(a.ws() + WS_BUF0);
    const float* lng = a.in(4) + (size_t)(layer * 2 + 0) * D; const float* lnb = a.in(5) + (size_t)(layer * 2 + 0) * D;
    const float* bg = a.in(15) + layer * 4; const float* be = a.in(17) + layer * 32;
    int* eid = (int*)(a.ws() + WS_EID); float* wt = (float*)(a.ws() + WS_WT);
    const unsigned short* xhin = (const unsigned short*)a.out();
    unsigned short* xhout = (unsigned short*)(a.ws() + WS_BUF0 + 1 * BUFSZ);
    const int tpw = ((M + NGW - 1) / NGW + 3) & ~3;
    int curb = -1; f32x4 g1v[4], lgv[4], lbv[4], scv[4], shv[4];
    for (int t0 = gw * tpw; t0 < (gw + 1) * tpw && t0 < M; t0 += 4) {
        const int b = t0 >> 12;
        if (b != curb) { curb = b; const float* mb = mod + (size_t)b * 6144;
#pragma unroll
            for (int j = 0; j < 4; ++j) { const int col = 4 * F.lane + 256 * j; g1v[j] = *(const f32x4*)(mb + 2048 + col); lgv[j] = *(const f32x4*)(lng + col); lbv[j] = *(const f32x4*)(lnb + col);
                scv[j] = *(const f32x4*)(mb + 4096 + col) + 1.0f; shv[j] = *(const f32x4*)(mb + 3072 + col); } }
        f32x4 hv[4][4];
        {
            f32x4 v[4][4]; float s[4] = {0.f, 0.f, 0.f, 0.f};
            u64 yw[4][4];
#pragma unroll
            for (int j = 0; j < 4; ++j)
#pragma unroll
                for (int tt = 0; tt < 4; ++tt) yw[tt][j] = *(const u64*)(yb + (size_t)(t0 + tt) * D + 4 * F.lane + 256 * j);
            if (layer == 0) {
#pragma unroll
                for (int j = 0; j < 4; ++j)
#pragma unroll
                    for (int tt = 0; tt < 4; ++tt) v[tt][j] = *(const f32x4*)(xin + (size_t)(t0 + tt) * D + 4 * F.lane + 256 * j);
            } else { u64 xr[4][4];
#pragma unroll
                for (int j = 0; j < 4; ++j)
#pragma unroll
                    for (int tt = 0; tt < 4; ++tt) xr[tt][j] = *(const u64*)(xhin + (size_t)(t0 + tt) * D + 4 * F.lane + 256 * j);
#pragma unroll
                for (int j = 0; j < 4; ++j)
#pragma unroll
                    for (int tt = 0; tt < 4; ++tt) v[tt][j] = unpk_h4(xr[tt][j]);
            }
#pragma unroll
            for (int j = 0; j < 4; ++j) { const f32x4 g1 = g1v[j];
#pragma unroll
                for (int tt = 0; tt < 4; ++tt) { const u64 y_ = yw[tt][j];
                    f32x4 yv; yv[0] = bflo((unsigned)y_); yv[1] = bfhi((unsigned)y_); yv[2] = bflo((unsigned)(y_ >> 32)); yv[3] = bfhi((unsigned)(y_ >> 32));
                    v[tt][j] = v[tt][j] * DN_ALPHA + g1 * yv; s[tt] += (v[tt][j][0] + v[tt][j][1]) + (v[tt][j][2] + v[tt][j][3]); } }
            float rstd[4];
#pragma unroll
            for (int tt = 0; tt < 4; ++tt) { const float mean = wave_sum(s[tt], F.lane) * (1.0f / D); float s2 = 0.f;
#pragma unroll
                for (int j = 0; j < 4; ++j) { v[tt][j] = v[tt][j] - mean; s2 += (v[tt][j][0] * v[tt][j][0] + v[tt][j][1] * v[tt][j][1]) + (v[tt][j][2] * v[tt][j][2] + v[tt][j][3] * v[tt][j][3]); }
                rstd[tt] = __builtin_amdgcn_rsqf(wave_sum(s2, F.lane) * (1.0f / D) + LN_EPS); }
#pragma unroll
            for (int j = 0; j < 4; ++j) { const int col = 4 * F.lane + 256 * j;
                const f32x4 lg_ = lgv[j], lb_ = lbv[j], sc2 = scv[j], sh2 = shv[j];
#pragma unroll
                for (int tt = 0; tt < 4; ++tt) { const size_t ro = (size_t)(t0 + tt) * D;
                    const f32x4 xo = v[tt][j] * rstd[tt] * lg_ + lb_;
                    *(u64*)(xhout + ro + col) = (u64)pkh(xo[0], xo[1]) | ((u64)pkh(xo[2], xo[3]) << 32);
                    const f32x4 hh2 = xo * sc2 + sh2; hv[tt][j] = hh2;
                    *(u64*)(h2 + ro + col) = (u64)pkbf(hh2[0], hh2[1]) | ((u64)pkbf(hh2[2], hh2[3]) << 32); } }
        }
        float gl[4][4];
        { f32x4 w[4][4];
#pragma unroll
          for (int g = 0; g < 4; ++g)
#pragma unroll
              for (int j = 0; j < 4; ++j) w[g][j] = *(const LAS f32x4*)(Wr + g * 1024 + 4 * F.lane + 256 * j);
#pragma unroll
          for (int tt = 0; tt < 4; ++tt)
#pragma unroll
              for (int g = 0; g < 4; ++g) { float s0 = 0.f;
#pragma unroll
                  for (int j = 0; j < 4; ++j) s0 += (hv[tt][j][0] * w[g][j][0] + hv[tt][j][1] * w[g][j][1]) + (hv[tt][j][2] * w[g][j][2] + hv[tt][j][3] * w[g][j][3]);
                  gl[tt][g] = wave_sum(s0, F.lane) + bg[g]; } }
#pragma unroll
        for (int tt = 0; tt < 4; ++tt) {
            int gi = 0; float gm = gl[tt][0];
#pragma unroll
            for (int g = 1; g < 4; ++g) if (gl[tt][g] > gm) { gm = gl[tt][g]; gi = g; }
            float gs = 0.f;
#pragma unroll
            for (int g = 0; g < 4; ++g) gs += fexp(gl[tt][g] - gm);
            const float gw_ = __builtin_amdgcn_rcpf(gs);
            gi = __builtin_amdgcn_readfirstlane(gi);
            float el[8];
#pragma unroll
            for (int half = 0; half < 2; ++half) { f32x4 w[4][4]; const LAS float* wrow = Wr + (4 + gi * 8 + half * 4) * 1024 + 4 * F.lane;
#pragma unroll
                for (int q = 0; q < 4; ++q)
#pragma unroll
                    for (int j = 0; j < 4; ++j) w[q][j] = *(const LAS f32x4*)(wrow + q * 1024 + 256 * j);
#pragma unroll
                for (int q = 0; q < 4; ++q) { float s0 = 0.f;
#pragma unroll
                    for (int j = 0; j < 4; ++j) s0 += (hv[tt][j][0] * w[q][j][0] + hv[tt][j][1] * w[q][j][1]) + (hv[tt][j][2] * w[q][j][2] + hv[tt][j][3] * w[q][j][3]);
                    el[half * 4 + q] = wave_sum(s0, F.lane) + be[gi * 8 + half * 4 + q]; } }
            int i0 = 0; float m0 = el[0];
#pragma unroll
            for (int q = 1; q < 8; ++q) if (el[q] > m0) { m0 = el[q]; i0 = q; }
            int i1 = -1; float m1 = -INFINITY;
#pragma unroll
            for (int q = 0; q < 8; ++q) if (q != i0 && el[q] > m1) { m1 = el[q]; i1 = q; }
            const float p1 = fexp(m1 - m0); const float rr_ = __builtin_amdgcn_rcpf(1.0f + p1); const float w0 = gw_ * rr_, w1 = gw_ * p1 * rr_;
            if (F.lane == 0) { const int e0 = gi * 8 + i0, e1 = gi * 8 + i1, tok = t0 + tt;
                *(int2*)(eid + 2 * tok) = make_int2(e0, e1); *(float2*)(wt + 2 * tok) = make_float2(w0, w1);
                __hip_atomic_fetch_add(&hist[e0], 1u, __ATOMIC_RELAXED, __HIP_MEMORY_SCOPE_WORKGROUP); __hip_atomic_fetch_add(&hist[e1], 1u, __ATOMIC_RELAXED, __HIP_MEMORY_SCOPE_WORKGROUP); }
        }
    }
    __syncthreads();
    if (F.tid < 32 && !dry) { const unsigned c = hist[F.tid]; if (c) __hip_atomic_fetch_add(F.ctl + CW_CNT + 256 * layer + F.tid, c, RLX_AGENT); }
}

__device__ __forceinline__ void phase_m2(Frame& F, const KA a, int layer) {
    LAS int* pstart = (LAS int*)(F.lds + RING_OFF);
    LAS unsigned* lhist = (LAS unsigned*)(F.lds + RING_OFF + 256);
    LAS int* lbase = (LAS int*)(F.lds + RING_OFF + 512);
    int* blk_e = (int*)(a.ws() + WS_BLKE) + layer * 1024;
    LAS int* cntl = (LAS int*)(F.lds + RING_OFF + 768);
    if (F.tid < 32) cntl[F.tid] = (int)__hip_atomic_load(F.ctl + CW_CNT + 256 * layer + F.tid, RLX_AGENT);
    __syncthreads();
    if (F.tid == 0) { int off = 0;
#pragma unroll 1
        for (int e = 0; e < 32; ++e) { pstart[e] = off; off += ((cntl[e] + 255) >> 8) << 8; }
        pstart[32] = off;
        if (F.bx == 0) __hip_atomic_store(F.ctl + CW_CNT + 256 * layer + 128, (unsigned)(off >> 8), RLX_AGENT); }
    __syncthreads();
    if (F.bx == 0) { const int nblk = pstart[32] >> 8;
        for (int blk = F.tid; blk < nblk; blk += NWAVES * 64) { int e = 0;
#pragma unroll 1
            for (int k = 1; k < 32; ++k) e = (pstart[k] <= blk * 256) ? k : e;
            blk_e[blk] = e; } }
    const int* eid = (const int*)(a.ws() + WS_EID);
    int* tslot = (int*)(a.ws() + WS_TSLOT);
    int* stok = (int*)(a.ws() + WS_STOK);
    for (int e = F.vcu; e < 32; e += F.G) { const int c = cntl[e];
        for (int s = pstart[e] + c + F.tid; s < pstart[e + 1]; s += NWAVES * 64) stok[s] = 0; }
    for (int chunk = F.vcu; chunk < M / 256; chunk += F.G) {
        if (F.tid < 32) lhist[F.tid] = 0u;
        __syncthreads();
        const int pi = chunk * 512 + F.tid;
        const int e = eid[pi];
        const unsigned rank = __hip_atomic_fetch_add(&lhist[e], 1u, __ATOMIC_RELAXED, __HIP_MEMORY_SCOPE_WORKGROUP);
        __syncthreads();
        if (F.tid < 32) { const unsigned c = lhist[F.tid]; lbase[F.tid] = pstart[F.tid] + (c ? (int)__hip_atomic_fetch_add(F.ctl + CW_CNT + 256 * layer + 64 + F.tid, c, RLX_AGENT) : 0); }
        __syncthreads();
        const int slot = lbase[e] + (int)rank;
        tslot[pi] = slot; stok[slot] = pi >> 1;
        __syncthreads();
    }
}

__device__ __forceinline__ void phase_l2(Frame& F, const KA a, int layer) {
    const int gw = F.vcu * NWAVES + F.wave, NGW = F.G * NWAVES;
    const float* mod = (const float*)(a.ws() + WS_MOD) + (size_t)layer * 16 * 6144;
    const bf16* ys = (const bf16*)(a.ws() + WS_BUF0 + 2 * BUFSZ); const int* tslot = (const int*)(a.ws() + WS_TSLOT); const float* wt = (const float*)(a.ws() + WS_WT);
    bf16* hn = (bf16*)(a.ws() + WS_BUF0);
    const float* lng = a.in(4) + (size_t)(layer * 2 + 1) * D; const float* lnb = a.in(5) + (size_t)(layer * 2 + 1) * D;
    float* x = a.out(); unsigned short* xho = (unsigned short*)a.out(); const unsigned short* xh = (const unsigned short*)(a.ws() + WS_BUF0 + 1 * BUFSZ);
    const int mlay = (layer < DEPTH - 1) ? 16 * 6144 : 0;
    const int tpw = ((M + NGW - 1) / NGW + 3) & ~3;
    for (int t0 = gw * tpw; t0 < (gw + 1) * tpw && t0 < M; t0 += 4) {
        const int b = t0 >> 12; const float* mb = mod + (size_t)b * 6144;
        int sl[8]; float rw[8];
        { const int4 s0 = *(const int4*)(tslot + 2 * t0), s1 = *(const int4*)(tslot + 2 * t0 + 4); sl[0] = s0.x; sl[1] = s0.y; sl[2] = s0.z; sl[3] = s0.w; sl[4] = s1.x; sl[5] = s1.y; sl[6] = s1.z; sl[7] = s1.w;
          const f32x4 w0 = *(const f32x4*)(wt + 2 * t0), w1 = *(const f32x4*)(wt + 2 * t0 + 4); rw[0] = w0[0]; rw[1] = w0[1]; rw[2] = w0[2]; rw[3] = w0[3]; rw[4] = w1[0]; rw[5] = w1[1]; rw[6] = w1[2]; rw[7] = w1[3]; }
        u64 xr[4][4], y0r[4][4], y1r[4][4];
#pragma unroll
        for (int j = 0; j < 4; ++j) { const int col = 4 * F.lane + 256 * j;
#pragma unroll
            for (int tt = 0; tt < 4; ++tt) { xr[tt][j] = *(const u64*)(xh + (size_t)(t0 + tt) * D + col);
                y0r[tt][j] = *(const u64*)(ys + (size_t)sl[2 * tt] * D + col); y1r[tt][j] = *(const u64*)(ys + (size_t)sl[2 * tt + 1] * D + col); } }
        f32x4 g2v[4];
#pragma unroll
        for (int j = 0; j < 4; ++j) g2v[j] = *(const f32x4*)(mb + 5120 + 4 * F.lane + 256 * j);
        asm volatile("" ::: "memory");
        f32x4 v[4][4]; float s[4] = {0.f, 0.f, 0.f, 0.f};
#pragma unroll
        for (int j = 0; j < 4; ++j) { const f32x4 g2 = g2v[j];
#pragma unroll
            for (int tt = 0; tt < 4; ++tt) {
                const f32x4 xv = unpk_h4(xr[tt][j]); const u64 y0 = y0r[tt][j], y1 = y1r[tt][j];
                const float wa = rw[2 * tt], wb = rw[2 * tt + 1];
                f32x4 yv; yv[0] = bflo((unsigned)y0) * wa + bflo((unsigned)y1) * wb; yv[1] = bfhi((unsigned)y0) * wa + bfhi((unsigned)y1) * wb;
                yv[2] = bflo((unsigned)(y0 >> 32)) * wa + bflo((unsigned)(y1 >> 32)) * wb; yv[3] = bfhi((unsigned)(y0 >> 32)) * wa + bfhi((unsigned)(y1 >> 32)) * wb;
                v[tt][j] = xv * DN_ALPHA + g2 * yv; s[tt] += (v[tt][j][0] + v[tt][j][1]) + (v[tt][j][2] + v[tt][j][3]); } }
        f32x4 lgv[4], lbv[4], scv[4], shv[4];
#pragma unroll
        for (int j = 0; j < 4; ++j) { const int col = 4 * F.lane + 256 * j; lgv[j] = *(const f32x4*)(lng + col); lbv[j] = *(const f32x4*)(lnb + col);
            scv[j] = *(const f32x4*)(mb + mlay + 1024 + col); shv[j] = *(const f32x4*)(mb + mlay + col); }
        asm volatile("" ::: "memory");
        float rstd[4];
#pragma unroll
        for (int tt = 0; tt < 4; ++tt) { const float mean = wave_sum(s[tt], F.lane) * (1.0f / D); float s2 = 0.f;
#pragma unroll
            for (int j = 0; j < 4; ++j) { v[tt][j] = v[tt][j] - mean; s2 += (v[tt][j][0] * v[tt][j][0] + v[tt][j][1] * v[tt][j][1]) + (v[tt][j][2] * v[tt][j][2] + v[tt][j][3] * v[tt][j][3]); }
            rstd[tt] = __builtin_amdgcn_rsqf(wave_sum(s2, F.lane) * (1.0f / D) + LN_EPS); }
        if (layer == DEPTH - 1) {
#pragma unroll
            for (int j = 0; j < 4; ++j) { const int col = 4 * F.lane + 256 * j;
#pragma unroll
                for (int tt = 0; tt < 4; ++tt) *(f32x4*)(x + (size_t)(t0 + tt) * D + col) = v[tt][j] * rstd[tt] * lgv[j] + lbv[j]; }
        } else {
#pragma unroll
            for (int j = 0; j < 4; ++j) { const int col = 4 * F.lane + 256 * j;
#pragma unroll
                for (int tt = 0; tt < 4; ++tt) { const size_t ro = (size_t)(t0 + tt) * D;
                    const f32x4 xo = v[tt][j] * rstd[tt] * lgv[j] + lbv[j];
                    *(u64*)(xho + ro + col) = (u64)pkh(xo[0], xo[1]) | ((u64)pkh(xo[2], xo[3]) << 32);
                    const f32x4 hv = xo * (scv[j] + 1.0f) + shv[j];
                    *(u64*)(hn + ro + col) = (u64)pkbf(hv[0], hv[1]) | ((u64)pkbf(hv[2], hv[3]) << 32); } }
        }
    }
}

#ifndef MK_SEPARATE
#define MK_SEPARATE 0
#endif
constexpr int N_PHASES = 2 + 10 * DEPTH;
#ifndef PH_MASK
#define PH_MASK 0xFFFFF
#endif
#define PH_ON(n) (((PH_MASK) >> (n)) & 1)
#ifndef DBL_MASK
#define DBL_MASK 0
#endif
#define DBL(n) for (int rep_ = 0; rep_ < 1 + (((DBL_MASK) >> (n)) & 1); ++rep_)
__global__ void __launch_bounds__(NWAVES * 64, 2) fwd_kernel(Args args) {
    extern __shared__ __attribute__((aligned(16))) unsigned char lds[];
    const int wave_s = __builtin_amdgcn_readfirstlane((int)threadIdx.x >> 6);
    gu32* const ctl0 = (gu32*)(karg_fresh().ws() + WS_CTL);
    for (int u = threadIdx.x; u < (LDS_BYTES - LDSCTL_OFF) / 4; u += NWAVES * 64) ((LAS unsigned*)((LAS unsigned char*)lds + LDSCTL_OFF))[u] = 0u;
    __syncthreads();
    XcdBarrier bar; bar.bar = (unsigned*)(ctl0 + CW_BAR); bar.x = 0; bar.st = nullptr;
    if (!MK_SEPARATE) bar = xcd_barrier_post((unsigned*)(ctl0 + CW_BAR), (volatile LAS unsigned*)((LAS unsigned char*)lds + MISC_OFF) + 8);
    const int lo = karg_fresh().ph_lo(), hi = karg_fresh().ph_hi();
    const bool PANEL = !MK_SEPARATE && gridDim.x == (unsigned)(M / 256);
#define IN(k) (lo <= (k) && (k) < hi)
#define FRESH() const KA ka = karg_fresh(); unsigned char* const ws = ka.ws(); (void)ws; Frame F; { int t_, g_ = gridDim.x, bx_ = blockIdx.x; asm volatile("v_mbcnt_lo_u32_b32 %0, -1, 0\n\tv_mbcnt_hi_u32_b32 %0, -1, %0" : "=v"(t_)); asm volatile("" : "+s"(g_), "+s"(bx_)); t_ |= wave_s << 6; \
        F.lds = (LAS unsigned char*)lds; F.MISC = (volatile LAS unsigned*)(F.lds + MISC_OFF); F.ctl = (gu32*)(ws + WS_CTL); F.tid = t_; F.lane = t_ & 63; F.wave = __builtin_amdgcn_readfirstlane(t_ >> 6); \
        F.G = g_; F.bx = bx_; F.vcu = (g_ % 8 == 0) ? (bx_ % 8) * (g_ / 8) + bx_ / 8 : bx_; }
#ifndef DBL_BARRIER
#define DBL_BARRIER 0
#endif
#define SEAM(k) do { if (IN(k) && IN((k) + 1)) { if (MK_SEPARATE) { } else { xcd_barrier(bar, wave_s); if (DBL_BARRIER) xcd_barrier(bar, wave_s); } } } while (0)
#define BUF(i) ((bf16*)(ws + WS_BUF0 + (size_t)(i) * BUFSZ))

    if (PH_ON(0) && IN(0)) { FRESH(); DBL(0) phase_p0a(F, ka); }
    SEAM(0);
    if (PH_ON(1) && IN(1)) { FRESH(); DBL(1) phase_p0b(F, ka); }
    SEAM(1);
    for (int i = 0; i < DEPTH; ++i) {
        const int pb = 2 + 10 * i, j = i >> 1;
        if ((i & 1) == 0) {
            if (PH_ON(2) && IN(pb)) { FRESH();
                pg8::Gemm g{BUF(0), (const bf16*)(ws + WS_WHIN) + (size_t)j * 4096 * 1024, M, 4096, D, 0, nullptr}; pg8::StaticOrder S; S.init(M, 4096, F.G, F.bx);
                pg8::EpiBf16<0> E{BUF(1), D, nullptr, D, BUFSZ / 2, 1.0f};
                DBL(2) pg8::gemm_phase<pg8::EpiBf16<0>, pg8::StaticOrder, true, true>(F.lds + RING_OFF, g, S, E, F.tid);
            }
            SEAM(pb);
            if (PH_ON(3) && IN(pb + 1)) { FRESH(); phase_hgrn_prep(F, ka, j); }
            SEAM(pb + 1);
            if (PH_ON(4) && IN(pb + 2)) { FRESH(); DBL(4) phase_hgrn_scan(F, ka, i); }
            SEAM(pb + 2);
            if (PH_ON(5) && IN(pb + 3)) { FRESH(); phase_normgate<0>(F, BUF(6), BUF(4), BUF(4), ka.in(9) + j * 128, 0.f, 1.0f); }
            if (!PANEL) SEAM(pb + 3);
        } else {
            if (PH_ON(6) && IN(pb)) { FRESH();
                pg8::Gemm g{BUF(0), (const bf16*)(ws + WS_WAIN) + (size_t)j * 3072 * 1024, M, 3072, D, 0, nullptr}; pg8::StaticOrder S; S.init(M, 3072, F.G, F.bx);
                pg8::EpiRope E{BUF(1), BUF(2), BUF(3), (const float*)(ws + WS_ROPE_C), (const float*)(ws + WS_ROPE_S), attn_body::C2, SEQ - 1};
                DBL(6) pg8::gemm_phase<pg8::EpiRope, pg8::StaticOrder, true, true>(F.lds + RING_OFF, g, S, E, F.tid);
            }
            SEAM(pb);
            if (PH_ON(7) && IN(pb + 1)) { FRESH();
                const attn_body::AttnTensors AT{(const attn_body::bf16*)BUF(1), (const attn_body::bf16*)BUF(2), (const attn_body::bf16*)BUF(3), (attn_body::bf16*)BUF(4), (attn_body::bf16*)BUF(5)};
                static_assert(attn_body::ATTNW_LDS_BYTES <= RING_BYTES, "attention LDS");
                const attn_body::StaticOrderW S((int)F.G, F.vcu);
                const float* lp = ka.in(12) + j * 256;
                const float d1 = wave_sum(lp[F.lane] * lp[64 + F.lane], F.lane), d2 = wave_sum(lp[128 + F.lane] * lp[192 + F.lane], F.lane);
                const float linit = (j == 0) ? 0.35550906759f : 0.55605820415f;
                const float lam = fexp(d1) - fexp(d2) + linit;
                const attn_body::CombineW CB{(const attn_body::bf16*)BUF(4), (attn_body::bf16*)BUF(6), ka.in(13) + j * 128, lam, 1.0f - linit};
                DBL(7) attn_body::attn_phase_w<8>((char*)lds + RING_OFF, AT, S, CB, F.tid);
            }
            SEAM(pb + 1);
        }
        if (PH_ON(9) && IN(pb + 4)) { FRESH();
            const bf16* A = (i & 1) ? BUF(6) : BUF(4);
            const bf16* W = (i & 1) ? (const bf16*)(ws + WS_WAOUT) + (size_t)j * 1024 * 1024 : (const bf16*)(ws + WS_WHOUT) + (size_t)j * 1024 * 1024;
            pg8::Gemm g{A, W, M, D, D, 0, nullptr};
            pg8::EpiBf16<0> E{BUF(1), D, nullptr, 0, 0, 1.0f};
            if (PANEL) {
                __syncthreads();
                pg8::PanelOrder S{F.vcu, D / 256};
                pg8::gemm_phase<pg8::EpiBf16<0>, pg8::PanelOrder, true, true>(F.lds + RING_OFF, g, S, E, F.tid);
                __syncthreads();
            } else {
                pg8::StaticOrder S; S.init(M, D, F.G, F.bx);
                DBL(9) pg8::gemm_phase<pg8::EpiBf16<0>, pg8::StaticOrder, true, true>(F.lds + RING_OFF, g, S, E, F.tid);
            }
        }
        if (!PANEL) SEAM(pb + 4);
        if (PH_ON(10) && IN(pb + 5)) { FRESH(); phase_l1(F, ka, i, i == 0 ? ka.in(0) : (const float*)ka.out(), false);
            if ((((DBL_MASK) >> 10) & 1) && i == 0) { __syncthreads(); phase_l1(F, ka, i, ka.in(0), true); } }
        SEAM(pb + 5);
        if (PH_ON(11) && IN(pb + 6)) { FRESH(); phase_m2(F, ka, i); }
        SEAM(pb + 6);
        if (PH_ON(12) && IN(pb + 7)) { FRESH();
            const int nblk = (int)__hip_atomic_load(F.ctl + CW_CNT + 256 * i + 128, RLX_AGENT);
            pg8::Gemm g{BUF(0), (const bf16*)moe_wbuf(ws, i), nblk * 256, 1024, D, (size_t)1024 * 1024 * 2, (const int*)(ws + WS_STOK)};
            pg8::MoeOrder S; S.init(nblk * 256, 1024, F.G, F.bx); S.blk_e = (const int*)(ws + WS_BLKE) + i * 1024;
            pg8::EpiSwiGLU E{BUF(5)};
            DBL(12) pg8::gemm_phase<pg8::EpiSwiGLU, pg8::MoeOrder, true, true, true>(F.lds + RING_OFF, g, S, E, F.tid);
        }
        SEAM(pb + 7);
        if (PH_ON(13) && IN(pb + 8)) { FRESH();
            const int nblk = (int)__hip_atomic_load(F.ctl + CW_CNT + 256 * i + 128, RLX_AGENT);
            pg8::Gemm g{BUF(5), (const bf16*)(moe_wbuf(ws, i) + 64 * MiB), nblk * 256, 1024, FF, (size_t)1024 * 512 * 2, nullptr};
            pg8::MoeOrder S; S.init(nblk * 256, 1024, F.G, F.bx); S.blk_e = (const int*)(ws + WS_BLKE) + i * 1024;
            pg8::EpiBf16<0> E{BUF(2), D, nullptr, 0, 0, 1.0f};
            DBL(13) pg8::gemm_phase<pg8::EpiBf16<0>, pg8::MoeOrder, true, true>(F.lds + RING_OFF, g, S, E, F.tid);
        }
        SEAM(pb + 8);
        if (PH_ON(14) && IN(pb + 9)) { FRESH(); DBL(14) phase_l2(F, ka, i); }
        SEAM(pb + 9);
    }
#undef IN
#undef SEAM
}

extern "C" void kernel_launch(void* const* d_in, const int* in_sizes, int n_in, void* d_out, int out_size, void* d_ws, size_t ws_size, hipStream_t stream) {
    static int grid = 0;
    if (grid == 0) {
        if (n_in != 21 || in_sizes[0] != M * D || out_size != M * D || ws_size < WS_END) { fprintf(stderr, "kernel_launch: unexpected shapes / workspace (n_in %d, ws %zu, need %zu)\n", n_in, ws_size, (size_t)WS_END); grid = -1; return; }
        int dev = 0, cus = 0, per_cu = 0;
        if (hipGetDevice(&dev) != hipSuccess || hipDeviceGetAttribute(&cus, hipDeviceAttributeMultiprocessorCount, dev) != hipSuccess) { grid = -1; return; }
        if (hipFuncSetAttribute((const void*)fwd_kernel, hipFuncAttributeMaxDynamicSharedMemorySize, LDS_BYTES) != hipSuccess) { fprintf(stderr, "kernel_launch: hipFuncSetAttribute failed\n"); grid = -1; return; }
        if (hipOccupancyMaxActiveBlocksPerMultiprocessor(&per_cu, (const void*)fwd_kernel, NWAVES * 64, LDS_BYTES) != hipSuccess || per_cu < 1) fprintf(stderr, "kernel_launch: occupancy query says %d\n", per_cu);
        (void)hipGetLastError();
        grid = cus;
    }
    if (grid < 0) return;
    if (hipMemsetAsync((char*)d_ws + WS_CTL, 0, CTL_ZERO_BYTES, stream) != hipSuccess) return;
    Args a{};
    for (int i = 0; i < 21; ++i) a.in[i] = (const float*)d_in[i];
    a.out = (float*)d_out; a.ws = (unsigned char*)d_ws;
#if MK_SEPARATE
    for (int p = 0; p < N_PHASES; ++p) {
        if (p >= 2 && (((p - 2) / 10) & 1) == 1 && ((p - 2) % 10) == 3) continue;
        a.ph_lo = p; a.ph_hi = p + 1;
        hipLaunchKernelGGL(fwd_kernel, dim3(grid), dim3(NWAVES * 64), LDS_BYTES, stream, a);
    }
#else
    a.ph_lo = 0; a.ph_hi = N_PHASES;
    hipLaunchKernelGGL(fwd_kernel, dim3(grid), dim3(NWAVES * 64), LDS_BYTES, stream, a);
#endif
}
```

```cpp
#include <hip/hip_runtime.h>
#include <cstdio>
#include <cstdint>
namespace pg8 {
#define PG8_LAS __attribute__((address_space(3)))
typedef unsigned short bf16_t;
typedef short bf16x8 __attribute__((ext_vector_type(8)));
typedef float f32x4 __attribute__((ext_vector_type(4)));
typedef unsigned u32x4 __attribute__((ext_vector_type(4)));
constexpr int BM = 256, BK = 64, HALF = 128, HTB = HALF * BK * 2  , STAGE_BYTES = 8 * HTB, NXCD = 8, WGM = 8;

__host__ __device__ __forceinline__ int lds_byte(int r, int c) { const int st = (r >> 4) * 2 + (c >> 5), rr = r & 15, cc = c & 31, ob = rr * 64 + cc * 2; return st * 1024 + (ob ^ (((ob >> 9) & 1) << 5)); }
__host__ __device__ __forceinline__ void stage_rc(int b, int& R, int& C) { const int st = b / 1024, sb = b % 1024, swz = sb ^ (((sb >> 9) & 1) << 5); R = (st >> 1) * 16 + swz / 64; C = (st & 1) * 32 + (swz % 64) / 2; }
__host__ __device__ __forceinline__ int perm32(int rho) { const int n = rho >> 4, i = rho & 15; return 8 * (i >> 2) + 4 * n + (i & 3); }

struct Unit { int pm, pn, e; };
struct Gemm { const bf16_t* A; const bf16_t* Bt; int M, N, K; size_t estride; const int* arow; };

struct StaticOrder {
    int nM, nN, nwg, G, c;
    __host__ __device__ void init(int M, int N, int G_, int c_) { nM = M / BM; nN = N / BM; nwg = nM * nN; G = G_; c = c_; }
    __host__ __device__ bool next(int i, Unit& u) const {
        const long L = (long)i * G + c; if (L >= nwg) return false;
        int wgid = (int)L; { const int q = nwg / NXCD, r = nwg % NXCD, xcd = wgid % NXCD, off = wgid / NXCD; wgid = (xcd < r ? xcd * (q + 1) : r * (q + 1) + (xcd - r) * q) + off; }
        const int nig = WGM * nN, gid = wgid / nig, fm = gid * WGM, gsz = (nM - fm) < WGM ? (nM - fm) : WGM;
        u.pm = fm + ((wgid % nig) % gsz); u.pn = (wgid % nig) / gsz; u.e = 0; return true;
    }
    __device__ __forceinline__ void a_ready(const Unit&) const {}
    __device__ __forceinline__ void done(const Unit&) const {}
};

__device__ __forceinline__ unsigned cvt_pk_bf16(float lo, float hi) { unsigned r; asm volatile("v_cvt_pk_bf16_f32 %0, %1, %2" : "=v"(r) : "v"(lo), "v"(hi)); return r; }
typedef float f32x2 __attribute__((ext_vector_type(2)));
__device__ __forceinline__ f32x2 gelu_pk(f32x2 v) {
    const f32x2 av = __builtin_elementwise_abs(v), d = av * 0.2316418882f + 1.0f;
    f32x2 t; t.x = __builtin_amdgcn_rcpf(d.x); t.y = __builtin_amdgcn_rcpf(d.y);
    f32x2 q = t * 0.5307027145f + (-0.7265760135f); q = q * t + 0.7107068705f; q = q * t + (-0.142248368f); q = q * t + 0.127414796f; q = q * t;
    const f32x2 s = (v * v) * (-0.72134752044f);
    f32x2 e; e.x = __builtin_amdgcn_exp2f(s.x); e.y = __builtin_amdgcn_exp2f(s.y);
    const f32x2 m = v * (q * e), r = v - m;
    f32x2 o; o.x = v.x < 0.f ? m.x : r.x; o.y = v.y < 0.f ? m.y : r.y; return o;
}

template <int ACT  > struct EpiBf16 {
    static constexpr bool PERM = true, AFTER_DRAIN = false; static_assert(ACT == 0 || ACT == 1, "EpiBf16: ACT is 0 (none) or 1 (gelu_pk)");
    bf16_t* O; int ldc; const float* bias; int split_cols; size_t split_stride; float scale0;
    __device__ __forceinline__ void operator()(const f32x4 (&acc)[2][2][4][2], const Unit& u, int wr, int wc, int fr, int fq) const {
        const int row0 = u.pm * BM + wr * 64 + fr; int colt = u.pn * BM; bf16_t* base = O;
        float sc = 1.f; if (split_cols) { const int t = colt / split_cols; base += (size_t)t * split_stride; colt -= t * split_cols; if (t == 0) sc = scale0; }
        const int col0 = colt + wc * 32 + 8 * fq, bcol0 = u.pn * BM + wc * 32 + 8 * fq;
        f32x4 bv[2][2];
#pragma unroll
        for (int bj = 0; bj < 2; ++bj)
#pragma unroll
            for (int n = 0; n < 2; ++n) bv[bj][n] = bias ? *(const f32x4*)(bias + bcol0 + bj * HALF + 4 * n) : (f32x4){0.f, 0.f, 0.f, 0.f};
#pragma unroll
        for (int ai = 0; ai < 2; ++ai)
#pragma unroll
            for (int m = 0; m < 4; ++m) { bf16_t* rowp = base + (size_t)(row0 + ai * HALF + m * 16) * ldc + col0;
#pragma unroll
                for (int bj = 0; bj < 2; ++bj) { f32x4 v0 = acc[ai][bj][m][0] + bv[bj][0], v1 = acc[ai][bj][m][1] + bv[bj][1];
                    if (ACT == 1) { f32x2 a = gelu_pk((f32x2){v0[0], v0[1]}), b = gelu_pk((f32x2){v0[2], v0[3]}), c = gelu_pk((f32x2){v1[0], v1[1]}), d = gelu_pk((f32x2){v1[2], v1[3]});
                        v0 = (f32x4){a.x, a.y, b.x, b.y}; v1 = (f32x4){c.x, c.y, d.x, d.y}; }
                    v0 = v0 * sc; v1 = v1 * sc; u32x4 w; w.x = cvt_pk_bf16(v0[0], v0[1]); w.y = cvt_pk_bf16(v0[2], v0[3]); w.z = cvt_pk_bf16(v1[0], v1[1]); w.w = cvt_pk_bf16(v1[2], v1[3]);
                    *(u32x4*)(rowp + bj * HALF) = w; } }
    }
};

template <class Epi, class Sched, bool ALIGN_EPI = false, bool SP2 = false, bool GATHER = false>
__device__ __forceinline__ void gemm_phase(PG8_LAS unsigned char* lds, const Gemm g, const Sched& S, const Epi& E, const int tid) {
        const int wid = __builtin_amdgcn_readfirstlane(tid >> 6), lane = tid & 63, wr = wid >> 2, wc = wid & 3, fr = lane & 15, fq = lane >> 4;
    const int K = g.K, nt = K / BK;
    unsigned voffA[2], voffB[2], gcolb[2];
#pragma unroll
    for (int i = 0; i < 2; ++i) { int R, C; stage_rc(tid * 16 + i * 8192, R, C); const int Rb = Epi::PERM ? ((R & ~31) + perm32(R & 31)) : R;
        voffA[i] = GATHER ? (unsigned)R * 4u   : (unsigned)(R * K + C) * 2u; voffB[i] = (unsigned)(Rb * K + C) * 2u; gcolb[i] = (unsigned)C * 2u; }
    unsigned gA[2][2] = {{0u, 0u}, {0u, 0u}}, gN[2][2] = {{0u, 0u}, {0u, 0u}};
#define PG8_ROWS(dst, u_) do { const char* rb_ = (const char*)(g.arow + (size_t)(u_).pm * BM); unsigned raw_[2][2];        \
        _Pragma("unroll") for (int _h = 0; _h < 2; ++_h) _Pragma("unroll") for (int _i = 0; _i < 2; ++_i) raw_[_h][_i] = (unsigned)*(const int*)(rb_ + voffA[_i] + _h * HALF * 4); \
        _Pragma("unroll") for (int _h = 0; _h < 2; ++_h) _Pragma("unroll") for (int _i = 0; _i < 2; ++_i) dst[_h][_i] = raw_[_h][_i] * (unsigned)(K * 2) + gcolb[_i]; } while (0)
    const size_t kstep = (size_t)(BK * 2);
    const size_t hstep = (size_t)HALF * K * 2;
    const size_t tstep = 2 * hstep;
    const unsigned ldsw = (unsigned)wid * 1024u;
    const int aoff = lds_byte(wr * 64 + fr, fq * 8), boff = lds_byte(wc * 32 + fr, fq * 8);
#define PG8_SA(b, h) (((b) * 2 + (h)) * HTB)
#define PG8_SB(b, h) ((4 + (b) * 2 + (h)) * HTB)
#define PG8_STAGE(bufoff, gbase, voff) do { _Pragma("unroll") for (int _i = 0; _i < 2; ++_i) \
        __builtin_amdgcn_global_load_lds((const unsigned*)((const char*)(gbase) + (voff)[_i]), (PG8_LAS unsigned*)(lds + (bufoff) + ldsw + _i * 8192), 16, 0, 0); } while (0)
#define PG8_STAGEA(bufoff, gbase, h_, nx_) do { if constexpr (GATHER) { _Pragma("unroll") for (int _i = 0; _i < 2; ++_i) \
        __builtin_amdgcn_global_load_lds((const unsigned*)((const char*)(gbase) + ((nx_) ? gN[h_][_i] : gA[h_][_i])), (PG8_LAS unsigned*)(lds + (bufoff) + ldsw + _i * 8192), 16, 0, 0); } \
        else { PG8_STAGE(bufoff, (gbase) + ((h_) ? hstep : (size_t)0), voffA); } } while (0)
#define PG8_LDA(dst, b, h) do { _Pragma("unroll") for (int m = 0; m < 4; ++m) _Pragma("unroll") for (int k = 0; k < 2; ++k) dst[m][k] = *(const PG8_LAS bf16x8*)(lds + PG8_SA(b, h) + aoff + m * 2048 + k * 1024); } while (0)
#define PG8_LDB(dst, b, h) do { _Pragma("unroll") for (int n = 0; n < 2; ++n) _Pragma("unroll") for (int k = 0; k < 2; ++k) dst[n][k] = *(const PG8_LAS bf16x8*)(lds + PG8_SB(b, h) + boff + n * 2048 + k * 1024); } while (0)
#define PG8_MMA(ai, bj, At, Bt) do { __builtin_amdgcn_s_setprio(1); _Pragma("unroll") for (int m = 0; m < 4; ++m) _Pragma("unroll") for (int n = 0; n < 2; ++n) _Pragma("unroll") for (int k = 0; k < 2; ++k) \
        acc[ai][bj][m][n] = __builtin_amdgcn_mfma_f32_16x16x32_bf16(Bt[n][k], At[m][k], acc[ai][bj][m][n], 0, 0, 0); __builtin_amdgcn_s_setprio(0); } while (0)
#define PG8_WAIT_V(n) asm volatile("s_waitcnt vmcnt(" #n ")" ::: "memory")
#define PG8_WAIT_L(n) asm volatile("s_waitcnt lgkmcnt(" #n ")" ::: "memory")
#define PG8_BAR __builtin_amdgcn_s_barrier()
#define PG8_SCHED __builtin_amdgcn_sched_barrier(0)
    Unit cur, nxt; int ui = 0;
    if (!S.next(0, cur)) return;
    f32x4 acc[2][2][4][2];
#pragma unroll
    for (int a = 0; a < 2; ++a)
#pragma unroll
        for (int b = 0; b < 2; ++b)
#pragma unroll
            for (int m = 0; m < 4; ++m)
#pragma unroll
                for (int n = 0; n < 2; ++n) acc[a][b][m][n] = (f32x4){0.f, 0.f, 0.f, 0.f};
    bf16x8 At[4][2], B0[2][2], B1[2][2];
    const char* cA = (const char*)g.A + (GATHER ? (size_t)0 : (size_t)cur.pm * tstep); const char* cB = (const char*)g.Bt + (size_t)cur.e * g.estride + (size_t)cur.pn * tstep;
    S.a_ready(cur);
    if constexpr (GATHER) PG8_ROWS(gA, cur);
    if constexpr (SP2) {
        PG8_STAGE(PG8_SB(0, 0), cB, voffB); PG8_STAGE(PG8_SB(0, 1), cB + hstep, voffB); PG8_STAGEA(PG8_SA(0, 0), cA, 0, false); PG8_STAGEA(PG8_SA(0, 1), cA, 1, false);
        if (wr == 1) PG8_BAR;
        PG8_WAIT_V(2); PG8_BAR;
        PG8_STAGE(PG8_SB(1, 0), cB + kstep, voffB); PG8_STAGEA(PG8_SA(1, 0), cA + kstep, 0, false); PG8_STAGE(PG8_SB(1, 1), cB + hstep + kstep, voffB);
        PG8_WAIT_V(6); PG8_BAR;
    } else {
        PG8_STAGE(PG8_SB(0, 0), cB, voffB); PG8_STAGEA(PG8_SA(0, 0), cA, 0, false); PG8_STAGE(PG8_SB(0, 1), cB + hstep, voffB); PG8_STAGEA(PG8_SA(0, 1), cA, 1, false);
        if (wr == 1) PG8_BAR;
        PG8_WAIT_V(4); PG8_BAR;
        PG8_STAGE(PG8_SB(1, 0), cB + kstep, voffB); PG8_STAGEA(PG8_SA(1, 0), cA + kstep, 0, false); PG8_STAGE(PG8_SB(1, 1), cB + hstep + kstep, voffB);
        PG8_WAIT_V(6); PG8_BAR;
    }
    for (;;) {
        const bool has_next = S.next(ui + 1, nxt);
        const char* nA = has_next ? (const char*)g.A + (GATHER ? (size_t)0 : (size_t)nxt.pm * tstep) : cA;
        if constexpr (GATHER) { if (has_next) PG8_ROWS(gN, nxt); else { _Pragma("unroll") for (int _h = 0; _h < 2; ++_h) _Pragma("unroll") for (int _i = 0; _i < 2; ++_i) gN[_h][_i] = gA[_h][_i]; } } const char* nB = has_next ? (const char*)g.Bt + (size_t)nxt.e * g.estride + (size_t)nxt.pn * tstep : cB;
        for (int t = 0; t < nt; t += 2) {
            const bool last = (t == nt - 2);
            const char* a1 = cA + (size_t)(t + 1) * kstep;
            const char* a2 = last ? nA : cA + (size_t)(t + 2) * kstep; const char* b2 = last ? nB : cB + (size_t)(t + 2) * kstep;
            const char* a3 = a2 + kstep; const char* b3 = b2 + kstep;
            if (last && has_next) S.a_ready(nxt);
            if constexpr (SP2) {
            PG8_LDB(B0, 0, 0); PG8_LDB(B1, 0, 1); PG8_SCHED; PG8_LDA(At, 0, 0); PG8_STAGEA(PG8_SA(1, 1), a1, 1, false);
            PG8_WAIT_V(8); PG8_WAIT_L(0); PG8_BAR; PG8_MMA(0, 0, At, B0); PG8_MMA(0, 1, At, B1); PG8_BAR; PG8_SCHED;
            PG8_LDA(At, 0, 1); PG8_STAGE(PG8_SB(0, 0), b2, voffB); PG8_STAGE(PG8_SB(0, 1), b2 + hstep, voffB); PG8_STAGEA(PG8_SA(0, 0), a2, 0, last);
            PG8_WAIT_V(8); PG8_WAIT_L(0); PG8_BAR; PG8_MMA(1, 0, At, B0); PG8_MMA(1, 1, At, B1); PG8_BAR; PG8_SCHED;
            PG8_LDB(B0, 1, 0); PG8_LDB(B1, 1, 1); PG8_SCHED; PG8_LDA(At, 1, 0); PG8_STAGEA(PG8_SA(0, 1), a2, 1, last);
            PG8_WAIT_V(8); PG8_WAIT_L(0); PG8_BAR; PG8_MMA(0, 0, At, B0); PG8_MMA(0, 1, At, B1); PG8_BAR; PG8_SCHED;
            PG8_LDA(At, 1, 1); PG8_STAGE(PG8_SB(1, 0), b3, voffB); PG8_STAGE(PG8_SB(1, 1), b3 + hstep, voffB); PG8_STAGEA(PG8_SA(1, 0), a3, 0, last);
            PG8_WAIT_V(8); PG8_WAIT_L(0); PG8_BAR; PG8_MMA(1, 0, At, B0); PG8_MMA(1, 1, At, B1); PG8_BAR; PG8_SCHED;
            } else {
            PG8_LDB(B0, 0, 0); PG8_SCHED; PG8_LDA(At, 0, 0); PG8_STAGEA(PG8_SA(1, 1), a1, 1, false);
            PG8_WAIT_L(8); PG8_BAR; PG8_WAIT_L(0); PG8_MMA(0, 0, At, B0); PG8_BAR; PG8_SCHED;
            PG8_LDB(B1, 0, 1); PG8_STAGE(PG8_SB(0, 0), b2, voffB);
            PG8_BAR; PG8_WAIT_L(0); PG8_MMA(0, 1, At, B1); PG8_BAR;
            PG8_LDA(At, 0, 1); PG8_STAGEA(PG8_SA(0, 0), a2, 0, last);
            PG8_BAR; PG8_WAIT_L(0); PG8_MMA(1, 0, At, B0); PG8_BAR; PG8_SCHED;
            PG8_STAGE(PG8_SB(0, 1), b2 + hstep, voffB);
            PG8_WAIT_V(6); PG8_BAR; PG8_MMA(1, 1, At, B1); PG8_BAR;
            PG8_LDB(B0, 1, 0); PG8_SCHED; PG8_LDA(At, 1, 0); PG8_STAGEA(PG8_SA(0, 1), a2, 1, last);
            PG8_WAIT_L(8); PG8_BAR; PG8_WAIT_L(0); PG8_MMA(0, 0, At, B0); PG8_BAR; PG8_SCHED;
            PG8_LDB(B1, 1, 1); PG8_STAGE(PG8_SB(1, 0), b3, voffB);
            PG8_BAR; PG8_WAIT_L(0); PG8_MMA(0, 1, At, B1); PG8_BAR;
            PG8_LDA(At, 1, 1); PG8_STAGEA(PG8_SA(1, 0), a3, 0, last);
            PG8_BAR; PG8_WAIT_L(0); PG8_MMA(1, 0, At, B0); PG8_BAR; PG8_SCHED;
            PG8_STAGE(PG8_SB(1, 1), b3 + hstep, voffB);
            PG8_WAIT_V(6); PG8_BAR; PG8_MMA(1, 1, At, B1); PG8_BAR;
            }
        }
        if constexpr (ALIGN_EPI) { if (wr == 0) PG8_BAR; }
        if constexpr (!Epi::AFTER_DRAIN) { E(acc, cur, wr, wc, fr, fq); S.done(cur); }
        if (!has_next) break;
#pragma unroll
        for (int a = 0; a < 2; ++a)
#pragma unroll
            for (int b = 0; b < 2; ++b)
#pragma unroll
                for (int m = 0; m < 4; ++m)
#pragma unroll
                    for (int n = 0; n < 2; ++n) acc[a][b][m][n] = (f32x4){0.f, 0.f, 0.f, 0.f};
        cur = nxt; cA = nA; cB = nB; ++ui;
        if constexpr (GATHER) { _Pragma("unroll") for (int _h = 0; _h < 2; ++_h) _Pragma("unroll") for (int _i = 0; _i < 2; ++_i) gA[_h][_i] = gN[_h][_i]; }
        if constexpr (ALIGN_EPI) { if (wr == 1) PG8_BAR; }
    }
    PG8_WAIT_V(0);
    if constexpr (!ALIGN_EPI) { if (wr == 0) PG8_BAR; }
    PG8_BAR;
    if constexpr (Epi::AFTER_DRAIN) { E.fused(acc, cur, wr, wc, fr, fq, lds, wid, lane); S.done(cur); }
#undef PG8_SA
#undef PG8_SB
#undef PG8_STAGE
#undef PG8_STAGEA
#undef PG8_ROWS
#undef PG8_LDA
#undef PG8_LDB
#undef PG8_MMA
#undef PG8_WAIT_V
#undef PG8_WAIT_L
#undef PG8_BAR
#undef PG8_SCHED
}
}

namespace pg8 {
__device__ __forceinline__ u32x4 pack8(const f32x4 a, const f32x4 b) { u32x4 w; w.x = cvt_pk_bf16(a[0], a[1]); w.y = cvt_pk_bf16(a[2], a[3]); w.z = cvt_pk_bf16(b[0], b[1]); w.w = cvt_pk_bf16(b[2], b[3]); return w; }
__device__ __forceinline__ float silu_f(float x) { return x * __builtin_amdgcn_rcpf(1.0f + __builtin_amdgcn_exp2f(-1.4426950408889634f * x)); }

struct EpiRope {
    static constexpr bool PERM = true, AFTER_DRAIN = false;
    bf16_t* Q; bf16_t* Kb; bf16_t* Vb; const float* cs; const float* sn; float qscale; int seqmask;
    __device__ __forceinline__ void operator()(const f32x4 (&acc)[2][2][4][2], const Unit& u, int wr, int wc, int fr, int fq) const {
        const int row0 = u.pm * BM + wr * 64 + fr; const int part = u.pn >> 2, pn4 = u.pn & 3;
        if (part == 2) {
            const int col0 = pn4 * BM + wc * 32 + 8 * fq;
#pragma unroll
            for (int ai = 0; ai < 2; ++ai)
#pragma unroll
                for (int m = 0; m < 4; ++m) { bf16_t* rowp = Vb + (size_t)(row0 + ai * HALF + m * 16) * 1024 + col0;
#pragma unroll
                    for (int bj = 0; bj < 2; ++bj) *(u32x4*)(rowp + bj * HALF) = pack8(acc[ai][bj][m][0], acc[ai][bj][m][1]); }
        } else {
            bf16_t* base = part == 0 ? Q : Kb; const float sc = part == 0 ? qscale : 1.0f;
            const int hm = pn4 * 4 + wc, j0 = 8 * fq;
#pragma unroll
            for (int q = 0; q < 4; ++q) {
                const int ai = q >> 1, mb = (q & 1) * 2;
                f32x4 c0[2], c1[2], s0[2], s1[2];
#pragma unroll
                for (int mm = 0; mm < 2; ++mm) { const int pos = (row0 + ai * HALF + (mb + mm) * 16) & seqmask;
                    c0[mm] = *(const f32x4*)(cs + pos * 32 + j0); c1[mm] = *(const f32x4*)(cs + pos * 32 + j0 + 4); s0[mm] = *(const f32x4*)(sn + pos * 32 + j0); s1[mm] = *(const f32x4*)(sn + pos * 32 + j0 + 4); }
#pragma unroll
                for (int mm = 0; mm < 2; ++mm) { const int m = mb + mm; const int row = row0 + ai * HALF + m * 16;
                    const f32x4 x1a = acc[ai][0][m][0] * sc, x1b = acc[ai][0][m][1] * sc, x2a = acc[ai][1][m][0] * sc, x2b = acc[ai][1][m][1] * sc;
                    const f32x4 o1a = x1a * c0[mm] - x2a * s0[mm], o1b = x1b * c1[mm] - x2b * s1[mm], o2a = x2a * c0[mm] + x1a * s0[mm], o2b = x2b * c1[mm] + x1b * s1[mm];
                    bf16_t* rowp = base + (size_t)row * 1024 + hm * 64 + j0;
                    *(u32x4*)(rowp) = pack8(o1a, o1b); *(u32x4*)(rowp + 32) = pack8(o2a, o2b); }
            }
        }
    }
};
struct EpiSwiGLU {
    static constexpr bool PERM = true, AFTER_DRAIN = false;
    bf16_t* act;
    __device__ __forceinline__ void operator()(const f32x4 (&acc)[2][2][4][2], const Unit& u, int wr, int wc, int fr, int fq) const {
        const int row0 = u.pm * BM + wr * 64 + fr, col0 = u.pn * HALF + wc * 32 + 8 * fq;
#pragma unroll
        for (int ai = 0; ai < 2; ++ai)
#pragma unroll
            for (int m = 0; m < 4; ++m) { f32x4 v0, v1;
#pragma unroll
                for (int j = 0; j < 4; ++j) { v0[j] = silu_f(acc[ai][0][m][0][j]) * acc[ai][1][m][0][j]; v1[j] = silu_f(acc[ai][0][m][1][j]) * acc[ai][1][m][1][j]; }
                *(u32x4*)(act + (size_t)(row0 + ai * HALF + m * 16) * 512 + col0) = pack8(v0, v1); }
    }
};
struct EpiRowScale {
    static constexpr bool PERM = true, AFTER_DRAIN = false;
    bf16_t* O; const float* roww;
    __device__ __forceinline__ void operator()(const f32x4 (&acc)[2][2][4][2], const Unit& u, int wr, int wc, int fr, int fq) const {
        const int row0 = u.pm * BM + wr * 64 + fr, col0 = u.pn * BM + wc * 32 + 8 * fq;
        float w8[8];
#pragma unroll
        for (int q = 0; q < 8; ++q) w8[q] = roww[row0 + (q >> 2) * HALF + (q & 3) * 16];
#pragma unroll
        for (int ai = 0; ai < 2; ++ai)
#pragma unroll
            for (int m = 0; m < 4; ++m) { const int row = row0 + ai * HALF + m * 16; const float w = w8[ai * 4 + m]; bf16_t* rowp = O + (size_t)row * 1024 + col0;
#pragma unroll
                for (int bj = 0; bj < 2; ++bj) *(u32x4*)(rowp + bj * HALF) = pack8(acc[ai][bj][m][0] * w, acc[ai][bj][m][1] * w); }
    }
};
struct PanelOrder {
    int pm, nN;
    __device__ __forceinline__ bool next(int i, Unit& u) const { if (i >= nN) return false; u.pm = pm; u.pn = i; u.e = 0; return true; }
    __device__ __forceinline__ void a_ready(const Unit&) const {}
    __device__ __forceinline__ void done(const Unit&) const {}
};
struct MoeOrder : StaticOrder {
    const int* blk_e;
    __device__ __forceinline__ bool next(int i, Unit& u) const { if (!StaticOrder::next(i, u)) return false; u.e = ((const __attribute__((address_space(4))) int*)blk_e)[u.pm]; return true; }
};
}
#include <hip/hip_bf16.h>
#include <cmath>
namespace attn_body {
using bf16=__hip_bfloat16;
using bf16x8=__attribute__((ext_vector_type(8)))short;
using s16x4=__attribute__((ext_vector_type(4)))short;
using f32x16=__attribute__((ext_vector_type(16)))float;
using u32x4=__attribute__((ext_vector_type(4)))unsigned;
constexpr int BATCH=16,NHEAD=16,SEQ=4096,D=64,DM=NHEAD*D;
constexpr int NW=8,QBLK=32,QB=QBLK*NW,KVBLK=64,NQB=SEQ/QB;
constexpr int ATTN_PITCH=DM, ATTN_UNIT_ROWS=QB;
__device__ __forceinline__ int crow(int r,int hi){return (r&3)+8*(r>>2)+4*hi;}
#define SBAR() __builtin_amdgcn_sched_barrier(0)
__device__ __forceinline__ void cmask(f32x16&p0,f32x16&p1,int jb,int qrel,int hi){
  const float NEG=-INFINITY; int kb=64*jb+4*hi;
  #pragma unroll
  for(int r=0;r<16;++r){int kv=kb+(r&3)+8*(r>>2); if(kv>qrel)p0[r]=NEG; if(kv+32>qrel)p1[r]=NEG;}
}

constexpr int NSLOT=3, SLOTB=8192;
constexpr int LDS_K=0, LDS_V=NSLOT*SLOTB, LDS_WS=2*NSLOT*SLOTB, LDS_OST=LDS_WS+NW*64*4, LDS_BYTES=LDS_OST+NW*4096;
constexpr float C2=0.125f*1.4426950408889634f;
__device__ __forceinline__ void glds16(const void*gsrc,unsigned lds_dst){unsigned keep;
  asm volatile("s_mov_b32 %0, m0\n\ts_mov_b32 m0, %2\n\ts_nop 0\n\tglobal_load_lds_dwordx4 %1, off\n\ts_mov_b32 m0, %0":"=&s"(keep):"v"(gsrc),"s"(lds_dst):"memory");}
__device__ __forceinline__ float max3f(float a,float b,float c){float r;asm("v_max3_f32 %0, %1, %2, %3":"=v"(r):"v"(a),"v"(b),"v"(c));return r;}
__device__ __forceinline__ float max2f(float a,float b){float r;asm("v_max_f32_e32 %0, %1, %2":"=v"(r):"v"(a),"v"(b));return r;}
__device__ __forceinline__ float fadd_s(float a,float b){float r;asm("v_add_f32_e32 %0, %1, %2":"=v"(r):"v"(a),"v"(b));return r;}
__device__ __forceinline__ float fsub_s(float a,float b){float r;asm("v_sub_f32_e32 %0, %1, %2":"=v"(r):"v"(a),"v"(b));return r;}
typedef float f32x2_t __attribute__((ext_vector_type(2))); typedef __bf16 bf16x2_t __attribute__((ext_vector_type(2)));
__device__ __forceinline__ unsigned cvtpk_s(float lo,float hi){f32x2_t v={lo,hi};bf16x2_t b=__builtin_convertvector(v,bf16x2_t);return __builtin_bit_cast(unsigned,b);}
#define WAIT_BAR(N) asm volatile("s_waitcnt vmcnt(" #N ") lgkmcnt(0)\n\ts_barrier":::"memory")

__device__ __forceinline__ void qkt(f32x16&p0,f32x16&p1,const char*Kslot,const bf16x8*qr,const f32x16&negm,int r32,int hi){
  const char*kb=Kslot+hi*1024+r32*16;
  #pragma unroll
  for(int d0=0;d0<4;++d0){
    const bf16x8 b0=*reinterpret_cast<const bf16x8*>(kb+d0*2048);
    const bf16x8 b1=*reinterpret_cast<const bf16x8*>(kb+d0*2048+512);
    if(d0==0){p0=__builtin_amdgcn_mfma_f32_32x32x16_bf16(b0,qr[0],negm,0,0,0);p1=__builtin_amdgcn_mfma_f32_32x32x16_bf16(b1,qr[0],negm,0,0,0);}
    else{p0=__builtin_amdgcn_mfma_f32_32x32x16_bf16(b0,qr[d0],p0,0,0,0);p1=__builtin_amdgcn_mfma_f32_32x32x16_bf16(b1,qr[d0],p1,0,0,0);}}
}
typedef __attribute__((address_space(3))) const char* lds_cptr;
typedef short v4i16_t __attribute__((ext_vector_type(4)));
__device__ __forceinline__ void kload8(bf16x8*kf,lds_cptr kp){
  kf[0]=*(const __attribute__((address_space(3))) bf16x8*)(kp);      kf[1]=*(const __attribute__((address_space(3))) bf16x8*)(kp+512);
  kf[2]=*(const __attribute__((address_space(3))) bf16x8*)(kp+2048); kf[3]=*(const __attribute__((address_space(3))) bf16x8*)(kp+2560);
  kf[4]=*(const __attribute__((address_space(3))) bf16x8*)(kp+4096); kf[5]=*(const __attribute__((address_space(3))) bf16x8*)(kp+4608);
  kf[6]=*(const __attribute__((address_space(3))) bf16x8*)(kp+6144); kf[7]=*(const __attribute__((address_space(3))) bf16x8*)(kp+6656);
}
__device__ __forceinline__ void kload2(bf16x8*kf,lds_cptr kp,int j){ kf[2*j]=*(const __attribute__((address_space(3))) bf16x8*)(kp+j*2048); kf[2*j+1]=*(const __attribute__((address_space(3))) bf16x8*)(kp+j*2048+512); }
__device__ __forceinline__ s16x4 vtr(lds_cptr p){ return __builtin_bit_cast(s16x4,__builtin_amdgcn_ds_read_tr16_b64_v4i16((__attribute__((address_space(3))) v4i16_t*)p)); }
__device__ __forceinline__ float rowmax(const f32x16&p0,const f32x16&p1){
  float a=max3f(p0[0],p0[1],p1[0]),b=max3f(p0[2],p0[3],p1[1]);a=max3f(a,p1[2],p1[3]);
  #pragma unroll
  for(int r=4;r<16;r+=4){a=max3f(a,p0[r],p0[r+1]);b=max3f(b,p0[r+2],p0[r+3]);a=max3f(a,p1[r],p1[r+1]);b=max3f(b,p1[r+2],p1[r+3]);}
  const float m=max2f(a,b);
  auto rr=__builtin_amdgcn_permlane32_swap(__float_as_uint(m),__float_as_uint(m),false,false);
  return max2f(__uint_as_float(rr[0]),__uint_as_float(rr[1]));
}
__device__ __forceinline__ void pv(f32x16*o,int vb,bf16x8 pa0,bf16x8 pa1,bf16x8 pa2,bf16x8 pa3){
  #pragma unroll
  for(int d0=0;d0<2;++d0){s16x4 lo[4],hi[4];
    #pragma unroll
    for(int ks=0;ks<4;++ks){
      asm volatile("ds_read_b64_tr_b16 %0,%1 offset:%c2":"=&v"(lo[ks]):"v"(vb),"i"(d0*4096+ks*1024):"memory");
      asm volatile("ds_read_b64_tr_b16 %0,%1 offset:%c2":"=&v"(hi[ks]):"v"(vb),"i"(d0*4096+ks*1024+512):"memory");}
    asm volatile("s_waitcnt lgkmcnt(0)":::"memory");SBAR();
    #define PK(k) (bf16x8){lo[k][0],lo[k][1],lo[k][2],lo[k][3],hi[k][0],hi[k][1],hi[k][2],hi[k][3]}
    o[d0]=__builtin_amdgcn_mfma_f32_32x32x16_bf16(pa0,PK(0),o[d0],0,0,0);
    o[d0]=__builtin_amdgcn_mfma_f32_32x32x16_bf16(pa1,PK(1),o[d0],0,0,0);
    o[d0]=__builtin_amdgcn_mfma_f32_32x32x16_bf16(pa2,PK(2),o[d0],0,0,0);
    o[d0]=__builtin_amdgcn_mfma_f32_32x32x16_bf16(pa3,PK(3),o[d0],0,0,0);
    #undef PK
  }
}

#ifndef ATTN_STORE16
#define ATTN_STORE16(p,v) (*(u32x4*)(p)=(v))
#endif
template<int THRL> __device__ __forceinline__ void attn_unit(int b,int qcol,int kcol,int vcol,int ocol,int qb,const bf16*Q,const bf16* K,const bf16* V,bf16*O,char*shm,int tid){
  const int lane=tid&63,r32=lane&31,hi=lane>>5; const int wid=__builtin_amdgcn_readfirstlane(tid>>6);
  const long rowbase=(long)b*SEQ; const int q0=qb*QB;
  const bf16*Qw=Q+(rowbase+q0+wid*QBLK)*DM+qcol;
  const bf16*Kh=K+rowbase*DM+kcol,*Vh=V+rowbase*DM+vcol;
  const unsigned lds0=(unsigned)(uintptr_t)shm;
  float*wsf=(float*)(shm+LDS_WS)+wid*64;
  const bf16*ksrc=Kh+(long)lane*DM+wid*8;
  const bf16*vsrc=Vh+(long)(16*(wid&3)+(lane>>2))*DM+(wid>>2)*32+(lane&3)*8;
  const unsigned kdst=lds0+LDS_K+wid*1024, vdst=lds0+LDS_V+wid*1024;
  #define DMA_K(t,slot) glds16(ksrc+(long)(t)*KVBLK*DM,(unsigned)__builtin_amdgcn_readfirstlane(kdst+(slot)))
  #define DMA_V(t,slot) glds16(vsrc+(long)(t)*KVBLK*DM,(unsigned)__builtin_amdgcn_readfirstlane(vdst+(slot)))
  const int vb0=(int)(lds0+LDS_V)+((lane>>4)&1)*32+(lane&3)*8+(4*hi+((lane&15)>>2))*64;
  const char*Kbase=shm+LDS_K; bf16x8 kf[8];
  const lds_cptr shm3=(lds_cptr)shm; const lds_cptr kp0=shm3+LDS_K+hi*1024+r32*16; const lds_cptr vp0=shm3+LDS_V+((lane>>4)&1)*32+(lane&3)*8+(4*hi+((lane&15)>>2))*64;
  const int NT=(q0+QB)/KVBLK;
  DMA_K(0,0);DMA_V(0,0);DMA_K(1,SLOTB);
  bf16x8 qr[4];
  #pragma unroll
  for(int d0=0;d0<4;++d0)qr[d0]=*reinterpret_cast<const bf16x8*>(&Qw[(long)r32*DM+d0*16+hi*8]);
  float mhat=0.f,l_reg=0.f;f32x16 o[2];o[0]=f32x16{};o[1]=f32x16{};f32x16 negm=f32x16{};asm volatile("":"+v"(negm));
  const int qrel=wid*QBLK+r32;
  #define CMASK(P0,P1,t) do{int jb_=(t)-(NT-4); if(jb_>=0)cmask(P0,P1,jb_,qrel,hi);}while(0)
  bool resc=false;
  #define START(P0,P1) do{ const float rm=rowmax(P0,P1); resc=false; \
    { const float dl=rm; mhat=fadd_s(mhat,dl); \
      _Pragma("unroll") for(int r=0;r<16;++r){P0[r]=fsub_s(P0[r],dl);P1[r]=fsub_s(P1[r],dl);} \
      _Pragma("unroll") for(int r=0;r<16;++r)negm[r]=-mhat; asm volatile("":"+v"(negm)); } \
    _Pragma("unroll") for(int r=0;r<16;++r)P0[r]=__builtin_amdgcn_exp2f(P0[r]); }while(0)
  #define RESC() do{ if(resc){ asm volatile("s_waitcnt lgkmcnt(0)":::"memory"); \
      _Pragma("unroll") for(int d_=0;d_<2;++d_) _Pragma("unroll") for(int r=0;r<16;++r)o[d_][r]*=wsf[crow(r,hi)]; } }while(0)
  f32x16 pA0,pA1,pB0,pB1;
  int sl_prev=0,sl_cur=0,sl_next=SLOTB;
  #define ROT() do{sl_prev=sl_cur;sl_cur=sl_next;sl_next=(sl_next==(NSLOT-1)*SLOTB)?0:sl_next+SLOTB;}while(0)
  DMA_K(2,2*SLOTB);
  WAIT_BAR(3);
  qkt(pA0,pA1,Kbase,qr,negm,r32,hi);asm volatile("s_nop 15\n\ts_nop 7":"+v"(pA0),"+v"(pA1));CMASK(pA0,pA1,0);
  START(pA0,pA1);
  _Pragma("unroll") for(int r=0;r<16;++r)pA1[r]=__builtin_amdgcn_exp2f(pA1[r]);
  WAIT_BAR(0);
  DMA_K(3,0);DMA_V(1,SLOTB);
  ROT();
  kload8(kf,kp0+sl_cur);
  WAIT_BAR(2);
  s16x4 vlo[8],vhi[8]; u32x4 pw0,pw1,pw2,pw3;
  #define PKW(P,B) cvtpk_s(P[B],P[B+1])
  #define PAF(k) __builtin_bit_cast(bf16x8,pw##k)
  #define VFR(i) (bf16x8){vlo[i][0],vlo[i][1],vlo[i][2],vlo[i][3],vhi[i][0],vhi[i][1],vhi[i][2],vhi[i][3]}
  #define PIN(x) asm volatile("":"+v"(x))
  #define MX3(a,b,c) __builtin_fmaxf(__builtin_fmaxf((a),(b)),(c))
  #define GAPA(MF,A0,A1,A2,A3,W0,W1,PW) do{ MF; sacc+=A0; sacc+=A1; sacc+=A2; sacc+=A3; PIN(sacc); W0; W1; PIN(PW); SBAR(); }while(0)
  #define EX(v) __builtin_amdgcn_exp2f(v)
  #define GAPB(MF,X,B) do{ MF; X[B]=EX(X[B]); X[B+1]=EX(X[B+1]); X[B+2]=EX(X[B+2]); X[B+3]=EX(X[B+3]); PIN(X); SBAR(); }while(0)
  #define VRD(i) do{ vlo[i]=vtr(vp_+(((i)>>2)*4096+((i)&3)*1024)); vhi[i]=vtr(vp_+(((i)>>2)*4096+((i)&3)*1024+512)); }while(0)
  #define KRD(G,j) do{ if(G){ kload2(kf,kp0+sl_next,j); SBAR(); } }while(0)
  #define STEP(C0,C1,P0,P1,t,GK,GV,GL) do{ SBAR(); \
    const lds_cptr vp_=vp0+sl_prev; \
    VRD(0); SBAR(); float sacc=(P0[0]+P0[1]); \
    GAPA(C0=__builtin_amdgcn_mfma_f32_32x32x16_bf16(kf[0],qr[0],negm,0,0,0), P0[2],P0[3],P0[4],P0[5],     pw0[0]=PKW(P0,0), pw0[1]=PKW(P0,2), pw0); \
    VRD(4); SBAR(); GAPA(C1=__builtin_amdgcn_mfma_f32_32x32x16_bf16(kf[1],qr[0],negm,0,0,0), P0[6],P0[7],P0[8],P0[9],     pw0[2]=PKW(P0,4), pw0[3]=PKW(P0,6), pw0); \
    VRD(1); SBAR(); GAPA(C0=__builtin_amdgcn_mfma_f32_32x32x16_bf16(kf[2],qr[1],C0,0,0,0),   P0[10],P0[11],P0[12],P0[13], pw1[0]=PKW(P0,8), pw1[1]=PKW(P0,10), pw1); \
    VRD(5); SBAR(); GAPA(C1=__builtin_amdgcn_mfma_f32_32x32x16_bf16(kf[3],qr[1],C1,0,0,0),   P0[14],P0[15],P1[0],P1[1],   pw1[2]=PKW(P0,12),pw1[3]=PKW(P0,14), pw1); \
    VRD(2); SBAR(); GAPA(C0=__builtin_amdgcn_mfma_f32_32x32x16_bf16(kf[4],qr[2],C0,0,0,0),   P1[2],P1[3],P1[4],P1[5],     pw2[0]=PKW(P1,0), pw2[1]=PKW(P1,2), pw2); \
    VRD(6); SBAR(); GAPA(C1=__builtin_amdgcn_mfma_f32_32x32x16_bf16(kf[5],qr[2],C1,0,0,0),   P1[6],P1[7],P1[8],P1[9],     pw2[2]=PKW(P1,4), pw2[3]=PKW(P1,6), pw2); \
    VRD(3); SBAR(); GAPA(C0=__builtin_amdgcn_mfma_f32_32x32x16_bf16(kf[6],qr[3],C0,0,0,0),   P1[10],P1[11],P1[12],P1[13], pw3[0]=PKW(P1,8), pw3[1]=PKW(P1,10), pw3); \
    VRD(7); SBAR(); GAPA(C1=__builtin_amdgcn_mfma_f32_32x32x16_bf16(kf[7],qr[3],C1,0,0,0),   P1[14],P1[15],0.f,0.f,       pw3[2]=PKW(P1,12),pw3[3]=PKW(P1,14), pw3); \
    l_reg+=sacc; \
    if(GK){DMA_K((t)+3,sl_cur);} if(GV){DMA_V((t)+1,sl_next);} \
    CMASK(C0,C1,t); \
    { float a=MX3(C0[0],C0[1],C1[0]),b=MX3(C0[2],C0[3],C1[1]); a=MX3(a,C1[2],C1[3]); \
      _Pragma("unroll") for(int r=4;r<16;r+=4){a=MX3(a,C0[r],C0[r+1]);b=MX3(b,C0[r+2],C0[r+3]);a=MX3(a,C1[r],C1[r+1]);b=MX3(b,C1[r+2],C1[r+3]);} \
      float rm=__builtin_fmaxf(a,b); { auto rr=__builtin_amdgcn_permlane32_swap(__float_as_uint(rm),__float_as_uint(rm),false,false); rm=__builtin_fmaxf(__uint_as_float(rr[0]),__uint_as_float(rr[1])); } \
      resc=false; \
      if(__builtin_expect(__any(rm>(float)THRL),0)){ const float dl=__builtin_fmaxf(rm,0.f); mhat+=dl; \
        _Pragma("unroll") for(int r=0;r<16;++r){C0[r]-=dl;C1[r]-=dl;} \
        _Pragma("unroll") for(int r=0;r<16;++r)negm[r]=-mhat; asm volatile("":"+v"(negm)); \
        const float f=__builtin_amdgcn_exp2f(-dl); l_reg*=f; if(hi==0)wsf[r32]=f; resc=true; } } \
    SBAR(); \
    GAPB(o[0]=__builtin_amdgcn_mfma_f32_32x32x16_bf16(PAF(0),VFR(0),o[0],0,0,0), C0,0); \
    GAPB(o[1]=__builtin_amdgcn_mfma_f32_32x32x16_bf16(PAF(0),VFR(4),o[1],0,0,0), C0,4); \
    KRD(GL,0); GAPB(o[0]=__builtin_amdgcn_mfma_f32_32x32x16_bf16(PAF(1),VFR(1),o[0],0,0,0), C0,8); \
    KRD(GL,1); GAPB(o[1]=__builtin_amdgcn_mfma_f32_32x32x16_bf16(PAF(1),VFR(5),o[1],0,0,0), C0,12); \
    KRD(GL,2); GAPB(o[0]=__builtin_amdgcn_mfma_f32_32x32x16_bf16(PAF(2),VFR(2),o[0],0,0,0), C1,0); \
    KRD(GL,3); GAPB(o[1]=__builtin_amdgcn_mfma_f32_32x32x16_bf16(PAF(2),VFR(6),o[1],0,0,0), C1,4); \
    GAPB(o[0]=__builtin_amdgcn_mfma_f32_32x32x16_bf16(PAF(3),VFR(3),o[0],0,0,0), C1,8); \
    GAPB(o[1]=__builtin_amdgcn_mfma_f32_32x32x16_bf16(PAF(3),VFR(7),o[1],0,0,0), C1,12); \
    }while(0)
  int t=1;
  #undef CMASK
  #define CMASK(P0,P1,t) do{}while(0)
  for(;t+5<NT;t+=2){
    STEP(pB0,pB1,pA0,pA1,t,true,true,true);     WAIT_BAR(2); RESC(); ROT();
    STEP(pA0,pA1,pB0,pB1,t+1,true,true,true);   WAIT_BAR(2); RESC(); ROT();
  }
  #undef CMASK
  #define CMASK(P0,P1,t) do{int jb_=(t)-(NT-4); if(jb_>=0)cmask(P0,P1,jb_,qrel,hi);}while(0)
  #define ENDW(tt) do{ if((tt)+3<NT){WAIT_BAR(2);} else if((tt)+2<NT){WAIT_BAR(1);} else {WAIT_BAR(0);} }while(0)
  for(;t+1<NT;t+=2){
    STEP(pB0,pB1,pA0,pA1,t,(t+3<NT),(t+1<NT),(t+1<NT));       ENDW(t);   RESC(); ROT();
    STEP(pA0,pA1,pB0,pB1,t+1,(t+4<NT),(t+2<NT),(t+2<NT));     ENDW(t+1); RESC(); ROT();
  }
  STEP(pB0,pB1,pA0,pA1,NT-1,false,false,false); RESC();
  { float sacc=pB0[0]+pB0[1]; _Pragma("unroll") for(int r=2;r<16;++r)sacc+=pB0[r]; _Pragma("unroll") for(int r=0;r<16;++r)sacc+=pB1[r]; l_reg+=sacc;
    pw0=(u32x4){PKW(pB0,0),PKW(pB0,2),PKW(pB0,4),PKW(pB0,6)};pw1=(u32x4){PKW(pB0,8),PKW(pB0,10),PKW(pB0,12),PKW(pB0,14)};pw2=(u32x4){PKW(pB1,0),PKW(pB1,2),PKW(pB1,4),PKW(pB1,6)};pw3=(u32x4){PKW(pB1,8),PKW(pB1,10),PKW(pB1,12),PKW(pB1,14)};
    SBAR(); pv(o,vb0+sl_cur,PAF(0),PAF(1),PAF(2),PAF(3)); }
  #undef PKW
  #undef PAF
  #undef VFR
  #undef PIN
  #undef MX3
  #undef GAPA
  #undef GAPB
  #undef EX
  #undef VRD
  #undef KRD
  #undef STEP
  #undef ENDW
  {auto rr=__builtin_amdgcn_permlane32_swap(__float_as_uint(l_reg),__float_as_uint(l_reg),false,false);l_reg=__uint_as_float(rr[0])+__uint_as_float(rr[1]);}
  if(hi==0)wsf[32+r32]=l_reg;asm volatile("s_waitcnt lgkmcnt(0)":::"memory");
  float rli[16];
  #pragma unroll
  for(int r=0;r<16;++r)rli[r]=__builtin_amdgcn_rcpf(wsf[32+crow(r,hi)]);
  bf16*Ow=O+(rowbase+q0+wid*QBLK)*DM+ocol;
  { bf16*stg=(bf16*)(shm+LDS_OST)+wid*2048;
    #pragma unroll
    for(int r=0;r<16;++r){const int orow=crow(r,hi);
      #pragma unroll
      for(int d0=0;d0<2;++d0)stg[orow*64+d0*32+r32]=__float2bfloat16(o[d0][r]*rli[r]);}
    asm volatile("s_waitcnt lgkmcnt(0)":::"memory");
    #pragma unroll
    for(int i=0;i<4;++i){const int row=i*8+(lane>>3),ch=lane&7; const u32x4 v=*(const u32x4*)(stg+row*64+ch*8); ATTN_STORE16(Ow+(long)row*DM+ch*8,v);} }
  asm volatile("s_waitcnt lgkmcnt(0)\n\ts_barrier":::"memory");
  #undef DMA_K
  #undef DMA_V
  #undef CMASK
  #undef START
  #undef RESC
  #undef ROT
}
constexpr int ATTN_LDS_BYTES=LDS_BYTES;
struct AttnTensors { const bf16* Q; const bf16* K; const bf16* V; bf16* O0; bf16* O1; };
struct AttnUnit { int b, qcol, kcol, vcol, ocol, m, qb; };
struct StaticOrder {
  int vcu, G;
  __device__ __forceinline__ StaticOrder(int grid,int vcu_):vcu(vcu_),G(grid){}
  __device__ __forceinline__ bool next(int i,AttnUnit&u)const{
    int b,h,m,vhalf,qb;
    if(G==256){ if(i>=32)return false; const int xcd=vcu>>5,l=vcu&31,vh=l&3,qs=l>>2,bh=xcd*16+(i>>1); b=bh>>3; h=bh&7; m=(vh>>1)&1; vhalf=vh&1; qb=(i&1)?qs:15-qs; }
    else { const int ci=vcu+G*(i>>4); if(ci>=BATCH*32)return false; const int vh=ci&31; h=vh>>2; m=(vh>>1)&1; vhalf=vh&1; b=ci>>5; qb=15-(i&15); }
    u.b=b; u.qcol=(2*h+m)*64; u.kcol=u.qcol; u.vcol=h*128+vhalf*64; u.ocol=u.vcol; u.m=m; u.qb=qb; return true; }
  __device__ __forceinline__ void a_ready(const AttnUnit&)const{}
  __device__ __forceinline__ void done(const AttnUnit&)const{}
};
template<class Sched,int THRL=8> __device__ __forceinline__ void attn_phase(char*lds,const AttnTensors&T,const Sched&S,const int tid_){
  AttnUnit u;
  for(int i=0;S.next(i,u);++i){ S.a_ready(u); attn_unit<THRL>(u.b,u.qcol,u.kcol,u.vcol,u.ocol,u.qb,T.Q,T.K,T.V,u.m?T.O1:T.O0,lds,tid_); S.done(u); }
}
constexpr int VSLOTB=16384;
constexpr int WL_K=0, WL_V=NSLOT*SLOTB, WL_WS=WL_V+NSLOT*VSLOTB, WL_Q=WL_WS+NW*64*4, WL_OST=WL_Q+NW*4096, WL_BYTES=WL_OST+NW*4096;
__device__ __forceinline__ void cmask2(f32x16&p0,f32x16&p1,int jb,int qrel,int hi){
  const float NEG=-INFINITY; const int qq=qrel-64*jb-4*hi;
  #pragma unroll
  for(int r=0;r<16;++r){const int c=(r&3)+8*(r>>2); if(c>qq)p0[r]=NEG; if(c+32>qq)p1[r]=NEG;}
}
__device__ __forceinline__ void pv4(f32x16*o,int vb,bf16x8 pa0,bf16x8 pa1,bf16x8 pa2,bf16x8 pa3){
  #pragma unroll
  for(int d0=0;d0<4;++d0){s16x4 lo[4],hi[4];
    #pragma unroll
    for(int ks=0;ks<4;++ks){
      asm volatile("ds_read_b64_tr_b16 %0,%1 offset:%c2":"=&v"(lo[ks]):"v"(vb),"i"(d0*4096+ks*1024):"memory");
      asm volatile("ds_read_b64_tr_b16 %0,%1 offset:%c2":"=&v"(hi[ks]):"v"(vb),"i"(d0*4096+ks*1024+512):"memory");}
    asm volatile("s_waitcnt lgkmcnt(0)":::"memory");SBAR();
    #define PK(k) (bf16x8){lo[k][0],lo[k][1],lo[k][2],lo[k][3],hi[k][0],hi[k][1],hi[k][2],hi[k][3]}
    o[d0]=__builtin_amdgcn_mfma_f32_32x32x16_bf16(pa0,PK(0),o[d0],0,0,0);
    o[d0]=__builtin_amdgcn_mfma_f32_32x32x16_bf16(pa1,PK(1),o[d0],0,0,0);
    o[d0]=__builtin_amdgcn_mfma_f32_32x32x16_bf16(pa2,PK(2),o[d0],0,0,0);
    o[d0]=__builtin_amdgcn_mfma_f32_32x32x16_bf16(pa3,PK(3),o[d0],0,0,0);
    #undef PK
  }
}
using f32x4_t=__attribute__((ext_vector_type(4)))float;
struct CombineW { const bf16* O0; bf16* A2; const float* w; float lam, mul; };
template<int THRL> __device__ __forceinline__ void attn_unit_w(int b,int qcol,int vcol,int qb,int m,const bf16*Q,const bf16* K,const bf16* V,bf16*O,const CombineW&CB,char*shm,int tid){
  const int lane=tid&63,r32=lane&31,hi=lane>>5; const int wid=__builtin_amdgcn_readfirstlane(tid>>6);
  const long rowbase=(long)b*SEQ; const int q0=qb*QB;
  int hi4=4*hi; asm volatile("":"+v"(hi4));
  #define CROWO(r) (((r)&3)+8*((r)>>2)+hi4)
  const bf16*Qw=Q+(rowbase+q0+wid*QBLK)*DM+qcol;
  const bf16*Kh=K+rowbase*DM+qcol,*Vh=V+rowbase*DM+vcol;
  const unsigned lds0=(unsigned)(uintptr_t)shm;
  float*wsf=(float*)(shm+WL_WS)+wid*64;
  const bf16*ksrc=Kh+(long)lane*DM+wid*8;
  const bf16*vsrc=Vh+(long)(16*(wid&3)+(lane>>2))*DM+(wid>>2)*32+(lane&3)*8;
  const unsigned kdst=lds0+WL_K+wid*1024, vdst=lds0+WL_V+wid*1024;
  #define DMA_K(t,slot) glds16(ksrc+(long)(t)*KVBLK*DM,(unsigned)__builtin_amdgcn_readfirstlane(kdst+(slot)))
  #define DMA_V(t,slot) do{ glds16(vsrc+(long)(t)*KVBLK*DM,(unsigned)__builtin_amdgcn_readfirstlane(vdst+2*(slot))); glds16(vsrc+(long)(t)*KVBLK*DM+64,(unsigned)__builtin_amdgcn_readfirstlane(vdst+2*(slot)+8192)); }while(0)
  const int vb0=(int)(lds0+WL_V)+((lane>>4)&1)*32+(lane&3)*8+(4*hi+((lane&15)>>2))*64;
  const char*Kbase=shm+WL_K; bf16x8 kf[8];
  const lds_cptr shm3=(lds_cptr)shm; const lds_cptr kp0=shm3+WL_K+hi*1024+r32*16; const lds_cptr vp0=shm3+WL_V+((lane>>4)&1)*32+(lane&3)*8+(4*hi+((lane&15)>>2))*64;
  const lds_cptr qp=shm3+WL_Q+wid*4096+lane*16;
  const int NT=(q0+QB)/KVBLK;
  DMA_K(0,0);DMA_V(0,0);DMA_K(1,SLOTB);
  bf16x8 qr[4];
  #pragma unroll
  for(int d0=0;d0<4;++d0)qr[d0]=*reinterpret_cast<const bf16x8*>(&Qw[(long)r32*DM+d0*16+hi*8]);
  #pragma unroll
  for(int d0=0;d0<4;++d0)*(__attribute__((address_space(3))) bf16x8*)(qp+d0*1024)=qr[d0];
  float mhat=0.f,l_reg=0.f;f32x16 o[4];o[0]=f32x16{};o[1]=f32x16{};o[2]=f32x16{};o[3]=f32x16{};
  const f32x16 zero16=f32x16{};
  const int qrel=wid*QBLK+r32;
  #define CMASK(P0,P1,t) do{int jb_=(t)-(NT-4); if(jb_>=0)cmask2(P0,P1,jb_,qrel,hi);}while(0)
  bool resc=false;
  #define START(P0,P1) do{ const float rm=rowmax(P0,P1); resc=false; \
    { const float dl=rm; mhat=fadd_s(mhat,dl); \
      _Pragma("unroll") for(int r=0;r<16;++r){P0[r]=fsub_s(P0[r],dl);P1[r]=fsub_s(P1[r],dl);} } \
    _Pragma("unroll") for(int r=0;r<16;++r)P0[r]=__builtin_amdgcn_exp2f(P0[r]); }while(0)
  #define RESC() do{ if(resc){ asm volatile("s_waitcnt lgkmcnt(0)":::"memory"); \
      _Pragma("unroll") for(int d_=0;d_<4;++d_) _Pragma("unroll") for(int r=0;r<16;++r)o[d_][r]*=wsf[CROWO(r)]; } }while(0)
  f32x16 pA0,pA1,pB0,pB1;
  int sl_prev=0,sl_cur=0,sl_next=SLOTB;
  #define ROT() do{sl_prev=sl_cur;sl_cur=sl_next;sl_next=(sl_next==(NSLOT-1)*SLOTB)?0:sl_next+SLOTB;}while(0)
  DMA_K(2,2*SLOTB);
  WAIT_BAR(3);
  qkt(pA0,pA1,Kbase,qr,zero16,r32,hi);asm volatile("s_nop 15\n\ts_nop 7":"+v"(pA0),"+v"(pA1));CMASK(pA0,pA1,0);
  START(pA0,pA1);
  _Pragma("unroll") for(int r=0;r<16;++r)pA1[r]=__builtin_amdgcn_exp2f(pA1[r]);
  WAIT_BAR(0);
  DMA_K(3,0);DMA_V(1,SLOTB);
  ROT();
  kload8(kf,kp0+sl_cur);
  WAIT_BAR(3);
  s16x4 vlo[16],vhi[16]; u32x4 pw0,pw1,pw2,pw3;
  #define PKW(P,B) cvtpk_s(P[B],P[B+1])
  #define PAF(k) __builtin_bit_cast(bf16x8,pw##k)
  #define VFR(i) (bf16x8){vlo[i][0],vlo[i][1],vlo[i][2],vlo[i][3],vhi[i][0],vhi[i][1],vhi[i][2],vhi[i][3]}
  #define PIN(x) asm volatile("":"+v"(x))
  #define MX3(a,b,c) __builtin_fmaxf(__builtin_fmaxf((a),(b)),(c))
  #define GAPA(MF,A0,A1,A2,A3,W0,W1,PW) do{ MF; sacc+=A0; sacc+=A1; sacc+=A2; sacc+=A3; PIN(sacc); W0; W1; PIN(PW); SBAR(); }while(0)
  #define EX(v) __builtin_amdgcn_exp2f(v)
  #define GAPB(MF,X,B) do{ MF; X[B]=EX(X[B]); X[B+1]=EX(X[B+1]); PIN(X); SBAR(); }while(0)
  #define VRD(i) do{ vlo[i]=vtr(vp_+(((i)>>2)*4096+((i)&3)*1024)); vhi[i]=vtr(vp_+(((i)>>2)*4096+((i)&3)*1024+512)); }while(0)
  #define KRD(G,j) do{ if(G){ kload2(kf,kp0+sl_next,j); SBAR(); } }while(0)
  #define QRD(d) (*(const __attribute__((address_space(3))) bf16x8*)(qp+(d)*1024))
  #define MF32(a_,b_,c_) __builtin_amdgcn_mfma_f32_32x32x16_bf16(a_,b_,c_,0,0,0)
  #define STEP(C0,C1,P0,P1,t,GK,GV,GL) do{ SBAR(); \
    const lds_cptr vp_=vp0+2*sl_prev; bf16x8 q0_,q1_,q2_,q3_; \
    q0_=QRD(0); VRD(0); SBAR(); float sacc=(P0[0]+P0[1]); \
    GAPA(C0=MF32(kf[0],q0_,zero16), P0[2],P0[3],P0[4],P0[5],     pw0[0]=PKW(P0,0), pw0[1]=PKW(P0,2), pw0); \
    q1_=QRD(1); SBAR(); GAPA(C1=MF32(kf[1],q0_,zero16), P0[6],P0[7],P0[8],P0[9],     pw0[2]=PKW(P0,4), pw0[3]=PKW(P0,6), pw0); \
    VRD(4); SBAR(); GAPA(C0=MF32(kf[2],q1_,C0),   P0[10],P0[11],P0[12],P0[13], pw1[0]=PKW(P0,8), pw1[1]=PKW(P0,10), pw1); \
    q2_=QRD(2); SBAR(); GAPA(C1=MF32(kf[3],q1_,C1),   P0[14],P0[15],P1[0],P1[1],   pw1[2]=PKW(P0,12),pw1[3]=PKW(P0,14), pw1); \
    VRD(8); SBAR(); GAPA(C0=MF32(kf[4],q2_,C0),   P1[2],P1[3],P1[4],P1[5],     pw2[0]=PKW(P1,0), pw2[1]=PKW(P1,2), pw2); \
    q3_=QRD(3); SBAR(); GAPA(C1=MF32(kf[5],q2_,C1),   P1[6],P1[7],P1[8],P1[9],     pw2[2]=PKW(P1,4), pw2[3]=PKW(P1,6), pw2); \
    VRD(12); SBAR(); GAPA(C0=MF32(kf[6],q3_,C0),   P1[10],P1[11],P1[12],P1[13], pw3[0]=PKW(P1,8), pw3[1]=PKW(P1,10), pw3); \
    GAPA(C1=MF32(kf[7],q3_,C1),   P1[14],P1[15],0.f,0.f,       pw3[2]=PKW(P1,12),pw3[3]=PKW(P1,14), pw3); \
    l_reg+=sacc; \
    if(GK){DMA_K((t)+3,sl_cur);} if(GV){DMA_V((t)+1,sl_next);} \
    CMASK(C0,C1,t); \
    { float a=MX3(C0[0],C0[1],C1[0]),b=MX3(C0[2],C0[3],C1[1]); a=MX3(a,C1[2],C1[3]); \
      _Pragma("unroll") for(int r=4;r<16;r+=4){a=MX3(a,C0[r],C0[r+1]);b=MX3(b,C0[r+2],C0[r+3]);a=MX3(a,C1[r],C1[r+1]);b=MX3(b,C1[r+2],C1[r+3]);} \
      float rm=__builtin_fmaxf(a,b); { auto rr=__builtin_amdgcn_permlane32_swap(__float_as_uint(rm),__float_as_uint(rm),false,false); rm=__builtin_fmaxf(__uint_as_float(rr[0]),__uint_as_float(rr[1])); } \
      rm-=mhat; resc=false; \
      if(__builtin_expect(__any(rm>(float)THRL),0)){ const float dl=__builtin_fmaxf(rm,0.f); mhat+=dl; \
        const float f=__builtin_amdgcn_exp2f(-dl); l_reg*=f; if(hi==0)wsf[r32]=f; resc=true; } \
      _Pragma("unroll") for(int r=0;r<16;++r){C0[r]-=mhat;C1[r]-=mhat;} } \
    SBAR(); \
    VRD(1);  GAPB(o[0]=MF32(PAF(0),VFR(0), o[0]), C0,0); \
    VRD(5);  GAPB(o[1]=MF32(PAF(0),VFR(4), o[1]), C0,2); \
    VRD(9);  GAPB(o[2]=MF32(PAF(0),VFR(8), o[2]), C0,4); \
    VRD(13); GAPB(o[3]=MF32(PAF(0),VFR(12),o[3]), C0,6); \
    VRD(2);  KRD(GL,0); GAPB(o[0]=MF32(PAF(1),VFR(1), o[0]), C0,8); \
    VRD(6);  GAPB(o[1]=MF32(PAF(1),VFR(5), o[1]), C0,10); \
    VRD(10); KRD(GL,1); GAPB(o[2]=MF32(PAF(1),VFR(9), o[2]), C0,12); \
    VRD(14); GAPB(o[3]=MF32(PAF(1),VFR(13),o[3]), C0,14); \
    VRD(3);  KRD(GL,2); GAPB(o[0]=MF32(PAF(2),VFR(2), o[0]), C1,0); \
    VRD(7);  GAPB(o[1]=MF32(PAF(2),VFR(6), o[1]), C1,2); \
    VRD(11); KRD(GL,3); GAPB(o[2]=MF32(PAF(2),VFR(10),o[2]), C1,4); \
    VRD(15); GAPB(o[3]=MF32(PAF(2),VFR(14),o[3]), C1,6); \
    GAPB(o[0]=MF32(PAF(3),VFR(3), o[0]), C1,8); \
    GAPB(o[1]=MF32(PAF(3),VFR(7), o[1]), C1,10); \
    GAPB(o[2]=MF32(PAF(3),VFR(11),o[2]), C1,12); \
    GAPB(o[3]=MF32(PAF(3),VFR(15),o[3]), C1,14); \
    }while(0)
  int t=1;
  #undef CMASK
  #define CMASK(P0,P1,t) do{}while(0)
  for(;t+5<NT;t+=2){
    STEP(pB0,pB1,pA0,pA1,t,true,true,true);     WAIT_BAR(3); RESC(); ROT();
    STEP(pA0,pA1,pB0,pB1,t+1,true,true,true);   WAIT_BAR(3); RESC(); ROT();
  }
  #undef CMASK
  #define CMASK(P0,P1,t) do{int jb_=(t)-(NT-4); if(jb_>=0)cmask2(P0,P1,jb_,qrel,hi);}while(0)
  #define ENDW(tt) do{ if((tt)+3<NT){WAIT_BAR(3);} else if((tt)+2<NT){WAIT_BAR(2);} else {WAIT_BAR(0);} }while(0)
  for(;t+1<NT;t+=2){
    STEP(pB0,pB1,pA0,pA1,t,(t+3<NT),(t+1<NT),(t+1<NT));       ENDW(t);   RESC(); ROT();
    STEP(pA0,pA1,pB0,pB1,t+1,(t+4<NT),(t+2<NT),(t+2<NT));     ENDW(t+1); RESC(); ROT();
  }
  STEP(pB0,pB1,pA0,pA1,NT-1,false,false,false); RESC();
  { float sacc=pB0[0]+pB0[1]; _Pragma("unroll") for(int r=2;r<16;++r)sacc+=pB0[r]; _Pragma("unroll") for(int r=0;r<16;++r)sacc+=pB1[r]; l_reg+=sacc;
    pw0=(u32x4){PKW(pB0,0),PKW(pB0,2),PKW(pB0,4),PKW(pB0,6)};pw1=(u32x4){PKW(pB0,8),PKW(pB0,10),PKW(pB0,12),PKW(pB0,14)};pw2=(u32x4){PKW(pB1,0),PKW(pB1,2),PKW(pB1,4),PKW(pB1,6)};pw3=(u32x4){PKW(pB1,8),PKW(pB1,10),PKW(pB1,12),PKW(pB1,14)};
    SBAR(); pv4(o,vb0+2*sl_cur,PAF(0),PAF(1),PAF(2),PAF(3)); }
  #undef PKW
  #undef PAF
  #undef VFR
  #undef PIN
  #undef MX3
  #undef GAPA
  #undef GAPB
  #undef EX
  #undef VRD
  #undef KRD
  #undef QRD
  #undef MF32
  #undef STEP
  #undef ENDW
  {auto rr=__builtin_amdgcn_permlane32_swap(__float_as_uint(l_reg),__float_as_uint(l_reg),false,false);l_reg=__uint_as_float(rr[0])+__uint_as_float(rr[1]);}
  if(hi==0)wsf[32+r32]=l_reg;asm volatile("s_waitcnt lgkmcnt(0)":::"memory");
  float rli[16];
  #pragma unroll
  for(int r=0;r<16;++r)rli[r]=__builtin_amdgcn_rcpf(wsf[32+CROWO(r)]);
  const long obase=(rowbase+q0+wid*QBLK)*DM+vcol;
  bf16*stg=(bf16*)(shm+WL_OST)+wid*2048;
  if(m==0){ bf16*Ow=O+obase;
    #pragma unroll
    for(int half=0;half<2;++half){
      #pragma unroll
      for(int r=0;r<16;++r){const int orow=CROWO(r);
        #pragma unroll
        for(int d0=0;d0<2;++d0)stg[orow*64+d0*32+r32]=__float2bfloat16(o[2*half+d0][r]*rli[r]);}
      asm volatile("s_waitcnt lgkmcnt(0)":::"memory");
      #pragma unroll
      for(int i=0;i<4;++i){const int row=i*8+(lane>>3),ch=lane&7; const u32x4 v=*(const u32x4*)(stg+row*64+ch*8); ATTN_STORE16(Ow+(long)row*DM+half*64+ch*8,v);}
      asm volatile("s_waitcnt lgkmcnt(0)":::"memory"); }
  } else {
    const bf16*O0w=CB.O0+obase; bf16*Aw=CB.A2+obase; const float lam=CB.lam;
    float df[2][4][8]; float ssq[4]={0.f,0.f,0.f,0.f};
    #pragma unroll
    for(int half=0;half<2;++half){
      u32x4 a[4];
      #pragma unroll
      for(int i=0;i<4;++i){const int row=i*8+(lane>>3),ch=lane&7; a[i]=*(const u32x4*)(O0w+(long)row*DM+half*64+ch*8);}
      #pragma unroll
      for(int r=0;r<16;++r){const int orow=CROWO(r);
        #pragma unroll
        for(int d0=0;d0<2;++d0)stg[orow*64+d0*32+r32]=__float2bfloat16(o[2*half+d0][r]*rli[r]);}
      asm volatile("s_waitcnt lgkmcnt(0)":::"memory");
      #pragma unroll
      for(int i=0;i<4;++i){const int row=i*8+(lane>>3),ch=lane&7; const u32x4 v=*(const u32x4*)(stg+row*64+ch*8);
        #pragma unroll
        for(int k=0;k<4;++k){ const float d0_=__uint_as_float(a[i][k]<<16)-lam*__uint_as_float(v[k]<<16), d1_=__uint_as_float(a[i][k]&0xffff0000u)-lam*__uint_as_float(v[k]&0xffff0000u);
          df[half][i][2*k]=d0_; df[half][i][2*k+1]=d1_; ssq[i]+=d0_*d0_; ssq[i]+=d1_*d1_; } }
      asm volatile("s_waitcnt lgkmcnt(0)":::"memory"); }
    #pragma unroll
    for(int i=0;i<4;++i){ float ss=ssq[i];
      ss+=__builtin_bit_cast(float,__builtin_amdgcn_update_dpp(0,__builtin_bit_cast(int,ss),0xB1,0xF,0xF,true));
      ss+=__builtin_bit_cast(float,__builtin_amdgcn_update_dpp(0,__builtin_bit_cast(int,ss),0x4E,0xF,0xF,true));
      ss+=__builtin_bit_cast(float,__builtin_amdgcn_update_dpp(0,__builtin_bit_cast(int,ss),0x141,0xF,0xF,true));
      ssq[i]=1.0f/sqrtf(ss*(1.0f/128.0f)+1e-5f); }
    #pragma unroll
    for(int half=0;half<2;++half){ const int ch=lane&7;
      const f32x4_t w0=*(const f32x4_t*)(CB.w+half*64+ch*8),w1=*(const f32x4_t*)(CB.w+half*64+ch*8+4);
      #pragma unroll
      for(int i=0;i<4;++i){const int row=i*8+(lane>>3); const float rs=ssq[i]; u32x4 ov;
        #pragma unroll
        for(int k=0;k<4;++k){ const float wa=(k<2?w0[2*k]:w1[2*k-4])*CB.mul, wb=(k<2?w0[2*k+1]:w1[2*k-3])*CB.mul; ov[k]=cvtpk_s(df[half][i][2*k]*rs*wa,df[half][i][2*k+1]*rs*wb); }
        ATTN_STORE16(Aw+(long)row*DM+half*64+ch*8,ov);} }
  }
  asm volatile("s_waitcnt lgkmcnt(0)\n\ts_barrier":::"memory");
  #undef DMA_K
  #undef DMA_V
  #undef CMASK
  #undef START
  #undef RESC
  #undef ROT
  #undef CROWO
}
constexpr int ATTNW_LDS_BYTES=WL_BYTES;
struct AttnUnitW { int b, qcol, vcol, m, qb; };
struct StaticOrderW {
  int vcu, G;
  __device__ __forceinline__ StaticOrderW(int grid,int vcu_):vcu(vcu_),G(grid){}
  __device__ __forceinline__ bool next(int i,AttnUnitW&u)const{
    int b,h,m,qb;
    if(G==256){ if(i>=16)return false; const int xcd=vcu>>5,l=vcu&31,s=l>>1,ip=i>>1,bh=xcd*16+8*(l&1)+ip; m=i&1; b=bh>>3; h=bh&7; qb=(ip&1)?s:15-s; }
    else { const int i2=i>>1,ci=vcu+G*(i2>>4); if(ci>=BATCH*8)return false; h=ci&7; m=i&1; b=ci>>3; qb=15-(i2&15); }
    u.b=b; u.qcol=(2*h+m)*64; u.vcol=h*128; u.m=m; u.qb=qb; return true; }
};
template<int THRL=8> __device__ __forceinline__ void attn_phase_w(char*lds,const AttnTensors&T,const StaticOrderW&S,const CombineW&CB,const int tid_){
  AttnUnitW u;
  for(int i=0;S.next(i,u);++i){ attn_unit_w<THRL>(u.b,u.qcol,u.vcol,u.qb,u.m,T.Q,T.K,T.V,T.O0,CB,lds,tid_); }
}
#undef SBAR
#undef WAIT_BAR
}

constexpr int NWAVES = 8;
constexpr int BATCH = 16, SEQ = 4096, D = 1024, M = BATCH * SEQ, DEPTH = 4;
constexpr int NEXP = 32, FF = 512;
constexpr int NSLOT_MAX = 2 * M + NEXP * 256, NBLK_MAX = NSLOT_MAX / 256;
constexpr float LN_EPS = 1e-5f;
constexpr float DN_ALPHA = 1.681792830507429f;
constexpr int HG_CHUNK = 32, HG_NCH = SEQ / HG_CHUNK;

constexpr size_t MiB = 1u << 20;
constexpr size_t WS_CTL = 0, CTL_ZERO_BYTES = 1 * MiB;
constexpr size_t WS_MOD = 1 * MiB;
constexpr size_t WS_ROPE_C = 3 * MiB, WS_ROPE_S = 3 * MiB + 512 * 1024;
constexpr size_t WS_RT = 4 * MiB;
constexpr size_t WS_EID = 5 * MiB;
constexpr size_t WS_WT = 5 * MiB + 512 * 1024;
constexpr size_t WS_TSLOT = 6 * MiB;
constexpr size_t WS_SLOTW = 6 * MiB + 512 * 1024;
constexpr size_t WS_BLKE = 7 * MiB + 128 * 1024;
constexpr size_t WS_STOK = 7 * MiB + 256 * 1024;
constexpr size_t WS_HGD = 8 * MiB;
constexpr size_t WS_WHIN = 16 * MiB;
constexpr size_t WS_WAIN = 32 * MiB;
constexpr size_t WS_WHOUT = 44 * MiB;
constexpr size_t WS_WAOUT = 48 * MiB;
constexpr size_t WS_W13 = 52 * MiB;
constexpr size_t WS_W2 = 116 * MiB;
constexpr size_t WS_BUF0 = 148 * MiB, BUFSZ = 128 * MiB;
constexpr size_t WS_WB2 = WS_BUF0 + 7 * BUFSZ;
constexpr size_t WS_END = WS_WB2 + 96 * MiB;
constexpr int CW_TMO = 0, CW_CODE = 1;
constexpr int CW_BAR = 4096;
constexpr int CW_CNT = 8192;
static_assert((CW_CNT + 4 * 256) * 4 <= (int)CTL_ZERO_BYTES, "ctl");

constexpr int RING_OFF = 0, RING_BYTES = 147456;
constexpr int LDSCTL_OFF = RING_BYTES, MISC_OFF = LDSCTL_OFF + 512;
constexpr int LDS_BYTES = RING_BYTES + 1024;
static_assert(MISC_OFF + 128 <= LDS_BYTES, "LDS map");
#define GAS __attribute__((address_space(1)))
#define LAS __attribute__((address_space(3)))
typedef unsigned short bf16;
typedef unsigned v4u __attribute__((ext_vector_type(4)));
typedef float f32x4 __attribute__((ext_vector_type(4)));
typedef short bf16x8 __attribute__((ext_vector_type(8)));
typedef GAS unsigned gu32;
typedef GAS unsigned long long gu64;
#define RLX_AGENT __ATOMIC_RELAXED, __HIP_MEMORY_SCOPE_AGENT
#define LDS_WAIT() asm volatile("s_waitcnt lgkmcnt(0)" ::: "memory")
#define VM_WAIT() asm volatile("s_waitcnt vmcnt(0)" ::: "memory")
__device__ __forceinline__ unsigned long long rt() { return __builtin_amdgcn_s_memrealtime(); }
__device__ __forceinline__ unsigned f2bf(float f) { unsigned u = __builtin_bit_cast(unsigned, f); return (u + 0x7fffu + ((u >> 16) & 1u)) >> 16; }
__device__ __forceinline__ unsigned pk2(float lo, float hi) { return f2bf(lo) | (f2bf(hi) << 16); }

#define XB_TMO      128
#define XB_XCNT(j)  (256  + 64 * (j))
#define XB_XSUB(j)  (1280 + 64 * (j))
#define XB_XGEN(j)  (2304 + 64 * (j))
#define XB_TOP      3328
#define XB_TOPGEN   3392
#define XCD_BAR_WORDS 3456
#define XB_SPIN_CAP (1u << 18)

__device__ __forceinline__ unsigned xb_ld(unsigned* p)              { return __hip_atomic_load(p, __ATOMIC_RELAXED, __HIP_MEMORY_SCOPE_AGENT); }
__device__ __forceinline__ unsigned xb_add(unsigned* p, unsigned v) { return __hip_atomic_fetch_add(p, v, __ATOMIC_RELAXED, __HIP_MEMORY_SCOPE_AGENT); }
__device__ __forceinline__ unsigned xb_xcc_id() { return (unsigned)__builtin_amdgcn_s_getreg((3 << 11) | 20) & 0xFu; }
#define XB_SPIN(cond, bar) do { unsigned _sp = 0; while (cond) { __builtin_amdgcn_s_sleep(1); \
    if ((++_sp & 255u) == 0u) { if (xb_ld(&(bar)[XB_TMO])) break; if (_sp > XB_SPIN_CAP) { atomicAdd(&(bar)[XB_TMO], 1u); break; } } } } while (0)

struct XcdBarrier {
    unsigned* bar; unsigned x;
    volatile LAS unsigned* st;
};

__device__ __forceinline__ XcdBarrier xcd_barrier_post(unsigned* bar, volatile LAS unsigned* st) {
    XcdBarrier b; b.bar = bar; b.x = xb_xcc_id(); b.st = st;
    if (threadIdx.x == 0) (void)xb_add(&bar[XB_XCNT(b.x)], 1u);
    return b;
}
__device__ __forceinline__ void xcd_barrier_complete(unsigned* bar, unsigned x, unsigned& nloc, unsigned& nx) {
    const unsigned G = gridDim.x * gridDim.y * gridDim.z;
    unsigned sum, cnt, mine, sp = 0u;
    for (;;) {
        sum = 0u; cnt = 0u; mine = 0u;
#pragma unroll
        for (unsigned j = 0; j < 16; ++j) { const unsigned c = xb_ld(&bar[XB_XCNT(j)]); sum += c; cnt += (c > 0u) ? 1u : 0u; mine = (j == x) ? c : mine; }
        if (sum == G) break;
        __builtin_amdgcn_s_sleep(1);
        if ((++sp & 255u) == 0u) { if (xb_ld(&bar[XB_TMO])) break; if (sp > XB_SPIN_CAP) { atomicAdd(&bar[XB_TMO], 1u); break; } }
    }
    nloc = mine > 0u ? mine : 1u; nx = cnt > 0u ? cnt : 1u;
}

__device__ __forceinline__ void xcd_barrier(const XcdBarrier& b, const int wave_s) {
    asm volatile("s_waitcnt vmcnt(0)" ::: "memory");
    __syncthreads();
    unsigned lane_; asm volatile("v_mbcnt_lo_u32_b32 %0, -1, 0\n\tv_mbcnt_hi_u32_b32 %0, -1, %0" : "=v"(lane_));
    if (wave_s == 0 && lane_ == 0u) {
        unsigned* bar = b.bar; asm volatile("" : "+s"(bar));
        __builtin_amdgcn_s_waitcnt(0);
        unsigned nloc = b.st[0], nx = b.st[1];
        if (nloc == 0u) { xcd_barrier_complete(bar, b.x, nloc, nx); b.st[0] = nloc; b.st[1] = nx; }
        const unsigned old = xb_add(&bar[XB_XSUB(b.x)], 1u);
        const unsigned gen = old / nloc;
        if (old + 1u == (gen + 1u) * nloc) {
            __builtin_amdgcn_fence(__ATOMIC_RELEASE, "agent");
            asm volatile("s_waitcnt vmcnt(0)" ::: "memory");
            const unsigned og = xb_add(&bar[XB_TOP], 1u);
            const unsigned tg = og / nx;
            if (og + 1u == (tg + 1u) * nx) xb_add(&bar[XB_TOPGEN], 1u);
            else XB_SPIN(xb_ld(&bar[XB_TOPGEN]) == tg, bar);
            __builtin_amdgcn_fence(__ATOMIC_ACQUIRE, "agent");
            xb_add(&bar[XB_XGEN(b.x)], 1u);
            asm volatile("s_waitcnt vmcnt(0)" ::: "memory");
        } else {
            XB_SPIN(xb_ld(&bar[XB_XGEN(b.x)]) == gen, bar);
            __builtin_amdgcn_fence(__ATOMIC_ACQUIRE, "agent");
            asm volatile("s_waitcnt vmcnt(0)" ::: "memory");
        }
    }
    __syncthreads();
}

struct Args { const float* in[21]; float* out; unsigned char* ws; int ph_lo, ph_hi; };
#define CAS __attribute__((address_space(4)))
struct KA { const CAS char* p;
    __device__ __forceinline__ const float* in(int k) const { return *(const float* const CAS*)(p + 8 * k); }
    __device__ __forceinline__ float* out() const { return *(float* const CAS*)(p + 8 * 21); }
    __device__ __forceinline__ unsigned char* ws() const { return *(unsigned char* const CAS*)(p + 8 * 22); }
    __device__ __forceinline__ int ph_lo() const { return *(const CAS int*)(p + 8 * 23); }
    __device__ __forceinline__ int ph_hi() const { return *(const CAS int*)(p + 8 * 23 + 4); }
};
__device__ __forceinline__ KA karg_fresh() { const CAS char* q = (const CAS char*)__builtin_amdgcn_kernarg_segment_ptr(); asm volatile("" : "+s"(q)); KA k; k.p = q; return k; }
struct Frame {
    LAS unsigned char* lds; volatile LAS unsigned* MISC; gu32* ctl;
    int tid, lane, wave, vcu, G, bx;
};
typedef unsigned long long u64;
typedef float f32x16 __attribute__((ext_vector_type(16)));
template <int CTRL> __device__ __forceinline__ float dpp_mov(float v) { return __builtin_bit_cast(float, __builtin_amdgcn_update_dpp(0, __builtin_bit_cast(int, v), CTRL, 0xF, 0xF, true)); }
__device__ __forceinline__ float row8_sum(float v) { v += dpp_mov<0xB1>(v); v += dpp_mov<0x4E>(v); v += dpp_mov<0x141>(v); return v; }
__device__ __forceinline__ float wave_sum(float v, int) { v = row8_sum(v); v += dpp_mov<0x140>(v);
    const float r0 = __builtin_bit_cast(float, __builtin_amdgcn_readlane(__builtin_bit_cast(int, v), 0)), r1 = __builtin_bit_cast(float, __builtin_amdgcn_readlane(__builtin_bit_cast(int, v), 16));
    const float r2 = __builtin_bit_cast(float, __builtin_amdgcn_readlane(__builtin_bit_cast(int, v), 32)), r3 = __builtin_bit_cast(float, __builtin_amdgcn_readlane(__builtin_bit_cast(int, v), 48));
    return (r0 + r1) + (r2 + r3); }
__device__ __forceinline__ float bf2f(unsigned b) { return __uint_as_float(b << 16); }
__device__ __forceinline__ float bflo(unsigned w) { return __uint_as_float(w << 16); }
__device__ __forceinline__ float bfhi(unsigned w) { return __uint_as_float(w & 0xffff0000u); }
__device__ __forceinline__ float fexp(float x) { return __builtin_amdgcn_exp2f(1.4426950408889634f * x); }
__device__ __forceinline__ float sigmoid_f(float x) { return __builtin_amdgcn_rcpf(1.0f + fexp(-x)); }
__device__ __forceinline__ unsigned pkbf(float lo, float hi) { return pg8::cvt_pk_bf16(lo, hi); }
typedef _Float16 f16x2_t __attribute__((ext_vector_type(2))); typedef float f32x2_t2 __attribute__((ext_vector_type(2)));
__device__ __forceinline__ unsigned pkh(float lo, float hi) { const f32x2_t2 v = {lo, hi}; return __builtin_bit_cast(unsigned, __builtin_convertvector(v, f16x2_t)); }
__device__ __forceinline__ f32x4 unpk_h4(u64 w) { const f16x2_t a = __builtin_bit_cast(f16x2_t, (unsigned)w), b = __builtin_bit_cast(f16x2_t, (unsigned)(w >> 32)); return (f32x4){(float)a[0], (float)a[1], (float)b[0], (float)b[1]}; }
__device__ __forceinline__ int swap23(int p) { return (p & ~12) | ((p & 4) << 1) | ((p & 8) >> 1); }
__device__ __forceinline__ int crow16(int i, int hh) { return (i & 3) + 8 * (i >> 2) + 4 * hh; }

struct MapId { __device__ __forceinline__ int operator()(int n) const { return n; } };
struct MapW13 { int add; __device__ __forceinline__ int operator()(int u) const { return ((u >> 7) << 8) + add + (u & 127); } };
struct MapHgrnIn { __device__ __forceinline__ int operator()(int n) const { return (n < 2048) ? ((n & ~1023) | swap23(n & 1023)) : n; } };
struct MapAttnIn { __device__ __forceinline__ int operator()(int n) const { if (n >= 2048) return n; const int part = n >> 10, c = n & 1023, hm = c >> 6, dim = c & 63;
    return part * 1024 + (hm >> 2) * 256 + (dim >> 5) * 128 + (hm & 3) * 32 + (dim & 31); } };
template <class MapF>
__device__ __forceinline__ void transpose_item(const float* W, int K, int N, bf16* WT, LAS float* scr, int item, int lane, MapF map) {
    const int nblk = N / 32, kb = item / nblk, nb = item % nblk, k0 = 64 * kb, n0 = 32 * nb;
#pragma unroll 8
    for (int i = 0; i < 32; ++i) { const int kk = 2 * i + (lane >> 5); scr[kk * 33 + (lane & 31)] = W[(size_t)(k0 + kk) * N + n0 + (lane & 31)]; }
    LDS_WAIT(); asm volatile("" ::: "memory");
    const int c = lane & 7;
#pragma unroll
    for (int j = 0; j < 4; ++j) { const int n = (lane >> 3) + 8 * j; const LAS float* s = scr + (8 * c) * 33 + n;
        v4u o; o.x = pkbf(s[0 * 33], s[1 * 33]); o.y = pkbf(s[2 * 33], s[3 * 33]); o.z = pkbf(s[4 * 33], s[5 * 33]); o.w = pkbf(s[6 * 33], s[7 * 33]);
        *(GAS v4u*)(WT + (size_t)map(n0 + n) * K + k0 + 8 * c) = o; }
    LDS_WAIT(); asm volatile("" ::: "memory");
}
__device__ __forceinline__ unsigned char* moe_wbuf(unsigned char* ws, int L) { return (L & 1) ? ws + WS_WB2 : ws + WS_W13; }
struct ConvItem { const float* W; bf16* WT; int K, N, k0, n0, add; };
__device__ __forceinline__ ConvItem conv_item(const KA a, int L, int it) {
    const int e = it / 768, r = it % 768; const size_t eo = (size_t)(L * 32 + e) * 1024 * 512; ConvItem c;
    bf16* W13 = (bf16*)moe_wbuf(a.ws(), L) + (size_t)e * 1024 * 1024; bf16* W2 = (bf16*)(moe_wbuf(a.ws(), L) + 64 * MiB) + (size_t)e * 1024 * 512;
    if (r < 512) { const int rr = r & 255; c.W = (r < 256 ? a.in(18) : a.in(19)) + eo; c.WT = W13; c.K = 1024; c.N = 512; c.k0 = 64 * (rr >> 4); c.n0 = 32 * (rr & 15); c.add = (r < 256) ? 0 : 128; }
    else { const int rr = r - 512; c.W = a.in(20) + eo; c.WT = W2; c.K = 512; c.N = 1024; c.k0 = 64 * (rr >> 5); c.n0 = 32 * (rr & 31); c.add = -1; }
    return c;
}
__device__ __forceinline__ void conv_load(const ConvItem& c, int lane, f32x4 (&v)[8]) {
#pragma unroll
    for (int i = 0; i < 8; ++i) v[i] = *(const f32x4*)(c.W + (size_t)(c.k0 + 8 * (lane >> 3) + i) * c.N + c.n0 + 4 * (lane & 7));
}
__device__ __forceinline__ void conv_store(const ConvItem& c, int lane, const f32x4 (&v)[8]) {
#pragma unroll
    for (int cc = 0; cc < 4; ++cc) { const int n = c.n0 + 4 * (lane & 7) + cc;
        const int row = (c.add == -1) ? n : (c.add == -2) ? MapHgrnIn{}(n) : (c.add == -3) ? MapAttnIn{}(n) : (((n >> 7) << 8) + c.add + (n & 127));
        v4u o; o.x = pkbf(v[0][cc], v[1][cc]); o.y = pkbf(v[2][cc], v[3][cc]); o.z = pkbf(v[4][cc], v[5][cc]); o.w = pkbf(v[6][cc], v[7][cc]);
        *(GAS v4u*)(c.WT + (size_t)row * c.K + c.k0 + 8 * (lane >> 3)) = o; }
}
constexpr int MIX_HIN = 16 * 128, MIX_OUT = 16 * 32, MIX_AIN = 16 * 96, MIX_PER = MIX_HIN + MIX_OUT + MIX_AIN + MIX_OUT, MIX_FIRST = MIX_HIN + MIX_OUT;
__device__ __forceinline__ ConvItem mix_item(const KA a, int it) {
    const int j = it / MIX_PER; int r = it % MIX_PER; ConvItem c; c.K = 1024;
    if (r < MIX_HIN) { c.W = a.in(6) + (size_t)j * 1024 * 4096; c.WT = (bf16*)(a.ws() + WS_WHIN) + (size_t)j * 4096 * 1024; c.N = 4096; c.add = -2; }
    else if ((r -= MIX_HIN) < MIX_OUT) { c.W = a.in(7) + (size_t)j * 1024 * 1024; c.WT = (bf16*)(a.ws() + WS_WHOUT) + (size_t)j * 1024 * 1024; c.N = 1024; c.add = -1; }
    else if ((r -= MIX_OUT) < MIX_AIN) { c.W = a.in(10) + (size_t)j * 1024 * 3072; c.WT = (bf16*)(a.ws() + WS_WAIN) + (size_t)j * 3072 * 1024; c.N = 3072; c.add = -3; }
    else { r -= MIX_AIN; c.W = a.in(11) + (size_t)j * 1024 * 1024; c.WT = (bf16*)(a.ws() + WS_WAOUT) + (size_t)j * 1024 * 1024; c.N = 1024; c.add = -1; }
    const int nblk = c.N / 32; c.k0 = 64 * (r / nblk); c.n0 = 32 * (r % nblk);
    return c;
}
__device__ __forceinline__ void convert_mixer(const KA a, int lane, int first, int last, int gw, int ngw) {
    for (int it = first + gw; it < last; it += ngw) { const ConvItem c = mix_item(a, it); f32x4 v[8]; conv_load(c, lane, v); conv_store(c, lane, v); }
}
__device__ __forceinline__ void convert_moe(Frame& F, const KA a, int L, int cw, int nconv) {
    const int gw = F.vcu * nconv + cw, NGW = F.G * nconv;
    if (gw >= 32 * 768) return;
    ConvItem cur = conv_item(a, L, gw); f32x4 v[8]; conv_load(cur, F.lane, v);
    for (int it = gw; it < 32 * 768; it += NGW) {
        const int nx = it + NGW; ConvItem nxt = cur; f32x4 vn[8];
        if (nx < 32 * 768) { nxt = conv_item(a, L, nx); conv_load(nxt, F.lane, vn); }
        conv_store(cur, F.lane, v);
        cur = nxt;
#pragma unroll
        for (int i = 0; i < 8; ++i) v[i] = vn[i];
    }
}

__device__ __forceinline__ void phase_p0a(Frame& F, const KA a) {
    const int gw = F.vcu * NWAVES + F.wave, NGW = F.G * NWAVES;
    const float* c = a.in(1); const float* ada_w = a.in(2); const float* ada_b = a.in(3);
    float* mod = (float*)(a.ws() + WS_MOD);
    if (F.vcu < 4 * 24) {
        LAS float* sl = (LAS float*)(F.lds + RING_OFF + 65536);
        for (int idx = F.tid; idx < 16 * 1024; idx += 512) { const int k = idx & 1023, b = idx >> 10; const float cv = c[idx]; sl[k * 16 + b] = cv * sigmoid_f(cv); }
        __syncthreads();
    }
    for (int it = F.vcu; it < 4 * 24; it += F.G) {
        const int i = it / 24, nb = it % 24;
        f32x4 acc[16];
#pragma unroll
        for (int b = 0; b < 16; ++b) acc[b] = (f32x4){0.f, 0.f, 0.f, 0.f};
        const float* wp = ada_w + ((size_t)i * 1024 + F.wave * 128) * 6144 + nb * 256 + 4 * F.lane;
        const LAS float* sw = (const LAS float*)(F.lds + RING_OFF + 65536) + F.wave * 128 * 16;
        for (int k0 = 0; k0 < 128; k0 += 16) {
            f32x4 w4[16];
#pragma unroll
            for (int kk = 0; kk < 16; ++kk) w4[kk] = *(const f32x4*)(wp + (size_t)(k0 + kk) * 6144);
            asm volatile("" ::: "memory");
#pragma unroll
            for (int kk = 0; kk < 16; ++kk) {
                const LAS f32x4* sp = (const LAS f32x4*)(sw + (k0 + kk) * 16);
                const f32x4 s0 = sp[0], s1 = sp[1], s2 = sp[2], s3 = sp[3];
#pragma unroll
                for (int b = 0; b < 4; ++b) { acc[b] += w4[kk] * s0[b]; acc[4 + b] += w4[kk] * s1[b]; acc[8 + b] += w4[kk] * s2[b]; acc[12 + b] += w4[kk] * s3[b]; }
            }
        }
        LAS float* red = (LAS float*)(F.lds + RING_OFF);
#pragma unroll
        for (int hb = 0; hb < 2; ++hb) {
#pragma unroll
            for (int b = 0; b < 8; ++b) *(LAS f32x4*)(red + (F.wave * 8 + b) * 256 + 4 * F.lane) = acc[8 * hb + b];
            __syncthreads();
            const float bias_ = ada_b[i * 6144 + nb * 256 + (F.tid & 255)];
            for (int r = 0; r < 4; ++r) { const int idx = F.tid + 512 * r, b = idx >> 8, col = idx & 255; float s = bias_;
#pragma unroll
                for (int w = 0; w < 8; ++w) s += red[(w * 8 + b) * 256 + col];
                mod[((size_t)i * 16 + 8 * hb + b) * 6144 + nb * 256 + col] = s; }
            __syncthreads();
        }
    }
    {
        float* cs = (float*)(a.ws() + WS_ROPE_C); float* sn = (float*)(a.ws() + WS_ROPE_S);
        for (int idx = gw * 64 + F.lane; idx < SEQ * 32; idx += NGW * 64) {
            const int pos = idx >> 5, j = idx & 31;
            double f = 1.0; const double r1 = 0.74989420933245582730;
            double p = r1;
#pragma unroll
            for (int bit = 0; bit < 5; ++bit) { if (j & (1 << bit)) f *= p; p *= p; }
            const double ang = (double)pos * f;
            const double kq = __builtin_rint(ang * 0.63661977236758134308);
            const double rr = (ang - kq * 1.57079632679489655800e+00) - kq * 6.12323399573676603587e-17;
            const double r2 = rr * rr;
            const double sp = rr * (1.0 + r2 * (-1.0 / 6 + r2 * (1.0 / 120 + r2 * (-1.0 / 5040 + r2 * (1.0 / 362880 + r2 * (-1.0 / 39916800 + r2 * (1.0 / 6227020800.0)))))));
            const double cp = 1.0 + r2 * (-0.5 + r2 * (1.0 / 24 + r2 * (-1.0 / 720 + r2 * (1.0 / 40320 + r2 * (-1.0 / 3628800 + r2 * (1.0 / 479001600.0 + r2 * (-1.0 / 87178291200.0)))))));
            const int q = ((int)kq) & 3;
            const double sv = (q == 0) ? sp : (q == 1) ? cp : (q == 2) ? -sp : -cp;
            const double cv = (q == 0) ? cp : (q == 1) ? -sp : (q == 2) ? -cp : sp;
            cs[idx] = (float)cv; sn[idx] = (float)sv;
        }
    }
    {
        float* rt = (float*)(a.ws() + WS_RT); const float* rgw = a.in(14); const float* rew = a.in(16);
        for (int idx = gw * 64 + F.lane; idx < 4 * 36 * 1024; idx += NGW * 64) {
            const int l = idx / 36864, e = (idx >> 10) % 36, k = idx & 1023;
            rt[idx] = (e < 4) ? rgw[((size_t)l * 1024 + k) * 4 + e] : rew[((size_t)l * 1024 + k) * 32 + (e - 4)];
        }
    }
    convert_mixer(a, F.lane, 0, MIX_FIRST, gw, NGW);
}

__device__ __forceinline__ void phase_p0b(Frame& F, const KA a) {
    const int gw = F.vcu * NWAVES + F.wave, NGW = F.G * NWAVES;
    const float* x = a.in(0); const float* mod = (const float*)(a.ws() + WS_MOD); bf16* h = (bf16*)(a.ws() + WS_BUF0);
#define P0B_LOAD(X, t_) do { _Pragma("unroll") for (int tt = 0; tt < 4; ++tt) _Pragma("unroll") for (int j = 0; j < 4; ++j) X[tt][j] = *(const f32x4*)(x + (size_t)((t_) + tt) * D + 4 * F.lane + 256 * j); } while (0)
#define P0B_PROC(X, t_) do { const float* mb = mod + (size_t)((t_) >> 12) * 6144; \
        _Pragma("unroll") for (int j = 0; j < 4; ++j) { const int col = 4 * F.lane + 256 * j; const f32x4 sh = *(const f32x4*)(mb + col), sc = *(const f32x4*)(mb + 1024 + col) + 1.0f; \
            _Pragma("unroll") for (int tt = 0; tt < 4; ++tt) { const f32x4 hv = X[tt][j] * sc + sh; \
                *(u64*)(h + (size_t)((t_) + tt) * D + col) = (u64)pkbf(hv[0], hv[1]) | ((u64)pkbf(hv[2], hv[3]) << 32); } } } while (0)
    const int step = NGW * 4;
    f32x4 xa[4][4], xb[4][4];
    int t0 = gw * 4;
    if (t0 < M) P0B_LOAD(xa, t0);
    for (; t0 < M; t0 += 2 * step) {
        const int t1 = t0 + step, t2 = t1 + step;
        if (t1 < M) P0B_LOAD(xb, t1);
        P0B_PROC(xa, t0);
        if (t2 < M) P0B_LOAD(xa, t2);
        if (t1 < M) P0B_PROC(xb, t1);
    }
#undef P0B_LOAD
#undef P0B_PROC
}

__device__ __forceinline__ void phase_hgrn_prep(Frame& F, const KA a, int j) {
    bf16* Qb = (bf16*)(a.ws() + WS_BUF0 + 1 * BUFSZ); bf16* Zb = (bf16*)(a.ws() + WS_BUF0 + 2 * BUFSZ);
    float* dd = (float*)(a.ws() + WS_HGD);
    const float* lb = a.in(8);
    const int grp = F.tid >> 7, jt = F.tid & 127, col = 8 * jt, h = col >> 7, pos = col & 127;
    const int ch0 = swap23(pos), ch1 = swap23(pos + 4);
    float oml[8];
#pragma unroll
    for (int c = 0; c < 8; ++c) oml[c] = 1.0f;
    if (j == 1) {
#pragma unroll
        for (int c = 0; c < 4; ++c) { oml[c] = 1.0f - sigmoid_f(lb[1024 + h * 128 + ch0 + c] - lb[h * 128 + ch0 + c]); oml[4 + c] = 1.0f - sigmoid_f(lb[1024 + h * 128 + ch1 + c] - lb[h * 128 + ch1 + c]); } }
    constexpr int NIT = BATCH * HG_NCH;
    float bs[8];
#define HP_IT(s_) (F.vcu + F.G * (grp + 4 * ((s_) >> 2)))
#define HP_LOAD(Z, Q, s_) do { int it_ = HP_IT(s_); it_ = (it_ < NIT) ? it_ : 0;        \
        const size_t tk_ = (size_t)(it_ >> 7) * SEQ + (it_ & (HG_NCH - 1)) * HG_CHUNK + 8 * ((s_) & 3); \
        _Pragma("unroll") for (int t = 0; t < 8; ++t) { Z[t] = *(const v4u*)(Zb + (tk_ + t) * D + col); Q[t] = *(const v4u*)(Qb + (tk_ + t) * D + col); } } while (0)
#define HP_PROC(Z, Q, s_) do { const int it_ = HP_IT(s_); const int chunk_ = it_ & (HG_NCH - 1), b_ = it_ >> 7; const size_t tk_ = (size_t)b_ * SEQ + chunk_ * HG_CHUNK + 8 * ((s_) & 3); \
        if (((s_) & 3) == 0) { _Pragma("unroll") for (int c = 0; c < 8; ++c) bs[c] = 0.f; } \
        _Pragma("unroll") for (int t = 0; t < 8; ++t) { v4u qo, ko; \
            _Pragma("unroll") for (int i = 0; i < 4; ++i) { \
                const float k0 = oml[2 * i] * sigmoid_f(-bflo(Z[t][i])), k1 = oml[2 * i + 1] * sigmoid_f(-bfhi(Z[t][i])); \
                const float g0 = (k0 < 0.05f) ? -k0 * (1.0f + k0 * (0.5f + k0 * (0.33333333f + k0 * 0.25f))) : 0.69314718056f * __builtin_amdgcn_logf(1.0f - k0); \
                const float g1 = (k1 < 0.05f) ? -k1 * (1.0f + k1 * (0.5f + k1 * (0.33333333f + k1 * 0.25f))) : 0.69314718056f * __builtin_amdgcn_logf(1.0f - k1); \
                bs[2 * i] += g0; bs[2 * i + 1] += g1; \
                qo[i] = pkbf(bflo(Q[t][i]) * fexp(bs[2 * i]), bfhi(Q[t][i]) * fexp(bs[2 * i + 1])); \
                ko[i] = pkbf(k0 * fexp(fminf(-bs[2 * i], 80.0f)), k1 * fexp(fminf(-bs[2 * i + 1], 80.0f))); } \
            *(v4u*)(Qb + (tk_ + t) * D + col) = qo; *(v4u*)(Zb + (tk_ + t) * D + col) = ko; } \
        if (((s_) & 3) == 3) { const size_t rowbase_ = ((size_t)(b_ * 8 + h) * HG_NCH + chunk_) * 128; \
            *(f32x4*)(dd + rowbase_ + ch0) = (f32x4){fexp(bs[0]), fexp(bs[1]), fexp(bs[2]), fexp(bs[3])}; *(f32x4*)(dd + rowbase_ + ch1) = (f32x4){fexp(bs[4]), fexp(bs[5]), fexp(bs[6]), fexp(bs[7])}; } } while (0)
    v4u za[8], qa[8], zb[8], qb[8];
    int s = 0;
    HP_LOAD(za, qa, 0);
    for (; HP_IT(s) < NIT; s += 2) {
        HP_LOAD(zb, qb, s + 1);
        HP_PROC(za, qa, s);
        HP_LOAD(za, qa, s + 2);
        HP_PROC(zb, qb, s + 1);
    }
#undef HP_IT
#undef HP_LOAD
#undef HP_PROC
}

#define MFMA32(a_, b_, c_) __builtin_amdgcn_mfma_f32_32x32x16_bf16((a_), (b_), (c_), 0, 0, 0)
typedef float f32x2_pk __attribute__((ext_vector_type(2))); typedef __bf16 bf16x2_pk __attribute__((ext_vector_type(2)));
__device__ __forceinline__ unsigned cvt2(float lo, float hi) { const f32x2_pk v = {lo, hi}; return __builtin_bit_cast(unsigned, __builtin_convertvector(v, bf16x2_pk)); }
__device__ __forceinline__ bf16x8 pack_half(const f32x16& x, int s) {
    v4u p; p.x = cvt2(x[8 * s + 0], x[8 * s + 1]); p.y = cvt2(x[8 * s + 2], x[8 * s + 3]); p.z = cvt2(x[8 * s + 4], x[8 * s + 5]); p.w = cvt2(x[8 * s + 6], x[8 * s + 7]);
    return __builtin_bit_cast(bf16x8, p);
}
constexpr int HS_Q = 0, HS_K = 8192, HS_V = 16384, HS_D = 18432, HS_BUF = 18944, HS_NBUF = 3, HS_WAVE = HS_NBUF * HS_BUF, HS_OST = 2 * HS_WAVE, HS_CONV = HS_OST + 4096, HS_NCONV = 6;
static_assert(HS_CONV <= RING_BYTES, "scan LDS map");
typedef short s16x4_t __attribute__((ext_vector_type(4)));
__device__ __forceinline__ void phase_hgrn_scan(Frame& F, const KA a, int layer) {
    const bf16* Qt = (const bf16*)(a.ws() + WS_BUF0 + 1 * BUFSZ); const bf16* Kt = (const bf16*)(a.ws() + WS_BUF0 + 2 * BUFSZ);
    const bf16* Vb = (const bf16*)(a.ws() + WS_BUF0 + 3 * BUFSZ); const float* dd = (const float*)(a.ws() + WS_HGD);
    bf16* O = (bf16*)(a.ws() + WS_BUF0 + 6 * BUFSZ);
    if (F.wave >= 2) {
        if (F.wave < 2 + HS_NCONV) { if (layer == 0) convert_mixer(a, F.lane, MIX_FIRST, 2 * MIX_PER, F.vcu * HS_NCONV + F.wave - 2, F.G * HS_NCONV);
            convert_moe(F, a, layer, F.wave - 2, HS_NCONV); convert_moe(F, a, layer + 1, F.wave - 2, HS_NCONV); }
        return; }
    LAS unsigned char* ring = F.lds + RING_OFF + F.wave * HS_WAVE;
    LAS unsigned char* ost = F.lds + RING_OFF + HS_OST + F.wave * 2048;
    for (int u = F.vcu; u < BATCH * 8 * 2; u += F.G) {
        const int bh = u >> 1, vt = (u & 1) * 2 + F.wave, b = bh >> 3, h = bh & 7;
        const int r = F.lane & 31, hh = F.lane >> 5;
        f32x16 S[4];
#pragma unroll
        for (int kt = 0; kt < 4; ++kt)
#pragma unroll
            for (int i = 0; i < 16; ++i) S[kt][i] = 0.f;
        const bf16* Qp = Qt + ((size_t)b * SEQ + r) * D + h * 128 + 8 * hh;
        const bf16* Kp = Kt + ((size_t)b * SEQ + r) * D + h * 128 + 8 * hh;
        const bf16* Vp = Vb + ((size_t)b * SEQ + (F.lane >> 2)) * D + h * 128 + 32 * vt + 8 * (F.lane & 3);
        const float* dp = dd + (size_t)bh * HG_NCH * 128 + F.lane;
        bf16* op2 = O + ((size_t)b * SEQ + 4 * hh) * D + h * 128 + 32 * vt + r;
        const int i16 = F.lane & 15, blk = (F.lane >> 4) & 1, tq = i16 >> 2, tp = i16 & 3, tpp = ((tp & 1) << 1) | (tp >> 1);
        const int trb = HS_K + blk * 1024 + (tpp >> 1) * 512 + (4 * hh + tq) * 16 + (tpp & 1) * 8;
        const int vtrb = HS_V + (4 * hh + tq) * 64 + 32 * blk + 8 * tp;
#define HS_DMA(c_, buf_) do { LAS unsigned char* bb_ = ring + (buf_) * HS_BUF; \
        _Pragma("unroll") for (int ks = 0; ks < 8; ++ks) { __builtin_amdgcn_global_load_lds((const unsigned*)(Qp + (size_t)(c_) * 32 * D + 16 * ks), (LAS unsigned*)(bb_ + HS_Q + ks * 1024), 16, 0, 0); \
                                                        __builtin_amdgcn_global_load_lds((const unsigned*)(Kp + (size_t)(c_) * 32 * D + 16 * ks), (LAS unsigned*)(bb_ + HS_K + ks * 1024), 16, 0, 0); } \
        _Pragma("unroll") for (int st = 0; st < 2; ++st) __builtin_amdgcn_global_load_lds((const unsigned*)(Vp + ((size_t)(c_) * 32 + 16 * st) * D), (LAS unsigned*)(bb_ + HS_V + st * 1024), 16, 0, 0); \
        _Pragma("unroll") for (int q_ = 0; q_ < 2; ++q_) __builtin_amdgcn_global_load_lds((const unsigned*)(dp + (size_t)(c_) * 128 + 64 * q_), (LAS unsigned*)(bb_ + HS_D + q_ * 256), 4, 0, 0); } while (0)
        asm volatile("s_waitcnt lgkmcnt(0)" ::: "memory");
        HS_DMA(0, 0); HS_DMA(1, 1);
        int bcur = 0, bnext = 2;
        for (int c = 0; c < HG_NCH; ++c) {
            const int cn = (c + 2 < HG_NCH) ? c + 2 : HG_NCH - 1;
            HS_DMA(cn, bnext);
            if (c == 0) asm volatile("s_waitcnt vmcnt(40)" ::: "memory");
            else asm volatile("s_waitcnt vmcnt(56)" ::: "memory");
            const LAS unsigned char* bbase = ring + bcur * HS_BUF;
            const LAS unsigned char* bb = bbase + F.lane * 16;
            bf16x8 Qf[8], Kf[8], Vf[2];
            { const unsigned vba = (unsigned)(uintptr_t)(bbase + vtrb); s16x4_t v0, v1, v2, v3;
              asm volatile("ds_read_b64_tr_b16 %0, %1 offset:0" : "=&v"(v0) : "v"(vba) : "memory"); asm volatile("ds_read_b64_tr_b16 %0, %1 offset:512" : "=&v"(v1) : "v"(vba) : "memory");
              asm volatile("ds_read_b64_tr_b16 %0, %1 offset:1024" : "=&v"(v2) : "v"(vba) : "memory"); asm volatile("ds_read_b64_tr_b16 %0, %1 offset:1536" : "=&v"(v3) : "v"(vba) : "memory");
#pragma unroll
              for (int ks = 0; ks < 8; ++ks) { Qf[ks] = *(const LAS bf16x8*)(bb + HS_Q + ks * 1024); Kf[ks] = *(const LAS bf16x8*)(bb + HS_K + ks * 1024); }
              asm volatile("s_waitcnt lgkmcnt(0)" : "+v"(v0), "+v"(v1), "+v"(v2), "+v"(v3) :: "memory");
              Vf[0] = (bf16x8){v0[0], v0[1], v0[2], v0[3], v1[0], v1[1], v1[2], v1[3]}; Vf[1] = (bf16x8){v2[0], v2[1], v2[2], v2[3], v3[0], v3[1], v3[2], v3[3]}; }
            f32x16 sc0, sc1;
#pragma unroll
            for (int i = 0; i < 16; ++i) { sc0[i] = 0.f; sc1[i] = 0.f; }
#pragma unroll
            for (int ks = 0; ks < 8; ks += 2) { sc0 = MFMA32(Kf[ks], Qf[ks], sc0); sc1 = MFMA32(Kf[ks + 1], Qf[ks + 1], sc1); }
#pragma unroll
            for (int i = 0; i < 16; ++i) sc0[i] = (crow16(i, hh) > r) ? 0.f : (sc0[i] + sc1[i]);
            f32x16 oA, oB;
#pragma unroll
            for (int i = 0; i < 16; ++i) { oA[i] = 0.f; oB[i] = 0.f; }
#pragma unroll
            for (int kt = 0; kt < 4; kt += 2)
#pragma unroll
                for (int st = 0; st < 2; ++st) { oA = MFMA32(Qf[2 * kt + st], pack_half(S[kt], st), oA); oB = MFMA32(Qf[2 * kt + 2 + st], pack_half(S[kt + 1], st), oB); }
            oA = MFMA32(pack_half(sc0, 0), Vf[0], oA); oB = MFMA32(pack_half(sc0, 1), Vf[1], oB);
            const LAS float* dl = (const LAS float*)(bbase + HS_D) + 4 * hh;
            const unsigned tba = (unsigned)(uintptr_t)(bbase + trb);
            s16x4_t klo[8], khi[8];
#pragma unroll
            for (int f = 0; f < 8; ++f) {
                asm volatile("ds_read_b64_tr_b16 %0, %1 offset:%c2" : "=&v"(klo[f]) : "v"(tba), "i"((f >> 1) * 2048 + (f & 1) * 256) : "memory");
                asm volatile("ds_read_b64_tr_b16 %0, %1 offset:%c2" : "=&v"(khi[f]) : "v"(tba), "i"((f >> 1) * 2048 + (f & 1) * 256 + 128) : "memory"); }
            asm volatile("s_waitcnt lgkmcnt(0)" : "+v"(klo[0]), "+v"(klo[1]), "+v"(klo[2]), "+v"(klo[3]), "+v"(klo[4]), "+v"(klo[5]), "+v"(klo[6]), "+v"(klo[7]) :: "memory");
            asm volatile("" : "+v"(khi[0]), "+v"(khi[1]), "+v"(khi[2]), "+v"(khi[3]), "+v"(khi[4]), "+v"(khi[5]), "+v"(khi[6]), "+v"(khi[7]) :: "memory");
#pragma unroll
            for (int kt = 0; kt < 4; ++kt) {
#pragma unroll
                for (int st = 0; st < 2; ++st) { const int f = kt * 2 + st;
                    const bf16x8 kh = (bf16x8){klo[f][0], klo[f][1], klo[f][2], klo[f][3], khi[f][0], khi[f][1], khi[f][2], khi[f][3]};
                    S[kt] = MFMA32(kh, Vf[st], S[kt]); }
#pragma unroll
                for (int g = 0; g < 4; ++g) { const f32x4 dv = *(const LAS f32x4*)(dl + 32 * kt + 8 * g);
#pragma unroll
                    for (int i = 0; i < 4; ++i) S[kt][4 * g + i] *= dv[i]; }
            }
#pragma unroll
            for (int i = 0; i < 16; ++i) *(unsigned short*)(op2 + ((size_t)c * 32 + crow16(i, 0)) * D) = (unsigned short)(pkbf(oA[i] + oB[i], 0.f) & 0xffffu);
            asm volatile("s_waitcnt lgkmcnt(0)" ::: "memory");
            bcur = (bcur == HS_NBUF - 1) ? 0 : bcur + 1; bnext = (bnext == HS_NBUF - 1) ? 0 : bnext + 1;
        }
        asm volatile("s_waitcnt vmcnt(0)" ::: "memory");
#undef HS_DMA
    }
}

template <int MODE>
__device__ __forceinline__ void phase_normgate(Frame& F, const bf16* P0, const bf16* P1, bf16* out, const float* w, float lam, float mul) {
    const int gw = F.vcu * NWAVES + F.wave, NGW = F.G * NWAVES;
    float wv[16];
#pragma unroll
    for (int i = 0; i < 16; ++i) wv[i] = w[((16 * F.lane) & 127) + i] * mul;
    const int tpw = ((M + NGW - 1) / NGW + 3) & ~3;
#define NG_LOAD(A0, A1, B0, B1, t_) do { _Pragma("unroll") for (int tt = 0; tt < 4; ++tt) { const size_t off = (size_t)((t_) + tt) * D + 16 * F.lane; \
        A0[tt] = *(const v4u*)(P0 + off); A1[tt] = *(const v4u*)(P0 + off + 8); B0[tt] = *(const v4u*)(P1 + off); B1[tt] = *(const v4u*)(P1 + off + 8); } } while (0)
#define NG_PROC(A0, A1, B0, B1, t_) do { _Pragma("unroll") for (int tt = 0; tt < 4; ++tt) { \
            float av[16], bv[16]; \
            _Pragma("unroll") for (int i = 0; i < 4; ++i) { av[2 * i] = bflo(A0[tt][i]); av[2 * i + 1] = bfhi(A0[tt][i]); av[8 + 2 * i] = bflo(A1[tt][i]); av[8 + 2 * i + 1] = bfhi(A1[tt][i]); \
                                          bv[2 * i] = bflo(B0[tt][i]); bv[2 * i + 1] = bfhi(B0[tt][i]); bv[8 + 2 * i] = bflo(B1[tt][i]); bv[8 + 2 * i + 1] = bfhi(B1[tt][i]); } \
            float ss = 0.f; \
            _Pragma("unroll") for (int i = 0; i < 16; ++i) { if (MODE == 1) av[i] = av[i] - lam * bv[i]; ss += av[i] * av[i]; } \
            ss = row8_sum(ss); \
            const float rs = 1.0f / sqrtf(ss * (1.0f / 128.0f) + LN_EPS); \
            v4u o0, o1; \
            _Pragma("unroll") for (int i = 0; i < 8; ++i) { float v0 = av[2 * i] * rs * wv[2 * i], v1 = av[2 * i + 1] * rs * wv[2 * i + 1]; \
                if (MODE == 0) { v0 *= bv[2 * i] * sigmoid_f(bv[2 * i]); v1 *= bv[2 * i + 1] * sigmoid_f(bv[2 * i + 1]); } \
                if (i < 4) o0[i] = pkbf(v0, v1); else o1[i - 4] = pkbf(v0, v1); } \
            const size_t off = (size_t)((t_) + tt) * D + 16 * F.lane; \
            *(v4u*)(out + off) = o0; *(v4u*)(out + off + 8) = o1; } } while (0)
    const int tend = ((gw + 1) * tpw < M) ? (gw + 1) * tpw : M;
    v4u a0[4], a1[4], b0[4], b1[4], c0[4], c1[4], e0[4], e1[4];
    int t0 = gw * tpw;
    if (t0 < tend) NG_LOAD(a0, a1, b0, b1, t0);
    for (; t0 < tend; t0 += 8) {
        if (t0 + 4 < tend) NG_LOAD(c0, c1, e0, e1, t0 + 4);
        NG_PROC(a0, a1, b0, b1, t0);
        if (t0 + 8 < tend) NG_LOAD(a0, a1, b0, b1, t0 + 8);
        if (t0 + 4 < tend) NG_PROC(c0, c1, e0, e1, t0 + 4);
    }
#undef NG_LOAD
#undef NG_PROC
}

__device__ __forceinline__ void phase_l1(Frame& F, const KA a, int layer, const float* xin, const bool dry) {
    const int gw = F.vcu * NWAVES + F.wave, NGW = F.G * NWAVES;
    LAS float* Wr = (LAS float*)(F.lds + RING_OFF);
    LAS unsigned* hist = (LAS unsigned*)(F.lds + LDSCTL_OFF);
    { const f32x4* src = (const f32x4*)((const float*)(a.ws() + WS_RT) + (size_t)layer * 36 * 1024);
      f32x4 tmp[18];
#pragma unroll
      for (int k = 0; k < 18; ++k) tmp[k] = src[F.tid + 512 * k];
#pragma unroll
      for (int k = 0; k < 18; ++k) *(LAS f32x4*)(Wr + 4 * (F.tid + 512 * k)) = tmp[k];
      if (F.tid < 32) hist[F.tid] = 0u; }
    __syncthreads();
    const float* mod = (const float*)(a.ws() + WS_MOD) + (size_t)layer * 16 * 6144;
    const bf16* yb = (const bf16*)(a.ws() + WS_BUF0 + 1 * BUFSZ);
    bf16* h2 = (bf16*)(a.ws() + WS_BUF0);
    const float* lng = a.in(4) + (size_t)(layer * 2 + 0) * D; const float* lnb = a.in(5) + (size_t)(layer * 2 + 0) * D;
    const float* bg = a.in(15) + layer * 4; const float* be = a.in(17) + layer * 32;
    int* eid = (int*)(a.ws() + WS_EID); float* wt = (float*)(a.ws() + WS_WT);
    const unsigned short* xhin = (const unsigned short*)a.out();
    unsigned short* xhout = (unsigned short*)(a.ws() + WS_BUF0 + 1 * BUFSZ);
    const int tpw = ((M + NGW - 1) / NGW + 3) & ~3;
    int curb = -1; f32x4 g1v[4], lgv[4], lbv[4], scv[4], shv[4];
    for (int t0 = gw * tpw; t0 < (gw + 1) * tpw && t0 < M; t0 += 4) {
        const int b = t0 >> 12;
        if (b != curb) { curb = b; const float* mb = mod + (size_t)b * 6144;
#pragma unroll
            for (int j = 0; j < 4; ++j) { const int col = 4 * F.lane + 256 * j; g1v[j] = *(const f32x4*)(mb + 2048 + col); lgv[j] = *(const f32x4*)(lng + col); lbv[j] = *(const f32x4*)(lnb + col);
                scv[j] = *(const f32x4*)(mb + 4096 + col) + 1.0f; shv[j] = *(const f32x4*)(mb + 3072 + col); } }
        f32x4 hv[4][4];
        {
            f32x4 v[4][4]; float s[4] = {0.f, 0.f, 0.f, 0.f};
            u64 yw[4][4];
#pragma unroll
            for (int j = 0; j < 4; ++j)
#pragma unroll
                for (int tt = 0; tt < 4; ++tt) yw[tt][j] = *(const u64*)(yb + (size_t)(t0 + tt) * D + 4 * F.lane + 256 * j);
            if (layer == 0) {
#pragma unroll
                for (int j = 0; j < 4; ++j)
#pragma unroll
                    for (int tt = 0; tt < 4; ++tt) v[tt][j] = *(const f32x4*)(xin + (size_t)(t0 + tt) * D + 4 * F.lane + 256 * j);
            } else { u64 xr[4][4];
#pragma unroll
                for (int j = 0; j < 4; ++j)
#pragma unroll
                    for (int tt = 0; tt < 4; ++tt) xr[tt][j] = *(const u64*)(xhin + (size_t)(t0 + tt) * D + 4 * F.lane + 256 * j);
#pragma unroll
                for (int j = 0; j < 4; ++j)
#pragma unroll
                    for (int tt = 0; tt < 4; ++tt) v[tt][j] = unpk_h4(xr[tt][j]);
            }
#pragma unroll
            for (int j = 0; j < 4; ++j) { const f32x4 g1 = g1v[j];
#pragma unroll
                for (int tt = 0; tt < 4; ++tt) { const u64 y_ = yw[tt][j];
                    f32x4 yv; yv[0] = bflo((unsigned)y_); yv[1] = bfhi((unsigned)y_); yv[2] = bflo((unsigned)(y_ >> 32)); yv[3] = bfhi((unsigned)(y_ >> 32));
                    v[tt][j] = v[tt][j] * DN_ALPHA + g1 * yv; s[tt] += (v[tt][j][0] + v[tt][j][1]) + (v[tt][j][2] + v[tt][j][3]); } }
            float rstd[4];
#pragma unroll
            for (int tt = 0; tt < 4; ++tt) { const float mean = wave_sum(s[tt], F.lane) * (1.0f / D); float s2 = 0.f;
#pragma unroll
                for (int j = 0; j < 4; ++j) { v[tt][j] = v[tt][j] - mean; s2 += (v[tt][j][0] * v[tt][j][0] + v[tt][j][1] * v[tt][j][1]) + (v[tt][j][2] * v[tt][j][2] + v[tt][j][3] * v[tt][j][3]); }
                rstd[tt] = __builtin_amdgcn_rsqf(wave_sum(s2, F.lane) * (1.0f / D) + LN_EPS); }
#pragma unroll
            for (int j = 0; j < 4; ++j) { const int col = 4 * F.lane + 256 * j;
                const f32x4 lg_ = lgv[j], lb_ = lbv[j], sc2 = scv[j], sh2 = shv[j];
#pragma unroll
                for (int tt = 0; tt < 4; ++tt) { const size_t ro = (size_t)(t0 + tt) * D;
                    const f32x4 xo = v[tt][j] * rstd[tt] * lg_ + lb_;
                    *(u64*)(xhout + ro + col) = (u64)pkh(xo[0], xo[1]) | ((u64)pkh(xo[2], xo[3]) << 32);
                    const f32x4 hh2 = xo * sc2 + sh2; hv[tt][j] = hh2;
                    *(u64*)(h2 + ro + col) = (u64)pkbf(hh2[0], hh2[1]) | ((u64)pkbf(hh2[2], hh2[3]) << 32); } }
        }
        float gl[4][4];
        { f32x4 w[4][4];
#pragma unroll
          for (int g = 0; g < 4; ++g)
#pragma unroll
              for (int j = 0; j < 4; ++j) w[g][j] = *(const LAS f32x4*)(Wr + g * 1024 + 4 * F.lane + 256 * j);
#pragma unroll
          for (int tt = 0; tt < 4; ++tt)
#pragma unroll
              for (int g = 0; g < 4; ++g) { float s0 = 0.f;
#pragma unroll
                  for (int j = 0; j < 4; ++j) s0 += (hv[tt][j][0] * w[g][j][0] + hv[tt][j][1] * w[g][j][1]) + (hv[tt][j][2] * w[g][j][2] + hv[tt][j][3] * w[g][j][3]);
                  gl[tt][g] = wave_sum(s0, F.lane) + bg[g]; } }
#pragma unroll
        for (int tt = 0; tt < 4; ++tt) {
            int gi = 0; float gm = gl[tt][0];
#pragma unroll
            for (int g = 1; g < 4; ++g) if (gl[tt][g] > gm) { gm = gl[tt][g]; gi = g; }
            float gs = 0.f;
#pragma unroll
            for (int g = 0; g < 4; ++g) gs += fexp(gl[tt][g] - gm);
            const float gw_ = __builtin_amdgcn_rcpf(gs);
            gi = __builtin_amdgcn_readfirstlane(gi);
            float el[8];
#pragma unroll
            for (int half = 0; half < 2; ++half) { f32x4 w[4][4]; const LAS float* wrow = Wr + (4 + gi * 8 + half * 4) * 1024 + 4 * F.lane;
#pragma unroll
                for (int q = 0; q < 4; ++q)
#pragma unroll
                    for (int j = 0; j < 4; ++j) w[q][j] = *(const LAS f32x4*)(wrow + q * 1024 + 256 * j);
#pragma unroll
                for (int q = 0; q < 4; ++q) { float s0 = 0.f;
#pragma unroll
                    for (int j = 0; j < 4; ++j) s0 += (hv[tt][j][0] * w[q][j][0] + hv[tt][j][1] * w[q][j][1]) + (hv[tt][j][2] * w[q][j][2] + hv[tt][j][3] * w[q][j][3]);
                    el[half * 4 + q] = wave_sum(s0, F.lane) + be[gi * 8 + half * 4 + q]; } }
            int i0 = 0; float m0 = el[0];
#pragma unroll
            for (int q = 1; q < 8; ++q) if (el[q] > m0) { m0 = el[q]; i0 = q; }
            int i1 = -1; float m1 = -INFINITY;
#pragma unroll
            for (int q = 0; q < 8; ++q) if (q != i0 && el[q] > m1) { m1 = el[q]; i1 = q; }
            const float p1 = fexp(m1 - m0); const float rr_ = __builtin_amdgcn_rcpf(1.0f + p1); const float w0 = gw_ * rr_, w1 = gw_ * p1 * rr_;
            if (F.lane == 0) { const int e0 = gi * 8 + i0, e1 = gi * 8 + i1, tok = t0 + tt;
                *(int2*)(eid + 2 * tok) = make_int2(e0, e1); *(float2*)(wt + 2 * tok) = make_float2(w0, w1);
                __hip_atomic_fetch_add(&hist[e0], 1u, __ATOMIC_RELAXED, __HIP_MEMORY_SCOPE_WORKGROUP); __hip_atomic_fetch_add(&hist[e1], 1u, __ATOMIC_RELAXED, __HIP_MEMORY_SCOPE_WORKGROUP); }
        }
    }
    __syncthreads();
    if (F.tid < 32 && !dry) { const unsigned c = hist[F.tid]; if (c) __hip_atomic_fetch_add(F.ctl + CW_CNT + 256 * layer + F.tid, c, RLX_AGENT); }
}

__device__ __forceinline__ void phase_m2(Frame& F, const KA a, int layer) {
    LAS int* pstart = (LAS int*)(F.lds + RING_OFF);
    LAS unsigned* lhist = (LAS unsigned*)(F.lds + RING_OFF + 256);
    LAS int* lbase = (LAS int*)(F.lds + RING_OFF + 512);
    int* blk_e = (int*)(a.ws() + WS_BLKE) + layer * 1024;
    LAS int* cntl = (LAS int*)(F.lds + RING_OFF + 768);
    if (F.tid < 32) cntl[F.tid] = (int)__hip_atomic_load(F.ctl + CW_CNT + 256 * layer + F.tid, RLX_AGENT);
    __syncthreads();
    if (F.tid == 0) { int off = 0;
#pragma unroll 1
        for (int e = 0; e < 32; ++e) { pstart[e] = off; off += ((cntl[e] + 255) >> 8) << 8; }
        pstart[32] = off;
        if (F.bx == 0) __hip_atomic_store(F.ctl + CW_CNT + 256 * layer + 128, (unsigned)(off >> 8), RLX_AGENT); }
    __syncthreads();
    if (F.bx == 0) { const int nblk = pstart[32] >> 8;
        for (int blk = F.tid; blk < nblk; blk += NWAVES * 64) { int e = 0;
#pragma unroll 1
            for (int k = 1; k < 32; ++k) e = (pstart[k] <= blk * 256) ? k : e;
            blk_e[blk] = e; } }
    const int* eid = (const int*)(a.ws() + WS_EID); const float* wt = (const float*)(a.ws() + WS_WT);
    int* tslot = (int*)(a.ws() + WS_TSLOT); float* slotw = (float*)(a.ws() + WS_SLOTW);
    int* stok = (int*)(a.ws() + WS_STOK);
    for (int e = F.vcu; e < 32; e += F.G) { const int c = cntl[e];
        for (int s = pstart[e] + c + F.tid; s < pstart[e + 1]; s += NWAVES * 64) stok[s] = 0; }
    for (int chunk = F.vcu; chunk < M / 256; chunk += F.G) {
        if (F.tid < 32) lhist[F.tid] = 0u;
        __syncthreads();
        const int pi = chunk * 512 + F.tid;
        const int e = eid[pi];
        const unsigned rank = __hip_atomic_fetch_add(&lhist[e], 1u, __ATOMIC_RELAXED, __HIP_MEMORY_SCOPE_WORKGROUP);
        __syncthreads();
        if (F.tid < 32) { const unsigned c = lhist[F.tid]; lbase[F.tid] = pstart[F.tid] + (c ? (int)__hip_atomic_fetch_add(F.ctl + CW_CNT + 256 * layer + 64 + F.tid, c, RLX_AGENT) : 0); }
        __syncthreads();
        const int slot = lbase[e] + (int)rank;
        tslot[pi] = slot; slotw[slot] = wt[pi]; stok[slot] = pi >> 1;
        __syncthreads();
    }
}

__device__ __forceinline__ void phase_l2(Frame& F, const KA a, int layer) {
    const int gw = F.vcu * NWAVES + F.wave, NGW = F.G * NWAVES;
    const float* mod = (const float*)(a.ws() + WS_MOD) + (size_t)layer * 16 * 6144;
    const bf16* ys = (const bf16*)(a.ws() + WS_BUF0 + 2 * BUFSZ); const int* tslot = (const int*)(a.ws() + WS_TSLOT);
    bf16* hn = (bf16*)(a.ws() + WS_BUF0);
    const float* lng = a.in(4) + (size_t)(layer * 2 + 1) * D; const float* lnb = a.in(5) + (size_t)(layer * 2 + 1) * D;
    float* x = a.out(); unsigned short* xho = (unsigned short*)a.out(); const unsigned short* xh = (const unsigned short*)(a.ws() + WS_BUF0 + 1 * BUFSZ);
    const int mlay = (layer < DEPTH - 1) ? 16 * 6144 : 0;
    const int tpw = ((M + NGW - 1) / NGW + 3) & ~3;
    for (int t0 = gw * tpw; t0 < (gw + 1) * tpw && t0 < M; t0 += 4) {
        const int b = t0 >> 12; const float* mb = mod + (size_t)b * 6144;
        int sl[8];
        { const int4 s0 = *(const int4*)(tslot + 2 * t0), s1 = *(const int4*)(tslot + 2 * t0 + 4); sl[0] = s0.x; sl[1] = s0.y; sl[2] = s0.z; sl[3] = s0.w; sl[4] = s1.x; sl[5] = s1.y; sl[6] = s1.z; sl[7] = s1.w; }
        u64 xr[4][4], y0r[4][4], y1r[4][4];
#pragma unroll
        for (int j = 0; j < 4; ++j) { const int col = 4 * F.lane + 256 * j;
#pragma unroll
            for (int tt = 0; tt < 4; ++tt) { xr[tt][j] = *(const u64*)(xh + (size_t)(t0 + tt) * D + col);
                y0r[tt][j] = *(const u64*)(ys + (size_t)sl[2 * tt] * D + col); y1r[tt][j] = *(const u64*)(ys + (size_t)sl[2 * tt + 1] * D + col); } }
        f32x4 g2v[4];
#pragma unroll
        for (int j = 0; j < 4; ++j) g2v[j] = *(const f32x4*)(mb + 5120 + 4 * F.lane + 256 * j);
        asm volatile("" ::: "memory");
        f32x4 v[4][4]; float s[4] = {0.f, 0.f, 0.f, 0.f};
#pragma unroll
        for (int j = 0; j < 4; ++j) { const f32x4 g2 = g2v[j];
#pragma unroll
            for (int tt = 0; tt < 4; ++tt) {
                const f32x4 xv = unpk_h4(xr[tt][j]); const u64 y0 = y0r[tt][j], y1 = y1r[tt][j];
                f32x4 yv; yv[0] = bflo((unsigned)y0) + bflo((unsigned)y1); yv[1] = bfhi((unsigned)y0) + bfhi((unsigned)y1);
                yv[2] = bflo((unsigned)(y0 >> 32)) + bflo((unsigned)(y1 >> 32)); yv[3] = bfhi((unsigned)(y0 >> 32)) + bfhi((unsigned)(y1 >> 32));
                v[tt][j] = xv * DN_ALPHA + g2 * yv; s[tt] += (v[tt][j][0] + v[tt][j][1]) + (v[tt][j][2] + v[tt][j][3]); } }
        f32x4 lgv[4], lbv[4], scv[4], shv[4];
#pragma unroll
        for (int j = 0; j < 4; ++j) { const int col = 4 * F.lane + 256 * j; lgv[j] = *(const f32x4*)(lng + col); lbv[j] = *(const f32x4*)(lnb + col);
            scv[j] = *(const f32x4*)(mb + mlay + 1024 + col); shv[j] = *(const f32x4*)(mb + mlay + col); }
        asm volatile("" ::: "memory");
        float rstd[4];
#pragma unroll
        for (int tt = 0; tt < 4; ++tt) { const float mean = wave_sum(s[tt], F.lane) * (1.0f / D); float s2 = 0.f;
#pragma unroll
            for (int j = 0; j < 4; ++j) { v[tt][j] = v[tt][j] - mean; s2 += (v[tt][j][0] * v[tt][j][0] + v[tt][j][1] * v[tt][j][1]) + (v[tt][j][2] * v[tt][j][2] + v[tt][j][3] * v[tt][j][3]); }
            rstd[tt] = __builtin_amdgcn_rsqf(wave_sum(s2, F.lane) * (1.0f / D) + LN_EPS); }
        if (layer == DEPTH - 1) {
#pragma unroll
            for (int j = 0; j < 4; ++j) { const int col = 4 * F.lane + 256 * j;
#pragma unroll
                for (int tt = 0; tt < 4; ++tt) *(f32x4*)(x + (size_t)(t0 + tt) * D + col) = v[tt][j] * rstd[tt] * lgv[j] + lbv[j]; }
        } else {
#pragma unroll
            for (int j = 0; j < 4; ++j) { const int col = 4 * F.lane + 256 * j;
#pragma unroll
                for (int tt = 0; tt < 4; ++tt) { const size_t ro = (size_t)(t0 + tt) * D;
                    const f32x4 xo = v[tt][j] * rstd[tt] * lgv[j] + lbv[j];
                    *(u64*)(xho + ro + col) = (u64)pkh(xo[0], xo[1]) | ((u64)pkh(xo[2], xo[3]) << 32);
                    const f32x4 hv = xo * (scv[j] + 1.0f) + shv[j];
                    *(u64*)(hn + ro + col) = (u64)pkbf(hv[0], hv[1]) | ((u64)pkbf(hv[2], hv[3]) << 32); } }
        }
    }
}

#ifndef MK_SEPARATE
#define MK_SEPARATE 0
#endif
constexpr int N_PHASES = 2 + 10 * DEPTH;
#ifndef PH_MASK
#define PH_MASK 0xFFFFF
#endif
#define PH_ON(n) (((PH_MASK) >> (n)) & 1)
#ifndef DBL_MASK
#define DBL_MASK 0
#endif
#define DBL(n) for (int rep_ = 0; rep_ < 1 + (((DBL_MASK) >> (n)) & 1); ++rep_)
__global__ void __launch_bounds__(NWAVES * 64, 2) fwd_kernel(Args args) {
    extern __shared__ __attribute__((aligned(16))) unsigned char lds[];
    const int wave_s = __builtin_amdgcn_readfirstlane((int)threadIdx.x >> 6);
    gu32* const ctl0 = (gu32*)(karg_fresh().ws() + WS_CTL);
    for (int u = threadIdx.x; u < (LDS_BYTES - LDSCTL_OFF) / 4; u += NWAVES * 64) ((LAS unsigned*)((LAS unsigned char*)lds + LDSCTL_OFF))[u] = 0u;
    __syncthreads();
    XcdBarrier bar; bar.bar = (unsigned*)(ctl0 + CW_BAR); bar.x = 0; bar.st = nullptr;
    if (!MK_SEPARATE) bar = xcd_barrier_post((unsigned*)(ctl0 + CW_BAR), (volatile LAS unsigned*)((LAS unsigned char*)lds + MISC_OFF) + 8);
    const int lo = karg_fresh().ph_lo(), hi = karg_fresh().ph_hi();
    const bool PANEL = !MK_SEPARATE && gridDim.x == (unsigned)(M / 256);
#define IN(k) (lo <= (k) && (k) < hi)
#define FRESH() const KA ka = karg_fresh(); unsigned char* const ws = ka.ws(); (void)ws; Frame F; { int t_, g_ = gridDim.x, bx_ = blockIdx.x; asm volatile("v_mbcnt_lo_u32_b32 %0, -1, 0\n\tv_mbcnt_hi_u32_b32 %0, -1, %0" : "=v"(t_)); asm volatile("" : "+s"(g_), "+s"(bx_)); t_ |= wave_s << 6; \
        F.lds = (LAS unsigned char*)lds; F.MISC = (volatile LAS unsigned*)(F.lds + MISC_OFF); F.ctl = (gu32*)(ws + WS_CTL); F.tid = t_; F.lane = t_ & 63; F.wave = __builtin_amdgcn_readfirstlane(t_ >> 6); \
        F.G = g_; F.bx = bx_; F.vcu = (g_ % 8 == 0) ? (bx_ % 8) * (g_ / 8) + bx_ / 8 : bx_; }
#ifndef DBL_BARRIER
#define DBL_BARRIER 0
#endif
#define SEAM(k) do { if (IN(k) && IN((k) + 1)) { if (MK_SEPARATE) { } else { xcd_barrier(bar, wave_s); if (DBL_BARRIER) xcd_barrier(bar, wave_s); } } } while (0)
#define BUF(i) ((bf16*)(ws + WS_BUF0 + (size_t)(i) * BUFSZ))

    if (PH_ON(0) && IN(0)) { FRESH(); DBL(0) phase_p0a(F, ka); }
    SEAM(0);
    if (PH_ON(1) && IN(1)) { FRESH(); DBL(1) phase_p0b(F, ka); }
    SEAM(1);
    for (int i = 0; i < DEPTH; ++i) {
        const int pb = 2 + 10 * i, j = i >> 1;
        if ((i & 1) == 0) {
            if (PH_ON(2) && IN(pb)) { FRESH();
                pg8::Gemm g{BUF(0), (const bf16*)(ws + WS_WHIN) + (size_t)j * 4096 * 1024, M, 4096, D, 0, nullptr}; pg8::StaticOrder S; S.init(M, 4096, F.G, F.bx);
                pg8::EpiBf16<0> E{BUF(1), D, nullptr, D, BUFSZ / 2, 1.0f};
                DBL(2) pg8::gemm_phase<pg8::EpiBf16<0>, pg8::StaticOrder, true, true>(F.lds + RING_OFF, g, S, E, F.tid);
            }
            SEAM(pb);
            if (PH_ON(3) && IN(pb + 1)) { FRESH(); phase_hgrn_prep(F, ka, j); }
            SEAM(pb + 1);
            if (PH_ON(4) && IN(pb + 2)) { FRESH(); DBL(4) phase_hgrn_scan(F, ka, i); }
            SEAM(pb + 2);
            if (PH_ON(5) && IN(pb + 3)) { FRESH(); phase_normgate<0>(F, BUF(6), BUF(4), BUF(4), ka.in(9) + j * 128, 0.f, 1.0f); }
            if (!PANEL) SEAM(pb + 3);
        } else {
            if (PH_ON(6) && IN(pb)) { FRESH();
                pg8::Gemm g{BUF(0), (const bf16*)(ws + WS_WAIN) + (size_t)j * 3072 * 1024, M, 3072, D, 0, nullptr}; pg8::StaticOrder S; S.init(M, 3072, F.G, F.bx);
                pg8::EpiRope E{BUF(1), BUF(2), BUF(3), (const float*)(ws + WS_ROPE_C), (const float*)(ws + WS_ROPE_S), attn_body::C2, SEQ - 1};
                DBL(6) pg8::gemm_phase<pg8::EpiRope, pg8::StaticOrder, true, true>(F.lds + RING_OFF, g, S, E, F.tid);
            }
            SEAM(pb);
            if (PH_ON(7) && IN(pb + 1)) { FRESH();
                const attn_body::AttnTensors AT{(const attn_body::bf16*)BUF(1), (const attn_body::bf16*)BUF(2), (const attn_body::bf16*)BUF(3), (attn_body::bf16*)BUF(4), (attn_body::bf16*)BUF(5)};
                static_assert(attn_body::ATTNW_LDS_BYTES <= RING_BYTES, "attention LDS");
                const attn_body::StaticOrderW S((int)F.G, F.vcu);
                const float* lp = ka.in(12) + j * 256;
                const float d1 = wave_sum(lp[F.lane] * lp[64 + F.lane], F.lane), d2 = wave_sum(lp[128 + F.lane] * lp[192 + F.lane], F.lane);
                const float linit = (j == 0) ? 0.35550906759f : 0.55605820415f;
                const float lam = fexp(d1) - fexp(d2) + linit;
                const attn_body::CombineW CB{(const attn_body::bf16*)BUF(4), (attn_body::bf16*)BUF(6), ka.in(13) + j * 128, lam, 1.0f - linit};
                DBL(7) attn_body::attn_phase_w<8>((char*)lds + RING_OFF, AT, S, CB, F.tid);
            }
            SEAM(pb + 1);
        }
        if (PH_ON(9) && IN(pb + 4)) { FRESH();
            const bf16* A = (i & 1) ? BUF(6) : BUF(4);
            const bf16* W = (i & 1) ? (const bf16*)(ws + WS_WAOUT) + (size_t)j * 1024 * 1024 : (const bf16*)(ws + WS_WHOUT) + (size_t)j * 1024 * 1024;
            pg8::Gemm g{A, W, M, D, D, 0, nullptr};
            pg8::EpiBf16<0> E{BUF(1), D, nullptr, 0, 0, 1.0f};
            if (PANEL) {
                __syncthreads();
                pg8::PanelOrder S{F.vcu, D / 256};
                pg8::gemm_phase<pg8::EpiBf16<0>, pg8::PanelOrder, true, true>(F.lds + RING_OFF, g, S, E, F.tid);
                __syncthreads();
            } else {
                pg8::StaticOrder S; S.init(M, D, F.G, F.bx);
                DBL(9) pg8::gemm_phase<pg8::EpiBf16<0>, pg8::StaticOrder, true, true>(F.lds + RING_OFF, g, S, E, F.tid);
            }
        }
        if (!PANEL) SEAM(pb + 4);
        if (PH_ON(10) && IN(pb + 5)) { FRESH(); phase_l1(F, ka, i, i == 0 ? ka.in(0) : (const float*)ka.out(), false);
            if ((((DBL_MASK) >> 10) & 1) && i == 0) { __syncthreads(); phase_l1(F, ka, i, ka.in(0), true); } }
        SEAM(pb + 5);
        if (PH_ON(11) && IN(pb + 6)) { FRESH(); phase_m2(F, ka, i); }
        SEAM(pb + 6);
        if (PH_ON(12) && IN(pb + 7)) { FRESH();
            const int nblk = (int)__hip_atomic_load(F.ctl + CW_CNT + 256 * i + 128, RLX_AGENT);
            pg8::Gemm g{BUF(0), (const bf16*)moe_wbuf(ws, i), nblk * 256, 1024, D, (size_t)1024 * 1024 * 2, (const int*)(ws + WS_STOK)};
            pg8::MoeOrder S; S.init(nblk * 256, 1024, F.G, F.bx); S.blk_e = (const int*)(ws + WS_BLKE) + i * 1024;
            pg8::EpiSwiGLU E{BUF(5)};
            DBL(12) pg8::gemm_phase<pg8::EpiSwiGLU, pg8::MoeOrder, true, true, true>(F.lds + RING_OFF, g, S, E, F.tid);
        }
        SEAM(pb + 7);
        if (PH_ON(13) && IN(pb + 8)) { FRESH();
            const int nblk = (int)__hip_atomic_load(F.ctl + CW_CNT + 256 * i + 128, RLX_AGENT);
            pg8::Gemm g{BUF(5), (const bf16*)(moe_wbuf(ws, i) + 64 * MiB), nblk * 256, 1024, FF, (size_t)1024 * 512 * 2, nullptr};
            pg8::MoeOrder S; S.init(nblk * 256, 1024, F.G, F.bx); S.blk_e = (const int*)(ws + WS_BLKE) + i * 1024;
            pg8::EpiRowScale E{BUF(2), (const float*)(ws + WS_SLOTW)};
            DBL(13) pg8::gemm_phase<pg8::EpiRowScale, pg8::MoeOrder, true, true>(F.lds + RING_OFF, g, S, E, F.tid);
        }
        SEAM(pb + 8);
        if (PH_ON(14) && IN(pb + 9)) { FRESH(); DBL(14) phase_l2(F, ka, i); }
        SEAM(pb + 9);
    }
#undef IN
#undef SEAM
}

extern "C" void kernel_launch(void* const* d_in, const int* in_sizes, int n_in, void* d_out, int out_size, void* d_ws, size_t ws_size, hipStream_t stream) {
    static int grid = 0;
    if (grid == 0) {
        if (n_in != 21 || in_sizes[0] != M * D || out_size != M * D || ws_size < WS_END) { fprintf(stderr, "kernel_launch: unexpected shapes / workspace (n_in %d, ws %zu, need %zu)\n", n_in, ws_size, (size_t)WS_END); grid = -1; return; }
        int dev = 0, cus = 0, per_cu = 0;
        if (hipGetDevice(&dev) != hipSuccess || hipDeviceGetAttribute(&cus, hipDeviceAttributeMultiprocessorCount, dev) != hipSuccess) { grid = -1; return; }
        if (hipFuncSetAttribute((const void*)fwd_kernel, hipFuncAttributeMaxDynamicSharedMemorySize, LDS_BYTES) != hipSuccess) { fprintf(stderr, "kernel_launch: hipFuncSetAttribute failed\n"); grid = -1; return; }
        if (hipOccupancyMaxActiveBlocksPerMultiprocessor(&per_cu, (const void*)fwd_kernel, NWAVES * 64, LDS_BYTES) != hipSuccess || per_cu < 1) fprintf(stderr, "kernel_launch: occupancy query says %d\n", per_cu);
        (void)hipGetLastError();
        grid = cus;
    }
    if (grid < 0) return;
    if (hipMemsetAsync((char*)d_ws + WS_CTL, 0, CTL_ZERO_BYTES, stream) != hipSuccess) return;
    Args a{};
    for (int i = 0; i < 21; ++i) a.in[i] = (const float*)d_in[i];
    a.out = (float*)d_out; a.ws = (unsigned char*)d_ws;
#if MK_SEPARATE
    for (int p = 0; p < N_PHASES; ++p) {
        if (p >= 2 && (((p - 2) / 10) & 1) == 1 && ((p - 2) % 10) == 3) continue;
        a.ph_lo = p; a.ph_hi = p + 1;
        hipLaunchKernelGGL(fwd_kernel, dim3(grid), dim3(NWAVES * 64), LDS_BYTES, stream, a);
    }
#else
    a.ph_lo = 0; a.ph_hi = N_PHASES;
    hipLaunchKernelGGL(fwd_kernel, dim3(grid), dim3(NWAVES * 64), LDS_BYTES, stream, a);
#endif
}
```

```cpp
#include <hip/hip_runtime.h>
#include <cstdio>
#include <cstdint>
namespace pg8 {
#define PG8_LAS __attribute__((address_space(3)))
typedef unsigned short bf16_t;
typedef short bf16x8 __attribute__((ext_vector_type(8)));
typedef float f32x4 __attribute__((ext_vector_type(4)));
typedef unsigned u32x4 __attribute__((ext_vector_type(4)));
constexpr int BM = 256, BK = 64, HALF = 128, HTB = HALF * BK * 2  , STAGE_BYTES = 8 * HTB, NXCD = 8, WGM = 8;

__host__ __device__ __forceinline__ int lds_byte(int r, int c) { const int st = (r >> 4) * 2 + (c >> 5), rr = r & 15, cc = c & 31, ob = rr * 64 + cc * 2; return st * 1024 + (ob ^ (((ob >> 9) & 1) << 5)); }
__host__ __device__ __forceinline__ void stage_rc(int b, int& R, int& C) { const int st = b / 1024, sb = b % 1024, swz = sb ^ (((sb >> 9) & 1) << 5); R = (st >> 1) * 16 + swz / 64; C = (st & 1) * 32 + (swz % 64) / 2; }
__host__ __device__ __forceinline__ int perm32(int rho) { const int n = rho >> 4, i = rho & 15; return 8 * (i >> 2) + 4 * n + (i & 3); }

struct Unit { int pm, pn, e; };
struct Gemm { const bf16_t* A; const bf16_t* Bt; int M, N, K; size_t estride; const int* arow; };

struct StaticOrder {
    int nM, nN, nwg, G, c;
    __host__ __device__ void init(int M, int N, int G_, int c_) { nM = M / BM; nN = N / BM; nwg = nM * nN; G = G_; c = c_; }
    __host__ __device__ bool next(int i, Unit& u) const {
        const long L = (long)i * G + c; if (L >= nwg) return false;
        int wgid = (int)L; { const int q = nwg / NXCD, r = nwg % NXCD, xcd = wgid % NXCD, off = wgid / NXCD; wgid = (xcd < r ? xcd * (q + 1) : r * (q + 1) + (xcd - r) * q) + off; }
        const int nig = WGM * nN, gid = wgid / nig, fm = gid * WGM, gsz = (nM - fm) < WGM ? (nM - fm) : WGM;
        u.pm = fm + ((wgid % nig) % gsz); u.pn = (wgid % nig) / gsz; u.e = 0; return true;
    }
    __device__ __forceinline__ void a_ready(const Unit&) const {}
    __device__ __forceinline__ void done(const Unit&) const {}
};

__device__ __forceinline__ unsigned cvt_pk_bf16(float lo, float hi) { unsigned r; asm volatile("v_cvt_pk_bf16_f32 %0, %1, %2" : "=v"(r) : "v"(lo), "v"(hi)); return r; }
typedef float f32x2 __attribute__((ext_vector_type(2)));
__device__ __forceinline__ f32x2 gelu_pk(f32x2 v) {
    const f32x2 av = __builtin_elementwise_abs(v), d = av * 0.2316418882f + 1.0f;
    f32x2 t; t.x = __builtin_amdgcn_rcpf(d.x); t.y = __builtin_amdgcn_rcpf(d.y);
    f32x2 q = t * 0.5307027145f + (-0.7265760135f); q = q * t + 0.7107068705f; q = q * t + (-0.142248368f); q = q * t + 0.127414796f; q = q * t;
    const f32x2 s = (v * v) * (-0.72134752044f);
    f32x2 e; e.x = __builtin_amdgcn_exp2f(s.x); e.y = __builtin_amdgcn_exp2f(s.y);
    const f32x2 m = v * (q * e), r = v - m;
    f32x2 o; o.x = v.x < 0.f ? m.x : r.x; o.y = v.y < 0.f ? m.y : r.y; return o;
}

template <int ACT  > struct EpiBf16 {
    static constexpr bool PERM = true, AFTER_DRAIN = false; static_assert(ACT == 0 || ACT == 1, "EpiBf16: ACT is 0 (none) or 1 (gelu_pk)");
    bf16_t* O; int ldc; const float* bias; int split_cols; size_t split_stride; float scale0;
    __device__ __forceinline__ void operator()(const f32x4 (&acc)[2][2][4][2], const Unit& u, int wr, int wc, int fr, int fq) const {
        const int row0 = u.pm * BM + wr * 64 + fr; int colt = u.pn * BM; bf16_t* base = O;
        float sc = 1.f; if (split_cols) { const int t = colt / split_cols; base += (size_t)t * split_stride; colt -= t * split_cols; if (t == 0) sc = scale0; }
        const int col0 = colt + wc * 32 + 8 * fq, bcol0 = u.pn * BM + wc * 32 + 8 * fq;
        f32x4 bv[2][2];
#pragma unroll
        for (int bj = 0; bj < 2; ++bj)
#pragma unroll
            for (int n = 0; n < 2; ++n) bv[bj][n] = bias ? *(const f32x4*)(bias + bcol0 + bj * HALF + 4 * n) : (f32x4){0.f, 0.f, 0.f, 0.f};
#pragma unroll
        for (int ai = 0; ai < 2; ++ai)
#pragma unroll
            for (int m = 0; m < 4; ++m) { bf16_t* rowp = base + (size_t)(row0 + ai * HALF + m * 16) * ldc + col0;
#pragma unroll
                for (int bj = 0; bj < 2; ++bj) { f32x4 v0 = acc[ai][bj][m][0] + bv[bj][0], v1 = acc[ai][bj][m][1] + bv[bj][1];
                    if (ACT == 1) { f32x2 a = gelu_pk((f32x2){v0[0], v0[1]}), b = gelu_pk((f32x2){v0[2], v0[3]}), c = gelu_pk((f32x2){v1[0], v1[1]}), d = gelu_pk((f32x2){v1[2], v1[3]});
                        v0 = (f32x4){a.x, a.y, b.x, b.y}; v1 = (f32x4){c.x, c.y, d.x, d.y}; }
                    v0 = v0 * sc; v1 = v1 * sc; u32x4 w; w.x = cvt_pk_bf16(v0[0], v0[1]); w.y = cvt_pk_bf16(v0[2], v0[3]); w.z = cvt_pk_bf16(v1[0], v1[1]); w.w = cvt_pk_bf16(v1[2], v1[3]);
                    *(u32x4*)(rowp + bj * HALF) = w; } }
    }
};

template <class Epi, class Sched, bool ALIGN_EPI = false, bool SP2 = false, bool GATHER = false>
__device__ __forceinline__ void gemm_phase(PG8_LAS unsigned char* lds, const Gemm g, const Sched& S, const Epi& E, const int tid) {
        const int wid = __builtin_amdgcn_readfirstlane(tid >> 6), lane = tid & 63, wr = wid >> 2, wc = wid & 3, fr = lane & 15, fq = lane >> 4;
    const int K = g.K, nt = K / BK;
    unsigned voffA[2], voffB[2], gcolb[2];
#pragma unroll
    for (int i = 0; i < 2; ++i) { int R, C; stage_rc(tid * 16 + i * 8192, R, C); const int Rb = Epi::PERM ? ((R & ~31) + perm32(R & 31)) : R;
        voffA[i] = GATHER ? (unsigned)R * 4u   : (unsigned)(R * K + C) * 2u; voffB[i] = (unsigned)(Rb * K + C) * 2u; gcolb[i] = (unsigned)C * 2u; }
    unsigned gA[2][2] = {{0u, 0u}, {0u, 0u}}, gN[2][2] = {{0u, 0u}, {0u, 0u}};
#define PG8_ROWS(dst, u_) do { const char* rb_ = (const char*)(g.arow + (size_t)(u_).pm * BM); unsigned raw_[2][2];        \
        _Pragma("unroll") for (int _h = 0; _h < 2; ++_h) _Pragma("unroll") for (int _i = 0; _i < 2; ++_i) raw_[_h][_i] = (unsigned)*(const int*)(rb_ + voffA[_i] + _h * HALF * 4); \
        _Pragma("unroll") for (int _h = 0; _h < 2; ++_h) _Pragma("unroll") for (int _i = 0; _i < 2; ++_i) dst[_h][_i] = raw_[_h][_i] * (unsigned)(K * 2) + gcolb[_i]; } while (0)
    const size_t kstep = (size_t)(BK * 2);
    const size_t hstep = (size_t)HALF * K * 2;
    const size_t tstep = 2 * hstep;
    const unsigned ldsw = (unsigned)wid * 1024u;
    const int aoff = lds_byte(wr * 64 + fr, fq * 8), boff = lds_byte(wc * 32 + fr, fq * 8);
#define PG8_SA(b, h) (((b) * 2 + (h)) * HTB)
#define PG8_SB(b, h) ((4 + (b) * 2 + (h)) * HTB)
#define PG8_STAGE(bufoff, gbase, voff) do { _Pragma("unroll") for (int _i = 0; _i < 2; ++_i) \
        __builtin_amdgcn_global_load_lds((const unsigned*)((const char*)(gbase) + (voff)[_i]), (PG8_LAS unsigned*)(lds + (bufoff) + ldsw + _i * 8192), 16, 0, 0); } while (0)
#define PG8_STAGEA(bufoff, gbase, h_, nx_) do { if constexpr (GATHER) { _Pragma("unroll") for (int _i = 0; _i < 2; ++_i) \
        __builtin_amdgcn_global_load_lds((const unsigned*)((const char*)(gbase) + ((nx_) ? gN[h_][_i] : gA[h_][_i])), (PG8_LAS unsigned*)(lds + (bufoff) + ldsw + _i * 8192), 16, 0, 0); } \
        else { PG8_STAGE(bufoff, (gbase) + ((h_) ? hstep : (size_t)0), voffA); } } while (0)
#define PG8_LDA(dst, b, h) do { _Pragma("unroll") for (int m = 0; m < 4; ++m) _Pragma("unroll") for (int k = 0; k < 2; ++k) dst[m][k] = *(const PG8_LAS bf16x8*)(lds + PG8_SA(b, h) + aoff + m * 2048 + k * 1024); } while (0)
#define PG8_LDB(dst, b, h) do { _Pragma("unroll") for (int n = 0; n < 2; ++n) _Pragma("unroll") for (int k = 0; k < 2; ++k) dst[n][k] = *(const PG8_LAS bf16x8*)(lds + PG8_SB(b, h) + boff + n * 2048 + k * 1024); } while (0)
#define PG8_MMA(ai, bj, At, Bt) do { __builtin_amdgcn_s_setprio(1); _Pragma("unroll") for (int m = 0; m < 4; ++m) _Pragma("unroll") for (int n = 0; n < 2; ++n) _Pragma("unroll") for (int k = 0; k < 2; ++k) \
        acc[ai][bj][m][n] = __builtin_amdgcn_mfma_f32_16x16x32_bf16(Bt[n][k], At[m][k], acc[ai][bj][m][n], 0, 0, 0); __builtin_amdgcn_s_setprio(0); } while (0)
#define PG8_WAIT_V(n) asm volatile("s_waitcnt vmcnt(" #n ")" ::: "memory")
#define PG8_WAIT_L(n) asm volatile("s_waitcnt lgkmcnt(" #n ")" ::: "memory")
#define PG8_BAR __builtin_amdgcn_s_barrier()
#define PG8_SCHED __builtin_amdgcn_sched_barrier(0)
    Unit cur, nxt; int ui = 0;
    if (!S.next(0, cur)) return;
    f32x4 acc[2][2][4][2];
#pragma unroll
    for (int a = 0; a < 2; ++a)
#pragma unroll
        for (int b = 0; b < 2; ++b)
#pragma unroll
            for (int m = 0; m < 4; ++m)
#pragma unroll
                for (int n = 0; n < 2; ++n) acc[a][b][m][n] = (f32x4){0.f, 0.f, 0.f, 0.f};
    bf16x8 At[4][2], B0[2][2], B1[2][2];
    const char* cA = (const char*)g.A + (GATHER ? (size_t)0 : (size_t)cur.pm * tstep); const char* cB = (const char*)g.Bt + (size_t)cur.e * g.estride + (size_t)cur.pn * tstep;
    S.a_ready(cur);
    if constexpr (GATHER) PG8_ROWS(gA, cur);
    if constexpr (SP2) {
        PG8_STAGE(PG8_SB(0, 0), cB, voffB); PG8_STAGE(PG8_SB(0, 1), cB + hstep, voffB); PG8_STAGEA(PG8_SA(0, 0), cA, 0, false); PG8_STAGEA(PG8_SA(0, 1), cA, 1, false);
        if (wr == 1) PG8_BAR;
        PG8_WAIT_V(2); PG8_BAR;
        PG8_STAGE(PG8_SB(1, 0), cB + kstep, voffB); PG8_STAGEA(PG8_SA(1, 0), cA + kstep, 0, false); PG8_STAGE(PG8_SB(1, 1), cB + hstep + kstep, voffB);
        PG8_WAIT_V(6); PG8_BAR;
    } else {
        PG8_STAGE(PG8_SB(0, 0), cB, voffB); PG8_STAGEA(PG8_SA(0, 0), cA, 0, false); PG8_STAGE(PG8_SB(0, 1), cB + hstep, voffB); PG8_STAGEA(PG8_SA(0, 1), cA, 1, false);
        if (wr == 1) PG8_BAR;
        PG8_WAIT_V(4); PG8_BAR;
        PG8_STAGE(PG8_SB(1, 0), cB + kstep, voffB); PG8_STAGEA(PG8_SA(1, 0), cA + kstep, 0, false); PG8_STAGE(PG8_SB(1, 1), cB + hstep + kstep, voffB);
        PG8_WAIT_V(6); PG8_BAR;
    }
    for (;;) {
        const bool has_next = S.next(ui + 1, nxt);
        const char* nA = has_next ? (const char*)g.A + (GATHER ? (size_t)0 : (size_t)nxt.pm * tstep) : cA;
        if constexpr (GATHER) { if (has_next) PG8_ROWS(gN, nxt); else { _Pragma("unroll") for (int _h = 0; _h < 2; ++_h) _Pragma("unroll") for (int _i = 0; _i < 2; ++_i) gN[_h][_i] = gA[_h][_i]; } } const char* nB = has_next ? (const char*)g.Bt + (size_t)nxt.e * g.estride + (size_t)nxt.pn * tstep : cB;
        for (int t = 0; t < nt; t += 2) {
            const bool last = (t == nt - 2);
            const char* a1 = cA + (size_t)(t + 1) * kstep;
            const char* a2 = last ? nA : cA + (size_t)(t + 2) * kstep; const char* b2 = last ? nB : cB + (size_t)(t + 2) * kstep;
            const char* a3 = a2 + kstep; const char* b3 = b2 + kstep;
            if (last && has_next) S.a_ready(nxt);
            if constexpr (SP2) {
            PG8_LDB(B0, 0, 0); PG8_LDB(B1, 0, 1); PG8_SCHED; PG8_LDA(At, 0, 0); PG8_STAGEA(PG8_SA(1, 1), a1, 1, false);
            PG8_WAIT_V(8); PG8_WAIT_L(0); PG8_BAR; PG8_MMA(0, 0, At, B0); PG8_MMA(0, 1, At, B1); PG8_BAR; PG8_SCHED;
            PG8_LDA(At, 0, 1); PG8_STAGE(PG8_SB(0, 0), b2, voffB); PG8_STAGE(PG8_SB(0, 1), b2 + hstep, voffB); PG8_STAGEA(PG8_SA(0, 0), a2, 0, last);
            PG8_WAIT_V(8); PG8_WAIT_L(0); PG8_BAR; PG8_MMA(1, 0, At, B0); PG8_MMA(1, 1, At, B1); PG8_BAR; PG8_SCHED;
            PG8_LDB(B0, 1, 0); PG8_LDB(B1, 1, 1); PG8_SCHED; PG8_LDA(At, 1, 0); PG8_STAGEA(PG8_SA(0, 1), a2, 1, last);
            PG8_WAIT_V(8); PG8_WAIT_L(0); PG8_BAR; PG8_MMA(0, 0, At, B0); PG8_MMA(0, 1, At, B1); PG8_BAR; PG8_SCHED;
            PG8_LDA(At, 1, 1); PG8_STAGE(PG8_SB(1, 0), b3, voffB); PG8_STAGE(PG8_SB(1, 1), b3 + hstep, voffB); PG8_STAGEA(PG8_SA(1, 0), a3, 0, last);
            PG8_WAIT_V(8); PG8_WAIT_L(0); PG8_BAR; PG8_MMA(1, 0, At, B0); PG8_MMA(1, 1, At, B1); PG8_BAR; PG8_SCHED;
            } else {
            PG8_LDB(B0, 0, 0); PG8_SCHED; PG8_LDA(At, 0, 0); PG8_STAGEA(PG8_SA(1, 1), a1, 1, false);
            PG8_WAIT_L(8); PG8_BAR; PG8_WAIT_L(0); PG8_MMA(0, 0, At, B0); PG8_BAR; PG8_SCHED;
            PG8_LDB(B1, 0, 1); PG8_STAGE(PG8_SB(0, 0), b2, voffB);
            PG8_BAR; PG8_WAIT_L(0); PG8_MMA(0, 1, At, B1); PG8_BAR;
            PG8_LDA(At, 0, 1); PG8_STAGEA(PG8_SA(0, 0), a2, 0, last);
            PG8_BAR; PG8_WAIT_L(0); PG8_MMA(1, 0, At, B0); PG8_BAR; PG8_SCHED;
            PG8_STAGE(PG8_SB(0, 1), b2 + hstep, voffB);
            PG8_WAIT_V(6); PG8_BAR; PG8_MMA(1, 1, At, B1); PG8_BAR;
            PG8_LDB(B0, 1, 0); PG8_SCHED; PG8_LDA(At, 1, 0); PG8_STAGEA(PG8_SA(0, 1), a2, 1, last);
            PG8_WAIT_L(8); PG8_BAR; PG8_WAIT_L(0); PG8_MMA(0, 0, At, B0); PG8_BAR; PG8_SCHED;
            PG8_LDB(B1, 1, 1); PG8_STAGE(PG8_SB(1, 0), b3, voffB);
            PG8_BAR; PG8_WAIT_L(0); PG8_MMA(0, 1, At, B1); PG8_BAR;
            PG8_LDA(At, 1, 1); PG8_STAGEA(PG8_SA(1, 0), a3, 0, last);
            PG8_BAR; PG8_WAIT_L(0); PG8_MMA(1, 0, At, B0); PG8_BAR; PG8_SCHED;
            PG8_STAGE(PG8_SB(1, 1), b3 + hstep, voffB);
            PG8_WAIT_V(6); PG8_BAR; PG8_MMA(1, 1, At, B1); PG8_BAR;
            }
        }
        if constexpr (ALIGN_EPI) { if (wr == 0) PG8_BAR; }
        if constexpr (!Epi::AFTER_DRAIN) { E(acc, cur, wr, wc, fr, fq); S.done(cur); }
        if (!has_next) break;
#pragma unroll
        for (int a = 0; a < 2; ++a)
#pragma unroll
            for (int b = 0; b < 2; ++b)
#pragma unroll
                for (int m = 0; m < 4; ++m)
#pragma unroll
                    for (int n = 0; n < 2; ++n) acc[a][b][m][n] = (f32x4){0.f, 0.f, 0.f, 0.f};
        cur = nxt; cA = nA; cB = nB; ++ui;
        if constexpr (GATHER) { _Pragma("unroll") for (int _h = 0; _h < 2; ++_h) _Pragma("unroll") for (int _i = 0; _i < 2; ++_i) gA[_h][_i] = gN[_h][_i]; }
        if constexpr (ALIGN_EPI) { if (wr == 1) PG8_BAR; }
    }
    PG8_WAIT_V(0);
    if constexpr (!ALIGN_EPI) { if (wr == 0) PG8_BAR; }
    PG8_BAR;
    if constexpr (Epi::AFTER_DRAIN) { E.fused(acc, cur, wr, wc, fr, fq, lds, wid, lane); S.done(cur); }
#undef PG8_SA
#undef PG8_SB
#undef PG8_STAGE
#undef PG8_STAGEA
#undef PG8_ROWS
#undef PG8_LDA
#undef PG8_LDB
#undef PG8_MMA
#undef PG8_WAIT_V
#undef PG8_WAIT_L
#undef PG8_BAR
#undef PG8_SCHED
}
}

namespace pg8 {
__device__ __forceinline__ u32x4 pack8(const f32x4 a, const f32x4 b) { u32x4 w; w.x = cvt_pk_bf16(a[0], a[1]); w.y = cvt_pk_bf16(a[2], a[3]); w.z = cvt_pk_bf16(b[0], b[1]); w.w = cvt_pk_bf16(b[2], b[3]); return w; }
__device__ __forceinline__ float silu_f(float x) { return x * __builtin_amdgcn_rcpf(1.0f + __builtin_amdgcn_exp2f(-1.4426950408889634f * x)); }

struct EpiRope {
    static constexpr bool PERM = true, AFTER_DRAIN = false;
    bf16_t* Q; bf16_t* Kb; bf16_t* Vb; const float* cs; const float* sn; float qscale; int seqmask;
    __device__ __forceinline__ void operator()(const f32x4 (&acc)[2][2][4][2], const Unit& u, int wr, int wc, int fr, int fq) const {
        const int row0 = u.pm * BM + wr * 64 + fr; const int part = u.pn >> 2, pn4 = u.pn & 3;
        if (part == 2) {
            const int col0 = pn4 * BM + wc * 32 + 8 * fq;
#pragma unroll
            for (int ai = 0; ai < 2; ++ai)
#pragma unroll
                for (int m = 0; m < 4; ++m) { bf16_t* rowp = Vb + (size_t)(row0 + ai * HALF + m * 16) * 1024 + col0;
#pragma unroll
                    for (int bj = 0; bj < 2; ++bj) *(u32x4*)(rowp + bj * HALF) = pack8(acc[ai][bj][m][0], acc[ai][bj][m][1]); }
        } else {
            bf16_t* base = part == 0 ? Q : Kb; const float sc = part == 0 ? qscale : 1.0f;
            const int hm = pn4 * 4 + wc, j0 = 8 * fq;
#pragma unroll
            for (int q = 0; q < 4; ++q) {
                const int ai = q >> 1, mb = (q & 1) * 2;
                f32x4 c0[2], c1[2], s0[2], s1[2];
#pragma unroll
                for (int mm = 0; mm < 2; ++mm) { const int pos = (row0 + ai * HALF + (mb + mm) * 16) & seqmask;
                    c0[mm] = *(const f32x4*)(cs + pos * 32 + j0); c1[mm] = *(const f32x4*)(cs + pos * 32 + j0 + 4); s0[mm] = *(const f32x4*)(sn + pos * 32 + j0); s1[mm] = *(const f32x4*)(sn + pos * 32 + j0 + 4); }
#pragma unroll
                for (int mm = 0; mm < 2; ++mm) { const int m = mb + mm; const int row = row0 + ai * HALF + m * 16;
                    const f32x4 x1a = acc[ai][0][m][0] * sc, x1b = acc[ai][0][m][1] * sc, x2a = acc[ai][1][m][0] * sc, x2b = acc[ai][1][m][1] * sc;
                    const f32x4 o1a = x1a * c0[mm] - x2a * s0[mm], o1b = x1b * c1[mm] - x2b * s1[mm], o2a = x2a * c0[mm] + x1a * s0[mm], o2b = x2b * c1[mm] + x1b * s1[mm];
                    bf16_t* rowp = base + (size_t)row * 1024 + hm * 64 + j0;
                    *(u32x4*)(rowp) = pack8(o1a, o1b); *(u32x4*)(rowp + 32) = pack8(o2a, o2b); }
            }
        }
    }
};
struct EpiSwiGLU {
    static constexpr bool PERM = true, AFTER_DRAIN = false;
    bf16_t* act;
    __device__ __forceinline__ void operator()(const f32x4 (&acc)[2][2][4][2], const Unit& u, int wr, int wc, int fr, int fq) const {
        const int row0 = u.pm * BM + wr * 64 + fr, col0 = u.pn * HALF + wc * 32 + 8 * fq;
#pragma unroll
        for (int ai = 0; ai < 2; ++ai)
#pragma unroll
            for (int m = 0; m < 4; ++m) { f32x4 v0, v1;
#pragma unroll
                for (int j = 0; j < 4; ++j) { v0[j] = silu_f(acc[ai][0][m][0][j]) * acc[ai][1][m][0][j]; v1[j] = silu_f(acc[ai][0][m][1][j]) * acc[ai][1][m][1][j]; }
                *(u32x4*)(act + (size_t)(row0 + ai * HALF + m * 16) * 512 + col0) = pack8(v0, v1); }
    }
};
struct EpiRowScale {
    static constexpr bool PERM = true, AFTER_DRAIN = false;
    bf16_t* O; const float* roww;
    __device__ __forceinline__ void operator()(const f32x4 (&acc)[2][2][4][2], const Unit& u, int wr, int wc, int fr, int fq) const {
        const int row0 = u.pm * BM + wr * 64 + fr, col0 = u.pn * BM + wc * 32 + 8 * fq;
        float w8[8];
#pragma unroll
        for (int q = 0; q < 8; ++q) w8[q] = roww[row0 + (q >> 2) * HALF + (q & 3) * 16];
#pragma unroll
        for (int ai = 0; ai < 2; ++ai)
#pragma unroll
            for (int m = 0; m < 4; ++m) { const int row = row0 + ai * HALF + m * 16; const float w = w8[ai * 4 + m]; bf16_t* rowp = O + (size_t)row * 1024 + col0;
#pragma unroll
                for (int bj = 0; bj < 2; ++bj) *(u32x4*)(rowp + bj * HALF) = pack8(acc[ai][bj][m][0] * w, acc[ai][bj][m][1] * w); }
    }
};
struct PanelOrder {
    int pm, nN;
    __device__ __forceinline__ bool next(int i, Unit& u) const { if (i >= nN) return false; u.pm = pm; u.pn = i; u.e = 0; return true; }
    __device__ __forceinline__ void a_ready(const Unit&) const {}
    __device__ __forceinline__ void done(const Unit&) const {}
};
struct MoeOrder : StaticOrder {
    const int* blk_e;
    __device__ __forceinline__ bool next(int i, Unit& u) const { if (!StaticOrder::next(i, u)) return false; u.e = ((const __attribute__((address_space(4))) int*)blk_e)[u.pm]; return true; }
};
}
#include <hip/hip_bf16.h>
#include <cmath>
namespace attn_body {
using bf16=__hip_bfloat16;
using bf16x8=__attribute__((ext_vector_type(8)))short;
using s16x4=__attribute__((ext_vector_type(4)))short;
using f32x16=__attribute__((ext_vector_type(16)))float;
using u32x4=__attribute__((ext_vector_type(4)))unsigned;
constexpr int BATCH=16,NHEAD=16,SEQ=4096,D=64,DM=NHEAD*D;
constexpr int NW=8,QBLK=32,QB=QBLK*NW,KVBLK=64,NQB=SEQ/QB;
constexpr int ATTN_PITCH=DM, ATTN_UNIT_ROWS=QB;
__device__ __forceinline__ int crow(int r,int hi){return (r&3)+8*(r>>2)+4*hi;}
#define SBAR() __builtin_amdgcn_sched_barrier(0)
__device__ __forceinline__ void cmask(f32x16&p0,f32x16&p1,int jb,int qrel,int hi){
  const float NEG=-INFINITY; int kb=64*jb+4*hi;
  #pragma unroll
  for(int r=0;r<16;++r){int kv=kb+(r&3)+8*(r>>2); if(kv>qrel)p0[r]=NEG; if(kv+32>qrel)p1[r]=NEG;}
}

constexpr int NSLOT=3, SLOTB=8192;
constexpr int LDS_K=0, LDS_V=NSLOT*SLOTB, LDS_WS=2*NSLOT*SLOTB, LDS_OST=LDS_WS+NW*64*4, LDS_BYTES=LDS_OST+NW*4096;
constexpr float C2=0.125f*1.4426950408889634f;
__device__ __forceinline__ void glds16(const void*gsrc,unsigned lds_dst){unsigned keep;
  asm volatile("s_mov_b32 %0, m0\n\ts_mov_b32 m0, %2\n\ts_nop 0\n\tglobal_load_lds_dwordx4 %1, off\n\ts_mov_b32 m0, %0":"=&s"(keep):"v"(gsrc),"s"(lds_dst):"memory");}
__device__ __forceinline__ float max3f(float a,float b,float c){float r;asm("v_max3_f32 %0, %1, %2, %3":"=v"(r):"v"(a),"v"(b),"v"(c));return r;}
__device__ __forceinline__ float max2f(float a,float b){float r;asm("v_max_f32_e32 %0, %1, %2":"=v"(r):"v"(a),"v"(b));return r;}
__device__ __forceinline__ float fadd_s(float a,float b){float r;asm("v_add_f32_e32 %0, %1, %2":"=v"(r):"v"(a),"v"(b));return r;}
__device__ __forceinline__ float fsub_s(float a,float b){float r;asm("v_sub_f32_e32 %0, %1, %2":"=v"(r):"v"(a),"v"(b));return r;}
typedef float f32x2_t __attribute__((ext_vector_type(2))); typedef __bf16 bf16x2_t __attribute__((ext_vector_type(2)));
__device__ __forceinline__ unsigned cvtpk_s(float lo,float hi){f32x2_t v={lo,hi};bf16x2_t b=__builtin_convertvector(v,bf16x2_t);return __builtin_bit_cast(unsigned,b);}
#define WAIT_BAR(N) asm volatile("s_waitcnt vmcnt(" #N ") lgkmcnt(0)\n\ts_barrier":::"memory")

__device__ __forceinline__ void qkt(f32x16&p0,f32x16&p1,const char*Kslot,const bf16x8*qr,const f32x16&negm,int r32,int hi){
  const char*kb=Kslot+hi*1024+r32*16;
  #pragma unroll
  for(int d0=0;d0<4;++d0){
    const bf16x8 b0=*reinterpret_cast<const bf16x8*>(kb+d0*2048);
    const bf16x8 b1=*reinterpret_cast<const bf16x8*>(kb+d0*2048+512);
    if(d0==0){p0=__builtin_amdgcn_mfma_f32_32x32x16_bf16(b0,qr[0],negm,0,0,0);p1=__builtin_amdgcn_mfma_f32_32x32x16_bf16(b1,qr[0],negm,0,0,0);}
    else{p0=__builtin_amdgcn_mfma_f32_32x32x16_bf16(b0,qr[d0],p0,0,0,0);p1=__builtin_amdgcn_mfma_f32_32x32x16_bf16(b1,qr[d0],p1,0,0,0);}}
}
typedef __attribute__((address_space(3))) const char* lds_cptr;
typedef short v4i16_t __attribute__((ext_vector_type(4)));
__device__ __forceinline__ void kload8(bf16x8*kf,lds_cptr kp){
  kf[0]=*(const __attribute__((address_space(3))) bf16x8*)(kp);      kf[1]=*(const __attribute__((address_space(3))) bf16x8*)(kp+512);
  kf[2]=*(const __attribute__((address_space(3))) bf16x8*)(kp+2048); kf[3]=*(const __attribute__((address_space(3))) bf16x8*)(kp+2560);
  kf[4]=*(const __attribute__((address_space(3))) bf16x8*)(kp+4096); kf[5]=*(const __attribute__((address_space(3))) bf16x8*)(kp+4608);
  kf[6]=*(const __attribute__((address_space(3))) bf16x8*)(kp+6144); kf[7]=*(const __attribute__((address_space(3))) bf16x8*)(kp+6656);
}
__device__ __forceinline__ void kload2(bf16x8*kf,lds_cptr kp,int j){ kf[2*j]=*(const __attribute__((address_space(3))) bf16x8*)(kp+j*2048); kf[2*j+1]=*(const __attribute__((address_space(3))) bf16x8*)(kp+j*2048+512); }
__device__ __forceinline__ s16x4 vtr(lds_cptr p){ return __builtin_bit_cast(s16x4,__builtin_amdgcn_ds_read_tr16_b64_v4i16((__attribute__((address_space(3))) v4i16_t*)p)); }
__device__ __forceinline__ float rowmax(const f32x16&p0,const f32x16&p1){
  float a=max3f(p0[0],p0[1],p1[0]),b=max3f(p0[2],p0[3],p1[1]);a=max3f(a,p1[2],p1[3]);
  #pragma unroll
  for(int r=4;r<16;r+=4){a=max3f(a,p0[r],p0[r+1]);b=max3f(b,p0[r+2],p0[r+3]);a=max3f(a,p1[r],p1[r+1]);b=max3f(b,p1[r+2],p1[r+3]);}
  const float m=max2f(a,b);
  auto rr=__builtin_amdgcn_permlane32_swap(__float_as_uint(m),__float_as_uint(m),false,false);
  return max2f(__uint_as_float(rr[0]),__uint_as_float(rr[1]));
}
__device__ __forceinline__ void pv(f32x16*o,int vb,bf16x8 pa0,bf16x8 pa1,bf16x8 pa2,bf16x8 pa3){
  #pragma unroll
  for(int d0=0;d0<2;++d0){s16x4 lo[4],hi[4];
    #pragma unroll
    for(int ks=0;ks<4;++ks){
      asm volatile("ds_read_b64_tr_b16 %0,%1 offset:%c2":"=&v"(lo[ks]):"v"(vb),"i"(d0*4096+ks*1024):"memory");
      asm volatile("ds_read_b64_tr_b16 %0,%1 offset:%c2":"=&v"(hi[ks]):"v"(vb),"i"(d0*4096+ks*1024+512):"memory");}
    asm volatile("s_waitcnt lgkmcnt(0)":::"memory");SBAR();
    #define PK(k) (bf16x8){lo[k][0],lo[k][1],lo[k][2],lo[k][3],hi[k][0],hi[k][1],hi[k][2],hi[k][3]}
    o[d0]=__builtin_amdgcn_mfma_f32_32x32x16_bf16(pa0,PK(0),o[d0],0,0,0);
    o[d0]=__builtin_amdgcn_mfma_f32_32x32x16_bf16(pa1,PK(1),o[d0],0,0,0);
    o[d0]=__builtin_amdgcn_mfma_f32_32x32x16_bf16(pa2,PK(2),o[d0],0,0,0);
    o[d0]=__builtin_amdgcn_mfma_f32_32x32x16_bf16(pa3,PK(3),o[d0],0,0,0);
    #undef PK
  }
}

#ifndef ATTN_STORE16
#define ATTN_STORE16(p,v) (*(u32x4*)(p)=(v))
#endif
template<int THRL> __device__ __forceinline__ void attn_unit(int b,int qcol,int kcol,int vcol,int ocol,int qb,const bf16*Q,const bf16* K,const bf16* V,bf16*O,char*shm,int tid){
  const int lane=tid&63,r32=lane&31,hi=lane>>5; const int wid=__builtin_amdgcn_readfirstlane(tid>>6);
  const long rowbase=(long)b*SEQ; const int q0=qb*QB;
  const bf16*Qw=Q+(rowbase+q0+wid*QBLK)*DM+qcol;
  const bf16*Kh=K+rowbase*DM+kcol,*Vh=V+rowbase*DM+vcol;
  const unsigned lds0=(unsigned)(uintptr_t)shm;
  float*wsf=(float*)(shm+LDS_WS)+wid*64;
  const bf16*ksrc=Kh+(long)lane*DM+wid*8;
  const bf16*vsrc=Vh+(long)(16*(wid&3)+(lane>>2))*DM+(wid>>2)*32+(lane&3)*8;
  const unsigned kdst=lds0+LDS_K+wid*1024, vdst=lds0+LDS_V+wid*1024;
  #define DMA_K(t,slot) glds16(ksrc+(long)(t)*KVBLK*DM,(unsigned)__builtin_amdgcn_readfirstlane(kdst+(slot)))
  #define DMA_V(t,slot) glds16(vsrc+(long)(t)*KVBLK*DM,(unsigned)__builtin_amdgcn_readfirstlane(vdst+(slot)))
  const int vb0=(int)(lds0+LDS_V)+((lane>>4)&1)*32+(lane&3)*8+(4*hi+((lane&15)>>2))*64;
  const char*Kbase=shm+LDS_K; bf16x8 kf[8];
  const lds_cptr shm3=(lds_cptr)shm; const lds_cptr kp0=shm3+LDS_K+hi*1024+r32*16; const lds_cptr vp0=shm3+LDS_V+((lane>>4)&1)*32+(lane&3)*8+(4*hi+((lane&15)>>2))*64;
  const int NT=(q0+QB)/KVBLK;
  DMA_K(0,0);DMA_V(0,0);DMA_K(1,SLOTB);
  bf16x8 qr[4];
  #pragma unroll
  for(int d0=0;d0<4;++d0)qr[d0]=*reinterpret_cast<const bf16x8*>(&Qw[(long)r32*DM+d0*16+hi*8]);
  float mhat=0.f,l_reg=0.f;f32x16 o[2];o[0]=f32x16{};o[1]=f32x16{};f32x16 negm=f32x16{};asm volatile("":"+v"(negm));
  const int qrel=wid*QBLK+r32;
  #define CMASK(P0,P1,t) do{int jb_=(t)-(NT-4); if(jb_>=0)cmask(P0,P1,jb_,qrel,hi);}while(0)
  bool resc=false;
  #define START(P0,P1) do{ const float rm=rowmax(P0,P1); resc=false; \
    { const float dl=rm; mhat=fadd_s(mhat,dl); \
      _Pragma("unroll") for(int r=0;r<16;++r){P0[r]=fsub_s(P0[r],dl);P1[r]=fsub_s(P1[r],dl);} \
      _Pragma("unroll") for(int r=0;r<16;++r)negm[r]=-mhat; asm volatile("":"+v"(negm)); } \
    _Pragma("unroll") for(int r=0;r<16;++r)P0[r]=__builtin_amdgcn_exp2f(P0[r]); }while(0)
  #define RESC() do{ if(resc){ asm volatile("s_waitcnt lgkmcnt(0)":::"memory"); \
      _Pragma("unroll") for(int d_=0;d_<2;++d_) _Pragma("unroll") for(int r=0;r<16;++r)o[d_][r]*=wsf[crow(r,hi)]; } }while(0)
  f32x16 pA0,pA1,pB0,pB1;
  int sl_prev=0,sl_cur=0,sl_next=SLOTB;
  #define ROT() do{sl_prev=sl_cur;sl_cur=sl_next;sl_next=(sl_next==(NSLOT-1)*SLOTB)?0:sl_next+SLOTB;}while(0)
  DMA_K(2,2*SLOTB);
  WAIT_BAR(3);
  qkt(pA0,pA1,Kbase,qr,negm,r32,hi);asm volatile("s_nop 15\n\ts_nop 7":"+v"(pA0),"+v"(pA1));CMASK(pA0,pA1,0);
  START(pA0,pA1);
  _Pragma("unroll") for(int r=0;r<16;++r)pA1[r]=__builtin_amdgcn_exp2f(pA1[r]);
  WAIT_BAR(0);
  DMA_K(3,0);DMA_V(1,SLOTB);
  ROT();
  kload8(kf,kp0+sl_cur);
  WAIT_BAR(2);
  s16x4 vlo[8],vhi[8]; u32x4 pw0,pw1,pw2,pw3;
  #define PKW(P,B) cvtpk_s(P[B],P[B+1])
  #define PAF(k) __builtin_bit_cast(bf16x8,pw##k)
  #define VFR(i) (bf16x8){vlo[i][0],vlo[i][1],vlo[i][2],vlo[i][3],vhi[i][0],vhi[i][1],vhi[i][2],vhi[i][3]}
  #define PIN(x) asm volatile("":"+v"(x))
  #define MX3(a,b,c) __builtin_fmaxf(__builtin_fmaxf((a),(b)),(c))
  #define GAPA(MF,A0,A1,A2,A3,W0,W1,PW) do{ MF; sacc+=A0; sacc+=A1; sacc+=A2; sacc+=A3; PIN(sacc); W0; W1; PIN(PW); SBAR(); }while(0)
  #define EX(v) __builtin_amdgcn_exp2f(v)
  #define GAPB(MF,X,B) do{ MF; X[B]=EX(X[B]); X[B+1]=EX(X[B+1]); X[B+2]=EX(X[B+2]); X[B+3]=EX(X[B+3]); PIN(X); SBAR(); }while(0)
  #define VRD(i) do{ vlo[i]=vtr(vp_+(((i)>>2)*4096+((i)&3)*1024)); vhi[i]=vtr(vp_+(((i)>>2)*4096+((i)&3)*1024+512)); }while(0)
  #define KRD(G,j) do{ if(G){ kload2(kf,kp0+sl_next,j); SBAR(); } }while(0)
  #define STEP(C0,C1,P0,P1,t,GK,GV,GL) do{ SBAR(); \
    const lds_cptr vp_=vp0+sl_prev; \
    VRD(0); SBAR(); float sacc=(P0[0]+P0[1]); \
    GAPA(C0=__builtin_amdgcn_mfma_f32_32x32x16_bf16(kf[0],qr[0],negm,0,0,0), P0[2],P0[3],P0[4],P0[5],     pw0[0]=PKW(P0,0), pw0[1]=PKW(P0,2), pw0); \
    VRD(4); SBAR(); GAPA(C1=__builtin_amdgcn_mfma_f32_32x32x16_bf16(kf[1],qr[0],negm,0,0,0), P0[6],P0[7],P0[8],P0[9],     pw0[2]=PKW(P0,4), pw0[3]=PKW(P0,6), pw0); \
    VRD(1); SBAR(); GAPA(C0=__builtin_amdgcn_mfma_f32_32x32x16_bf16(kf[2],qr[1],C0,0,0,0),   P0[10],P0[11],P0[12],P0[13], pw1[0]=PKW(P0,8), pw1[1]=PKW(P0,10), pw1); \
    VRD(5); SBAR(); GAPA(C1=__builtin_amdgcn_mfma_f32_32x32x16_bf16(kf[3],qr[1],C1,0,0,0),   P0[14],P0[15],P1[0],P1[1],   pw1[2]=PKW(P0,12),pw1[3]=PKW(P0,14), pw1); \
    VRD(2); SBAR(); GAPA(C0=__builtin_amdgcn_mfma_f32_32x32x16_bf16(kf[4],qr[2],C0,0,0,0),   P1[2],P1[3],P1[4],P1[5],     pw2[0]=PKW(P1,0), pw2[1]=PKW(P1,2), pw2); \
    VRD(6); SBAR(); GAPA(C1=__builtin_amdgcn_mfma_f32_32x32x16_bf16(kf[5],qr[2],C1,0,0,0),   P1[6],P1[7],P1[8],P1[9],     pw2[2]=PKW(P1,4), pw2[3]=PKW(P1,6), pw2); \
    VRD(3); SBAR(); GAPA(C0=__builtin_amdgcn_mfma_f32_32x32x16_bf16(kf[6],qr[3],C0,0,0,0),   P1[10],P1[11],P1[12],P1[13], pw3[0]=PKW(P1,8), pw3[1]=PKW(P1,10), pw3); \
    VRD(7); SBAR(); GAPA(C1=__builtin_amdgcn_mfma_f32_32x32x16_bf16(kf[7],qr[3],C1,0,0,0),   P1[14],P1[15],0.f,0.f,       pw3[2]=PKW(P1,12),pw3[3]=PKW(P1,14), pw3); \
    l_reg+=sacc; \
    if(GK){DMA_K((t)+3,sl_cur);} if(GV){DMA_V((t)+1,sl_next);} \
    CMASK(C0,C1,t); \
    { float a=MX3(C0[0],C0[1],C1[0]),b=MX3(C0[2],C0[3],C1[1]); a=MX3(a,C1[2],C1[3]); \
      _Pragma("unroll") for(int r=4;r<16;r+=4){a=MX3(a,C0[r],C0[r+1]);b=MX3(b,C0[r+2],C0[r+3]);a=MX3(a,C1[r],C1[r+1]);b=MX3(b,C1[r+2],C1[r+3]);} \
      float rm=__builtin_fmaxf(a,b); { auto rr=__builtin_amdgcn_permlane32_swap(__float_as_uint(rm),__float_as_uint(rm),false,false); rm=__builtin_fmaxf(__uint_as_float(rr[0]),__uint_as_float(rr[1])); } \
      resc=false; \
      if(__builtin_expect(__any(rm>(float)THRL),0)){ const float dl=__builtin_fmaxf(rm,0.f); mhat+=dl; \
        _Pragma("unroll") for(int r=0;r<16;++r){C0[r]-=dl;C1[r]-=dl;} \
        _Pragma("unroll") for(int r=0;r<16;++r)negm[r]=-mhat; asm volatile("":"+v"(negm)); \
        const float f=__builtin_amdgcn_exp2f(-dl); l_reg*=f; if(hi==0)wsf[r32]=f; resc=true; } } \
    SBAR(); \
    GAPB(o[0]=__builtin_amdgcn_mfma_f32_32x32x16_bf16(PAF(0),VFR(0),o[0],0,0,0), C0,0); \
    GAPB(o[1]=__builtin_amdgcn_mfma_f32_32x32x16_bf16(PAF(0),VFR(4),o[1],0,0,0), C0,4); \
    KRD(GL,0); GAPB(o[0]=__builtin_amdgcn_mfma_f32_32x32x16_bf16(PAF(1),VFR(1),o[0],0,0,0), C0,8); \
    KRD(GL,1); GAPB(o[1]=__builtin_amdgcn_mfma_f32_32x32x16_bf16(PAF(1),VFR(5),o[1],0,0,0), C0,12); \
    KRD(GL,2); GAPB(o[0]=__builtin_amdgcn_mfma_f32_32x32x16_bf16(PAF(2),VFR(2),o[0],0,0,0), C1,0); \
    KRD(GL,3); GAPB(o[1]=__builtin_amdgcn_mfma_f32_32x32x16_bf16(PAF(2),VFR(6),o[1],0,0,0), C1,4); \
    GAPB(o[0]=__builtin_amdgcn_mfma_f32_32x32x16_bf16(PAF(3),VFR(3),o[0],0,0,0), C1,8); \
    GAPB(o[1]=__builtin_amdgcn_mfma_f32_32x32x16_bf16(PAF(3),VFR(7),o[1],0,0,0), C1,12); \
    }while(0)
  int t=1;
  #undef CMASK
  #define CMASK(P0,P1,t) do{}while(0)
  for(;t+5<NT;t+=2){
    STEP(pB0,pB1,pA0,pA1,t,true,true,true);     WAIT_BAR(2); RESC(); ROT();
    STEP(pA0,pA1,pB0,pB1,t+1,true,true,true);   WAIT_BAR(2); RESC(); ROT();
  }
  #undef CMASK
  #define CMASK(P0,P1,t) do{int jb_=(t)-(NT-4); if(jb_>=0)cmask(P0,P1,jb_,qrel,hi);}while(0)
  #define ENDW(tt) do{ if((tt)+3<NT){WAIT_BAR(2);} else if((tt)+2<NT){WAIT_BAR(1);} else {WAIT_BAR(0);} }while(0)
  for(;t+1<NT;t+=2){
    STEP(pB0,pB1,pA0,pA1,t,(t+3<NT),(t+1<NT),(t+1<NT));       ENDW(t);   RESC(); ROT();
    STEP(pA0,pA1,pB0,pB1,t+1,(t+4<NT),(t+2<NT),(t+2<NT));     ENDW(t+1); RESC(); ROT();
  }
  STEP(pB0,pB1,pA0,pA1,NT-1,false,false,false); RESC();
  { float sacc=pB0[0]+pB0[1]; _Pragma("unroll") for(int r=2;r<16;++r)sacc+=pB0[r]; _Pragma("unroll") for(int r=0;r<16;++r)sacc+=pB1[r]; l_reg+=sacc;
    pw0=(u32x4){PKW(pB0,0),PKW(pB0,2),PKW(pB0,4),PKW(pB0,6)};pw1=(u32x4){PKW(pB0,8),PKW(pB0,10),PKW(pB0,12),PKW(pB0,14)};pw2=(u32x4){PKW(pB1,0),PKW(pB1,2),PKW(pB1,4),PKW(pB1,6)};pw3=(u32x4){PKW(pB1,8),PKW(pB1,10),PKW(pB1,12),PKW(pB1,14)};
    SBAR(); pv(o,vb0+sl_cur,PAF(0),PAF(1),PAF(2),PAF(3)); }
  #undef PKW
  #undef PAF
  #undef VFR
  #undef PIN
  #undef MX3
  #undef GAPA
  #undef GAPB
  #undef EX
  #undef VRD
  #undef KRD
  #undef STEP
  #undef ENDW
  {auto rr=__builtin_amdgcn_permlane32_swap(__float_as_uint(l_reg),__float_as_uint(l_reg),false,false);l_reg=__uint_as_float(rr[0])+__uint_as_float(rr[1]);}
  if(hi==0)wsf[32+r32]=l_reg;asm volatile("s_waitcnt lgkmcnt(0)":::"memory");
  float rli[16];
  #pragma unroll
  for(int r=0;r<16;++r)rli[r]=__builtin_amdgcn_rcpf(wsf[32+crow(r,hi)]);
  bf16*Ow=O+(rowbase+q0+wid*QBLK)*DM+ocol;
  { bf16*stg=(bf16*)(shm+LDS_OST)+wid*2048;
    #pragma unroll
    for(int r=0;r<16;++r){const int orow=crow(r,hi);
      #pragma unroll
      for(int d0=0;d0<2;++d0)stg[orow*64+d0*32+r32]=__float2bfloat16(o[d0][r]*rli[r]);}
    asm volatile("s_waitcnt lgkmcnt(0)":::"memory");
    #pragma unroll
    for(int i=0;i<4;++i){const int row=i*8+(lane>>3),ch=lane&7; const u32x4 v=*(const u32x4*)(stg+row*64+ch*8); ATTN_STORE16(Ow+(long)row*DM+ch*8,v);} }
  asm volatile("s_waitcnt lgkmcnt(0)\n\ts_barrier":::"memory");
  #undef DMA_K
  #undef DMA_V
  #undef CMASK
  #undef START
  #undef RESC
  #undef ROT
}
constexpr int ATTN_LDS_BYTES=LDS_BYTES;
struct AttnTensors { const bf16* Q; const bf16* K; const bf16* V; bf16* O0; bf16* O1; };
struct AttnUnit { int b, qcol, kcol, vcol, ocol, m, qb; };
struct StaticOrder {
  int vcu, G;
  __device__ __forceinline__ StaticOrder(int grid,int vcu_):vcu(vcu_),G(grid){}
  __device__ __forceinline__ bool next(int i,AttnUnit&u)const{
    int b,h,m,vhalf,qb;
    if(G==256){ if(i>=32)return false; const int xcd=vcu>>5,l=vcu&31,vh=l&3,qs=l>>2,bh=xcd*16+(i>>1); b=bh>>3; h=bh&7; m=(vh>>1)&1; vhalf=vh&1; qb=(i&1)?qs:15-qs; }
    else { const int ci=vcu+G*(i>>4); if(ci>=BATCH*32)return false; const int vh=ci&31; h=vh>>2; m=(vh>>1)&1; vhalf=vh&1; b=ci>>5; qb=15-(i&15); }
    u.b=b; u.qcol=(2*h+m)*64; u.kcol=u.qcol; u.vcol=h*128+vhalf*64; u.ocol=u.vcol; u.m=m; u.qb=qb; return true; }
  __device__ __forceinline__ void a_ready(const AttnUnit&)const{}
  __device__ __forceinline__ void done(const AttnUnit&)const{}
};
template<class Sched,int THRL=8> __device__ __forceinline__ void attn_phase(char*lds,const AttnTensors&T,const Sched&S,const int tid_){
  AttnUnit u;
  for(int i=0;S.next(i,u);++i){ S.a_ready(u); attn_unit<THRL>(u.b,u.qcol,u.kcol,u.vcol,u.ocol,u.qb,T.Q,T.K,T.V,u.m?T.O1:T.O0,lds,tid_); S.done(u); }
}
constexpr int VSLOTB=16384;
constexpr int WL_K=0, WL_V=NSLOT*SLOTB, WL_WS=WL_V+NSLOT*VSLOTB, WL_Q=WL_WS+NW*64*4, WL_OST=WL_Q+NW*4096, WL_BYTES=WL_OST+NW*4096;
__device__ __forceinline__ void cmask2(f32x16&p0,f32x16&p1,int jb,int qrel,int hi){
  const float NEG=-INFINITY; const int qq=qrel-64*jb-4*hi;
  #pragma unroll
  for(int r=0;r<16;++r){const int c=(r&3)+8*(r>>2); if(c>qq)p0[r]=NEG; if(c+32>qq)p1[r]=NEG;}
}
__device__ __forceinline__ void pv4(f32x16*o,int vb,bf16x8 pa0,bf16x8 pa1,bf16x8 pa2,bf16x8 pa3){
  #pragma unroll
  for(int d0=0;d0<4;++d0){s16x4 lo[4],hi[4];
    #pragma unroll
    for(int ks=0;ks<4;++ks){
      asm volatile("ds_read_b64_tr_b16 %0,%1 offset:%c2":"=&v"(lo[ks]):"v"(vb),"i"(d0*4096+ks*1024):"memory");
      asm volatile("ds_read_b64_tr_b16 %0,%1 offset:%c2":"=&v"(hi[ks]):"v"(vb),"i"(d0*4096+ks*1024+512):"memory");}
    asm volatile("s_waitcnt lgkmcnt(0)":::"memory");SBAR();
    #define PK(k) (bf16x8){lo[k][0],lo[k][1],lo[k][2],lo[k][3],hi[k][0],hi[k][1],hi[k][2],hi[k][3]}
    o[d0]=__builtin_amdgcn_mfma_f32_32x32x16_bf16(pa0,PK(0),o[d0],0,0,0);
    o[d0]=__builtin_amdgcn_mfma_f32_32x32x16_bf16(pa1,PK(1),o[d0],0,0,0);
    o[d0]=__builtin_amdgcn_mfma_f32_32x32x16_bf16(pa2,PK(2),o[d0],0,0,0);
    o[d0]=__builtin_amdgcn_mfma_f32_32x32x16_bf16(pa3,PK(3),o[d0],0,0,0);
    #undef PK
  }
}
using f32x4_t=__attribute__((ext_vector_type(4)))float;
struct CombineW { const bf16* O0; bf16* A2; const float* w; float lam, mul; };
template<int THRL> __device__ __forceinline__ void attn_unit_w(int b,int qcol,int vcol,int qb,int m,const bf16*Q,const bf16* K,const bf16* V,bf16*O,const CombineW&CB,char*shm,int tid){
  const int lane=tid&63,r32=lane&31,hi=lane>>5; const int wid=__builtin_amdgcn_readfirstlane(tid>>6);
  const long rowbase=(long)b*SEQ; const int q0=qb*QB;
  int hi4=4*hi; asm volatile("":"+v"(hi4));
  #define CROWO(r) (((r)&3)+8*((r)>>2)+hi4)
  const bf16*Qw=Q+(rowbase+q0+wid*QBLK)*DM+qcol;
  const bf16*Kh=K+rowbase*DM+qcol,*Vh=V+rowbase*DM+vcol;
  const unsigned lds0=(unsigned)(uintptr_t)shm;
  float*wsf=(float*)(shm+WL_WS)+wid*64;
  const bf16*ksrc=Kh+(long)lane*DM+wid*8;
  const bf16*vsrc=Vh+(long)(16*(wid&3)+(lane>>2))*DM+(wid>>2)*32+(lane&3)*8;
  const unsigned kdst=lds0+WL_K+wid*1024, vdst=lds0+WL_V+wid*1024;
  #define DMA_K(t,slot) glds16(ksrc+(long)(t)*KVBLK*DM,(unsigned)__builtin_amdgcn_readfirstlane(kdst+(slot)))
  #define DMA_V(t,slot) do{ glds16(vsrc+(long)(t)*KVBLK*DM,(unsigned)__builtin_amdgcn_readfirstlane(vdst+2*(slot))); glds16(vsrc+(long)(t)*KVBLK*DM+64,(unsigned)__builtin_amdgcn_readfirstlane(vdst+2*(slot)+8192)); }while(0)
  const int vb0=(int)(lds0+WL_V)+((lane>>4)&1)*32+(lane&3)*8+(4*hi+((lane&15)>>2))*64;
  const char*Kbase=shm+WL_K; bf16x8 kf[8];
  const lds_cptr shm3=(lds_cptr)shm; const lds_cptr kp0=shm3+WL_K+hi*1024+r32*16; const lds_cptr vp0=shm3+WL_V+((lane>>4)&1)*32+(lane&3)*8+(4*hi+((lane&15)>>2))*64;
  const lds_cptr qp=shm3+WL_Q+wid*4096+lane*16;
  const int NT=(q0+QB)/KVBLK;
  DMA_K(0,0);DMA_V(0,0);DMA_K(1,SLOTB);
  bf16x8 qr[4];
  #pragma unroll
  for(int d0=0;d0<4;++d0)qr[d0]=*reinterpret_cast<const bf16x8*>(&Qw[(long)r32*DM+d0*16+hi*8]);
  #pragma unroll
  for(int d0=0;d0<4;++d0)*(__attribute__((address_space(3))) bf16x8*)(qp+d0*1024)=qr[d0];
  float mhat=0.f,l_reg=0.f;f32x16 o[4];o[0]=f32x16{};o[1]=f32x16{};o[2]=f32x16{};o[3]=f32x16{};
  const f32x16 zero16=f32x16{};
  const int qrel=wid*QBLK+r32;
  #define CMASK(P0,P1,t) do{int jb_=(t)-(NT-4); if(jb_>=0)cmask2(P0,P1,jb_,qrel,hi);}while(0)
  bool resc=false;
  #define START(P0,P1) do{ const float rm=rowmax(P0,P1); resc=false; \
    { const float dl=rm; mhat=fadd_s(mhat,dl); \
      _Pragma("unroll") for(int r=0;r<16;++r){P0[r]=fsub_s(P0[r],dl);P1[r]=fsub_s(P1[r],dl);} } \
    _Pragma("unroll") for(int r=0;r<16;++r)P0[r]=__builtin_amdgcn_exp2f(P0[r]); }while(0)
  #define RESC() do{ if(resc){ asm volatile("s_waitcnt lgkmcnt(0)":::"memory"); \
      _Pragma("unroll") for(int d_=0;d_<4;++d_) _Pragma("unroll") for(int r=0;r<16;++r)o[d_][r]*=wsf[CROWO(r)]; } }while(0)
  f32x16 pA0,pA1,pB0,pB1;
  int sl_prev=0,sl_cur=0,sl_next=SLOTB;
  #define ROT() do{sl_prev=sl_cur;sl_cur=sl_next;sl_next=(sl_next==(NSLOT-1)*SLOTB)?0:sl_next+SLOTB;}while(0)
  DMA_K(2,2*SLOTB);
  WAIT_BAR(3);
  qkt(pA0,pA1,Kbase,qr,zero16,r32,hi);asm volatile("s_nop 15\n\ts_nop 7":"+v"(pA0),"+v"(pA1));CMASK(pA0,pA1,0);
  START(pA0,pA1);
  _Pragma("unroll") for(int r=0;r<16;++r)pA1[r]=__builtin_amdgcn_exp2f(pA1[r]);
  WAIT_BAR(0);
  DMA_K(3,0);DMA_V(1,SLOTB);
  ROT();
  kload8(kf,kp0+sl_cur);
  WAIT_BAR(3);
  s16x4 vlo[16],vhi[16]; u32x4 pw0,pw1,pw2,pw3;
  #define PKW(P,B) cvtpk_s(P[B],P[B+1])
  #define PAF(k) __builtin_bit_cast(bf16x8,pw##k)
  #define VFR(i) (bf16x8){vlo[i][0],vlo[i][1],vlo[i][2],vlo[i][3],vhi[i][0],vhi[i][1],vhi[i][2],vhi[i][3]}
  #define PIN(x) asm volatile("":"+v"(x))
  #define MX3(a,b,c) __builtin_fmaxf(__builtin_fmaxf((a),(b)),(c))
  #define GAPA(MF,A0,A1,A2,A3,W0,W1,PW) do{ MF; sacc+=A0; sacc+=A1; sacc+=A2; sacc+=A3; PIN(sacc); W0; W1; PIN(PW); SBAR(); }while(0)
  #define EX(v) __builtin_amdgcn_exp2f(v)
  #define GAPB(MF,X,B) do{ MF; X[B]=EX(X[B]); X[B+1]=EX(X[B+1]); PIN(X); SBAR(); }while(0)
  #define VRD(i) do{ vlo[i]=vtr(vp_+(((i)>>2)*4096+((i)&3)*1024)); vhi[i]=vtr(vp_+(((i)>>2)*4096+((i)&3)*1024+512)); }while(0)
  #define KRD(G,j) do{ if(G){ kload2(kf,kp0+sl_next,j); SBAR(); } }while(0)
  #define QRD(d) (*(const __attribute__((address_space(3))) bf16x8*)(qp+(d)*1024))
  #define MF32(a_,b_,c_) __builtin_amdgcn_mfma_f32_32x32x16_bf16(a_,b_,c_,0,0,0)
  #define STEP(C0,C1,P0,P1,t,GK,GV,GL) do{ SBAR(); \
    const lds_cptr vp_=vp0+2*sl_prev; bf16x8 q0_,q1_,q2_,q3_; \
    q0_=QRD(0); VRD(0); SBAR(); float sacc=(P0[0]+P0[1]); \
    GAPA(C0=MF32(kf[0],q0_,zero16), P0[2],P0[3],P0[4],P0[5],     pw0[0]=PKW(P0,0), pw0[1]=PKW(P0,2), pw0); \
    q1_=QRD(1); SBAR(); GAPA(C1=MF32(kf[1],q0_,zero16), P0[6],P0[7],P0[8],P0[9],     pw0[2]=PKW(P0,4), pw0[3]=PKW(P0,6), pw0); \
    VRD(4); SBAR(); GAPA(C0=MF32(kf[2],q1_,C0),   P0[10],P0[11],P0[12],P0[13], pw1[0]=PKW(P0,8), pw1[1]=PKW(P0,10), pw1); \
    q2_=QRD(2); SBAR(); GAPA(C1=MF32(kf[3],q1_,C1),   P0[14],P0[15],P1[0],P1[1],   pw1[2]=PKW(P0,12),pw1[3]=PKW(P0,14), pw1); \
    VRD(8); SBAR(); GAPA(C0=MF32(kf[4],q2_,C0),   P1[2],P1[3],P1[4],P1[5],     pw2[0]=PKW(P1,0), pw2[1]=PKW(P1,2), pw2); \
    q3_=QRD(3); SBAR(); GAPA(C1=MF32(kf[5],q2_,C1),   P1[6],P1[7],P1[8],P1[9],     pw2[2]=PKW(P1,4), pw2[3]=PKW(P1,6), pw2); \
    VRD(12); SBAR(); GAPA(C0=MF32(kf[6],q3_,C0),   P1[10],P1[11],P1[12],P1[13], pw3[0]=PKW(P1,8), pw3[1]=PKW(P1,10), pw3); \
    GAPA(C1=MF32(kf[7],q3_,C1),   P1[14],P1[15],0.f,0.f,       pw3[2]=PKW(P1,12),pw3[3]=PKW(P1,14), pw3); \
    l_reg+=sacc; \
    if(GK){DMA_K((t)+3,sl_cur);} if(GV){DMA_V((t)+1,sl_next);} \
    CMASK(C0,C1,t); \
    { float a=MX3(C0[0],C0[1],C1[0]),b=MX3(C0[2],C0[3],C1[1]); a=MX3(a,C1[2],C1[3]); \
      _Pragma("unroll") for(int r=4;r<16;r+=4){a=MX3(a,C0[r],C0[r+1]);b=MX3(b,C0[r+2],C0[r+3]);a=MX3(a,C1[r],C1[r+1]);b=MX3(b,C1[r+2],C1[r+3]);} \
      float rm=__builtin_fmaxf(a,b); { auto rr=__builtin_amdgcn_permlane32_swap(__float_as_uint(rm),__float_as_uint(rm),false,false); rm=__builtin_fmaxf(__uint_as_float(rr[0]),__uint_as_float(rr[1])); } \
      rm-=mhat; resc=false; \
      if(__builtin_expect(__any(rm>(float)THRL),0)){ const float dl=__builtin_fmaxf(rm,0.f); mhat+=dl; \
        const float f=__builtin_amdgcn_exp2f(-dl); l_reg*=f; if(hi==0)wsf[r32]=f; resc=true; } \
      _Pragma("unroll") for(int r=0;r<16;++r){C0[r]-=mhat;C1[r]-=mhat;} } \
    SBAR(); \
    VRD(1);  GAPB(o[0]=MF32(PAF(0),VFR(0), o[0]), C0,0); \
    VRD(5);  GAPB(o[1]=MF32(PAF(0),VFR(4), o[1]), C0,2); \
    VRD(9);  GAPB(o[2]=MF32(PAF(0),VFR(8), o[2]), C0,4); \
    VRD(13); GAPB(o[3]=MF32(PAF(0),VFR(12),o[3]), C0,6); \
    VRD(2);  KRD(GL,0); GAPB(o[0]=MF32(PAF(1),VFR(1), o[0]), C0,8); \
    VRD(6);  GAPB(o[1]=MF32(PAF(1),VFR(5), o[1]), C0,10); \
    VRD(10); KRD(GL,1); GAPB(o[2]=MF32(PAF(1),VFR(9), o[2]), C0,12); \
    VRD(14); GAPB(o[3]=MF32(PAF(1),VFR(13),o[3]), C0,14); \
    VRD(3);  KRD(GL,2); GAPB(o[0]=MF32(PAF(2),VFR(2), o[0]), C1,0); \
    VRD(7);  GAPB(o[1]=MF32(PAF(2),VFR(6), o[1]), C1,2); \
    VRD(11); KRD(GL,3); GAPB(o[2]=MF32(PAF(2),VFR(10),o[2]), C1,4); \
    VRD(15); GAPB(o[3]=MF32(PAF(2),VFR(14),o[3]), C1,6); \
    GAPB(o[0]=MF32(PAF(3),VFR(3), o[0]), C1,8); \
    GAPB(o[1]=MF32(PAF(3),VFR(7), o[1]), C1,10); \
    GAPB(o[2]=MF32(PAF(3),VFR(11),o[2]), C1,12); \
    GAPB(o[3]=MF32(PAF(3),VFR(15),o[3]), C1,14); \
    }while(0)
  int t=1;
  #undef CMASK
  #define CMASK(P0,P1,t) do{}while(0)
  for(;t+5<NT;t+=2){
    STEP(pB0,pB1,pA0,pA1,t,true,true,true);     WAIT_BAR(3); RESC(); ROT();
    STEP(pA0,pA1,pB0,pB1,t+1,true,true,true);   WAIT_BAR(3); RESC(); ROT();
  }
  #undef CMASK
  #define CMASK(P0,P1,t) do{int jb_=(t)-(NT-4); if(jb_>=0)cmask2(P0,P1,jb_,qrel,hi);}while(0)
  #define ENDW(tt) do{ if((tt)+3<NT){WAIT_BAR(3);} else if((tt)+2<NT){WAIT_BAR(2);} else {WAIT_BAR(0);} }while(0)
  for(;t+1<NT;t+=2){
    STEP(pB0,pB1,pA0,pA1,t,(t+3<NT),(t+1<NT),(t+1<NT));       ENDW(t);   RESC(); ROT();
    STEP(pA0,pA1,pB0,pB1,t+1,(t+4<NT),(t+2<NT),(t+2<NT));     ENDW(t+1); RESC(); ROT();
  }
  STEP(pB0,pB1,pA0,pA1,NT-1,false,false,false); RESC();
  u32x4 a0v[2][4];
  if(m==1){ const bf16*O0p=CB.O0+(rowbase+q0+wid*QBLK)*DM+vcol;
    #pragma unroll
    for(int half=0;half<2;++half)
      #pragma unroll
      for(int i=0;i<4;++i)a0v[half][i]=*(const u32x4*)(O0p+(long)(i*8+(lane>>3))*DM+half*64+(lane&7)*8);
    asm volatile("":::"memory"); }
  { float sacc=pB0[0]+pB0[1]; _Pragma("unroll") for(int r=2;r<16;++r)sacc+=pB0[r]; _Pragma("unroll") for(int r=0;r<16;++r)sacc+=pB1[r]; l_reg+=sacc;
    pw0=(u32x4){PKW(pB0,0),PKW(pB0,2),PKW(pB0,4),PKW(pB0,6)};pw1=(u32x4){PKW(pB0,8),PKW(pB0,10),PKW(pB0,12),PKW(pB0,14)};pw2=(u32x4){PKW(pB1,0),PKW(pB1,2),PKW(pB1,4),PKW(pB1,6)};pw3=(u32x4){PKW(pB1,8),PKW(pB1,10),PKW(pB1,12),PKW(pB1,14)};
    SBAR(); pv4(o,vb0+2*sl_cur,PAF(0),PAF(1),PAF(2),PAF(3)); }
  #undef PKW
  #undef PAF
  #undef VFR
  #undef PIN
  #undef MX3
  #undef GAPA
  #undef GAPB
  #undef EX
  #undef VRD
  #undef KRD
  #undef QRD
  #undef MF32
  #undef STEP
  #undef ENDW
  {auto rr=__builtin_amdgcn_permlane32_swap(__float_as_uint(l_reg),__float_as_uint(l_reg),false,false);l_reg=__uint_as_float(rr[0])+__uint_as_float(rr[1]);}
  if(hi==0)wsf[32+r32]=l_reg;asm volatile("s_waitcnt lgkmcnt(0)":::"memory");
  float rli[16];
  #pragma unroll
  for(int r=0;r<16;++r)rli[r]=__builtin_amdgcn_rcpf(wsf[32+CROWO(r)]);
  const long obase=(rowbase+q0+wid*QBLK)*DM+vcol;
  bf16*stg=(bf16*)(shm+WL_OST)+wid*2048;
  if(m==0){ bf16*Ow=O+obase;
    #pragma unroll
    for(int half=0;half<2;++half){
      #pragma unroll
      for(int r=0;r<16;++r){const int orow=CROWO(r);
        #pragma unroll
        for(int d0=0;d0<2;++d0)stg[orow*64+d0*32+r32]=__float2bfloat16(o[2*half+d0][r]*rli[r]);}
      asm volatile("s_waitcnt lgkmcnt(0)":::"memory");
      #pragma unroll
      for(int i=0;i<4;++i){const int row=i*8+(lane>>3),ch=lane&7; const u32x4 v=*(const u32x4*)(stg+row*64+ch*8); ATTN_STORE16(Ow+(long)row*DM+half*64+ch*8,v);}
      asm volatile("s_waitcnt lgkmcnt(0)":::"memory"); }
  } else {
    bf16*Aw=CB.A2+obase; const float lam=CB.lam;
    float df[2][4][8]; float ssq[4]={0.f,0.f,0.f,0.f};
    #pragma unroll
    for(int half=0;half<2;++half){
      u32x4 a[4];
      #pragma unroll
      for(int i=0;i<4;++i)a[i]=a0v[half][i];
      #pragma unroll
      for(int r=0;r<16;++r){const int orow=CROWO(r);
        #pragma unroll
        for(int d0=0;d0<2;++d0)stg[orow*64+d0*32+r32]=__float2bfloat16(o[2*half+d0][r]*rli[r]);}
      asm volatile("s_waitcnt lgkmcnt(0)":::"memory");
      #pragma unroll
      for(int i=0;i<4;++i){const int row=i*8+(lane>>3),ch=lane&7; const u32x4 v=*(const u32x4*)(stg+row*64+ch*8);
        #pragma unroll
        for(int k=0;k<4;++k){ const float d0_=__uint_as_float(a[i][k]<<16)-lam*__uint_as_float(v[k]<<16), d1_=__uint_as_float(a[i][k]&0xffff0000u)-lam*__uint_as_float(v[k]&0xffff0000u);
          df[half][i][2*k]=d0_; df[half][i][2*k+1]=d1_; ssq[i]+=d0_*d0_; ssq[i]+=d1_*d1_; } }
      asm volatile("s_waitcnt lgkmcnt(0)":::"memory"); }
    #pragma unroll
    for(int i=0;i<4;++i){ float ss=ssq[i];
      ss+=__builtin_bit_cast(float,__builtin_amdgcn_update_dpp(0,__builtin_bit_cast(int,ss),0xB1,0xF,0xF,true));
      ss+=__builtin_bit_cast(float,__builtin_amdgcn_update_dpp(0,__builtin_bit_cast(int,ss),0x4E,0xF,0xF,true));
      ss+=__builtin_bit_cast(float,__builtin_amdgcn_update_dpp(0,__builtin_bit_cast(int,ss),0x141,0xF,0xF,true));
      ssq[i]=1.0f/sqrtf(ss*(1.0f/128.0f)+1e-5f); }
    #pragma unroll
    for(int half=0;half<2;++half){ const int ch=lane&7;
      const f32x4_t w0=*(const f32x4_t*)(CB.w+half*64+ch*8),w1=*(const f32x4_t*)(CB.w+half*64+ch*8+4);
      #pragma unroll
      for(int i=0;i<4;++i){const int row=i*8+(lane>>3); const float rs=ssq[i]; u32x4 ov;
        #pragma unroll
        for(int k=0;k<4;++k){ const float wa=(k<2?w0[2*k]:w1[2*k-4])*CB.mul, wb=(k<2?w0[2*k+1]:w1[2*k-3])*CB.mul; ov[k]=cvtpk_s(df[half][i][2*k]*rs*wa,df[half][i][2*k+1]*rs*wb); }
        ATTN_STORE16(Aw+(long)row*DM+half*64+ch*8,ov);} }
  }
  asm volatile("s_waitcnt lgkmcnt(0)\n\ts_barrier":::"memory");
  #undef DMA_K
  #undef DMA_V
  #undef CMASK
  #undef START
  #undef RESC
  #undef ROT
  #undef CROWO
}
constexpr int ATTNW_LDS_BYTES=WL_BYTES;
struct AttnUnitW { int b, qcol, vcol, m, qb; };
struct StaticOrderW {
  int vcu, G;
  __device__ __forceinline__ StaticOrderW(int grid,int vcu_):vcu(vcu_),G(grid){}
  __device__ __forceinline__ bool next(int i,AttnUnitW&u)const{
    int b,h,m,qb;
    if(G==256){ if(i>=16)return false; const int xcd=vcu>>5,l=vcu&31,s=l>>1,ip=i>>1,bh=xcd*16+8*(l&1)+ip; m=i&1; b=bh>>3; h=bh&7; qb=(ip&1)?s:15-s; }
    else { const int i2=i>>1,ci=vcu+G*(i2>>4); if(ci>=BATCH*8)return false; h=ci&7; m=i&1; b=ci>>3; qb=15-(i2&15); }
    u.b=b; u.qcol=(2*h+m)*64; u.vcol=h*128; u.m=m; u.qb=qb; return true; }
};
template<int THRL=8> __device__ __forceinline__ void attn_phase_w(char*lds,const AttnTensors&T,const StaticOrderW&S,const CombineW&CB,const int tid_){
  AttnUnitW u;
  for(int i=0;S.next(i,u);++i){ attn_unit_w<THRL>(u.b,u.qcol,u.vcol,u.qb,u.m,T.Q,T.K,T.V,T.O0,CB,lds,tid_); }
}
#undef SBAR
#undef WAIT_BAR
}

constexpr int NWAVES = 8;
constexpr int BATCH = 16, SEQ = 4096, D = 1024, M = BATCH * SEQ, DEPTH = 4;
constexpr int NEXP = 32, FF = 512;
constexpr int NSLOT_MAX = 2 * M + NEXP * 256, NBLK_MAX = NSLOT_MAX / 256;
constexpr float LN_EPS = 1e-5f;
constexpr float DN_ALPHA = 1.681792830507429f;
constexpr int HG_CHUNK = 32, HG_NCH = SEQ / HG_CHUNK;

constexpr size_t MiB = 1u << 20;
constexpr size_t WS_CTL = 0, CTL_ZERO_BYTES = 1 * MiB;
constexpr size_t WS_MOD = 1 * MiB;
constexpr size_t WS_ROPE_C = 3 * MiB, WS_ROPE_S = 3 * MiB + 512 * 1024;
constexpr size_t WS_RT = 4 * MiB;
constexpr size_t WS_EID = 5 * MiB;
constexpr size_t WS_WT = 5 * MiB + 512 * 1024;
constexpr size_t WS_TSLOT = 6 * MiB;
constexpr size_t WS_SLOTW = 6 * MiB + 512 * 1024;
constexpr size_t WS_BLKE = 7 * MiB + 128 * 1024;
constexpr size_t WS_STOK = 7 * MiB + 256 * 1024;
constexpr size_t WS_HGD = 8 * MiB;
constexpr size_t WS_WHIN = 16 * MiB;
constexpr size_t WS_WAIN = 32 * MiB;
constexpr size_t WS_WHOUT = 44 * MiB;
constexpr size_t WS_WAOUT = 48 * MiB;
constexpr size_t WS_W13 = 52 * MiB;
constexpr size_t WS_W2 = 116 * MiB;
constexpr size_t WS_BUF0 = 148 * MiB, BUFSZ = 128 * MiB;
constexpr size_t WS_WB2 = WS_BUF0 + 7 * BUFSZ;
constexpr size_t WS_END = WS_WB2 + 96 * MiB;
constexpr int CW_TMO = 0, CW_CODE = 1;
constexpr int CW_BAR = 4096;
constexpr int CW_CNT = 8192;
static_assert((CW_CNT + 4 * 256) * 4 <= (int)CTL_ZERO_BYTES, "ctl");

constexpr int RING_OFF = 0, RING_BYTES = 147456;
constexpr int LDSCTL_OFF = RING_BYTES, MISC_OFF = LDSCTL_OFF + 512;
constexpr int LDS_BYTES = RING_BYTES + 1024;
static_assert(MISC_OFF + 128 <= LDS_BYTES, "LDS map");
#define GAS __attribute__((address_space(1)))
#define LAS __attribute__((address_space(3)))
typedef unsigned short bf16;
typedef unsigned v4u __attribute__((ext_vector_type(4)));
typedef float f32x4 __attribute__((ext_vector_type(4)));
typedef short bf16x8 __attribute__((ext_vector_type(8)));
typedef GAS unsigned gu32;
typedef GAS unsigned long long gu64;
#define RLX_AGENT __ATOMIC_RELAXED, __HIP_MEMORY_SCOPE_AGENT
#define LDS_WAIT() asm volatile("s_waitcnt lgkmcnt(0)" ::: "memory")
#define VM_WAIT() asm volatile("s_waitcnt vmcnt(0)" ::: "memory")
__device__ __forceinline__ unsigned long long rt() { return __builtin_amdgcn_s_memrealtime(); }
__device__ __forceinline__ unsigned f2bf(float f) { unsigned u = __builtin_bit_cast(unsigned, f); return (u + 0x7fffu + ((u >> 16) & 1u)) >> 16; }
__device__ __forceinline__ unsigned pk2(float lo, float hi) { return f2bf(lo) | (f2bf(hi) << 16); }

#define XB_TMO      128
#define XB_XCNT(j)  (256  + 64 * (j))
#define XB_XSUB(j)  (1280 + 64 * (j))
#define XB_XGEN(j)  (2304 + 64 * (j))
#define XB_TOP      3328
#define XB_TOPGEN   3392
#define XCD_BAR_WORDS 3456
#define XB_SPIN_CAP (1u << 18)

__device__ __forceinline__ unsigned xb_ld(unsigned* p)              { return __hip_atomic_load(p, __ATOMIC_RELAXED, __HIP_MEMORY_SCOPE_AGENT); }
__device__ __forceinline__ unsigned xb_add(unsigned* p, unsigned v) { return __hip_atomic_fetch_add(p, v, __ATOMIC_RELAXED, __HIP_MEMORY_SCOPE_AGENT); }
__device__ __forceinline__ unsigned xb_xcc_id() { return (unsigned)__builtin_amdgcn_s_getreg((3 << 11) | 20) & 0xFu; }
#define XB_SPIN(cond, bar) do { unsigned _sp = 0; while (cond) { __builtin_amdgcn_s_sleep(1); \
    if ((++_sp & 255u) == 0u) { if (xb_ld(&(bar)[XB_TMO])) break; if (_sp > XB_SPIN_CAP) { atomicAdd(&(bar)[XB_TMO], 1u); break; } } } } while (0)

struct XcdBarrier {
    unsigned* bar; unsigned x;
    volatile LAS unsigned* st;
};

__device__ __forceinline__ XcdBarrier xcd_barrier_post(unsigned* bar, volatile LAS unsigned* st) {
    XcdBarrier b; b.bar = bar; b.x = xb_xcc_id(); b.st = st;
    if (threadIdx.x == 0) (void)xb_add(&bar[XB_XCNT(b.x)], 1u);
    return b;
}
__device__ __forceinline__ void xcd_barrier_complete(unsigned* bar, unsigned x, unsigned& nloc, unsigned& nx) {
    const unsigned G = gridDim.x * gridDim.y * gridDim.z;
    unsigned sum, cnt, mine, sp = 0u;
    for (;;) {
        sum = 0u; cnt = 0u; mine = 0u;
#pragma unroll
        for (unsigned j = 0; j < 16; ++j) { const unsigned c = xb_ld(&bar[XB_XCNT(j)]); sum += c; cnt += (c > 0u) ? 1u : 0u; mine = (j == x) ? c : mine; }
        if (sum == G) break;
        __builtin_amdgcn_s_sleep(1);
        if ((++sp & 255u) == 0u) { if (xb_ld(&bar[XB_TMO])) break; if (sp > XB_SPIN_CAP) { atomicAdd(&bar[XB_TMO], 1u); break; } }
    }
    nloc = mine > 0u ? mine : 1u; nx = cnt > 0u ? cnt : 1u;
}

__device__ __forceinline__ void xcd_barrier(const XcdBarrier& b, const int wave_s) {
    asm volatile("s_waitcnt vmcnt(0)" ::: "memory");
    __syncthreads();
    unsigned lane_; asm volatile("v_mbcnt_lo_u32_b32 %0, -1, 0\n\tv_mbcnt_hi_u32_b32 %0, -1, %0" : "=v"(lane_));
    if (wave_s == 0 && lane_ == 0u) {
        unsigned* bar = b.bar; asm volatile("" : "+s"(bar));
        __builtin_amdgcn_s_waitcnt(0);
        unsigned nloc = b.st[0], nx = b.st[1];
        if (nloc == 0u) { xcd_barrier_complete(bar, b.x, nloc, nx); b.st[0] = nloc; b.st[1] = nx; }
        const unsigned old = xb_add(&bar[XB_XSUB(b.x)], 1u);
        const unsigned gen = old / nloc;
        if (old + 1u == (gen + 1u) * nloc) {
            __builtin_amdgcn_fence(__ATOMIC_RELEASE, "agent");
            asm volatile("s_waitcnt vmcnt(0)" ::: "memory");
            const unsigned og = xb_add(&bar[XB_TOP], 1u);
            const unsigned tg = og / nx;
            if (og + 1u == (tg + 1u) * nx) xb_add(&bar[XB_TOPGEN], 1u);
            else XB_SPIN(xb_ld(&bar[XB_TOPGEN]) == tg, bar);
            __builtin_amdgcn_fence(__ATOMIC_ACQUIRE, "agent");
            xb_add(&bar[XB_XGEN(b.x)], 1u);
            asm volatile("s_waitcnt vmcnt(0)" ::: "memory");
        } else {
            XB_SPIN(xb_ld(&bar[XB_XGEN(b.x)]) == gen, bar);
            __builtin_amdgcn_fence(__ATOMIC_ACQUIRE, "agent");
            asm volatile("s_waitcnt vmcnt(0)" ::: "memory");
        }
    }
    __syncthreads();
}

struct Args { const float* in[21]; float* out; unsigned char* ws; int ph_lo, ph_hi; };
#define CAS __attribute__((address_space(4)))
struct KA { const CAS char* p;
    __device__ __forceinline__ const float* in(int k) const { return *(const float* const CAS*)(p + 8 * k); }
    __device__ __forceinline__ float* out() const { return *(float* const CAS*)(p + 8 * 21); }
    __device__ __forceinline__ unsigned char* ws() const { return *(unsigned char* const CAS*)(p + 8 * 22); }
    __device__ __forceinline__ int ph_lo() const { return *(const CAS int*)(p + 8 * 23); }
    __device__ __forceinline__ int ph_hi() const { return *(const CAS int*)(p + 8 * 23 + 4); }
};
__device__ __forceinline__ KA karg_fresh() { const CAS char* q = (const CAS char*)__builtin_amdgcn_kernarg_segment_ptr(); asm volatile("" : "+s"(q)); KA k; k.p = q; return k; }
struct Frame {
    LAS unsigned char* lds; volatile LAS unsigned* MISC; gu32* ctl;
    int tid, lane, wave, vcu, G, bx;
};
typedef unsigned long long u64;
typedef float f32x16 __attribute__((ext_vector_type(16)));
template <int CTRL> __device__ __forceinline__ float dpp_mov(float v) { return __builtin_bit_cast(float, __builtin_amdgcn_update_dpp(0, __builtin_bit_cast(int, v), CTRL, 0xF, 0xF, true)); }
__device__ __forceinline__ float row8_sum(float v) { v += dpp_mov<0xB1>(v); v += dpp_mov<0x4E>(v); v += dpp_mov<0x141>(v); return v; }
__device__ __forceinline__ float wave_sum(float v, int) { v = row8_sum(v); v += dpp_mov<0x140>(v);
    const float r0 = __builtin_bit_cast(float, __builtin_amdgcn_readlane(__builtin_bit_cast(int, v), 0)), r1 = __builtin_bit_cast(float, __builtin_amdgcn_readlane(__builtin_bit_cast(int, v), 16));
    const float r2 = __builtin_bit_cast(float, __builtin_amdgcn_readlane(__builtin_bit_cast(int, v), 32)), r3 = __builtin_bit_cast(float, __builtin_amdgcn_readlane(__builtin_bit_cast(int, v), 48));
    return (r0 + r1) + (r2 + r3); }
__device__ __forceinline__ float bf2f(unsigned b) { return __uint_as_float(b << 16); }
__device__ __forceinline__ float bflo(unsigned w) { return __uint_as_float(w << 16); }
__device__ __forceinline__ float bfhi(unsigned w) { return __uint_as_float(w & 0xffff0000u); }
__device__ __forceinline__ float fexp(float x) { return __builtin_amdgcn_exp2f(1.4426950408889634f * x); }
__device__ __forceinline__ float sigmoid_f(float x) { return __builtin_amdgcn_rcpf(1.0f + fexp(-x)); }
__device__ __forceinline__ unsigned pkbf(float lo, float hi) { return pg8::cvt_pk_bf16(lo, hi); }
typedef _Float16 f16x2_t __attribute__((ext_vector_type(2))); typedef float f32x2_t2 __attribute__((ext_vector_type(2)));
__device__ __forceinline__ unsigned pkh(float lo, float hi) { const f32x2_t2 v = {lo, hi}; return __builtin_bit_cast(unsigned, __builtin_convertvector(v, f16x2_t)); }
__device__ __forceinline__ f32x4 unpk_h4(u64 w) { const f16x2_t a = __builtin_bit_cast(f16x2_t, (unsigned)w), b = __builtin_bit_cast(f16x2_t, (unsigned)(w >> 32)); return (f32x4){(float)a[0], (float)a[1], (float)b[0], (float)b[1]}; }
__device__ __forceinline__ int swap23(int p) { return (p & ~12) | ((p & 4) << 1) | ((p & 8) >> 1); }
__device__ __forceinline__ int crow16(int i, int hh) { return (i & 3) + 8 * (i >> 2) + 4 * hh; }

struct MapId { __device__ __forceinline__ int operator()(int n) const { return n; } };
struct MapW13 { int add; __device__ __forceinline__ int operator()(int u) const { return ((u >> 7) << 8) + add + (u & 127); } };
struct MapHgrnIn { __device__ __forceinline__ int operator()(int n) const { return (n < 2048) ? ((n & ~1023) | swap23(n & 1023)) : n; } };
struct MapAttnIn { __device__ __forceinline__ int operator()(int n) const { if (n >= 2048) return n; const int part = n >> 10, c = n & 1023, hm = c >> 6, dim = c & 63;
    return part * 1024 + (hm >> 2) * 256 + (dim >> 5) * 128 + (hm & 3) * 32 + (dim & 31); } };
template <class MapF>
__device__ __forceinline__ void transpose_item(const float* W, int K, int N, bf16* WT, LAS float* scr, int item, int lane, MapF map) {
    const int nblk = N / 32, kb = item / nblk, nb = item % nblk, k0 = 64 * kb, n0 = 32 * nb;
#pragma unroll 8
    for (int i = 0; i < 32; ++i) { const int kk = 2 * i + (lane >> 5); scr[kk * 33 + (lane & 31)] = W[(size_t)(k0 + kk) * N + n0 + (lane & 31)]; }
    LDS_WAIT(); asm volatile("" ::: "memory");
    const int c = lane & 7;
#pragma unroll
    for (int j = 0; j < 4; ++j) { const int n = (lane >> 3) + 8 * j; const LAS float* s = scr + (8 * c) * 33 + n;
        v4u o; o.x = pkbf(s[0 * 33], s[1 * 33]); o.y = pkbf(s[2 * 33], s[3 * 33]); o.z = pkbf(s[4 * 33], s[5 * 33]); o.w = pkbf(s[6 * 33], s[7 * 33]);
        *(GAS v4u*)(WT + (size_t)map(n0 + n) * K + k0 + 8 * c) = o; }
    LDS_WAIT(); asm volatile("" ::: "memory");
}
__device__ __forceinline__ unsigned char* moe_wbuf(unsigned char* ws, int L) { return (L & 1) ? ws + WS_WB2 : ws + WS_W13; }
struct ConvItem { const float* W; bf16* WT; int K, N, k0, n0, add; };
__device__ __forceinline__ ConvItem conv_item(const KA a, int L, int it) {
    const int e = it / 768, r = it % 768; const size_t eo = (size_t)(L * 32 + e) * 1024 * 512; ConvItem c;
    bf16* W13 = (bf16*)moe_wbuf(a.ws(), L) + (size_t)e * 1024 * 1024; bf16* W2 = (bf16*)(moe_wbuf(a.ws(), L) + 64 * MiB) + (size_t)e * 1024 * 512;
    if (r < 512) { const int rr = r & 255; c.W = (r < 256 ? a.in(18) : a.in(19)) + eo; c.WT = W13; c.K = 1024; c.N = 512; c.k0 = 64 * (rr >> 4); c.n0 = 32 * (rr & 15); c.add = (r < 256) ? 0 : 128; }
    else { const int rr = r - 512; c.W = a.in(20) + eo; c.WT = W2; c.K = 512; c.N = 1024; c.k0 = 64 * (rr >> 5); c.n0 = 32 * (rr & 31); c.add = -1; }
    return c;
}
__device__ __forceinline__ void conv_load(const ConvItem& c, int lane, f32x4 (&v)[8]) {
#pragma unroll
    for (int i = 0; i < 8; ++i) v[i] = *(const f32x4*)(c.W + (size_t)(c.k0 + 8 * (lane >> 3) + i) * c.N + c.n0 + 4 * (lane & 7));
}
__device__ __forceinline__ void conv_store(const ConvItem& c, int lane, const f32x4 (&v)[8]) {
#pragma unroll
    for (int cc = 0; cc < 4; ++cc) { const int n = c.n0 + 4 * (lane & 7) + cc;
        const int row = (c.add == -1) ? n : (c.add == -2) ? MapHgrnIn{}(n) : (c.add == -3) ? MapAttnIn{}(n) : (((n >> 7) << 8) + c.add + (n & 127));
        v4u o; o.x = pkbf(v[0][cc], v[1][cc]); o.y = pkbf(v[2][cc], v[3][cc]); o.z = pkbf(v[4][cc], v[5][cc]); o.w = pkbf(v[6][cc], v[7][cc]);
        *(GAS v4u*)(c.WT + (size_t)row * c.K + c.k0 + 8 * (lane >> 3)) = o; }
}
constexpr int MIX_HIN = 16 * 128, MIX_OUT = 16 * 32, MIX_AIN = 16 * 96, MIX_PER = MIX_HIN + MIX_OUT + MIX_AIN + MIX_OUT, MIX_FIRST = MIX_HIN + MIX_OUT;
__device__ __forceinline__ ConvItem mix_item(const KA a, int it) {
    const int j = it / MIX_PER; int r = it % MIX_PER; ConvItem c; c.K = 1024;
    if (r < MIX_HIN) { c.W = a.in(6) + (size_t)j * 1024 * 4096; c.WT = (bf16*)(a.ws() + WS_WHIN) + (size_t)j * 4096 * 1024; c.N = 4096; c.add = -2; }
    else if ((r -= MIX_HIN) < MIX_OUT) { c.W = a.in(7) + (size_t)j * 1024 * 1024; c.WT = (bf16*)(a.ws() + WS_WHOUT) + (size_t)j * 1024 * 1024; c.N = 1024; c.add = -1; }
    else if ((r -= MIX_OUT) < MIX_AIN) { c.W = a.in(10) + (size_t)j * 1024 * 3072; c.WT = (bf16*)(a.ws() + WS_WAIN) + (size_t)j * 3072 * 1024; c.N = 3072; c.add = -3; }
    else { r -= MIX_AIN; c.W = a.in(11) + (size_t)j * 1024 * 1024; c.WT = (bf16*)(a.ws() + WS_WAOUT) + (size_t)j * 1024 * 1024; c.N = 1024; c.add = -1; }
    const int nblk = c.N / 32; c.k0 = 64 * (r / nblk); c.n0 = 32 * (r % nblk);
    return c;
}
__device__ __forceinline__ void convert_mixer(const KA a, int lane, int first, int last, int gw, int ngw) {
    for (int it = first + gw; it < last; it += ngw) { const ConvItem c = mix_item(a, it); f32x4 v[8]; conv_load(c, lane, v); conv_store(c, lane, v); }
}
__device__ __forceinline__ void convert_moe(Frame& F, const KA a, int L, int cw, int nconv) {
    const int gw = F.vcu * nconv + cw, NGW = F.G * nconv;
    if (gw >= 32 * 768) return;
    ConvItem cur = conv_item(a, L, gw); f32x4 v[8]; conv_load(cur, F.lane, v);
    for (int it = gw; it < 32 * 768; it += NGW) {
        const int nx = it + NGW; ConvItem nxt = cur; f32x4 vn[8];
        if (nx < 32 * 768) { nxt = conv_item(a, L, nx); conv_load(nxt, F.lane, vn); }
        conv_store(cur, F.lane, v);
        cur = nxt;
#pragma unroll
        for (int i = 0; i < 8; ++i) v[i] = vn[i];
    }
}

__device__ __forceinline__ void phase_p0a(Frame& F, const KA a) {
    const int gw = F.vcu * NWAVES + F.wave, NGW = F.G * NWAVES;
    const float* c = a.in(1); const float* ada_w = a.in(2); const float* ada_b = a.in(3);
    float* mod = (float*)(a.ws() + WS_MOD);
    if (F.vcu < 4 * 24) {
        LAS float* sl = (LAS float*)(F.lds + RING_OFF + 65536);
        for (int idx = F.tid; idx < 16 * 1024; idx += 512) { const int k = idx & 1023, b = idx >> 10; const float cv = c[idx]; sl[k * 16 + b] = cv * sigmoid_f(cv); }
        __syncthreads();
    }
    for (int it = F.vcu; it < 4 * 24; it += F.G) {
        const int i = it / 24, nb = it % 24;
        f32x4 acc[16];
#pragma unroll
        for (int b = 0; b < 16; ++b) acc[b] = (f32x4){0.f, 0.f, 0.f, 0.f};
        const float* wp = ada_w + ((size_t)i * 1024 + F.wave * 128) * 6144 + nb * 256 + 4 * F.lane;
        const LAS float* sw = (const LAS float*)(F.lds + RING_OFF + 65536) + F.wave * 128 * 16;
        for (int k0 = 0; k0 < 128; k0 += 16) {
            f32x4 w4[16];
#pragma unroll
            for (int kk = 0; kk < 16; ++kk) w4[kk] = *(const f32x4*)(wp + (size_t)(k0 + kk) * 6144);
            asm volatile("" ::: "memory");
#pragma unroll
            for (int kk = 0; kk < 16; ++kk) {
                const LAS f32x4* sp = (const LAS f32x4*)(sw + (k0 + kk) * 16);
                const f32x4 s0 = sp[0], s1 = sp[1], s2 = sp[2], s3 = sp[3];
#pragma unroll
                for (int b = 0; b < 4; ++b) { acc[b] += w4[kk] * s0[b]; acc[4 + b] += w4[kk] * s1[b]; acc[8 + b] += w4[kk] * s2[b]; acc[12 + b] += w4[kk] * s3[b]; }
            }
        }
        LAS float* red = (LAS float*)(F.lds + RING_OFF);
#pragma unroll
        for (int hb = 0; hb < 2; ++hb) {
#pragma unroll
            for (int b = 0; b < 8; ++b) *(LAS f32x4*)(red + (F.wave * 8 + b) * 256 + 4 * F.lane) = acc[8 * hb + b];
            __syncthreads();
            const float bias_ = ada_b[i * 6144 + nb * 256 + (F.tid & 255)];
            for (int r = 0; r < 4; ++r) { const int idx = F.tid + 512 * r, b = idx >> 8, col = idx & 255; float s = bias_;
#pragma unroll
                for (int w = 0; w < 8; ++w) s += red[(w * 8 + b) * 256 + col];
                mod[((size_t)i * 16 + 8 * hb + b) * 6144 + nb * 256 + col] = s; }
            __syncthreads();
        }
    }
    {
        float* cs = (float*)(a.ws() + WS_ROPE_C); float* sn = (float*)(a.ws() + WS_ROPE_S);
        for (int idx = gw * 64 + F.lane; idx < SEQ * 32; idx += NGW * 64) {
            const int pos = idx >> 5, j = idx & 31;
            double f = 1.0; const double r1 = 0.74989420933245582730;
            double p = r1;
#pragma unroll
            for (int bit = 0; bit < 5; ++bit) { if (j & (1 << bit)) f *= p; p *= p; }
            const double ang = (double)pos * f;
            const double kq = __builtin_rint(ang * 0.63661977236758134308);
            const double rr = (ang - kq * 1.57079632679489655800e+00) - kq * 6.12323399573676603587e-17;
            const double r2 = rr * rr;
            const double sp = rr * (1.0 + r2 * (-1.0 / 6 + r2 * (1.0 / 120 + r2 * (-1.0 / 5040 + r2 * (1.0 / 362880 + r2 * (-1.0 / 39916800 + r2 * (1.0 / 6227020800.0)))))));
            const double cp = 1.0 + r2 * (-0.5 + r2 * (1.0 / 24 + r2 * (-1.0 / 720 + r2 * (1.0 / 40320 + r2 * (-1.0 / 3628800 + r2 * (1.0 / 479001600.0 + r2 * (-1.0 / 87178291200.0)))))));
            const int q = ((int)kq) & 3;
            const double sv = (q == 0) ? sp : (q == 1) ? cp : (q == 2) ? -sp : -cp;
            const double cv = (q == 0) ? cp : (q == 1) ? -sp : (q == 2) ? -cp : sp;
            cs[idx] = (float)cv; sn[idx] = (float)sv;
        }
    }
    {
        float* rt = (float*)(a.ws() + WS_RT); const float* rgw = a.in(14); const float* rew = a.in(16);
        for (int idx = gw * 64 + F.lane; idx < 4 * 36 * 1024; idx += NGW * 64) {
            const int l = idx / 36864, e = (idx >> 10) % 36, k = idx & 1023;
            rt[idx] = (e < 4) ? rgw[((size_t)l * 1024 + k) * 4 + e] : rew[((size_t)l * 1024 + k) * 32 + (e - 4)];
        }
    }
    convert_mixer(a, F.lane, 0, MIX_FIRST, gw, NGW);
}

__device__ __forceinline__ void phase_p0b(Frame& F, const KA a) {
    const int gw = F.vcu * NWAVES + F.wave, NGW = F.G * NWAVES;
    const float* x = a.in(0); const float* mod = (const float*)(a.ws() + WS_MOD); bf16* h = (bf16*)(a.ws() + WS_BUF0);
#define P0B_LOAD(X, t_) do { _Pragma("unroll") for (int tt = 0; tt < 4; ++tt) _Pragma("unroll") for (int j = 0; j < 4; ++j) X[tt][j] = *(const f32x4*)(x + (size_t)((t_) + tt) * D + 4 * F.lane + 256 * j); } while (0)
#define P0B_PROC(X, t_) do { const float* mb = mod + (size_t)((t_) >> 12) * 6144; \
        _Pragma("unroll") for (int j = 0; j < 4; ++j) { const int col = 4 * F.lane + 256 * j; const f32x4 sh = *(const f32x4*)(mb + col), sc = *(const f32x4*)(mb + 1024 + col) + 1.0f; \
            _Pragma("unroll") for (int tt = 0; tt < 4; ++tt) { const f32x4 hv = X[tt][j] * sc + sh; \
                *(u64*)(h + (size_t)((t_) + tt) * D + col) = (u64)pkbf(hv[0], hv[1]) | ((u64)pkbf(hv[2], hv[3]) << 32); } } } while (0)
    const int step = NGW * 4;
    f32x4 xa[4][4], xb[4][4];
    int t0 = gw * 4;
    if (t0 < M) P0B_LOAD(xa, t0);
    for (; t0 < M; t0 += 2 * step) {
        const int t1 = t0 + step, t2 = t1 + step;
        if (t1 < M) P0B_LOAD(xb, t1);
        P0B_PROC(xa, t0);
        if (t2 < M) P0B_LOAD(xa, t2);
        if (t1 < M) P0B_PROC(xb, t1);
    }
#undef P0B_LOAD
#undef P0B_PROC
}

__device__ __forceinline__ void phase_hgrn_prep(Frame& F, const KA a, int j) {
    bf16* Qb = (bf16*)(a.ws() + WS_BUF0 + 1 * BUFSZ); bf16* Zb = (bf16*)(a.ws() + WS_BUF0 + 2 * BUFSZ);
    float* dd = (float*)(a.ws() + WS_HGD);
    const float* lb = a.in(8);
    const int grp = F.tid >> 7, jt = F.tid & 127, col = 8 * jt, h = col >> 7, pos = col & 127;
    const int ch0 = swap23(pos), ch1 = swap23(pos + 4);
    float oml[8];
#pragma unroll
    for (int c = 0; c < 8; ++c) oml[c] = 1.0f;
    if (j == 1) {
#pragma unroll
        for (int c = 0; c < 4; ++c) { oml[c] = 1.0f - sigmoid_f(lb[1024 + h * 128 + ch0 + c] - lb[h * 128 + ch0 + c]); oml[4 + c] = 1.0f - sigmoid_f(lb[1024 + h * 128 + ch1 + c] - lb[h * 128 + ch1 + c]); } }
    constexpr int NIT = BATCH * HG_NCH;
    float bs[8];
#define HP_IT(s_) (F.vcu + F.G * (grp + 4 * ((s_) >> 2)))
#define HP_LOAD(Z, Q, s_) do { int it_ = HP_IT(s_); it_ = (it_ < NIT) ? it_ : 0;        \
        const size_t tk_ = (size_t)(it_ >> 7) * SEQ + (it_ & (HG_NCH - 1)) * HG_CHUNK + 8 * ((s_) & 3); \
        _Pragma("unroll") for (int t = 0; t < 8; ++t) { Z[t] = *(const v4u*)(Zb + (tk_ + t) * D + col); Q[t] = *(const v4u*)(Qb + (tk_ + t) * D + col); } } while (0)
#define HP_PROC(Z, Q, s_) do { const int it_ = HP_IT(s_); const int chunk_ = it_ & (HG_NCH - 1), b_ = it_ >> 7; const size_t tk_ = (size_t)b_ * SEQ + chunk_ * HG_CHUNK + 8 * ((s_) & 3); \
        if (((s_) & 3) == 0) { _Pragma("unroll") for (int c = 0; c < 8; ++c) bs[c] = 0.f; } \
        _Pragma("unroll") for (int t = 0; t < 8; ++t) { v4u qo, ko; \
            _Pragma("unroll") for (int i = 0; i < 4; ++i) { \
                const float k0 = oml[2 * i] * sigmoid_f(-bflo(Z[t][i])), k1 = oml[2 * i + 1] * sigmoid_f(-bfhi(Z[t][i])); \
                const float g0 = (k0 < 0.05f) ? -k0 * (1.0f + k0 * (0.5f + k0 * (0.33333333f + k0 * 0.25f))) : 0.69314718056f * __builtin_amdgcn_logf(1.0f - k0); \
                const float g1 = (k1 < 0.05f) ? -k1 * (1.0f + k1 * (0.5f + k1 * (0.33333333f + k1 * 0.25f))) : 0.69314718056f * __builtin_amdgcn_logf(1.0f - k1); \
                bs[2 * i] += g0; bs[2 * i + 1] += g1; \
                qo[i] = pkbf(bflo(Q[t][i]) * fexp(bs[2 * i]), bfhi(Q[t][i]) * fexp(bs[2 * i + 1])); \
                ko[i] = pkbf(k0 * fexp(fminf(-bs[2 * i], 80.0f)), k1 * fexp(fminf(-bs[2 * i + 1], 80.0f))); } \
            *(v4u*)(Qb + (tk_ + t) * D + col) = qo; *(v4u*)(Zb + (tk_ + t) * D + col) = ko; } \
        if (((s_) & 3) == 3) { const size_t rowbase_ = ((size_t)(b_ * 8 + h) * HG_NCH + chunk_) * 128; \
            *(f32x4*)(dd + rowbase_ + ch0) = (f32x4){fexp(bs[0]), fexp(bs[1]), fexp(bs[2]), fexp(bs[3])}; *(f32x4*)(dd + rowbase_ + ch1) = (f32x4){fexp(bs[4]), fexp(bs[5]), fexp(bs[6]), fexp(bs[7])}; } } while (0)
    v4u za[8], qa[8], zb[8], qb[8];
    int s = 0;
    HP_LOAD(za, qa, 0);
    for (; HP_IT(s) < NIT; s += 2) {
        HP_LOAD(zb, qb, s + 1);
        HP_PROC(za, qa, s);
        HP_LOAD(za, qa, s + 2);
        HP_PROC(zb, qb, s + 1);
    }
#undef HP_IT
#undef HP_LOAD
#undef HP_PROC
}

#define MFMA32(a_, b_, c_) __builtin_amdgcn_mfma_f32_32x32x16_bf16((a_), (b_), (c_), 0, 0, 0)
typedef float f32x2_pk __attribute__((ext_vector_type(2))); typedef __bf16 bf16x2_pk __attribute__((ext_vector_type(2)));
__device__ __forceinline__ unsigned cvt2(float lo, float hi) { const f32x2_pk v = {lo, hi}; return __builtin_bit_cast(unsigned, __builtin_convertvector(v, bf16x2_pk)); }
__device__ __forceinline__ bf16x8 pack_half(const f32x16& x, int s) {
    v4u p; p.x = cvt2(x[8 * s + 0], x[8 * s + 1]); p.y = cvt2(x[8 * s + 2], x[8 * s + 3]); p.z = cvt2(x[8 * s + 4], x[8 * s + 5]); p.w = cvt2(x[8 * s + 6], x[8 * s + 7]);
    return __builtin_bit_cast(bf16x8, p);
}
constexpr int HS_Q = 0, HS_K = 8192, HS_V = 16384, HS_D = 18432, HS_BUF = 18944, HS_NBUF = 3, HS_WAVE = HS_NBUF * HS_BUF, HS_OST = 2 * HS_WAVE, HS_CONV = HS_OST + 4096, HS_NCONV = 6;
static_assert(HS_CONV <= RING_BYTES, "scan LDS map");
typedef short s16x4_t __attribute__((ext_vector_type(4)));
__device__ __forceinline__ void phase_hgrn_scan(Frame& F, const KA a, int layer) {
    const bf16* Qt = (const bf16*)(a.ws() + WS_BUF0 + 1 * BUFSZ); const bf16* Kt = (const bf16*)(a.ws() + WS_BUF0 + 2 * BUFSZ);
    const bf16* Vb = (const bf16*)(a.ws() + WS_BUF0 + 3 * BUFSZ); const float* dd = (const float*)(a.ws() + WS_HGD);
    bf16* O = (bf16*)(a.ws() + WS_BUF0 + 6 * BUFSZ);
    if (F.wave >= 2) {
        if (F.wave < 2 + HS_NCONV) { if (layer == 0) convert_mixer(a, F.lane, MIX_FIRST, 2 * MIX_PER, F.vcu * HS_NCONV + F.wave - 2, F.G * HS_NCONV);
            convert_moe(F, a, layer, F.wave - 2, HS_NCONV); convert_moe(F, a, layer + 1, F.wave - 2, HS_NCONV); }
        return; }
    LAS unsigned char* ring = F.lds + RING_OFF + F.wave * HS_WAVE;
    LAS unsigned char* ost = F.lds + RING_OFF + HS_OST + F.wave * 2048;
    for (int u = F.vcu; u < BATCH * 8 * 2; u += F.G) {
        const int bh = u >> 1, vt = (u & 1) * 2 + F.wave, b = bh >> 3, h = bh & 7;
        const int r = F.lane & 31, hh = F.lane >> 5;
        f32x16 S[4];
#pragma unroll
        for (int kt = 0; kt < 4; ++kt)
#pragma unroll
            for (int i = 0; i < 16; ++i) S[kt][i] = 0.f;
        const bf16* Qp = Qt + ((size_t)b * SEQ + r) * D + h * 128 + 8 * hh;
        const bf16* Kp = Kt + ((size_t)b * SEQ + r) * D + h * 128 + 8 * hh;
        const bf16* Vp = Vb + ((size_t)b * SEQ + (F.lane >> 2)) * D + h * 128 + 32 * vt + 8 * (F.lane & 3);
        const float* dp = dd + (size_t)bh * HG_NCH * 128 + F.lane;
        bf16* op2 = O + ((size_t)b * SEQ + 4 * hh) * D + h * 128 + 32 * vt + r;
        const int i16 = F.lane & 15, blk = (F.lane >> 4) & 1, tq = i16 >> 2, tp = i16 & 3, tpp = ((tp & 1) << 1) | (tp >> 1);
        const int trb = HS_K + blk * 1024 + (tpp >> 1) * 512 + (4 * hh + tq) * 16 + (tpp & 1) * 8;
        const int vtrb = HS_V + (4 * hh + tq) * 64 + 32 * blk + 8 * tp;
#define HS_DMA(c_, buf_) do { LAS unsigned char* bb_ = ring + (buf_) * HS_BUF; \
        _Pragma("unroll") for (int ks = 0; ks < 8; ++ks) { __builtin_amdgcn_global_load_lds((const unsigned*)(Qp + (size_t)(c_) * 32 * D + 16 * ks), (LAS unsigned*)(bb_ + HS_Q + ks * 1024), 16, 0, 0); \
                                                        __builtin_amdgcn_global_load_lds((const unsigned*)(Kp + (size_t)(c_) * 32 * D + 16 * ks), (LAS unsigned*)(bb_ + HS_K + ks * 1024), 16, 0, 0); } \
        _Pragma("unroll") for (int st = 0; st < 2; ++st) __builtin_amdgcn_global_load_lds((const unsigned*)(Vp + ((size_t)(c_) * 32 + 16 * st) * D), (LAS unsigned*)(bb_ + HS_V + st * 1024), 16, 0, 0); \
        _Pragma("unroll") for (int q_ = 0; q_ < 2; ++q_) __builtin_amdgcn_global_load_lds((const unsigned*)(dp + (size_t)(c_) * 128 + 64 * q_), (LAS unsigned*)(bb_ + HS_D + q_ * 256), 4, 0, 0); } while (0)
        asm volatile("s_waitcnt lgkmcnt(0)" ::: "memory");
        HS_DMA(0, 0); HS_DMA(1, 1);
        int bcur = 0, bnext = 2;
        for (int c = 0; c < HG_NCH; ++c) {
            const int cn = (c + 2 < HG_NCH) ? c + 2 : HG_NCH - 1;
            HS_DMA(cn, bnext);
            if (c == 0) asm volatile("s_waitcnt vmcnt(40)" ::: "memory");
            else asm volatile("s_waitcnt vmcnt(56)" ::: "memory");
            const LAS unsigned char* bbase = ring + bcur * HS_BUF;
            const LAS unsigned char* bb = bbase + F.lane * 16;
            bf16x8 Qf[8], Kf[8], Vf[2];
            { const unsigned vba = (unsigned)(uintptr_t)(bbase + vtrb); s16x4_t v0, v1, v2, v3;
              asm volatile("ds_read_b64_tr_b16 %0, %1 offset:0" : "=&v"(v0) : "v"(vba) : "memory"); asm volatile("ds_read_b64_tr_b16 %0, %1 offset:512" : "=&v"(v1) : "v"(vba) : "memory");
              asm volatile("ds_read_b64_tr_b16 %0, %1 offset:1024" : "=&v"(v2) : "v"(vba) : "memory"); asm volatile("ds_read_b64_tr_b16 %0, %1 offset:1536" : "=&v"(v3) : "v"(vba) : "memory");
#pragma unroll
              for (int ks = 0; ks < 8; ++ks) { Qf[ks] = *(const LAS bf16x8*)(bb + HS_Q + ks * 1024); Kf[ks] = *(const LAS bf16x8*)(bb + HS_K + ks * 1024); }
              asm volatile("s_waitcnt lgkmcnt(0)" : "+v"(v0), "+v"(v1), "+v"(v2), "+v"(v3) :: "memory");
              Vf[0] = (bf16x8){v0[0], v0[1], v0[2], v0[3], v1[0], v1[1], v1[2], v1[3]}; Vf[1] = (bf16x8){v2[0], v2[1], v2[2], v2[3], v3[0], v3[1], v3[2], v3[3]}; }
            f32x16 sc0, sc1;
#pragma unroll
            for (int i = 0; i < 16; ++i) { sc0[i] = 0.f; sc1[i] = 0.f; }
#pragma unroll
            for (int ks = 0; ks < 8; ks += 2) { sc0 = MFMA32(Kf[ks], Qf[ks], sc0); sc1 = MFMA32(Kf[ks + 1], Qf[ks + 1], sc1); }
#pragma unroll
            for (int i = 0; i < 16; ++i) sc0[i] = (crow16(i, hh) > r) ? 0.f : (sc0[i] + sc1[i]);
            f32x16 oA, oB;
#pragma unroll
            for (int i = 0; i < 16; ++i) { oA[i] = 0.f; oB[i] = 0.f; }
#pragma unroll
            for (int kt = 0; kt < 4; kt += 2)
#pragma unroll
                for (int st = 0; st < 2; ++st) { oA = MFMA32(Qf[2 * kt + st], pack_half(S[kt], st), oA); oB = MFMA32(Qf[2 * kt + 2 + st], pack_half(S[kt + 1], st), oB); }
            oA = MFMA32(pack_half(sc0, 0), Vf[0], oA); oB = MFMA32(pack_half(sc0, 1), Vf[1], oB);
            const LAS float* dl = (const LAS float*)(bbase + HS_D) + 4 * hh;
            const unsigned tba = (unsigned)(uintptr_t)(bbase + trb);
            s16x4_t klo[8], khi[8];
#pragma unroll
            for (int f = 0; f < 8; ++f) {
                asm volatile("ds_read_b64_tr_b16 %0, %1 offset:%c2" : "=&v"(klo[f]) : "v"(tba), "i"((f >> 1) * 2048 + (f & 1) * 256) : "memory");
                asm volatile("ds_read_b64_tr_b16 %0, %1 offset:%c2" : "=&v"(khi[f]) : "v"(tba), "i"((f >> 1) * 2048 + (f & 1) * 256 + 128) : "memory"); }
            asm volatile("s_waitcnt lgkmcnt(0)" : "+v"(klo[0]), "+v"(klo[1]), "+v"(klo[2]), "+v"(klo[3]), "+v"(klo[4]), "+v"(klo[5]), "+v"(klo[6]), "+v"(klo[7]) :: "memory");
            asm volatile("" : "+v"(khi[0]), "+v"(khi[1]), "+v"(khi[2]), "+v"(khi[3]), "+v"(khi[4]), "+v"(khi[5]), "+v"(khi[6]), "+v"(khi[7]) :: "memory");
#pragma unroll
            for (int kt = 0; kt < 4; ++kt) {
#pragma unroll
                for (int st = 0; st < 2; ++st) { const int f = kt * 2 + st;
                    const bf16x8 kh = (bf16x8){klo[f][0], klo[f][1], klo[f][2], klo[f][3], khi[f][0], khi[f][1], khi[f][2], khi[f][3]};
                    S[kt] = MFMA32(kh, Vf[st], S[kt]); }
#pragma unroll
                for (int g = 0; g < 4; ++g) { const f32x4 dv = *(const LAS f32x4*)(dl + 32 * kt + 8 * g);
#pragma unroll
                    for (int i = 0; i < 4; ++i) S[kt][4 * g + i] *= dv[i]; }
            }
#pragma unroll
            for (int i = 0; i < 16; ++i) *(unsigned short*)(op2 + ((size_t)c * 32 + crow16(i, 0)) * D) = (unsigned short)(pkbf(oA[i] + oB[i], 0.f) & 0xffffu);
            asm volatile("s_waitcnt lgkmcnt(0)" ::: "memory");
            bcur = (bcur == HS_NBUF - 1) ? 0 : bcur + 1; bnext = (bnext == HS_NBUF - 1) ? 0 : bnext + 1;
        }
        asm volatile("s_waitcnt vmcnt(0)" ::: "memory");
#undef HS_DMA
    }
}

template <int MODE>
__device__ __forceinline__ void phase_normgate(Frame& F, const bf16* P0, const bf16* P1, bf16* out, const float* w, float lam, float mul) {
    const int gw = F.vcu * NWAVES + F.wave, NGW = F.G * NWAVES;
    float wv[16];
#pragma unroll
    for (int i = 0; i < 16; ++i) wv[i] = w[((16 * F.lane) & 127) + i] * mul;
    const int tpw = ((M + NGW - 1) / NGW + 3) & ~3;
#define NG_LOAD(A0, A1, B0, B1, t_) do { _Pragma("unroll") for (int tt = 0; tt < 4; ++tt) { const size_t off = (size_t)((t_) + tt) * D + 16 * F.lane; \
        A0[tt] = *(const v4u*)(P0 + off); A1[tt] = *(const v4u*)(P0 + off + 8); B0[tt] = *(const v4u*)(P1 + off); B1[tt] = *(const v4u*)(P1 + off + 8); } } while (0)
#define NG_PROC(A0, A1, B0, B1, t_) do { _Pragma("unroll") for (int tt = 0; tt < 4; ++tt) { \
            float av[16], bv[16]; \
            _Pragma("unroll") for (int i = 0; i < 4; ++i) { av[2 * i] = bflo(A0[tt][i]); av[2 * i + 1] = bfhi(A0[tt][i]); av[8 + 2 * i] = bflo(A1[tt][i]); av[8 + 2 * i + 1] = bfhi(A1[tt][i]); \
                                          bv[2 * i] = bflo(B0[tt][i]); bv[2 * i + 1] = bfhi(B0[tt][i]); bv[8 + 2 * i] = bflo(B1[tt][i]); bv[8 + 2 * i + 1] = bfhi(B1[tt][i]); } \
            float ss = 0.f; \
            _Pragma("unroll") for (int i = 0; i < 16; ++i) { if (MODE == 1) av[i] = av[i] - lam * bv[i]; ss += av[i] * av[i]; } \
            ss = row8_sum(ss); \
            const float rs = 1.0f / sqrtf(ss * (1.0f / 128.0f) + LN_EPS); \
            v4u o0, o1; \
            _Pragma("unroll") for (int i = 0; i < 8; ++i) { float v0 = av[2 * i] * rs * wv[2 * i], v1 = av[2 * i + 1] * rs * wv[2 * i + 1]; \
                if (MODE == 0) { v0 *= bv[2 * i] * sigmoid_f(bv[2 * i]); v1 *= bv[2 * i + 1] * sigmoid_f(bv[2 * i + 1]); } \
                if (i < 4) o0[i] = pkbf(v0, v1); else o1[i - 4] = pkbf(v0, v1); } \
            const size_t off = (size_t)((t_) + tt) * D + 16 * F.lane; \
            *(v4u*)(out + off) = o0; *(v4u*)(out + off + 8) = o1; } } while (0)
    const int tend = ((gw + 1) * tpw < M) ? (gw + 1) * tpw : M;
    v4u a0[4], a1[4], b0[4], b1[4], c0[4], c1[4], e0[4], e1[4];
    int t0 = gw * tpw;
    if (t0 < tend) NG_LOAD(a0, a1, b0, b1, t0);
    for (; t0 < tend; t0 += 8) {
        if (t0 + 4 < tend) NG_LOAD(c0, c1, e0, e1, t0 + 4);
        NG_PROC(a0, a1, b0, b1, t0);
        if (t0 + 8 < tend) NG_LOAD(a0, a1, b0, b1, t0 + 8);
        if (t0 + 4 < tend) NG_PROC(c0, c1, e0, e1, t0 + 4);
    }
#undef NG_LOAD
#undef NG_PROC
}

__device__ __forceinline__ void phase_l1(Frame& F, const KA a, int layer, const float* xin, const bool dry) {
    const int gw = F.vcu * NWAVES + F.wave, NGW = F.G * NWAVES;
    LAS float* Wr = (LAS float*)(F.lds + RING_OFF);
    LAS unsigned* hist = (LAS unsigned*)(F.lds + LDSCTL_OFF);
    { const f32x4* src = (const f32x4*)((const float*)(a.ws() + WS_RT) + (size_t)layer * 36 * 1024);
      f32x4 tmp[18];
#pragma unroll
      for (int k = 0; k < 18; ++k) tmp[k] = src[F.tid + 512 * k];
#pragma unroll
      for (int k = 0; k < 18; ++k) *(LAS f32x4*)(Wr + 4 * (F.tid + 512 * k)) = tmp[k];
      if (F.tid < 32) hist[F.tid] = 0u; }
    __syncthreads();
    const float* mod = (const float*)(a.ws() + WS_MOD) + (size_t)layer * 16 * 6144;
    const bf16* yb = (const bf16*)(a.ws() + WS_BUF0 + 1 * BUFSZ);
    bf16* h2 = (bf16*)(a.ws() + WS_BUF0);
    const float* lng = a.in(4) + (size_t)(layer * 2 + 0) * D; const float* lnb = a.in(5) + (size_t)(layer * 2 + 0) * D;
    const float* bg = a.in(15) + layer * 4; const float* be = a.in(17) + layer * 32;
    int* eid = (int*)(a.ws() + WS_EID); float* wt = (float*)(a.ws() + WS_WT);
    const unsigned short* xhin = (const unsigned short*)a.out();
    unsigned short* xhout = (unsigned short*)(a.ws() + WS_BUF0 + 1 * BUFSZ);
    const int tpw = ((M + NGW - 1) / NGW + 3) & ~3;
    int curb = -1; f32x4 g1v[4], lgv[4], lbv[4], scv[4], shv[4];
    for (int t0 = gw * tpw; t0 < (gw + 1) * tpw && t0 < M; t0 += 4) {
        const int b = t0 >> 12;
        if (b != curb) { curb = b; const float* mb = mod + (size_t)b * 6144;
#pragma unroll
            for (int j = 0; j < 4; ++j) { const int col = 4 * F.lane + 256 * j; g1v[j] = *(const f32x4*)(mb + 2048 + col); lgv[j] = *(const f32x4*)(lng + col); lbv[j] = *(const f32x4*)(lnb + col);
                scv[j] = *(const f32x4*)(mb + 4096 + col) + 1.0f; shv[j] = *(const f32x4*)(mb + 3072 + col); } }
        f32x4 hv[4][4];
        {
            f32x4 v[4][4]; float s[4] = {0.f, 0.f, 0.f, 0.f};
            u64 yw[4][4];
#pragma unroll
            for (int j = 0; j < 4; ++j)
#pragma unroll
                for (int tt = 0; tt < 4; ++tt) yw[tt][j] = *(const u64*)(yb + (size_t)(t0 + tt) * D + 4 * F.lane + 256 * j);
            if (layer == 0) {
#pragma unroll
                for (int j = 0; j < 4; ++j)
#pragma unroll
                    for (int tt = 0; tt < 4; ++tt) v[tt][j] = *(const f32x4*)(xin + (size_t)(t0 + tt) * D + 4 * F.lane + 256 * j);
            } else { u64 xr[4][4];
#pragma unroll
                for (int j = 0; j < 4; ++j)
#pragma unroll
                    for (int tt = 0; tt < 4; ++tt) xr[tt][j] = *(const u64*)(xhin + (size_t)(t0 + tt) * D + 4 * F.lane + 256 * j);
#pragma unroll
                for (int j = 0; j < 4; ++j)
#pragma unroll
                    for (int tt = 0; tt < 4; ++tt) v[tt][j] = unpk_h4(xr[tt][j]);
            }
#pragma unroll
            for (int j = 0; j < 4; ++j) { const f32x4 g1 = g1v[j];
#pragma unroll
                for (int tt = 0; tt < 4; ++tt) { const u64 y_ = yw[tt][j];
                    f32x4 yv; yv[0] = bflo((unsigned)y_); yv[1] = bfhi((unsigned)y_); yv[2] = bflo((unsigned)(y_ >> 32)); yv[3] = bfhi((unsigned)(y_ >> 32));
                    v[tt][j] = v[tt][j] * DN_ALPHA + g1 * yv; s[tt] += (v[tt][j][0] + v[tt][j][1]) + (v[tt][j][2] + v[tt][j][3]); } }
            float rstd[4];
#pragma unroll
            for (int tt = 0; tt < 4; ++tt) { const float mean = wave_sum(s[tt], F.lane) * (1.0f / D); float s2 = 0.f;
#pragma unroll
                for (int j = 0; j < 4; ++j) { v[tt][j] = v[tt][j] - mean; s2 += (v[tt][j][0] * v[tt][j][0] + v[tt][j][1] * v[tt][j][1]) + (v[tt][j][2] * v[tt][j][2] + v[tt][j][3] * v[tt][j][3]); }
                rstd[tt] = __builtin_amdgcn_rsqf(wave_sum(s2, F.lane) * (1.0f / D) + LN_EPS); }
#pragma unroll
            for (int j = 0; j < 4; ++j) { const int col = 4 * F.lane + 256 * j;
                const f32x4 lg_ = lgv[j], lb_ = lbv[j], sc2 = scv[j], sh2 = shv[j];
#pragma unroll
                for (int tt = 0; tt < 4; ++tt) { const size_t ro = (size_t)(t0 + tt) * D;
                    const f32x4 xo = v[tt][j] * rstd[tt] * lg_ + lb_;
                    *(u64*)(xhout + ro + col) = (u64)pkh(xo[0], xo[1]) | ((u64)pkh(xo[2], xo[3]) << 32);
                    const f32x4 hh2 = xo * sc2 + sh2; hv[tt][j] = hh2;
                    *(u64*)(h2 + ro + col) = (u64)pkbf(hh2[0], hh2[1]) | ((u64)pkbf(hh2[2], hh2[3]) << 32); } }
        }
        float gl[4][4];
        { f32x4 w[4][4];
#pragma unroll
          for (int g = 0; g < 4; ++g)
#pragma unroll
              for (int j = 0; j < 4; ++j) w[g][j] = *(const LAS f32x4*)(Wr + g * 1024 + 4 * F.lane + 256 * j);
#pragma unroll
          for (int tt = 0; tt < 4; ++tt)
#pragma unroll
              for (int g = 0; g < 4; ++g) { float s0 = 0.f;
#pragma unroll
                  for (int j = 0; j < 4; ++j) s0 += (hv[tt][j][0] * w[g][j][0] + hv[tt][j][1] * w[g][j][1]) + (hv[tt][j][2] * w[g][j][2] + hv[tt][j][3] * w[g][j][3]);
                  gl[tt][g] = wave_sum(s0, F.lane) + bg[g]; } }
#pragma unroll
        for (int tt = 0; tt < 4; ++tt) {
            int gi = 0; float gm = gl[tt][0];
#pragma unroll
            for (int g = 1; g < 4; ++g) if (gl[tt][g] > gm) { gm = gl[tt][g]; gi = g; }
            float gs = 0.f;
#pragma unroll
            for (int g = 0; g < 4; ++g) gs += fexp(gl[tt][g] - gm);
            const float gw_ = __builtin_amdgcn_rcpf(gs);
            gi = __builtin_amdgcn_readfirstlane(gi);
            float el[8];
#pragma unroll
            for (int half = 0; half < 2; ++half) { f32x4 w[4][4]; const LAS float* wrow = Wr + (4 + gi * 8 + half * 4) * 1024 + 4 * F.lane;
#pragma unroll
                for (int q = 0; q < 4; ++q)
#pragma unroll
                    for (int j = 0; j < 4; ++j) w[q][j] = *(const LAS f32x4*)(wrow + q * 1024 + 256 * j);
#pragma unroll
                for (int q = 0; q < 4; ++q) { float s0 = 0.f;
#pragma unroll
                    for (int j = 0; j < 4; ++j) s0 += (hv[tt][j][0] * w[q][j][0] + hv[tt][j][1] * w[q][j][1]) + (hv[tt][j][2] * w[q][j][2] + hv[tt][j][3] * w[q][j][3]);
                    el[half * 4 + q] = wave_sum(s0, F.lane) + be[gi * 8 + half * 4 + q]; } }
            int i0 = 0; float m0 = el[0];
#pragma unroll
            for (int q = 1; q < 8; ++q) if (el[q] > m0) { m0 = el[q]; i0 = q; }
            int i1 = -1; float m1 = -INFINITY;
#pragma unroll
            for (int q = 0; q < 8; ++q) if (q != i0 && el[q] > m1) { m1 = el[q]; i1 = q; }
            const float p1 = fexp(m1 - m0); const float rr_ = __builtin_amdgcn_rcpf(1.0f + p1); const float w0 = gw_ * rr_, w1 = gw_ * p1 * rr_;
            if (F.lane == 0) { const int e0 = gi * 8 + i0, e1 = gi * 8 + i1, tok = t0 + tt;
                *(int2*)(eid + 2 * tok) = make_int2(e0, e1); *(float2*)(wt + 2 * tok) = make_float2(w0, w1);
                __hip_atomic_fetch_add(&hist[e0], 1u, __ATOMIC_RELAXED, __HIP_MEMORY_SCOPE_WORKGROUP); __hip_atomic_fetch_add(&hist[e1], 1u, __ATOMIC_RELAXED, __HIP_MEMORY_SCOPE_WORKGROUP); }
        }
    }
    __syncthreads();
    if (F.tid < 32 && !dry) { const unsigned c = hist[F.tid]; if (c) __hip_atomic_fetch_add(F.ctl + CW_CNT + 256 * layer + F.tid, c, RLX_AGENT); }
}

__device__ __forceinline__ void phase_m2(Frame& F, const KA a, int layer) {
    LAS int* pstart = (LAS int*)(F.lds + RING_OFF);
    LAS unsigned* lhist = (LAS unsigned*)(F.lds + RING_OFF + 256);
    LAS int* lbase = (LAS int*)(F.lds + RING_OFF + 512);
    int* blk_e = (int*)(a.ws() + WS_BLKE) + layer * 1024;
    LAS int* cntl = (LAS int*)(F.lds + RING_OFF + 768);
    if (F.tid < 32) cntl[F.tid] = (int)__hip_atomic_load(F.ctl + CW_CNT + 256 * layer + F.tid, RLX_AGENT);
    __syncthreads();
    if (F.tid == 0) { int off = 0;
#pragma unroll 1
        for (int e = 0; e < 32; ++e) { pstart[e] = off; off += ((cntl[e] + 255) >> 8) << 8; }
        pstart[32] = off;
        if (F.bx == 0) __hip_atomic_store(F.ctl + CW_CNT + 256 * layer + 128, (unsigned)(off >> 8), RLX_AGENT); }
    __syncthreads();
    if (F.bx == 0) { const int nblk = pstart[32] >> 8;
        for (int blk = F.tid; blk < nblk; blk += NWAVES * 64) { int e = 0;
#pragma unroll 1
            for (int k = 1; k < 32; ++k) e = (pstart[k] <= blk * 256) ? k : e;
            blk_e[blk] = e; } }
    const int* eid = (const int*)(a.ws() + WS_EID); const float* wt = (const float*)(a.ws() + WS_WT);
    int* tslot = (int*)(a.ws() + WS_TSLOT); float* slotw = (float*)(a.ws() + WS_SLOTW);
    int* stok = (int*)(a.ws() + WS_STOK);
    for (int e = F.vcu; e < 32; e += F.G) { const int c = cntl[e];
        for (int s = pstart[e] + c + F.tid; s < pstart[e + 1]; s += NWAVES * 64) stok[s] = 0; }
    for (int chunk = F.vcu; chunk < M / 256; chunk += F.G) {
        if (F.tid < 32) lhist[F.tid] = 0u;
        __syncthreads();
        const int pi = chunk * 512 + F.tid;
        const int e = eid[pi];
        const unsigned rank = __hip_atomic_fetch_add(&lhist[e], 1u, __ATOMIC_RELAXED, __HIP_MEMORY_SCOPE_WORKGROUP);
        __syncthreads();
        if (F.tid < 32) { const unsigned c = lhist[F.tid]; lbase[F.tid] = pstart[F.tid] + (c ? (int)__hip_atomic_fetch_add(F.ctl + CW_CNT + 256 * layer + 64 + F.tid, c, RLX_AGENT) : 0); }
        __syncthreads();
        const int slot = lbase[e] + (int)rank;
        tslot[pi] = slot; slotw[slot] = wt[pi]; stok[slot] = pi >> 1;
        __syncthreads();
    }
}

__device__ __forceinline__ void phase_l2(Frame& F, const KA a, int layer) {
    const int gw = F.vcu * NWAVES + F.wave, NGW = F.G * NWAVES;
    const float* mod = (const float*)(a.ws() + WS_MOD) + (size_t)layer * 16 * 6144;
    const bf16* ys = (const bf16*)(a.ws() + WS_BUF0 + 2 * BUFSZ); const int* tslot = (const int*)(a.ws() + WS_TSLOT);
    bf16* hn = (bf16*)(a.ws() + WS_BUF0);
    const float* lng = a.in(4) + (size_t)(layer * 2 + 1) * D; const float* lnb = a.in(5) + (size_t)(layer * 2 + 1) * D;
    float* x = a.out(); unsigned short* xho = (unsigned short*)a.out(); const unsigned short* xh = (const unsigned short*)(a.ws() + WS_BUF0 + 1 * BUFSZ);
    const int mlay = (layer < DEPTH - 1) ? 16 * 6144 : 0;
    const int tpw = ((M + NGW - 1) / NGW + 3) & ~3;
    for (int t0 = gw * tpw; t0 < (gw + 1) * tpw && t0 < M; t0 += 4) {
        const int b = t0 >> 12; const float* mb = mod + (size_t)b * 6144;
        int sl[8];
        { const int4 s0 = *(const int4*)(tslot + 2 * t0), s1 = *(const int4*)(tslot + 2 * t0 + 4); sl[0] = s0.x; sl[1] = s0.y; sl[2] = s0.z; sl[3] = s0.w; sl[4] = s1.x; sl[5] = s1.y; sl[6] = s1.z; sl[7] = s1.w; }
        u64 xr[4][4], y0r[4][4], y1r[4][4];
#pragma unroll
        for (int j = 0; j < 4; ++j) { const int col = 4 * F.lane + 256 * j;
#pragma unroll
            for (int tt = 0; tt < 4; ++tt) { xr[tt][j] = *(const u64*)(xh + (size_t)(t0 + tt) * D + col);
                y0r[tt][j] = *(const u64*)(ys + (size_t)sl[2 * tt] * D + col); y1r[tt][j] = *(const u64*)(ys + (size_t)sl[2 * tt + 1] * D + col); } }
        f32x4 g2v[4];
#pragma unroll
        for (int j = 0; j < 4; ++j) g2v[j] = *(const f32x4*)(mb + 5120 + 4 * F.lane + 256 * j);
        asm volatile("" ::: "memory");
        f32x4 v[4][4]; float s[4] = {0.f, 0.f, 0.f, 0.f};
#pragma unroll
        for (int j = 0; j < 4; ++j) { const f32x4 g2 = g2v[j];
#pragma unroll
            for (int tt = 0; tt < 4; ++tt) {
                const f32x4 xv = unpk_h4(xr[tt][j]); const u64 y0 = y0r[tt][j], y1 = y1r[tt][j];
                f32x4 yv; yv[0] = bflo((unsigned)y0) + bflo((unsigned)y1); yv[1] = bfhi((unsigned)y0) + bfhi((unsigned)y1);
                yv[2] = bflo((unsigned)(y0 >> 32)) + bflo((unsigned)(y1 >> 32)); yv[3] = bfhi((unsigned)(y0 >> 32)) + bfhi((unsigned)(y1 >> 32));
                v[tt][j] = xv * DN_ALPHA + g2 * yv; s[tt] += (v[tt][j][0] + v[tt][j][1]) + (v[tt][j][2] + v[tt][j][3]); } }
        f32x4 lgv[4], lbv[4], scv[4], shv[4];
#pragma unroll
        for (int j = 0; j < 4; ++j) { const int col = 4 * F.lane + 256 * j; lgv[j] = *(const f32x4*)(lng + col); lbv[j] = *(const f32x4*)(lnb + col);
            scv[j] = *(const f32x4*)(mb + mlay + 1024 + col); shv[j] = *(const f32x4*)(mb + mlay + col); }
        asm volatile("" ::: "memory");
        float rstd[4];
#pragma unroll
        for (int tt = 0; tt < 4; ++tt) { const float mean = wave_sum(s[tt], F.lane) * (1.0f / D); float s2 = 0.f;
#pragma unroll
            for (int j = 0; j < 4; ++j) { v[tt][j] = v[tt][j] - mean; s2 += (v[tt][j][0] * v[tt][j][0] + v[tt][j][1] * v[tt][j][1]) + (v[tt][j][2] * v[tt][j][2] + v[tt][j][3] * v[tt][j][3]); }
            rstd[tt] = __builtin_amdgcn_rsqf(wave_sum(s2, F.lane) * (1.0f / D) + LN_EPS); }
        if (layer == DEPTH - 1) {
#pragma unroll
            for (int j = 0; j < 4; ++j) { const int col = 4 * F.lane + 256 * j;
#pragma unroll
                for (int tt = 0; tt < 4; ++tt) *(f32x4*)(x + (size_t)(t0 + tt) * D + col) = v[tt][j] * rstd[tt] * lgv[j] + lbv[j]; }
        } else {
#pragma unroll
            for (int j = 0; j < 4; ++j) { const int col = 4 * F.lane + 256 * j;
#pragma unroll
                for (int tt = 0; tt < 4; ++tt) { const size_t ro = (size_t)(t0 + tt) * D;
                    const f32x4 xo = v[tt][j] * rstd[tt] * lgv[j] + lbv[j];
                    *(u64*)(xho + ro + col) = (u64)pkh(xo[0], xo[1]) | ((u64)pkh(xo[2], xo[3]) << 32);
                    const f32x4 hv = xo * (scv[j] + 1.0f) + shv[j];
                    *(u64*)(hn + ro + col) = (u64)pkbf(hv[0], hv[1]) | ((u64)pkbf(hv[2], hv[3]) << 32); } }
        }
    }
}

#ifndef MK_SEPARATE
#define MK_SEPARATE 0
#endif
constexpr int N_PHASES = 2 + 10 * DEPTH;
#ifndef PH_MASK
#define PH_MASK 0xFFFFF
#endif
#define PH_ON(n) (((PH_MASK) >> (n)) & 1)
#ifndef DBL_MASK
#define DBL_MASK 0
#endif
#define DBL(n) for (int rep_ = 0; rep_ < 1 + (((DBL_MASK) >> (n)) & 1); ++rep_)
__global__ void __launch_bounds__(NWAVES * 64, 2) fwd_kernel(Args args) {
    extern __shared__ __attribute__((aligned(16))) unsigned char lds[];
    const int wave_s = __builtin_amdgcn_readfirstlane((int)threadIdx.x >> 6);
    gu32* const ctl0 = (gu32*)(karg_fresh().ws() + WS_CTL);
    for (int u = threadIdx.x; u < (LDS_BYTES - LDSCTL_OFF) / 4; u += NWAVES * 64) ((LAS unsigned*)((LAS unsigned char*)lds + LDSCTL_OFF))[u] = 0u;
    __syncthreads();
    XcdBarrier bar; bar.bar = (unsigned*)(ctl0 + CW_BAR); bar.x = 0; bar.st = nullptr;
    if (!MK_SEPARATE) bar = xcd_barrier_post((unsigned*)(ctl0 + CW_BAR), (volatile LAS unsigned*)((LAS unsigned char*)lds + MISC_OFF) + 8);
    const int lo = karg_fresh().ph_lo(), hi = karg_fresh().ph_hi();
    const bool PANEL = !MK_SEPARATE && gridDim.x == (unsigned)(M / 256);
#define IN(k) (lo <= (k) && (k) < hi)
#define FRESH() const KA ka = karg_fresh(); unsigned char* const ws = ka.ws(); (void)ws; Frame F; { int t_, g_ = gridDim.x, bx_ = blockIdx.x; asm volatile("v_mbcnt_lo_u32_b32 %0, -1, 0\n\tv_mbcnt_hi_u32_b32 %0, -1, %0" : "=v"(t_)); asm volatile("" : "+s"(g_), "+s"(bx_)); t_ |= wave_s << 6; \
        F.lds = (LAS unsigned char*)lds; F.MISC = (volatile LAS unsigned*)(F.lds + MISC_OFF); F.ctl = (gu32*)(ws + WS_CTL); F.tid = t_; F.lane = t_ & 63; F.wave = __builtin_amdgcn_readfirstlane(t_ >> 6); \
        F.G = g_; F.bx = bx_; F.vcu = (g_ % 8 == 0) ? (bx_ % 8) * (g_ / 8) + bx_ / 8 : bx_; }
#ifndef DBL_BARRIER
#define DBL_BARRIER 0
#endif
#define SEAM(k) do { if (IN(k) && IN((k) + 1)) { if (MK_SEPARATE) { } else { xcd_barrier(bar, wave_s); if (DBL_BARRIER) xcd_barrier(bar, wave_s); } } } while (0)
#define BUF(i) ((bf16*)(ws + WS_BUF0 + (size_t)(i) * BUFSZ))

    if (PH_ON(0) && IN(0)) { FRESH(); DBL(0) phase_p0a(F, ka); }
    SEAM(0);
    if (PH_ON(1) && IN(1)) { FRESH(); DBL(1) phase_p0b(F, ka); }
    SEAM(1);
    for (int i = 0; i < DEPTH; ++i) {
        const int pb = 2 + 10 * i, j = i >> 1;
        if ((i & 1) == 0) {
            if (PH_ON(2) && IN(pb)) { FRESH();
                pg8::Gemm g{BUF(0), (const bf16*)(ws + WS_WHIN) + (size_t)j * 4096 * 1024, M, 4096, D, 0, nullptr}; pg8::StaticOrder S; S.init(M, 4096, F.G, F.bx);
                pg8::EpiBf16<0> E{BUF(1), D, nullptr, D, BUFSZ / 2, 1.0f};
                DBL(2) pg8::gemm_phase<pg8::EpiBf16<0>, pg8::StaticOrder, true, true>(F.lds + RING_OFF, g, S, E, F.tid);
            }
            SEAM(pb);
            if (PH_ON(3) && IN(pb + 1)) { FRESH(); phase_hgrn_prep(F, ka, j); }
            SEAM(pb + 1);
            if (PH_ON(4) && IN(pb + 2)) { FRESH(); DBL(4) phase_hgrn_scan(F, ka, i); }
            SEAM(pb + 2);
            if (PH_ON(5) && IN(pb + 3)) { FRESH(); phase_normgate<0>(F, BUF(6), BUF(4), BUF(4), ka.in(9) + j * 128, 0.f, 1.0f); }
            if (!PANEL) SEAM(pb + 3);
        } else {
            if (PH_ON(6) && IN(pb)) { FRESH();
                pg8::Gemm g{BUF(0), (const bf16*)(ws + WS_WAIN) + (size_t)j * 3072 * 1024, M, 3072, D, 0, nullptr}; pg8::StaticOrder S; S.init(M, 3072, F.G, F.bx);
                pg8::EpiRope E{BUF(1), BUF(2), BUF(3), (const float*)(ws + WS_ROPE_C), (const float*)(ws + WS_ROPE_S), attn_body::C2, SEQ - 1};
                DBL(6) pg8::gemm_phase<pg8::EpiRope, pg8::StaticOrder, true, true>(F.lds + RING_OFF, g, S, E, F.tid);
            }
            SEAM(pb);
            if (PH_ON(7) && IN(pb + 1)) { FRESH();
                const attn_body::AttnTensors AT{(const attn_body::bf16*)BUF(1), (const attn_body::bf16*)BUF(2), (const attn_body::bf16*)BUF(3), (attn_body::bf16*)BUF(4), (attn_body::bf16*)BUF(5)};
                static_assert(attn_body::ATTNW_LDS_BYTES <= RING_BYTES, "attention LDS");
                const attn_body::StaticOrderW S((int)F.G, F.vcu);
                const float* lp = ka.in(12) + j * 256;
                const float d1 = wave_sum(lp[F.lane] * lp[64 + F.lane], F.lane), d2 = wave_sum(lp[128 + F.lane] * lp[192 + F.lane], F.lane);
                const float linit = (j == 0) ? 0.35550906759f : 0.55605820415f;
                const float lam = fexp(d1) - fexp(d2) + linit;
                const attn_body::CombineW CB{(const attn_body::bf16*)BUF(4), (attn_body::bf16*)BUF(6), ka.in(13) + j * 128, lam, 1.0f - linit};
                DBL(7) attn_body::attn_phase_w<8>((char*)lds + RING_OFF, AT, S, CB, F.tid);
            }
            SEAM(pb + 1);
        }
        if (PH_ON(9) && IN(pb + 4)) { FRESH();
            const bf16* A = (i & 1) ? BUF(6) : BUF(4);
            const bf16* W = (i & 1) ? (const bf16*)(ws + WS_WAOUT) + (size_t)j * 1024 * 1024 : (const bf16*)(ws + WS_WHOUT) + (size_t)j * 1024 * 1024;
            pg8::Gemm g{A, W, M, D, D, 0, nullptr};
            pg8::EpiBf16<0> E{BUF(1), D, nullptr, 0, 0, 1.0f};
            if (PANEL) {
                __syncthreads();
                pg8::PanelOrder S{F.vcu, D / 256};
                pg8::gemm_phase<pg8::EpiBf16<0>, pg8::PanelOrder, true, true>(F.lds + RING_OFF, g, S, E, F.tid);
                __syncthreads();
            } else {
                pg8::StaticOrder S; S.init(M, D, F.G, F.bx);
                DBL(9) pg8::gemm_phase<pg8::EpiBf16<0>, pg8::StaticOrder, true, true>(F.lds + RING_OFF, g, S, E, F.tid);
            }
        }
        if (!PANEL) SEAM(pb + 4);
        if (PH_ON(10) && IN(pb + 5)) { FRESH(); phase_l1(F, ka, i, i == 0 ? ka.in(0) : (const float*)ka.out(), false);
            if ((((DBL_MASK) >> 10) & 1) && i == 0) { __syncthreads(); phase_l1(F, ka, i, ka.in(0), true); } }
        SEAM(pb + 5);
        if (PH_ON(11) && IN(pb + 6)) { FRESH(); phase_m2(F, ka, i); }
        SEAM(pb + 6);
        if (PH_ON(12) && IN(pb + 7)) { FRESH();
            const int nblk = (int)__hip_atomic_load(F.ctl + CW_CNT + 256 * i + 128, RLX_AGENT);
            pg8::Gemm g{BUF(0), (const bf16*)moe_wbuf(ws, i), nblk * 256, 1024, D, (size_t)1024 * 1024 * 2, (const int*)(ws + WS_STOK)};
            pg8::MoeOrder S; S.init(nblk * 256, 1024, F.G, F.bx); S.blk_e = (const int*)(ws + WS_BLKE) + i * 1024;
            pg8::EpiSwiGLU E{BUF(5)};
            DBL(12) pg8::gemm_phase<pg8::EpiSwiGLU, pg8::MoeOrder, true, true, true>(F.lds + RING_OFF, g, S, E, F.tid);
        }
        SEAM(pb + 7);
        if (PH_ON(13) && IN(pb + 8)) { FRESH();
            const int nblk = (int)__hip_atomic_load(F.ctl + CW_CNT + 256 * i + 128, RLX_AGENT);
            pg8::Gemm g{BUF(5), (const bf16*)(moe_wbuf(ws, i) + 64 * MiB), nblk * 256, 1024, FF, (size_t)1024 * 512 * 2, nullptr};
            pg8::MoeOrder S; S.init(nblk * 256, 1024, F.G, F.bx); S.blk_e = (const int*)(ws + WS_BLKE) + i * 1024;
            pg8::EpiRowScale E{BUF(2), (const float*)(ws + WS_SLOTW)};
            DBL(13) pg8::gemm_phase<pg8::EpiRowScale, pg8::MoeOrder, true, true>(F.lds + RING_OFF, g, S, E, F.tid);
        }
        SEAM(pb + 8);
        if (PH_ON(14) && IN(pb + 9)) { FRESH(); DBL(14) phase_l2(F, ka, i); }
        SEAM(pb + 9);
    }
#undef IN
#undef SEAM
}

extern "C" void kernel_launch(void* const* d_in, const int* in_sizes, int n_in, void* d_out, int out_size, void* d_ws, size_t ws_size, hipStream_t stream) {
    static int grid = 0;
    if (grid == 0) {
        if (n_in != 21 || in_sizes[0] != M * D || out_size != M * D || ws_size < WS_END) { fprintf(stderr, "kernel_launch: unexpected shapes / workspace (n_in %d, ws %zu, need %zu)\n", n_in, ws_size, (size_t)WS_END); grid = -1; return; }
        int dev = 0, cus = 0, per_cu = 0;
        if (hipGetDevice(&dev) != hipSuccess || hipDeviceGetAttribute(&cus, hipDeviceAttributeMultiprocessorCount, dev) != hipSuccess) { grid = -1; return; }
        if (hipFuncSetAttribute((const void*)fwd_kernel, hipFuncAttributeMaxDynamicSharedMemorySize, LDS_BYTES) != hipSuccess) { fprintf(stderr, "kernel_launch: hipFuncSetAttribute failed\n"); grid = -1; return; }
        if (hipOccupancyMaxActiveBlocksPerMultiprocessor(&per_cu, (const void*)fwd_kernel, NWAVES * 64, LDS_BYTES) != hipSuccess || per_cu < 1) fprintf(stderr, "kernel_launch: occupancy query says %d\n", per_cu);
        (void)hipGetLastError();
        grid = cus;
    }
    if (grid < 0) return;
    if (hipMemsetAsync((char*)d_ws + WS_CTL, 0, CTL_ZERO_BYTES, stream) != hipSuccess) return;
    Args a{};
    for (int i = 0; i < 21; ++i) a.in[i] = (const float*)d_in[i];
    a.out = (float*)d_out; a.ws = (unsigned char*)d_ws;
#if MK_SEPARATE
    for (int p = 0; p < N_PHASES; ++p) {
        if (p >= 2 && (((p - 2) / 10) & 1) == 1 && ((p - 2) % 10) == 3) continue;
        a.ph_lo = p; a.ph_hi = p + 1;
        hipLaunchKernelGGL(fwd_kernel, dim3(grid), dim3(NWAVES * 64), LDS_BYTES, stream, a);
    }
#else
    a.ph_lo = 0; a.ph_hi = N_PHASES;
    hipLaunchKernelGGL(fwd_kernel, dim3(grid), dim3(NWAVES * 64), LDS_BYTES, stream, a);
#endif
}
```

```cpp
#include <hip/hip_runtime.h>
#include <cstdio>
#include <cstdint>
namespace pg8 {
#define PG8_LAS __attribute__((address_space(3)))
typedef unsigned short bf16_t;
typedef short bf16x8 __attribute__((ext_vector_type(8)));
typedef float f32x4 __attribute__((ext_vector_type(4)));
typedef unsigned u32x4 __attribute__((ext_vector_type(4)));
constexpr int BM = 256, BK = 64, HALF = 128, HTB = HALF * BK * 2  , STAGE_BYTES = 8 * HTB, NXCD = 8, WGM = 8;

__host__ __device__ __forceinline__ int lds_byte(int r, int c) { const int st = (r >> 4) * 2 + (c >> 5), rr = r & 15, cc = c & 31, ob = rr * 64 + cc * 2; return st * 1024 + (ob ^ (((ob >> 9) & 1) << 5)); }
__host__ __device__ __forceinline__ void stage_rc(int b, int& R, int& C) { const int st = b / 1024, sb = b % 1024, swz = sb ^ (((sb >> 9) & 1) << 5); R = (st >> 1) * 16 + swz / 64; C = (st & 1) * 32 + (swz % 64) / 2; }
__host__ __device__ __forceinline__ int perm32(int rho) { const int n = rho >> 4, i = rho & 15; return 8 * (i >> 2) + 4 * n + (i & 3); }

struct Unit { int pm, pn, e; };
struct Gemm { const bf16_t* A; const bf16_t* Bt; int M, N, K; size_t estride; const int* arow; };

struct StaticOrder {
    int nM, nN, nwg, G, c;
    __host__ __device__ void init(int M, int N, int G_, int c_) { nM = M / BM; nN = N / BM; nwg = nM * nN; G = G_; c = c_; }
    __host__ __device__ bool next(int i, Unit& u) const {
        const long L = (long)i * G + c; if (L >= nwg) return false;
        int wgid = (int)L; { const int q = nwg / NXCD, r = nwg % NXCD, xcd = wgid % NXCD, off = wgid / NXCD; wgid = (xcd < r ? xcd * (q + 1) : r * (q + 1) + (xcd - r) * q) + off; }
        const int nig = WGM * nN, gid = wgid / nig, fm = gid * WGM, gsz = (nM - fm) < WGM ? (nM - fm) : WGM;
        u.pm = fm + ((wgid % nig) % gsz); u.pn = (wgid % nig) / gsz; u.e = 0; return true;
    }
    __device__ __forceinline__ void a_ready(const Unit&) const {}
    __device__ __forceinline__ void done(const Unit&) const {}
};

__device__ __forceinline__ unsigned cvt_pk_bf16(float lo, float hi) { unsigned r; asm volatile("v_cvt_pk_bf16_f32 %0, %1, %2" : "=v"(r) : "v"(lo), "v"(hi)); return r; }
typedef float f32x2 __attribute__((ext_vector_type(2)));
__device__ __forceinline__ f32x2 gelu_pk(f32x2 v) {
    const f32x2 av = __builtin_elementwise_abs(v), d = av * 0.2316418882f + 1.0f;
    f32x2 t; t.x = __builtin_amdgcn_rcpf(d.x); t.y = __builtin_amdgcn_rcpf(d.y);
    f32x2 q = t * 0.5307027145f + (-0.7265760135f); q = q * t + 0.7107068705f; q = q * t + (-0.142248368f); q = q * t + 0.127414796f; q = q * t;
    const f32x2 s = (v * v) * (-0.72134752044f);
    f32x2 e; e.x = __builtin_amdgcn_exp2f(s.x); e.y = __builtin_amdgcn_exp2f(s.y);
    const f32x2 m = v * (q * e), r = v - m;
    f32x2 o; o.x = v.x < 0.f ? m.x : r.x; o.y = v.y < 0.f ? m.y : r.y; return o;
}

template <int ACT  > struct EpiBf16 {
    static constexpr bool PERM = true, AFTER_DRAIN = false; static_assert(ACT == 0 || ACT == 1, "EpiBf16: ACT is 0 (none) or 1 (gelu_pk)");
    bf16_t* O; int ldc; const float* bias; int split_cols; size_t split_stride; float scale0;
    __device__ __forceinline__ void operator()(const f32x4 (&acc)[2][2][4][2], const Unit& u, int wr, int wc, int fr, int fq) const {
        const int row0 = u.pm * BM + wr * 64 + fr; int colt = u.pn * BM; bf16_t* base = O;
        float sc = 1.f; if (split_cols) { const int t = colt / split_cols; base += (size_t)t * split_stride; colt -= t * split_cols; if (t == 0) sc = scale0; }
        const int col0 = colt + wc * 32 + 8 * fq, bcol0 = u.pn * BM + wc * 32 + 8 * fq;
        f32x4 bv[2][2];
#pragma unroll
        for (int bj = 0; bj < 2; ++bj)
#pragma unroll
            for (int n = 0; n < 2; ++n) bv[bj][n] = bias ? *(const f32x4*)(bias + bcol0 + bj * HALF + 4 * n) : (f32x4){0.f, 0.f, 0.f, 0.f};
#pragma unroll
        for (int ai = 0; ai < 2; ++ai)
#pragma unroll
            for (int m = 0; m < 4; ++m) { bf16_t* rowp = base + (size_t)(row0 + ai * HALF + m * 16) * ldc + col0;
#pragma unroll
                for (int bj = 0; bj < 2; ++bj) { f32x4 v0 = acc[ai][bj][m][0] + bv[bj][0], v1 = acc[ai][bj][m][1] + bv[bj][1];
                    if (ACT == 1) { f32x2 a = gelu_pk((f32x2){v0[0], v0[1]}), b = gelu_pk((f32x2){v0[2], v0[3]}), c = gelu_pk((f32x2){v1[0], v1[1]}), d = gelu_pk((f32x2){v1[2], v1[3]});
                        v0 = (f32x4){a.x, a.y, b.x, b.y}; v1 = (f32x4){c.x, c.y, d.x, d.y}; }
                    v0 = v0 * sc; v1 = v1 * sc; u32x4 w; w.x = cvt_pk_bf16(v0[0], v0[1]); w.y = cvt_pk_bf16(v0[2], v0[3]); w.z = cvt_pk_bf16(v1[0], v1[1]); w.w = cvt_pk_bf16(v1[2], v1[3]);
                    *(u32x4*)(rowp + bj * HALF) = w; } }
    }
};

template <class Epi, class Sched, bool ALIGN_EPI = false, bool SP2 = false, bool GATHER = false>
__device__ __forceinline__ void gemm_phase(PG8_LAS unsigned char* lds, const Gemm g, const Sched& S, const Epi& E, const int tid) {
        const int wid = __builtin_amdgcn_readfirstlane(tid >> 6), lane = tid & 63, wr = wid >> 2, wc = wid & 3, fr = lane & 15, fq = lane >> 4;
    const int K = g.K, nt = K / BK;
    unsigned voffA[2], voffB[2], gcolb[2];
#pragma unroll
    for (int i = 0; i < 2; ++i) { int R, C; stage_rc(tid * 16 + i * 8192, R, C); const int Rb = Epi::PERM ? ((R & ~31) + perm32(R & 31)) : R;
        voffA[i] = GATHER ? (unsigned)R * 4u   : (unsigned)(R * K + C) * 2u; voffB[i] = (unsigned)(Rb * K + C) * 2u; gcolb[i] = (unsigned)C * 2u; }
    unsigned gA[2][2] = {{0u, 0u}, {0u, 0u}}, gN[2][2] = {{0u, 0u}, {0u, 0u}};
#define PG8_ROWS(dst, u_) do { const char* rb_ = (const char*)(g.arow + (size_t)(u_).pm * BM); unsigned raw_[2][2];        \
        _Pragma("unroll") for (int _h = 0; _h < 2; ++_h) _Pragma("unroll") for (int _i = 0; _i < 2; ++_i) raw_[_h][_i] = (unsigned)*(const int*)(rb_ + voffA[_i] + _h * HALF * 4); \
        _Pragma("unroll") for (int _h = 0; _h < 2; ++_h) _Pragma("unroll") for (int _i = 0; _i < 2; ++_i) dst[_h][_i] = raw_[_h][_i] * (unsigned)(K * 2) + gcolb[_i]; } while (0)
    const size_t kstep = (size_t)(BK * 2);
    const size_t hstep = (size_t)HALF * K * 2;
    const size_t tstep = 2 * hstep;
    const unsigned ldsw = (unsigned)wid * 1024u;
    const int aoff = lds_byte(wr * 64 + fr, fq * 8), boff = lds_byte(wc * 32 + fr, fq * 8);
#define PG8_SA(b, h) (((b) * 2 + (h)) * HTB)
#define PG8_SB(b, h) ((4 + (b) * 2 + (h)) * HTB)
#define PG8_STAGE(bufoff, gbase, voff) do { _Pragma("unroll") for (int _i = 0; _i < 2; ++_i) \
        __builtin_amdgcn_global_load_lds((const unsigned*)((const char*)(gbase) + (voff)[_i]), (PG8_LAS unsigned*)(lds + (bufoff) + ldsw + _i * 8192), 16, 0, 0); } while (0)
#define PG8_STAGEA(bufoff, gbase, h_, nx_) do { if constexpr (GATHER) { _Pragma("unroll") for (int _i = 0; _i < 2; ++_i) \
        __builtin_amdgcn_global_load_lds((const unsigned*)((const char*)(gbase) + ((nx_) ? gN[h_][_i] : gA[h_][_i])), (PG8_LAS unsigned*)(lds + (bufoff) + ldsw + _i * 8192), 16, 0, 0); } \
        else { PG8_STAGE(bufoff, (gbase) + ((h_) ? hstep : (size_t)0), voffA); } } while (0)
#define PG8_LDA(dst, b, h) do { _Pragma("unroll") for (int m = 0; m < 4; ++m) _Pragma("unroll") for (int k = 0; k < 2; ++k) dst[m][k] = *(const PG8_LAS bf16x8*)(lds + PG8_SA(b, h) + aoff + m * 2048 + k * 1024); } while (0)
#define PG8_LDB(dst, b, h) do { _Pragma("unroll") for (int n = 0; n < 2; ++n) _Pragma("unroll") for (int k = 0; k < 2; ++k) dst[n][k] = *(const PG8_LAS bf16x8*)(lds + PG8_SB(b, h) + boff + n * 2048 + k * 1024); } while (0)
#define PG8_MMA(ai, bj, At, Bt) do { __builtin_amdgcn_s_setprio(1); _Pragma("unroll") for (int m = 0; m < 4; ++m) _Pragma("unroll") for (int n = 0; n < 2; ++n) _Pragma("unroll") for (int k = 0; k < 2; ++k) \
        acc[ai][bj][m][n] = __builtin_amdgcn_mfma_f32_16x16x32_bf16(Bt[n][k], At[m][k], acc[ai][bj][m][n], 0, 0, 0); __builtin_amdgcn_s_setprio(0); } while (0)
#define PG8_WAIT_V(n) asm volatile("s_waitcnt vmcnt(" #n ")" ::: "memory")
#define PG8_WAIT_L(n) asm volatile("s_waitcnt lgkmcnt(" #n ")" ::: "memory")
#define PG8_BAR __builtin_amdgcn_s_barrier()
#define PG8_SCHED __builtin_amdgcn_sched_barrier(0)
    Unit cur, nxt; int ui = 0;
    if (!S.next(0, cur)) return;
    f32x4 acc[2][2][4][2];
#pragma unroll
    for (int a = 0; a < 2; ++a)
#pragma unroll
        for (int b = 0; b < 2; ++b)
#pragma unroll
            for (int m = 0; m < 4; ++m)
#pragma unroll
                for (int n = 0; n < 2; ++n) acc[a][b][m][n] = (f32x4){0.f, 0.f, 0.f, 0.f};
    bf16x8 At[4][2], B0[2][2], B1[2][2];
    const char* cA = (const char*)g.A + (GATHER ? (size_t)0 : (size_t)cur.pm * tstep); const char* cB = (const char*)g.Bt + (size_t)cur.e * g.estride + (size_t)cur.pn * tstep;
    S.a_ready(cur);
    if constexpr (GATHER) PG8_ROWS(gA, cur);
    if constexpr (SP2) {
        PG8_STAGE(PG8_SB(0, 0), cB, voffB); PG8_STAGE(PG8_SB(0, 1), cB + hstep, voffB); PG8_STAGEA(PG8_SA(0, 0), cA, 0, false); PG8_STAGEA(PG8_SA(0, 1), cA, 1, false);
        if (wr == 1) PG8_BAR;
        PG8_WAIT_V(2); PG8_BAR;
        PG8_STAGE(PG8_SB(1, 0), cB + kstep, voffB); PG8_STAGEA(PG8_SA(1, 0), cA + kstep, 0, false); PG8_STAGE(PG8_SB(1, 1), cB + hstep + kstep, voffB);
        PG8_WAIT_V(6); PG8_BAR;
    } else {
        PG8_STAGE(PG8_SB(0, 0), cB, voffB); PG8_STAGEA(PG8_SA(0, 0), cA, 0, false); PG8_STAGE(PG8_SB(0, 1), cB + hstep, voffB); PG8_STAGEA(PG8_SA(0, 1), cA, 1, false);
        if (wr == 1) PG8_BAR;
        PG8_WAIT_V(4); PG8_BAR;
        PG8_STAGE(PG8_SB(1, 0), cB + kstep, voffB); PG8_STAGEA(PG8_SA(1, 0), cA + kstep, 0, false); PG8_STAGE(PG8_SB(1, 1), cB + hstep + kstep, voffB);
        PG8_WAIT_V(6); PG8_BAR;
    }
    for (;;) {
        const bool has_next = S.next(ui + 1, nxt);
        const char* nA = has_next ? (const char*)g.A + (GATHER ? (size_t)0 : (size_t)nxt.pm * tstep) : cA;
        if constexpr (GATHER) { if (has_next) PG8_ROWS(gN, nxt); else { _Pragma("unroll") for (int _h = 0; _h < 2; ++_h) _Pragma("unroll") for (int _i = 0; _i < 2; ++_i) gN[_h][_i] = gA[_h][_i]; } } const char* nB = has_next ? (const char*)g.Bt + (size_t)nxt.e * g.estride + (size_t)nxt.pn * tstep : cB;
        for (int t = 0; t < nt; t += 2) {
            const bool last = (t == nt - 2);
            const char* a1 = cA + (size_t)(t + 1) * kstep;
            const char* a2 = last ? nA : cA + (size_t)(t + 2) * kstep; const char* b2 = last ? nB : cB + (size_t)(t + 2) * kstep;
            const char* a3 = a2 + kstep; const char* b3 = b2 + kstep;
            if (last && has_next) S.a_ready(nxt);
            if constexpr (SP2) {
            PG8_LDB(B0, 0, 0); PG8_LDB(B1, 0, 1); PG8_SCHED; PG8_LDA(At, 0, 0); PG8_STAGEA(PG8_SA(1, 1), a1, 1, false);
            PG8_WAIT_V(8); PG8_WAIT_L(0); PG8_BAR; PG8_MMA(0, 0, At, B0); PG8_MMA(0, 1, At, B1); PG8_BAR; PG8_SCHED;
            PG8_LDA(At, 0, 1); PG8_STAGE(PG8_SB(0, 0), b2, voffB); PG8_STAGE(PG8_SB(0, 1), b2 + hstep, voffB); PG8_STAGEA(PG8_SA(0, 0), a2, 0, last);
            PG8_WAIT_V(8); PG8_WAIT_L(0); PG8_BAR; PG8_MMA(1, 0, At, B0); PG8_MMA(1, 1, At, B1); PG8_BAR; PG8_SCHED;
            PG8_LDB(B0, 1, 0); PG8_LDB(B1, 1, 1); PG8_SCHED; PG8_LDA(At, 1, 0); PG8_STAGEA(PG8_SA(0, 1), a2, 1, last);
            PG8_WAIT_V(8); PG8_WAIT_L(0); PG8_BAR; PG8_MMA(0, 0, At, B0); PG8_MMA(0, 1, At, B1); PG8_BAR; PG8_SCHED;
            PG8_LDA(At, 1, 1); PG8_STAGE(PG8_SB(1, 0), b3, voffB); PG8_STAGE(PG8_SB(1, 1), b3 + hstep, voffB); PG8_STAGEA(PG8_SA(1, 0), a3, 0, last);
            PG8_WAIT_V(8); PG8_WAIT_L(0); PG8_BAR; PG8_MMA(1, 0, At, B0); PG8_MMA(1, 1, At, B1); PG8_BAR; PG8_SCHED;
            } else {
            PG8_LDB(B0, 0, 0); PG8_SCHED; PG8_LDA(At, 0, 0); PG8_STAGEA(PG8_SA(1, 1), a1, 1, false);
            PG8_WAIT_L(8); PG8_BAR; PG8_WAIT_L(0); PG8_MMA(0, 0, At, B0); PG8_BAR; PG8_SCHED;
            PG8_LDB(B1, 0, 1); PG8_STAGE(PG8_SB(0, 0), b2, voffB);
            PG8_BAR; PG8_WAIT_L(0); PG8_MMA(0, 1, At, B1); PG8_BAR;
            PG8_LDA(At, 0, 1); PG8_STAGEA(PG8_SA(0, 0), a2, 0, last);
            PG8_BAR; PG8_WAIT_L(0); PG8_MMA(1, 0, At, B0); PG8_BAR; PG8_SCHED;
            PG8_STAGE(PG8_SB(0, 1), b2 + hstep, voffB);
            PG8_WAIT_V(6); PG8_BAR; PG8_MMA(1, 1, At, B1); PG8_BAR;
            PG8_LDB(B0, 1, 0); PG8_SCHED; PG8_LDA(At, 1, 0); PG8_STAGEA(PG8_SA(0, 1), a2, 1, last);
            PG8_WAIT_L(8); PG8_BAR; PG8_WAIT_L(0); PG8_MMA(0, 0, At, B0); PG8_BAR; PG8_SCHED;
            PG8_LDB(B1, 1, 1); PG8_STAGE(PG8_SB(1, 0), b3, voffB);
            PG8_BAR; PG8_WAIT_L(0); PG8_MMA(0, 1, At, B1); PG8_BAR;
            PG8_LDA(At, 1, 1); PG8_STAGEA(PG8_SA(1, 0), a3, 0, last);
            PG8_BAR; PG8_WAIT_L(0); PG8_MMA(1, 0, At, B0); PG8_BAR; PG8_SCHED;
            PG8_STAGE(PG8_SB(1, 1), b3 + hstep, voffB);
            PG8_WAIT_V(6); PG8_BAR; PG8_MMA(1, 1, At, B1); PG8_BAR;
            }
        }
        if constexpr (ALIGN_EPI) { if (wr == 0) PG8_BAR; }
        if constexpr (!Epi::AFTER_DRAIN) { E(acc, cur, wr, wc, fr, fq); S.done(cur); }
        if (!has_next) break;
#pragma unroll
        for (int a = 0; a < 2; ++a)
#pragma unroll
            for (int b = 0; b < 2; ++b)
#pragma unroll
                for (int m = 0; m < 4; ++m)
#pragma unroll
                    for (int n = 0; n < 2; ++n) acc[a][b][m][n] = (f32x4){0.f, 0.f, 0.f, 0.f};
        cur = nxt; cA = nA; cB = nB; ++ui;
        if constexpr (GATHER) { _Pragma("unroll") for (int _h = 0; _h < 2; ++_h) _Pragma("unroll") for (int _i = 0; _i < 2; ++_i) gA[_h][_i] = gN[_h][_i]; }
        if constexpr (ALIGN_EPI) { if (wr == 1) PG8_BAR; }
    }
    PG8_WAIT_V(0);
    if constexpr (!ALIGN_EPI) { if (wr == 0) PG8_BAR; }
    PG8_BAR;
    if constexpr (Epi::AFTER_DRAIN) { E.fused(acc, cur, wr, wc, fr, fq, lds, wid, lane); S.done(cur); }
#undef PG8_SA
#undef PG8_SB
#undef PG8_STAGE
#undef PG8_STAGEA
#undef PG8_ROWS
#undef PG8_LDA
#undef PG8_LDB
#undef PG8_MMA
#undef PG8_WAIT_V
#undef PG8_WAIT_L
#undef PG8_BAR
#undef PG8_SCHED
}
}

namespace pg8 {
__device__ __forceinline__ u32x4 pack8(const f32x4 a, const f32x4 b) { u32x4 w; w.x = cvt_pk_bf16(a[0], a[1]); w.y = cvt_pk_bf16(a[2], a[3]); w.z = cvt_pk_bf16(b[0], b[1]); w.w = cvt_pk_bf16(b[2], b[3]); return w; }
__device__ __forceinline__ float silu_f(float x) { return x * __builtin_amdgcn_rcpf(1.0f + __builtin_amdgcn_exp2f(-1.4426950408889634f * x)); }

struct EpiRope {
    static constexpr bool PERM = true, AFTER_DRAIN = false;
    bf16_t* Q; bf16_t* Kb; bf16_t* Vb; const float* cs; const float* sn; float qscale; int seqmask;
    __device__ __forceinline__ void operator()(const f32x4 (&acc)[2][2][4][2], const Unit& u, int wr, int wc, int fr, int fq) const {
        const int row0 = u.pm * BM + wr * 64 + fr; const int part = u.pn >> 2, pn4 = u.pn & 3;
        if (part == 2) {
            const int col0 = pn4 * BM + wc * 32 + 8 * fq;
#pragma unroll
            for (int ai = 0; ai < 2; ++ai)
#pragma unroll
                for (int m = 0; m < 4; ++m) { bf16_t* rowp = Vb + (size_t)(row0 + ai * HALF + m * 16) * 1024 + col0;
#pragma unroll
                    for (int bj = 0; bj < 2; ++bj) *(u32x4*)(rowp + bj * HALF) = pack8(acc[ai][bj][m][0], acc[ai][bj][m][1]); }
        } else {
            bf16_t* base = part == 0 ? Q : Kb; const float sc = part == 0 ? qscale : 1.0f;
            const int hm = pn4 * 4 + wc, j0 = 8 * fq;
#pragma unroll
            for (int q = 0; q < 4; ++q) {
                const int ai = q >> 1, mb = (q & 1) * 2;
                f32x4 c0[2], c1[2], s0[2], s1[2];
#pragma unroll
                for (int mm = 0; mm < 2; ++mm) { const int pos = (row0 + ai * HALF + (mb + mm) * 16) & seqmask;
                    c0[mm] = *(const f32x4*)(cs + pos * 32 + j0); c1[mm] = *(const f32x4*)(cs + pos * 32 + j0 + 4); s0[mm] = *(const f32x4*)(sn + pos * 32 + j0); s1[mm] = *(const f32x4*)(sn + pos * 32 + j0 + 4); }
#pragma unroll
                for (int mm = 0; mm < 2; ++mm) { const int m = mb + mm; const int row = row0 + ai * HALF + m * 16;
                    const f32x4 x1a = acc[ai][0][m][0] * sc, x1b = acc[ai][0][m][1] * sc, x2a = acc[ai][1][m][0] * sc, x2b = acc[ai][1][m][1] * sc;
                    const f32x4 o1a = x1a * c0[mm] - x2a * s0[mm], o1b = x1b * c1[mm] - x2b * s1[mm], o2a = x2a * c0[mm] + x1a * s0[mm], o2b = x2b * c1[mm] + x1b * s1[mm];
                    bf16_t* rowp = base + (size_t)row * 1024 + hm * 64 + j0;
                    *(u32x4*)(rowp) = pack8(o1a, o1b); *(u32x4*)(rowp + 32) = pack8(o2a, o2b); }
            }
        }
    }
};
struct EpiSwiGLU {
    static constexpr bool PERM = true, AFTER_DRAIN = false;
    bf16_t* act;
    __device__ __forceinline__ void operator()(const f32x4 (&acc)[2][2][4][2], const Unit& u, int wr, int wc, int fr, int fq) const {
        const int row0 = u.pm * BM + wr * 64 + fr, col0 = u.pn * HALF + wc * 32 + 8 * fq;
#pragma unroll
        for (int ai = 0; ai < 2; ++ai)
#pragma unroll
            for (int m = 0; m < 4; ++m) { f32x4 v0, v1;
#pragma unroll
                for (int j = 0; j < 4; ++j) { v0[j] = silu_f(acc[ai][0][m][0][j]) * acc[ai][1][m][0][j]; v1[j] = silu_f(acc[ai][0][m][1][j]) * acc[ai][1][m][1][j]; }
                *(u32x4*)(act + (size_t)(row0 + ai * HALF + m * 16) * 512 + col0) = pack8(v0, v1); }
    }
};
struct EpiRowScale {
    static constexpr bool PERM = true, AFTER_DRAIN = false;
    bf16_t* O; const float* roww;
    __device__ __forceinline__ void operator()(const f32x4 (&acc)[2][2][4][2], const Unit& u, int wr, int wc, int fr, int fq) const {
        const int row0 = u.pm * BM + wr * 64 + fr, col0 = u.pn * BM + wc * 32 + 8 * fq;
        float w8[8];
#pragma unroll
        for (int q = 0; q < 8; ++q) w8[q] = roww[row0 + (q >> 2) * HALF + (q & 3) * 16];
#pragma unroll
        for (int ai = 0; ai < 2; ++ai)
#pragma unroll
            for (int m = 0; m < 4; ++m) { const int row = row0 + ai * HALF + m * 16; const float w = w8[ai * 4 + m]; bf16_t* rowp = O + (size_t)row * 1024 + col0;
#pragma unroll
                for (int bj = 0; bj < 2; ++bj) *(u32x4*)(rowp + bj * HALF) = pack8(acc[ai][bj][m][0] * w, acc[ai][bj][m][1] * w); }
    }
};
struct PanelOrder {
    int pm, nN;
    __device__ __forceinline__ bool next(int i, Unit& u) const { if (i >= nN) return false; u.pm = pm; u.pn = i; u.e = 0; return true; }
    __device__ __forceinline__ void a_ready(const Unit&) const {}
    __device__ __forceinline__ void done(const Unit&) const {}
};
struct MoeOrder : StaticOrder {
    const int* blk_e;
    __device__ __forceinline__ bool next(int i, Unit& u) const { if (!StaticOrder::next(i, u)) return false; u.e = ((const __attribute__((address_space(4))) int*)blk_e)[u.pm]; return true; }
};
}
#include <hip/hip_bf16.h>
#include <cmath>
namespace attn_body {
using bf16=__hip_bfloat16;
using bf16x8=__attribute__((ext_vector_type(8)))short;
using s16x4=__attribute__((ext_vector_type(4)))short;
using f32x16=__attribute__((ext_vector_type(16)))float;
using u32x4=__attribute__((ext_vector_type(4)))unsigned;
constexpr int BATCH=16,NHEAD=16,SEQ=4096,D=64,DM=NHEAD*D;
constexpr int NW=8,QBLK=32,QB=QBLK*NW,KVBLK=64,NQB=SEQ/QB;
constexpr int ATTN_PITCH=DM, ATTN_UNIT_ROWS=QB;
__device__ __forceinline__ int crow(int r,int hi){return (r&3)+8*(r>>2)+4*hi;}
#define SBAR() __builtin_amdgcn_sched_barrier(0)
__device__ __forceinline__ void cmask(f32x16&p0,f32x16&p1,int jb,int qrel,int hi){
  const float NEG=-INFINITY; int kb=64*jb+4*hi;
  #pragma unroll
  for(int r=0;r<16;++r){int kv=kb+(r&3)+8*(r>>2); if(kv>qrel)p0[r]=NEG; if(kv+32>qrel)p1[r]=NEG;}
}

constexpr int NSLOT=3, SLOTB=8192;
constexpr int LDS_K=0, LDS_V=NSLOT*SLOTB, LDS_WS=2*NSLOT*SLOTB, LDS_OST=LDS_WS+NW*64*4, LDS_BYTES=LDS_OST+NW*4096;
constexpr float C2=0.125f*1.4426950408889634f;
__device__ __forceinline__ void glds16(const void*gsrc,unsigned lds_dst){unsigned keep;
  asm volatile("s_mov_b32 %0, m0\n\ts_mov_b32 m0, %2\n\ts_nop 0\n\tglobal_load_lds_dwordx4 %1, off\n\ts_mov_b32 m0, %0":"=&s"(keep):"v"(gsrc),"s"(lds_dst):"memory");}
__device__ __forceinline__ float max3f(float a,float b,float c){float r;asm("v_max3_f32 %0, %1, %2, %3":"=v"(r):"v"(a),"v"(b),"v"(c));return r;}
__device__ __forceinline__ float max2f(float a,float b){float r;asm("v_max_f32_e32 %0, %1, %2":"=v"(r):"v"(a),"v"(b));return r;}
__device__ __forceinline__ float fadd_s(float a,float b){float r;asm("v_add_f32_e32 %0, %1, %2":"=v"(r):"v"(a),"v"(b));return r;}
__device__ __forceinline__ float fsub_s(float a,float b){float r;asm("v_sub_f32_e32 %0, %1, %2":"=v"(r):"v"(a),"v"(b));return r;}
typedef float f32x2_t __attribute__((ext_vector_type(2))); typedef __bf16 bf16x2_t __attribute__((ext_vector_type(2)));
__device__ __forceinline__ unsigned cvtpk_s(float lo,float hi){f32x2_t v={lo,hi};bf16x2_t b=__builtin_convertvector(v,bf16x2_t);return __builtin_bit_cast(unsigned,b);}
#define WAIT_BAR(N) asm volatile("s_waitcnt vmcnt(" #N ") lgkmcnt(0)\n\ts_barrier":::"memory")

__device__ __forceinline__ void qkt(f32x16&p0,f32x16&p1,const char*Kslot,const bf16x8*qr,const f32x16&negm,int r32,int hi){
  const char*kb=Kslot+hi*1024+r32*16;
  #pragma unroll
  for(int d0=0;d0<4;++d0){
    const bf16x8 b0=*reinterpret_cast<const bf16x8*>(kb+d0*2048);
    const bf16x8 b1=*reinterpret_cast<const bf16x8*>(kb+d0*2048+512);
    if(d0==0){p0=__builtin_amdgcn_mfma_f32_32x32x16_bf16(b0,qr[0],negm,0,0,0);p1=__builtin_amdgcn_mfma_f32_32x32x16_bf16(b1,qr[0],negm,0,0,0);}
    else{p0=__builtin_amdgcn_mfma_f32_32x32x16_bf16(b0,qr[d0],p0,0,0,0);p1=__builtin_amdgcn_mfma_f32_32x32x16_bf16(b1,qr[d0],p1,0,0,0);}}
}
typedef __attribute__((address_space(3))) const char* lds_cptr;
typedef short v4i16_t __attribute__((ext_vector_type(4)));
__device__ __forceinline__ void kload8(bf16x8*kf,lds_cptr kp){
  kf[0]=*(const __attribute__((address_space(3))) bf16x8*)(kp);      kf[1]=*(const __attribute__((address_space(3))) bf16x8*)(kp+512);
  kf[2]=*(const __attribute__((address_space(3))) bf16x8*)(kp+2048); kf[3]=*(const __attribute__((address_space(3))) bf16x8*)(kp+2560);
  kf[4]=*(const __attribute__((address_space(3))) bf16x8*)(kp+4096); kf[5]=*(const __attribute__((address_space(3))) bf16x8*)(kp+4608);
  kf[6]=*(const __attribute__((address_space(3))) bf16x8*)(kp+6144); kf[7]=*(const __attribute__((address_space(3))) bf16x8*)(kp+6656);
}
__device__ __forceinline__ void kload2(bf16x8*kf,lds_cptr kp,int j){ kf[2*j]=*(const __attribute__((address_space(3))) bf16x8*)(kp+j*2048); kf[2*j+1]=*(const __attribute__((address_space(3))) bf16x8*)(kp+j*2048+512); }
__device__ __forceinline__ s16x4 vtr(lds_cptr p){ return __builtin_bit_cast(s16x4,__builtin_amdgcn_ds_read_tr16_b64_v4i16((__attribute__((address_space(3))) v4i16_t*)p)); }
__device__ __forceinline__ float rowmax(const f32x16&p0,const f32x16&p1){
  float a=max3f(p0[0],p0[1],p1[0]),b=max3f(p0[2],p0[3],p1[1]);a=max3f(a,p1[2],p1[3]);
  #pragma unroll
  for(int r=4;r<16;r+=4){a=max3f(a,p0[r],p0[r+1]);b=max3f(b,p0[r+2],p0[r+3]);a=max3f(a,p1[r],p1[r+1]);b=max3f(b,p1[r+2],p1[r+3]);}
  const float m=max2f(a,b);
  auto rr=__builtin_amdgcn_permlane32_swap(__float_as_uint(m),__float_as_uint(m),false,false);
  return max2f(__uint_as_float(rr[0]),__uint_as_float(rr[1]));
}
__device__ __forceinline__ void pv(f32x16*o,int vb,bf16x8 pa0,bf16x8 pa1,bf16x8 pa2,bf16x8 pa3){
  #pragma unroll
  for(int d0=0;d0<2;++d0){s16x4 lo[4],hi[4];
    #pragma unroll
    for(int ks=0;ks<4;++ks){
      asm volatile("ds_read_b64_tr_b16 %0,%1 offset:%c2":"=&v"(lo[ks]):"v"(vb),"i"(d0*4096+ks*1024):"memory");
      asm volatile("ds_read_b64_tr_b16 %0,%1 offset:%c2":"=&v"(hi[ks]):"v"(vb),"i"(d0*4096+ks*1024+512):"memory");}
    asm volatile("s_waitcnt lgkmcnt(0)":::"memory");SBAR();
    #define PK(k) (bf16x8){lo[k][0],lo[k][1],lo[k][2],lo[k][3],hi[k][0],hi[k][1],hi[k][2],hi[k][3]}
    o[d0]=__builtin_amdgcn_mfma_f32_32x32x16_bf16(pa0,PK(0),o[d0],0,0,0);
    o[d0]=__builtin_amdgcn_mfma_f32_32x32x16_bf16(pa1,PK(1),o[d0],0,0,0);
    o[d0]=__builtin_amdgcn_mfma_f32_32x32x16_bf16(pa2,PK(2),o[d0],0,0,0);
    o[d0]=__builtin_amdgcn_mfma_f32_32x32x16_bf16(pa3,PK(3),o[d0],0,0,0);
    #undef PK
  }
}

#ifndef ATTN_STORE16
#define ATTN_STORE16(p,v) (*(u32x4*)(p)=(v))
#endif
template<int THRL> __device__ __forceinline__ void attn_unit(int b,int qcol,int kcol,int vcol,int ocol,int qb,const bf16*Q,const bf16* K,const bf16* V,bf16*O,char*shm,int tid){
  const int lane=tid&63,r32=lane&31,hi=lane>>5; const int wid=__builtin_amdgcn_readfirstlane(tid>>6);
  const long rowbase=(long)b*SEQ; const int q0=qb*QB;
  const bf16*Qw=Q+(rowbase+q0+wid*QBLK)*DM+qcol;
  const bf16*Kh=K+rowbase*DM+kcol,*Vh=V+rowbase*DM+vcol;
  const unsigned lds0=(unsigned)(uintptr_t)shm;
  float*wsf=(float*)(shm+LDS_WS)+wid*64;
  const bf16*ksrc=Kh+(long)lane*DM+wid*8;
  const bf16*vsrc=Vh+(long)(16*(wid&3)+(lane>>2))*DM+(wid>>2)*32+(lane&3)*8;
  const unsigned kdst=lds0+LDS_K+wid*1024, vdst=lds0+LDS_V+wid*1024;
  #define DMA_K(t,slot) glds16(ksrc+(long)(t)*KVBLK*DM,(unsigned)__builtin_amdgcn_readfirstlane(kdst+(slot)))
  #define DMA_V(t,slot) glds16(vsrc+(long)(t)*KVBLK*DM,(unsigned)__builtin_amdgcn_readfirstlane(vdst+(slot)))
  const int vb0=(int)(lds0+LDS_V)+((lane>>4)&1)*32+(lane&3)*8+(4*hi+((lane&15)>>2))*64;
  const char*Kbase=shm+LDS_K; bf16x8 kf[8];
  const lds_cptr shm3=(lds_cptr)shm; const lds_cptr kp0=shm3+LDS_K+hi*1024+r32*16; const lds_cptr vp0=shm3+LDS_V+((lane>>4)&1)*32+(lane&3)*8+(4*hi+((lane&15)>>2))*64;
  const int NT=(q0+QB)/KVBLK;
  DMA_K(0,0);DMA_V(0,0);DMA_K(1,SLOTB);
  bf16x8 qr[4];
  #pragma unroll
  for(int d0=0;d0<4;++d0)qr[d0]=*reinterpret_cast<const bf16x8*>(&Qw[(long)r32*DM+d0*16+hi*8]);
  float mhat=0.f,l_reg=0.f;f32x16 o[2];o[0]=f32x16{};o[1]=f32x16{};f32x16 negm=f32x16{};asm volatile("":"+v"(negm));
  const int qrel=wid*QBLK+r32;
  #define CMASK(P0,P1,t) do{int jb_=(t)-(NT-4); if(jb_>=0)cmask(P0,P1,jb_,qrel,hi);}while(0)
  bool resc=false;
  #define START(P0,P1) do{ const float rm=rowmax(P0,P1); resc=false; \
    { const float dl=rm; mhat=fadd_s(mhat,dl); \
      _Pragma("unroll") for(int r=0;r<16;++r){P0[r]=fsub_s(P0[r],dl);P1[r]=fsub_s(P1[r],dl);} \
      _Pragma("unroll") for(int r=0;r<16;++r)negm[r]=-mhat; asm volatile("":"+v"(negm)); } \
    _Pragma("unroll") for(int r=0;r<16;++r)P0[r]=__builtin_amdgcn_exp2f(P0[r]); }while(0)
  #define RESC() do{ if(resc){ asm volatile("s_waitcnt lgkmcnt(0)":::"memory"); \
      _Pragma("unroll") for(int d_=0;d_<2;++d_) _Pragma("unroll") for(int r=0;r<16;++r)o[d_][r]*=wsf[crow(r,hi)]; } }while(0)
  f32x16 pA0,pA1,pB0,pB1;
  int sl_prev=0,sl_cur=0,sl_next=SLOTB;
  #define ROT() do{sl_prev=sl_cur;sl_cur=sl_next;sl_next=(sl_next==(NSLOT-1)*SLOTB)?0:sl_next+SLOTB;}while(0)
  DMA_K(2,2*SLOTB);
  WAIT_BAR(3);
  qkt(pA0,pA1,Kbase,qr,negm,r32,hi);asm volatile("s_nop 15\n\ts_nop 7":"+v"(pA0),"+v"(pA1));CMASK(pA0,pA1,0);
  START(pA0,pA1);
  _Pragma("unroll") for(int r=0;r<16;++r)pA1[r]=__builtin_amdgcn_exp2f(pA1[r]);
  WAIT_BAR(0);
  DMA_K(3,0);DMA_V(1,SLOTB);
  ROT();
  kload8(kf,kp0+sl_cur);
  WAIT_BAR(2);
  s16x4 vlo[8],vhi[8]; u32x4 pw0,pw1,pw2,pw3;
  #define PKW(P,B) cvtpk_s(P[B],P[B+1])
  #define PAF(k) __builtin_bit_cast(bf16x8,pw##k)
  #define VFR(i) (bf16x8){vlo[i][0],vlo[i][1],vlo[i][2],vlo[i][3],vhi[i][0],vhi[i][1],vhi[i][2],vhi[i][3]}
  #define PIN(x) asm volatile("":"+v"(x))
  #define MX3(a,b,c) __builtin_fmaxf(__builtin_fmaxf((a),(b)),(c))
  #define GAPA(MF,A0,A1,A2,A3,W0,W1,PW) do{ MF; sacc+=A0; sacc+=A1; sacc+=A2; sacc+=A3; PIN(sacc); W0; W1; PIN(PW); SBAR(); }while(0)
  #define EX(v) __builtin_amdgcn_exp2f(v)
  #define GAPB(MF,X,B) do{ MF; X[B]=EX(X[B]); X[B+1]=EX(X[B+1]); X[B+2]=EX(X[B+2]); X[B+3]=EX(X[B+3]); PIN(X); SBAR(); }while(0)
  #define VRD(i) do{ vlo[i]=vtr(vp_+(((i)>>2)*4096+((i)&3)*1024)); vhi[i]=vtr(vp_+(((i)>>2)*4096+((i)&3)*1024+512)); }while(0)
  #define KRD(G,j) do{ if(G){ kload2(kf,kp0+sl_next,j); SBAR(); } }while(0)
  #define STEP(C0,C1,P0,P1,t,GK,GV,GL) do{ SBAR(); \
    const lds_cptr vp_=vp0+sl_prev; \
    VRD(0); SBAR(); float sacc=(P0[0]+P0[1]); \
    GAPA(C0=__builtin_amdgcn_mfma_f32_32x32x16_bf16(kf[0],qr[0],negm,0,0,0), P0[2],P0[3],P0[4],P0[5],     pw0[0]=PKW(P0,0), pw0[1]=PKW(P0,2), pw0); \
    VRD(4); SBAR(); GAPA(C1=__builtin_amdgcn_mfma_f32_32x32x16_bf16(kf[1],qr[0],negm,0,0,0), P0[6],P0[7],P0[8],P0[9],     pw0[2]=PKW(P0,4), pw0[3]=PKW(P0,6), pw0); \
    VRD(1); SBAR(); GAPA(C0=__builtin_amdgcn_mfma_f32_32x32x16_bf16(kf[2],qr[1],C0,0,0,0),   P0[10],P0[11],P0[12],P0[13], pw1[0]=PKW(P0,8), pw1[1]=PKW(P0,10), pw1); \
    VRD(5); SBAR(); GAPA(C1=__builtin_amdgcn_mfma_f32_32x32x16_bf16(kf[3],qr[1],C1,0,0,0),   P0[14],P0[15],P1[0],P1[1],   pw1[2]=PKW(P0,12),pw1[3]=PKW(P0,14), pw1); \
    VRD(2); SBAR(); GAPA(C0=__builtin_amdgcn_mfma_f32_32x32x16_bf16(kf[4],qr[2],C0,0,0,0),   P1[2],P1[3],P1[4],P1[5],     pw2[0]=PKW(P1,0), pw2[1]=PKW(P1,2), pw2); \
    VRD(6); SBAR(); GAPA(C1=__builtin_amdgcn_mfma_f32_32x32x16_bf16(kf[5],qr[2],C1,0,0,0),   P1[6],P1[7],P1[8],P1[9],     pw2[2]=PKW(P1,4), pw2[3]=PKW(P1,6), pw2); \
    VRD(3); SBAR(); GAPA(C0=__builtin_amdgcn_mfma_f32_32x32x16_bf16(kf[6],qr[3],C0,0,0,0),   P1[10],P1[11],P1[12],P1[13], pw3[0]=PKW(P1,8), pw3[1]=PKW(P1,10), pw3); \
    VRD(7); SBAR(); GAPA(C1=__builtin_amdgcn_mfma_f32_32x32x16_bf16(kf[7],qr[3],C1,0,0,0),   P1[14],P1[15],0.f,0.f,       pw3[2]=PKW(P1,12),pw3[3]=PKW(P1,14), pw3); \
    l_reg+=sacc; \
    if(GK){DMA_K((t)+3,sl_cur);} if(GV){DMA_V((t)+1,sl_next);} \
    CMASK(C0,C1,t); \
    { float a=MX3(C0[0],C0[1],C1[0]),b=MX3(C0[2],C0[3],C1[1]); a=MX3(a,C1[2],C1[3]); \
      _Pragma("unroll") for(int r=4;r<16;r+=4){a=MX3(a,C0[r],C0[r+1]);b=MX3(b,C0[r+2],C0[r+3]);a=MX3(a,C1[r],C1[r+1]);b=MX3(b,C1[r+2],C1[r+3]);} \
      float rm=__builtin_fmaxf(a,b); { auto rr=__builtin_amdgcn_permlane32_swap(__float_as_uint(rm),__float_as_uint(rm),false,false); rm=__builtin_fmaxf(__uint_as_float(rr[0]),__uint_as_float(rr[1])); } \
      resc=false; \
      if(__builtin_expect(__any(rm>(float)THRL),0)){ const float dl=__builtin_fmaxf(rm,0.f); mhat+=dl; \
        _Pragma("unroll") for(int r=0;r<16;++r){C0[r]-=dl;C1[r]-=dl;} \
        _Pragma("unroll") for(int r=0;r<16;++r)negm[r]=-mhat; asm volatile("":"+v"(negm)); \
        const float f=__builtin_amdgcn_exp2f(-dl); l_reg*=f; if(hi==0)wsf[r32]=f; resc=true; } } \
    SBAR(); \
    GAPB(o[0]=__builtin_amdgcn_mfma_f32_32x32x16_bf16(PAF(0),VFR(0),o[0],0,0,0), C0,0); \
    GAPB(o[1]=__builtin_amdgcn_mfma_f32_32x32x16_bf16(PAF(0),VFR(4),o[1],0,0,0), C0,4); \
    KRD(GL,0); GAPB(o[0]=__builtin_amdgcn_mfma_f32_32x32x16_bf16(PAF(1),VFR(1),o[0],0,0,0), C0,8); \
    KRD(GL,1); GAPB(o[1]=__builtin_amdgcn_mfma_f32_32x32x16_bf16(PAF(1),VFR(5),o[1],0,0,0), C0,12); \
    KRD(GL,2); GAPB(o[0]=__builtin_amdgcn_mfma_f32_32x32x16_bf16(PAF(2),VFR(2),o[0],0,0,0), C1,0); \
    KRD(GL,3); GAPB(o[1]=__builtin_amdgcn_mfma_f32_32x32x16_bf16(PAF(2),VFR(6),o[1],0,0,0), C1,4); \
    GAPB(o[0]=__builtin_amdgcn_mfma_f32_32x32x16_bf16(PAF(3),VFR(3),o[0],0,0,0), C1,8); \
    GAPB(o[1]=__builtin_amdgcn_mfma_f32_32x32x16_bf16(PAF(3),VFR(7),o[1],0,0,0), C1,12); \
    }while(0)
  int t=1;
  #undef CMASK
  #define CMASK(P0,P1,t) do{}while(0)
  for(;t+5<NT;t+=2){
    STEP(pB0,pB1,pA0,pA1,t,true,true,true);     WAIT_BAR(2); RESC(); ROT();
    STEP(pA0,pA1,pB0,pB1,t+1,true,true,true);   WAIT_BAR(2); RESC(); ROT();
  }
  #undef CMASK
  #define CMASK(P0,P1,t) do{int jb_=(t)-(NT-4); if(jb_>=0)cmask(P0,P1,jb_,qrel,hi);}while(0)
  #define ENDW(tt) do{ if((tt)+3<NT){WAIT_BAR(2);} else if((tt)+2<NT){WAIT_BAR(1);} else {WAIT_BAR(0);} }while(0)
  for(;t+1<NT;t+=2){
    STEP(pB0,pB1,pA0,pA1,t,(t+3<NT),(t+1<NT),(t+1<NT));       ENDW(t);   RESC(); ROT();
    STEP(pA0,pA1,pB0,pB1,t+1,(t+4<NT),(t+2<NT),(t+2<NT));     ENDW(t+1); RESC(); ROT();
  }
  STEP(pB0,pB1,pA0,pA1,NT-1,false,false,false); RESC();
  { float sacc=pB0[0]+pB0[1]; _Pragma("unroll") for(int r=2;r<16;++r)sacc+=pB0[r]; _Pragma("unroll") for(int r=0;r<16;++r)sacc+=pB1[r]; l_reg+=sacc;
    pw0=(u32x4){PKW(pB0,0),PKW(pB0,2),PKW(pB0,4),PKW(pB0,6)};pw1=(u32x4){PKW(pB0,8),PKW(pB0,10),PKW(pB0,12),PKW(pB0,14)};pw2=(u32x4){PKW(pB1,0),PKW(pB1,2),PKW(pB1,4),PKW(pB1,6)};pw3=(u32x4){PKW(pB1,8),PKW(pB1,10),PKW(pB1,12),PKW(pB1,14)};
    SBAR(); pv(o,vb0+sl_cur,PAF(0),PAF(1),PAF(2),PAF(3)); }
  #undef PKW
  #undef PAF
  #undef VFR
  #undef PIN
  #undef MX3
  #undef GAPA
  #undef GAPB
  #undef EX
  #undef VRD
  #undef KRD
  #undef STEP
  #undef ENDW
  {auto rr=__builtin_amdgcn_permlane32_swap(__float_as_uint(l_reg),__float_as_uint(l_reg),false,false);l_reg=__uint_as_float(rr[0])+__uint_as_float(rr[1]);}
  if(hi==0)wsf[32+r32]=l_reg;asm volatile("s_waitcnt lgkmcnt(0)":::"memory");
  float rli[16];
  #pragma unroll
  for(int r=0;r<16;++r)rli[r]=__builtin_amdgcn_rcpf(wsf[32+crow(r,hi)]);
  bf16*Ow=O+(rowbase+q0+wid*QBLK)*DM+ocol;
  { bf16*stg=(bf16*)(shm+LDS_OST)+wid*2048;
    #pragma unroll
    for(int r=0;r<16;++r){const int orow=crow(r,hi);
      #pragma unroll
      for(int d0=0;d0<2;++d0)stg[orow*64+d0*32+r32]=__float2bfloat16(o[d0][r]*rli[r]);}
    asm volatile("s_waitcnt lgkmcnt(0)":::"memory");
    #pragma unroll
    for(int i=0;i<4;++i){const int row=i*8+(lane>>3),ch=lane&7; const u32x4 v=*(const u32x4*)(stg+row*64+ch*8); ATTN_STORE16(Ow+(long)row*DM+ch*8,v);} }
  asm volatile("s_waitcnt lgkmcnt(0)\n\ts_barrier":::"memory");
  #undef DMA_K
  #undef DMA_V
  #undef CMASK
  #undef START
  #undef RESC
  #undef ROT
}
constexpr int ATTN_LDS_BYTES=LDS_BYTES;
struct AttnTensors { const bf16* Q; const bf16* K; const bf16* V; bf16* O0; bf16* O1; };
struct AttnUnit { int b, qcol, kcol, vcol, ocol, m, qb; };
struct StaticOrder {
  int vcu, G;
  __device__ __forceinline__ StaticOrder(int grid,int vcu_):vcu(vcu_),G(grid){}
  __device__ __forceinline__ bool next(int i,AttnUnit&u)const{
    int b,h,m,vhalf,qb;
    if(G==256){ if(i>=32)return false; const int xcd=vcu>>5,l=vcu&31,vh=l&3,qs=l>>2,bh=xcd*16+(i>>1); b=bh>>3; h=bh&7; m=(vh>>1)&1; vhalf=vh&1; qb=(i&1)?qs:15-qs; }
    else { const int ci=vcu+G*(i>>4); if(ci>=BATCH*32)return false; const int vh=ci&31; h=vh>>2; m=(vh>>1)&1; vhalf=vh&1; b=ci>>5; qb=15-(i&15); }
    u.b=b; u.qcol=(2*h+m)*64; u.kcol=u.qcol; u.vcol=h*128+vhalf*64; u.ocol=u.vcol; u.m=m; u.qb=qb; return true; }
  __device__ __forceinline__ void a_ready(const AttnUnit&)const{}
  __device__ __forceinline__ void done(const AttnUnit&)const{}
};
template<class Sched,int THRL=8> __device__ __forceinline__ void attn_phase(char*lds,const AttnTensors&T,const Sched&S,const int tid_){
  AttnUnit u;
  for(int i=0;S.next(i,u);++i){ S.a_ready(u); attn_unit<THRL>(u.b,u.qcol,u.kcol,u.vcol,u.ocol,u.qb,T.Q,T.K,T.V,u.m?T.O1:T.O0,lds,tid_); S.done(u); }
}
constexpr int VSLOTB=16384;
constexpr int WL_K=0, WL_V=NSLOT*SLOTB, WL_WS=WL_V+NSLOT*VSLOTB, WL_Q=WL_WS+NW*64*4, WL_OST=WL_Q+NW*4096, WL_BYTES=WL_OST+NW*4096;
__device__ __forceinline__ void cmask2(f32x16&p0,f32x16&p1,int jb,int qrel,int hi){
  const float NEG=-INFINITY; const int qq=qrel-64*jb-4*hi;
  #pragma unroll
  for(int r=0;r<16;++r){const int c=(r&3)+8*(r>>2); if(c>qq)p0[r]=NEG; if(c+32>qq)p1[r]=NEG;}
}
__device__ __forceinline__ void pv4(f32x16*o,int vb,bf16x8 pa0,bf16x8 pa1,bf16x8 pa2,bf16x8 pa3){
  #pragma unroll
  for(int d0=0;d0<4;++d0){s16x4 lo[4],hi[4];
    #pragma unroll
    for(int ks=0;ks<4;++ks){
      asm volatile("ds_read_b64_tr_b16 %0,%1 offset:%c2":"=&v"(lo[ks]):"v"(vb),"i"(d0*4096+ks*1024):"memory");
      asm volatile("ds_read_b64_tr_b16 %0,%1 offset:%c2":"=&v"(hi[ks]):"v"(vb),"i"(d0*4096+ks*1024+512):"memory");}
    asm volatile("s_waitcnt lgkmcnt(0)":::"memory");SBAR();
    #define PK(k) (bf16x8){lo[k][0],lo[k][1],lo[k][2],lo[k][3],hi[k][0],hi[k][1],hi[k][2],hi[k][3]}
    o[d0]=__builtin_amdgcn_mfma_f32_32x32x16_bf16(pa0,PK(0),o[d0],0,0,0);
    o[d0]=__builtin_amdgcn_mfma_f32_32x32x16_bf16(pa1,PK(1),o[d0],0,0,0);
    o[d0]=__builtin_amdgcn_mfma_f32_32x32x16_bf16(pa2,PK(2),o[d0],0,0,0);
    o[d0]=__builtin_amdgcn_mfma_f32_32x32x16_bf16(pa3,PK(3),o[d0],0,0,0);
    #undef PK
  }
}
using f32x4_t=__attribute__((ext_vector_type(4)))float;
struct CombineW { const bf16* O0; bf16* A2; const float* w; float lam, mul; };
template<int THRL> __device__ __forceinline__ void attn_unit_w(int b,int qcol,int vcol,int qb,int m,const bf16*Q,const bf16* K,const bf16* V,bf16*O,const CombineW&CB,char*shm,int tid){
  const int lane=tid&63,r32=lane&31,hi=lane>>5; const int wid=__builtin_amdgcn_readfirstlane(tid>>6);
  const long rowbase=(long)b*SEQ; const int q0=qb*QB;
  int hi4=4*hi; asm volatile("":"+v"(hi4));
  #define CROWO(r) (((r)&3)+8*((r)>>2)+hi4)
  const bf16*Qw=Q+(rowbase+q0+wid*QBLK)*DM+qcol;
  const bf16*Kh=K+rowbase*DM+qcol,*Vh=V+rowbase*DM+vcol;
  const unsigned lds0=(unsigned)(uintptr_t)shm;
  float*wsf=(float*)(shm+WL_WS)+wid*64;
  const bf16*ksrc=Kh+(long)lane*DM+wid*8;
  const bf16*vsrc=Vh+(long)(16*(wid&3)+(lane>>2))*DM+(wid>>2)*32+(lane&3)*8;
  const unsigned kdst=lds0+WL_K+wid*1024, vdst=lds0+WL_V+wid*1024;
  #define DMA_K(t,slot) glds16(ksrc+(long)(t)*KVBLK*DM,(unsigned)__builtin_amdgcn_readfirstlane(kdst+(slot)))
  #define DMA_V(t,slot) do{ glds16(vsrc+(long)(t)*KVBLK*DM,(unsigned)__builtin_amdgcn_readfirstlane(vdst+2*(slot))); glds16(vsrc+(long)(t)*KVBLK*DM+64,(unsigned)__builtin_amdgcn_readfirstlane(vdst+2*(slot)+8192)); }while(0)
  const int vb0=(int)(lds0+WL_V)+((lane>>4)&1)*32+(lane&3)*8+(4*hi+((lane&15)>>2))*64;
  const char*Kbase=shm+WL_K; bf16x8 kf[8];
  const lds_cptr shm3=(lds_cptr)shm; const lds_cptr kp0=shm3+WL_K+hi*1024+r32*16; const lds_cptr vp0=shm3+WL_V+((lane>>4)&1)*32+(lane&3)*8+(4*hi+((lane&15)>>2))*64;
  const lds_cptr qp=shm3+WL_Q+wid*4096+lane*16;
  const int NT=(q0+QB)/KVBLK;
  DMA_K(0,0);DMA_V(0,0);DMA_K(1,SLOTB);
  bf16x8 qr[4];
  #pragma unroll
  for(int d0=0;d0<4;++d0)qr[d0]=*reinterpret_cast<const bf16x8*>(&Qw[(long)r32*DM+d0*16+hi*8]);
  #pragma unroll
  for(int d0=0;d0<4;++d0)*(__attribute__((address_space(3))) bf16x8*)(qp+d0*1024)=qr[d0];
  float mhat=0.f,l_reg=0.f;f32x16 o[4];o[0]=f32x16{};o[1]=f32x16{};o[2]=f32x16{};o[3]=f32x16{};
  const f32x16 zero16=f32x16{};
  const int qrel=wid*QBLK+r32;
  #define CMASK(P0,P1,t) do{int jb_=(t)-(NT-4); if(jb_>=0)cmask2(P0,P1,jb_,qrel,hi);}while(0)
  bool resc=false;
  #define START(P0,P1) do{ const float rm=rowmax(P0,P1); resc=false; \
    { const float dl=rm; mhat=fadd_s(mhat,dl); \
      _Pragma("unroll") for(int r=0;r<16;++r){P0[r]=fsub_s(P0[r],dl);P1[r]=fsub_s(P1[r],dl);} } \
    _Pragma("unroll") for(int r=0;r<16;++r)P0[r]=__builtin_amdgcn_exp2f(P0[r]); }while(0)
  #define RESC() do{ if(resc){ asm volatile("s_waitcnt lgkmcnt(0)":::"memory"); \
      _Pragma("unroll") for(int d_=0;d_<4;++d_) _Pragma("unroll") for(int r=0;r<16;++r)o[d_][r]*=wsf[CROWO(r)]; } }while(0)
  f32x16 pA0,pA1,pB0,pB1;
  int sl_prev=0,sl_cur=0,sl_next=SLOTB;
  #define ROT() do{sl_prev=sl_cur;sl_cur=sl_next;sl_next=(sl_next==(NSLOT-1)*SLOTB)?0:sl_next+SLOTB;}while(0)
  DMA_K(2,2*SLOTB);
  WAIT_BAR(3);
  qkt(pA0,pA1,Kbase,qr,zero16,r32,hi);asm volatile("s_nop 15\n\ts_nop 7":"+v"(pA0),"+v"(pA1));CMASK(pA0,pA1,0);
  START(pA0,pA1);
  _Pragma("unroll") for(int r=0;r<16;++r)pA1[r]=__builtin_amdgcn_exp2f(pA1[r]);
  WAIT_BAR(0);
  DMA_K(3,0);DMA_V(1,SLOTB);
  ROT();
  kload8(kf,kp0+sl_cur);
  WAIT_BAR(3);
  s16x4 vlo[16],vhi[16]; u32x4 pw0,pw1,pw2,pw3;
  #define PKW(P,B) cvtpk_s(P[B],P[B+1])
  #define PAF(k) __builtin_bit_cast(bf16x8,pw##k)
  #define VFR(i) (bf16x8){vlo[i][0],vlo[i][1],vlo[i][2],vlo[i][3],vhi[i][0],vhi[i][1],vhi[i][2],vhi[i][3]}
  #define PIN(x) asm volatile("":"+v"(x))
  #define MX3(a,b,c) __builtin_fmaxf(__builtin_fmaxf((a),(b)),(c))
  #define GAPA(MF,A0,A1,A2,A3,W0,W1,PW) do{ MF; sacc+=A0; sacc+=A1; sacc+=A2; sacc+=A3; PIN(sacc); W0; W1; PIN(PW); SBAR(); }while(0)
  #define EX(v) __builtin_amdgcn_exp2f(v)
  #define GAPB(MF,X,B) do{ MF; X[B]=EX(X[B]); X[B+1]=EX(X[B+1]); PIN(X); SBAR(); }while(0)
  #define VRD(i) do{ vlo[i]=vtr(vp_+(((i)>>2)*4096+((i)&3)*1024)); vhi[i]=vtr(vp_+(((i)>>2)*4096+((i)&3)*1024+512)); }while(0)
  #define KRD(G,j) do{ if(G){ kload2(kf,kp0+sl_next,j); SBAR(); } }while(0)
  #define QRD(d) (*(const __attribute__((address_space(3))) bf16x8*)(qp+(d)*1024))
  #define MF32(a_,b_,c_) __builtin_amdgcn_mfma_f32_32x32x16_bf16(a_,b_,c_,0,0,0)
  #define STEP(C0,C1,P0,P1,t,GK,GV,GL) do{ SBAR(); \
    const lds_cptr vp_=vp0+2*sl_prev; bf16x8 q0_,q1_,q2_,q3_; \
    q0_=QRD(0); VRD(0); SBAR(); float sacc=(P0[0]+P0[1]); \
    GAPA(C0=MF32(kf[0],q0_,zero16), P0[2],P0[3],P0[4],P0[5],     pw0[0]=PKW(P0,0), pw0[1]=PKW(P0,2), pw0); \
    q1_=QRD(1); SBAR(); GAPA(C1=MF32(kf[1],q0_,zero16), P0[6],P0[7],P0[8],P0[9],     pw0[2]=PKW(P0,4), pw0[3]=PKW(P0,6), pw0); \
    VRD(4); SBAR(); GAPA(C0=MF32(kf[2],q1_,C0),   P0[10],P0[11],P0[12],P0[13], pw1[0]=PKW(P0,8), pw1[1]=PKW(P0,10), pw1); \
    q2_=QRD(2); SBAR(); GAPA(C1=MF32(kf[3],q1_,C1),   P0[14],P0[15],P1[0],P1[1],   pw1[2]=PKW(P0,12),pw1[3]=PKW(P0,14), pw1); \
    VRD(8); SBAR(); GAPA(C0=MF32(kf[4],q2_,C0),   P1[2],P1[3],P1[4],P1[5],     pw2[0]=PKW(P1,0), pw2[1]=PKW(P1,2), pw2); \
    q3_=QRD(3); SBAR(); GAPA(C1=MF32(kf[5],q2_,C1),   P1[6],P1[7],P1[8],P1[9],     pw2[2]=PKW(P1,4), pw2[3]=PKW(P1,6), pw2); \
    VRD(12); SBAR(); GAPA(C0=MF32(kf[6],q3_,C0),   P1[10],P1[11],P1[12],P1[13], pw3[0]=PKW(P1,8), pw3[1]=PKW(P1,10), pw3); \
    GAPA(C1=MF32(kf[7],q3_,C1),   P1[14],P1[15],0.f,0.f,       pw3[2]=PKW(P1,12),pw3[3]=PKW(P1,14), pw3); \
    l_reg+=sacc; \
    if(GK){DMA_K((t)+3,sl_cur);} if(GV){DMA_V((t)+1,sl_next);} \
    CMASK(C0,C1,t); \
    { float a=MX3(C0[0],C0[1],C1[0]),b=MX3(C0[2],C0[3],C1[1]); a=MX3(a,C1[2],C1[3]); \
      _Pragma("unroll") for(int r=4;r<16;r+=4){a=MX3(a,C0[r],C0[r+1]);b=MX3(b,C0[r+2],C0[r+3]);a=MX3(a,C1[r],C1[r+1]);b=MX3(b,C1[r+2],C1[r+3]);} \
      float rm=__builtin_fmaxf(a,b); { auto rr=__builtin_amdgcn_permlane32_swap(__float_as_uint(rm),__float_as_uint(rm),false,false); rm=__builtin_fmaxf(__uint_as_float(rr[0]),__uint_as_float(rr[1])); } \
      rm-=mhat; resc=false; \
      if(__builtin_expect(__any(rm>(float)THRL),0)){ const float dl=__builtin_fmaxf(rm,0.f); mhat+=dl; \
        const float f=__builtin_amdgcn_exp2f(-dl); l_reg*=f; if(hi==0)wsf[r32]=f; resc=true; } \
      _Pragma("unroll") for(int r=0;r<16;++r){C0[r]-=mhat;C1[r]-=mhat;} } \
    SBAR(); \
    VRD(1);  GAPB(o[0]=MF32(PAF(0),VFR(0), o[0]), C0,0); \
    VRD(5);  GAPB(o[1]=MF32(PAF(0),VFR(4), o[1]), C0,2); \
    VRD(9);  GAPB(o[2]=MF32(PAF(0),VFR(8), o[2]), C0,4); \
    VRD(13); GAPB(o[3]=MF32(PAF(0),VFR(12),o[3]), C0,6); \
    VRD(2);  KRD(GL,0); GAPB(o[0]=MF32(PAF(1),VFR(1), o[0]), C0,8); \
    VRD(6);  GAPB(o[1]=MF32(PAF(1),VFR(5), o[1]), C0,10); \
    VRD(10); KRD(GL,1); GAPB(o[2]=MF32(PAF(1),VFR(9), o[2]), C0,12); \
    VRD(14); GAPB(o[3]=MF32(PAF(1),VFR(13),o[3]), C0,14); \
    VRD(3);  KRD(GL,2); GAPB(o[0]=MF32(PAF(2),VFR(2), o[0]), C1,0); \
    VRD(7);  GAPB(o[1]=MF32(PAF(2),VFR(6), o[1]), C1,2); \
    VRD(11); KRD(GL,3); GAPB(o[2]=MF32(PAF(2),VFR(10),o[2]), C1,4); \
    VRD(15); GAPB(o[3]=MF32(PAF(2),VFR(14),o[3]), C1,6); \
    GAPB(o[0]=MF32(PAF(3),VFR(3), o[0]), C1,8); \
    GAPB(o[1]=MF32(PAF(3),VFR(7), o[1]), C1,10); \
    GAPB(o[2]=MF32(PAF(3),VFR(11),o[2]), C1,12); \
    GAPB(o[3]=MF32(PAF(3),VFR(15),o[3]), C1,14); \
    }while(0)
  int t=1;
  #undef CMASK
  #define CMASK(P0,P1,t) do{}while(0)
  for(;t+5<NT;t+=2){
    STEP(pB0,pB1,pA0,pA1,t,true,true,true);     WAIT_BAR(3); RESC(); ROT();
    STEP(pA0,pA1,pB0,pB1,t+1,true,true,true);   WAIT_BAR(3); RESC(); ROT();
  }
  #undef CMASK
  #define CMASK(P0,P1,t) do{int jb_=(t)-(NT-4); if(jb_>=0)cmask2(P0,P1,jb_,qrel,hi);}while(0)
  #define ENDW(tt) do{ if((tt)+3<NT){WAIT_BAR(3);} else if((tt)+2<NT){WAIT_BAR(2);} else {WAIT_BAR(0);} }while(0)
  for(;t+1<NT;t+=2){
    STEP(pB0,pB1,pA0,pA1,t,(t+3<NT),(t+1<NT),(t+1<NT));       ENDW(t);   RESC(); ROT();
    STEP(pA0,pA1,pB0,pB1,t+1,(t+4<NT),(t+2<NT),(t+2<NT));     ENDW(t+1); RESC(); ROT();
  }
  STEP(pB0,pB1,pA0,pA1,NT-1,false,false,false); RESC();
  u32x4 a0v[2][4];
  if(m==1){ const bf16*O0p=CB.O0+(rowbase+q0+wid*QBLK)*DM+vcol;
    #pragma unroll
    for(int half=0;half<2;++half)
      #pragma unroll
      for(int i=0;i<4;++i)a0v[half][i]=*(const u32x4*)(O0p+(long)(i*8+(lane>>3))*DM+half*64+(lane&7)*8);
    asm volatile("":::"memory"); }
  { float sacc=pB0[0]+pB0[1]; _Pragma("unroll") for(int r=2;r<16;++r)sacc+=pB0[r]; _Pragma("unroll") for(int r=0;r<16;++r)sacc+=pB1[r]; l_reg+=sacc;
    pw0=(u32x4){PKW(pB0,0),PKW(pB0,2),PKW(pB0,4),PKW(pB0,6)};pw1=(u32x4){PKW(pB0,8),PKW(pB0,10),PKW(pB0,12),PKW(pB0,14)};pw2=(u32x4){PKW(pB1,0),PKW(pB1,2),PKW(pB1,4),PKW(pB1,6)};pw3=(u32x4){PKW(pB1,8),PKW(pB1,10),PKW(pB1,12),PKW(pB1,14)};
    SBAR(); pv4(o,vb0+2*sl_cur,PAF(0),PAF(1),PAF(2),PAF(3)); }
  #undef PKW
  #undef PAF
  #undef VFR
  #undef PIN
  #undef MX3
  #undef GAPA
  #undef GAPB
  #undef EX
  #undef VRD
  #undef KRD
  #undef QRD
  #undef MF32
  #undef STEP
  #undef ENDW
  {auto rr=__builtin_amdgcn_permlane32_swap(__float_as_uint(l_reg),__float_as_uint(l_reg),false,false);l_reg=__uint_as_float(rr[0])+__uint_as_float(rr[1]);}
  if(hi==0)wsf[32+r32]=l_reg;asm volatile("s_waitcnt lgkmcnt(0)":::"memory");
  float rli[16];
  #pragma unroll
  for(int r=0;r<16;++r)rli[r]=__builtin_amdgcn_rcpf(wsf[32+CROWO(r)]);
  const long obase=(rowbase+q0+wid*QBLK)*DM+vcol;
  bf16*stg=(bf16*)(shm+WL_OST)+wid*2048;
  if(m==0){ bf16*Ow=O+obase;
    #pragma unroll
    for(int half=0;half<2;++half){
      #pragma unroll
      for(int r=0;r<16;++r){const int orow=CROWO(r);
        #pragma unroll
        for(int d0=0;d0<2;++d0)stg[orow*64+d0*32+r32]=__float2bfloat16(o[2*half+d0][r]*rli[r]);}
      asm volatile("s_waitcnt lgkmcnt(0)":::"memory");
      #pragma unroll
      for(int i=0;i<4;++i){const int row=i*8+(lane>>3),ch=lane&7; const u32x4 v=*(const u32x4*)(stg+row*64+ch*8); ATTN_STORE16(Ow+(long)row*DM+half*64+ch*8,v);}
      asm volatile("s_waitcnt lgkmcnt(0)":::"memory"); }
  } else {
    bf16*Aw=CB.A2+obase; const float lam=CB.lam;
    float df[2][4][8]; float ssq[4]={0.f,0.f,0.f,0.f};
    #pragma unroll
    for(int half=0;half<2;++half){
      u32x4 a[4];
      #pragma unroll
      for(int i=0;i<4;++i)a[i]=a0v[half][i];
      #pragma unroll
      for(int r=0;r<16;++r){const int orow=CROWO(r);
        #pragma unroll
        for(int d0=0;d0<2;++d0)stg[orow*64+d0*32+r32]=__float2bfloat16(o[2*half+d0][r]*rli[r]);}
      asm volatile("s_waitcnt lgkmcnt(0)":::"memory");
      #pragma unroll
      for(int i=0;i<4;++i){const int row=i*8+(lane>>3),ch=lane&7; const u32x4 v=*(const u32x4*)(stg+row*64+ch*8);
        #pragma unroll
        for(int k=0;k<4;++k){ const float d0_=__uint_as_float(a[i][k]<<16)-lam*__uint_as_float(v[k]<<16), d1_=__uint_as_float(a[i][k]&0xffff0000u)-lam*__uint_as_float(v[k]&0xffff0000u);
          df[half][i][2*k]=d0_; df[half][i][2*k+1]=d1_; ssq[i]+=d0_*d0_; ssq[i]+=d1_*d1_; } }
      asm volatile("s_waitcnt lgkmcnt(0)":::"memory"); }
    #pragma unroll
    for(int i=0;i<4;++i){ float ss=ssq[i];
      ss+=__builtin_bit_cast(float,__builtin_amdgcn_update_dpp(0,__builtin_bit_cast(int,ss),0xB1,0xF,0xF,true));
      ss+=__builtin_bit_cast(float,__builtin_amdgcn_update_dpp(0,__builtin_bit_cast(int,ss),0x4E,0xF,0xF,true));
      ss+=__builtin_bit_cast(float,__builtin_amdgcn_update_dpp(0,__builtin_bit_cast(int,ss),0x141,0xF,0xF,true));
      ssq[i]=1.0f/sqrtf(ss*(1.0f/128.0f)+1e-5f); }
    #pragma unroll
    for(int half=0;half<2;++half){ const int ch=lane&7;
      const f32x4_t w0=*(const f32x4_t*)(CB.w+half*64+ch*8),w1=*(const f32x4_t*)(CB.w+half*64+ch*8+4);
      #pragma unroll
      for(int i=0;i<4;++i){const int row=i*8+(lane>>3); const float rs=ssq[i]; u32x4 ov;
        #pragma unroll
        for(int k=0;k<4;++k){ const float wa=(k<2?w0[2*k]:w1[2*k-4])*CB.mul, wb=(k<2?w0[2*k+1]:w1[2*k-3])*CB.mul; ov[k]=cvtpk_s(df[half][i][2*k]*rs*wa,df[half][i][2*k+1]*rs*wb); }
        ATTN_STORE16(Aw+(long)row*DM+half*64+ch*8,ov);} }
  }
  asm volatile("s_waitcnt lgkmcnt(0)\n\ts_barrier":::"memory");
  #undef DMA_K
  #undef DMA_V
  #undef CMASK
  #undef START
  #undef RESC
  #undef ROT
  #undef CROWO
}
constexpr int ATTNW_LDS_BYTES=WL_BYTES;
struct AttnUnitW { int b, qcol, vcol, m, qb; };
struct StaticOrderW {
  int vcu, G;
  __device__ __forceinline__ StaticOrderW(int grid,int vcu_):vcu(vcu_),G(grid){}
  __device__ __forceinline__ bool next(int i,AttnUnitW&u)const{
    int b,h,m,qb;
    if(G==256){ if(i>=16)return false; const int xcd=vcu>>5,l=vcu&31,s=l>>1,ip=i>>1,bh=xcd*16+8*(l&1)+ip; m=i&1; b=bh>>3; h=bh&7; qb=(ip&1)?s:15-s; }
    else { const int i2=i>>1,ci=vcu+G*(i2>>4); if(ci>=BATCH*8)return false; h=ci&7; m=i&1; b=ci>>3; qb=15-(i2&15); }
    u.b=b; u.qcol=(2*h+m)*64; u.vcol=h*128; u.m=m; u.qb=qb; return true; }
};
template<int THRL=8> __device__ __forceinline__ void attn_phase_w(char*lds,const AttnTensors&T,const StaticOrderW&S,const CombineW&CB,const int tid_){
  AttnUnitW u;
  for(int i=0;S.next(i,u);++i){ attn_unit_w<THRL>(u.b,u.qcol,u.vcol,u.qb,u.m,T.Q,T.K,T.V,T.O0,CB,lds,tid_); }
}
#undef SBAR
#undef WAIT_BAR
}

constexpr int NWAVES = 8;
constexpr int BATCH = 16, SEQ = 4096, D = 1024, M = BATCH * SEQ, DEPTH = 4;
constexpr int NEXP = 32, FF = 512;
constexpr int NSLOT_MAX = 2 * M + NEXP * 256, NBLK_MAX = NSLOT_MAX / 256;
constexpr float LN_EPS = 1e-5f;
constexpr float DN_ALPHA = 1.681792830507429f;
constexpr int HG_CHUNK = 32, HG_NCH = SEQ / HG_CHUNK;

constexpr size_t MiB = 1u << 20;
constexpr size_t WS_CTL = 0, CTL_ZERO_BYTES = 1 * MiB;
constexpr size_t WS_MOD = 1 * MiB;
constexpr size_t WS_ROPE_C = 3 * MiB, WS_ROPE_S = 3 * MiB + 512 * 1024;
constexpr size_t WS_RT = 4 * MiB;
constexpr size_t WS_EID = 5 * MiB;
constexpr size_t WS_WT = 5 * MiB + 512 * 1024;
constexpr size_t WS_TSLOT = 6 * MiB;
constexpr size_t WS_SLOTW = 6 * MiB + 512 * 1024;
constexpr size_t WS_BLKE = 7 * MiB + 128 * 1024;
constexpr size_t WS_STOK = 7 * MiB + 256 * 1024;
constexpr size_t WS_HGD = 8 * MiB;
constexpr size_t WS_WHIN = 16 * MiB;
constexpr size_t WS_WAIN = 32 * MiB;
constexpr size_t WS_WHOUT = 44 * MiB;
constexpr size_t WS_WAOUT = 48 * MiB;
constexpr size_t WS_W13 = 52 * MiB;
constexpr size_t WS_W2 = 116 * MiB;
constexpr size_t WS_BUF0 = 148 * MiB, BUFSZ = 128 * MiB;
constexpr size_t WS_WB2 = WS_BUF0 + 7 * BUFSZ;
constexpr size_t WS_END = WS_WB2 + 96 * MiB;
constexpr int CW_TMO = 0, CW_CODE = 1;
constexpr int CW_BAR = 4096;
constexpr int CW_CNT = 8192;
static_assert((CW_CNT + 4 * 256) * 4 <= (int)CTL_ZERO_BYTES, "ctl");

constexpr int RING_OFF = 0, RING_BYTES = 147456;
constexpr int LDSCTL_OFF = RING_BYTES, MISC_OFF = LDSCTL_OFF + 512;
constexpr int LDS_BYTES = RING_BYTES + 1024;
static_assert(MISC_OFF + 128 <= LDS_BYTES, "LDS map");
#define GAS __attribute__((address_space(1)))
#define LAS __attribute__((address_space(3)))
typedef unsigned short bf16;
typedef unsigned v4u __attribute__((ext_vector_type(4)));
typedef float f32x4 __attribute__((ext_vector_type(4)));
typedef short bf16x8 __attribute__((ext_vector_type(8)));
typedef GAS unsigned gu32;
typedef GAS unsigned long long gu64;
#define RLX_AGENT __ATOMIC_RELAXED, __HIP_MEMORY_SCOPE_AGENT
#define LDS_WAIT() asm volatile("s_waitcnt lgkmcnt(0)" ::: "memory")
#define VM_WAIT() asm volatile("s_waitcnt vmcnt(0)" ::: "memory")
__device__ __forceinline__ unsigned long long rt() { return __builtin_amdgcn_s_memrealtime(); }
__device__ __forceinline__ unsigned f2bf(float f) { unsigned u = __builtin_bit_cast(unsigned, f); return (u + 0x7fffu + ((u >> 16) & 1u)) >> 16; }
__device__ __forceinline__ unsigned pk2(float lo, float hi) { return f2bf(lo) | (f2bf(hi) << 16); }

#define XB_TMO      128
#define XB_XCNT(j)  (256  + 64 * (j))
#define XB_XSUB(j)  (1280 + 64 * (j))
#define XB_XGEN(j)  (2304 + 64 * (j))
#define XB_TOP      3328
#define XB_TOPGEN   3392
#define XCD_BAR_WORDS 3456
#define XB_SPIN_CAP (1u << 18)

__device__ __forceinline__ unsigned xb_ld(unsigned* p)              { return __hip_atomic_load(p, __ATOMIC_RELAXED, __HIP_MEMORY_SCOPE_AGENT); }
__device__ __forceinline__ unsigned xb_add(unsigned* p, unsigned v) { return __hip_atomic_fetch_add(p, v, __ATOMIC_RELAXED, __HIP_MEMORY_SCOPE_AGENT); }
__device__ __forceinline__ unsigned xb_xcc_id() { return (unsigned)__builtin_amdgcn_s_getreg((3 << 11) | 20) & 0xFu; }
#define XB_SPIN(cond, bar) do { unsigned _sp = 0; while (cond) { __builtin_amdgcn_s_sleep(1); \
    if ((++_sp & 255u) == 0u) { if (xb_ld(&(bar)[XB_TMO])) break; if (_sp > XB_SPIN_CAP) { atomicAdd(&(bar)[XB_TMO], 1u); break; } } } } while (0)

struct XcdBarrier {
    unsigned* bar; unsigned x;
    volatile LAS unsigned* st;
};

__device__ __forceinline__ XcdBarrier xcd_barrier_post(unsigned* bar, volatile LAS unsigned* st) {
    XcdBarrier b; b.bar = bar; b.x = xb_xcc_id(); b.st = st;
    if (threadIdx.x == 0) (void)xb_add(&bar[XB_XCNT(b.x)], 1u);
    return b;
}
__device__ __forceinline__ void xcd_barrier_complete(unsigned* bar, unsigned x, unsigned& nloc, unsigned& nx) {
    const unsigned G = gridDim.x * gridDim.y * gridDim.z;
    unsigned sum, cnt, mine, sp = 0u;
    for (;;) {
        sum = 0u; cnt = 0u; mine = 0u;
#pragma unroll
        for (unsigned j = 0; j < 16; ++j) { const unsigned c = xb_ld(&bar[XB_XCNT(j)]); sum += c; cnt += (c > 0u) ? 1u : 0u; mine = (j == x) ? c : mine; }
        if (sum == G) break;
        __builtin_amdgcn_s_sleep(1);
        if ((++sp & 255u) == 0u) { if (xb_ld(&bar[XB_TMO])) break; if (sp > XB_SPIN_CAP) { atomicAdd(&bar[XB_TMO], 1u); break; } }
    }
    nloc = mine > 0u ? mine : 1u; nx = cnt > 0u ? cnt : 1u;
}

__device__ __forceinline__ void xcd_barrier(const XcdBarrier& b, const int wave_s) {
    asm volatile("s_waitcnt vmcnt(0)" ::: "memory");
    __syncthreads();
    unsigned lane_; asm volatile("v_mbcnt_lo_u32_b32 %0, -1, 0\n\tv_mbcnt_hi_u32_b32 %0, -1, %0" : "=v"(lane_));
    if (wave_s == 0 && lane_ == 0u) {
        unsigned* bar = b.bar; asm volatile("" : "+s"(bar));
        __builtin_amdgcn_s_waitcnt(0);
        unsigned nloc = b.st[0], nx = b.st[1];
        if (nloc == 0u) { xcd_barrier_complete(bar, b.x, nloc, nx); b.st[0] = nloc; b.st[1] = nx; }
        const unsigned old = xb_add(&bar[XB_XSUB(b.x)], 1u);
        const unsigned gen = old / nloc;
        if (old + 1u == (gen + 1u) * nloc) {
            __builtin_amdgcn_fence(__ATOMIC_RELEASE, "agent");
            asm volatile("s_waitcnt vmcnt(0)" ::: "memory");
            const unsigned og = xb_add(&bar[XB_TOP], 1u);
            const unsigned tg = og / nx;
            if (og + 1u == (tg + 1u) * nx) xb_add(&bar[XB_TOPGEN], 1u);
            else XB_SPIN(xb_ld(&bar[XB_TOPGEN]) == tg, bar);
            __builtin_amdgcn_fence(__ATOMIC_ACQUIRE, "agent");
            xb_add(&bar[XB_XGEN(b.x)], 1u);
            asm volatile("s_waitcnt vmcnt(0)" ::: "memory");
        } else {
            XB_SPIN(xb_ld(&bar[XB_XGEN(b.x)]) == gen, bar);
            __builtin_amdgcn_fence(__ATOMIC_ACQUIRE, "agent");
            asm volatile("s_waitcnt vmcnt(0)" ::: "memory");
        }
    }
    __syncthreads();
}

struct Args { const float* in[21]; float* out; unsigned char* ws; int ph_lo, ph_hi; };
#define CAS __attribute__((address_space(4)))
struct KA { const CAS char* p;
    __device__ __forceinline__ const float* in(int k) const { return *(const float* const CAS*)(p + 8 * k); }
    __device__ __forceinline__ float* out() const { return *(float* const CAS*)(p + 8 * 21); }
    __device__ __forceinline__ unsigned char* ws() const { return *(unsigned char* const CAS*)(p + 8 * 22); }
    __device__ __forceinline__ int ph_lo() const { return *(const CAS int*)(p + 8 * 23); }
    __device__ __forceinline__ int ph_hi() const { return *(const CAS int*)(p + 8 * 23 + 4); }
};
__device__ __forceinline__ KA karg_fresh() { const CAS char* q = (const CAS char*)__builtin_amdgcn_kernarg_segment_ptr(); asm volatile("" : "+s"(q)); KA k; k.p = q; return k; }
struct Frame {
    LAS unsigned char* lds; volatile LAS unsigned* MISC; gu32* ctl;
    int tid, lane, wave, vcu, G, bx;
};
typedef unsigned long long u64;
typedef float f32x16 __attribute__((ext_vector_type(16)));
template <int CTRL> __device__ __forceinline__ float dpp_mov(float v) { return __builtin_bit_cast(float, __builtin_amdgcn_update_dpp(0, __builtin_bit_cast(int, v), CTRL, 0xF, 0xF, true)); }
__device__ __forceinline__ float row8_sum(float v) { v += dpp_mov<0xB1>(v); v += dpp_mov<0x4E>(v); v += dpp_mov<0x141>(v); return v; }
__device__ __forceinline__ float wave_sum(float v, int) { v = row8_sum(v); v += dpp_mov<0x140>(v);
    v += __builtin_bit_cast(float, __builtin_amdgcn_update_dpp(0, __builtin_bit_cast(int, v), 0x142, 0xA, 0xF, false));
    v += __builtin_bit_cast(float, __builtin_amdgcn_update_dpp(0, __builtin_bit_cast(int, v), 0x143, 0xC, 0xF, false));
    return __builtin_bit_cast(float, __builtin_amdgcn_readlane(__builtin_bit_cast(int, v), 63)); }
__device__ __forceinline__ float bf2f(unsigned b) { return __uint_as_float(b << 16); }
__device__ __forceinline__ float bflo(unsigned w) { return __uint_as_float(w << 16); }
__device__ __forceinline__ float bfhi(unsigned w) { return __uint_as_float(w & 0xffff0000u); }
__device__ __forceinline__ float fexp(float x) { return __builtin_amdgcn_exp2f(1.4426950408889634f * x); }
__device__ __forceinline__ float sigmoid_f(float x) { return __builtin_amdgcn_rcpf(1.0f + fexp(-x)); }
__device__ __forceinline__ unsigned pkbf(float lo, float hi) { return pg8::cvt_pk_bf16(lo, hi); }
typedef _Float16 f16x2_t __attribute__((ext_vector_type(2))); typedef float f32x2_t2 __attribute__((ext_vector_type(2)));
__device__ __forceinline__ unsigned pkh(float lo, float hi) { const f32x2_t2 v = {lo, hi}; return __builtin_bit_cast(unsigned, __builtin_convertvector(v, f16x2_t)); }
__device__ __forceinline__ f32x4 unpk_h4(u64 w) { const f16x2_t a = __builtin_bit_cast(f16x2_t, (unsigned)w), b = __builtin_bit_cast(f16x2_t, (unsigned)(w >> 32)); return (f32x4){(float)a[0], (float)a[1], (float)b[0], (float)b[1]}; }
__device__ __forceinline__ int swap23(int p) { return (p & ~12) | ((p & 4) << 1) | ((p & 8) >> 1); }
__device__ __forceinline__ int crow16(int i, int hh) { return (i & 3) + 8 * (i >> 2) + 4 * hh; }

struct MapId { __device__ __forceinline__ int operator()(int n) const { return n; } };
struct MapW13 { int add; __device__ __forceinline__ int operator()(int u) const { return ((u >> 7) << 8) + add + (u & 127); } };
struct MapHgrnIn { __device__ __forceinline__ int operator()(int n) const { return (n < 2048) ? ((n & ~1023) | swap23(n & 1023)) : n; } };
struct MapAttnIn { __device__ __forceinline__ int operator()(int n) const { if (n >= 2048) return n; const int part = n >> 10, c = n & 1023, hm = c >> 6, dim = c & 63;
    return part * 1024 + (hm >> 2) * 256 + (dim >> 5) * 128 + (hm & 3) * 32 + (dim & 31); } };
template <class MapF>
__device__ __forceinline__ void transpose_item(const float* W, int K, int N, bf16* WT, LAS float* scr, int item, int lane, MapF map) {
    const int nblk = N / 32, kb = item / nblk, nb = item % nblk, k0 = 64 * kb, n0 = 32 * nb;
#pragma unroll 8
    for (int i = 0; i < 32; ++i) { const int kk = 2 * i + (lane >> 5); scr[kk * 33 + (lane & 31)] = W[(size_t)(k0 + kk) * N + n0 + (lane & 31)]; }
    LDS_WAIT(); asm volatile("" ::: "memory");
    const int c = lane & 7;
#pragma unroll
    for (int j = 0; j < 4; ++j) { const int n = (lane >> 3) + 8 * j; const LAS float* s = scr + (8 * c) * 33 + n;
        v4u o; o.x = pkbf(s[0 * 33], s[1 * 33]); o.y = pkbf(s[2 * 33], s[3 * 33]); o.z = pkbf(s[4 * 33], s[5 * 33]); o.w = pkbf(s[6 * 33], s[7 * 33]);
        *(GAS v4u*)(WT + (size_t)map(n0 + n) * K + k0 + 8 * c) = o; }
    LDS_WAIT(); asm volatile("" ::: "memory");
}
__device__ __forceinline__ unsigned char* moe_wbuf(unsigned char* ws, int L) { return (L & 1) ? ws + WS_WB2 : ws + WS_W13; }
struct ConvItem { const float* W; bf16* WT; int K, N, k0, n0, add; };
__device__ __forceinline__ ConvItem conv_item(const KA a, int L, int it) {
    const int e = it / 768, r = it % 768; const size_t eo = (size_t)(L * 32 + e) * 1024 * 512; ConvItem c;
    bf16* W13 = (bf16*)moe_wbuf(a.ws(), L) + (size_t)e * 1024 * 1024; bf16* W2 = (bf16*)(moe_wbuf(a.ws(), L) + 64 * MiB) + (size_t)e * 1024 * 512;
    if (r < 512) { const int rr = r & 255; c.W = (r < 256 ? a.in(18) : a.in(19)) + eo; c.WT = W13; c.K = 1024; c.N = 512; c.k0 = 64 * (rr >> 4); c.n0 = 32 * (rr & 15); c.add = (r < 256) ? 0 : 128; }
    else { const int rr = r - 512; c.W = a.in(20) + eo; c.WT = W2; c.K = 512; c.N = 1024; c.k0 = 64 * (rr >> 5); c.n0 = 32 * (rr & 31); c.add = -1; }
    return c;
}
__device__ __forceinline__ void conv_load(const ConvItem& c, int lane, f32x4 (&v)[8]) {
#pragma unroll
    for (int i = 0; i < 8; ++i) v[i] = *(const f32x4*)(c.W + (size_t)(c.k0 + 8 * (lane >> 3) + i) * c.N + c.n0 + 4 * (lane & 7));
}
__device__ __forceinline__ void conv_store(const ConvItem& c, int lane, const f32x4 (&v)[8]) {
#pragma unroll
    for (int cc = 0; cc < 4; ++cc) { const int n = c.n0 + 4 * (lane & 7) + cc;
        const int row = (c.add == -1) ? n : (c.add == -2) ? MapHgrnIn{}(n) : (c.add == -3) ? MapAttnIn{}(n) : (((n >> 7) << 8) + c.add + (n & 127));
        v4u o; o.x = pkbf(v[0][cc], v[1][cc]); o.y = pkbf(v[2][cc], v[3][cc]); o.z = pkbf(v[4][cc], v[5][cc]); o.w = pkbf(v[6][cc], v[7][cc]);
        *(GAS v4u*)(c.WT + (size_t)row * c.K + c.k0 + 8 * (lane >> 3)) = o; }
}
constexpr int MIX_HIN = 16 * 128, MIX_OUT = 16 * 32, MIX_AIN = 16 * 96, MIX_PER = MIX_HIN + MIX_OUT + MIX_AIN + MIX_OUT, MIX_FIRST = MIX_HIN + MIX_OUT;
__device__ __forceinline__ ConvItem mix_item(const KA a, int it) {
    const int j = it / MIX_PER; int r = it % MIX_PER; ConvItem c; c.K = 1024;
    if (r < MIX_HIN) { c.W = a.in(6) + (size_t)j * 1024 * 4096; c.WT = (bf16*)(a.ws() + WS_WHIN) + (size_t)j * 4096 * 1024; c.N = 4096; c.add = -2; }
    else if ((r -= MIX_HIN) < MIX_OUT) { c.W = a.in(7) + (size_t)j * 1024 * 1024; c.WT = (bf16*)(a.ws() + WS_WHOUT) + (size_t)j * 1024 * 1024; c.N = 1024; c.add = -1; }
    else if ((r -= MIX_OUT) < MIX_AIN) { c.W = a.in(10) + (size_t)j * 1024 * 3072; c.WT = (bf16*)(a.ws() + WS_WAIN) + (size_t)j * 3072 * 1024; c.N = 3072; c.add = -3; }
    else { r -= MIX_AIN; c.W = a.in(11) + (size_t)j * 1024 * 1024; c.WT = (bf16*)(a.ws() + WS_WAOUT) + (size_t)j * 1024 * 1024; c.N = 1024; c.add = -1; }
    const int nblk = c.N / 32; c.k0 = 64 * (r / nblk); c.n0 = 32 * (r % nblk);
    return c;
}
__device__ __forceinline__ void convert_mixer(const KA a, int lane, int first, int last, int gw, int ngw) {
    for (int it = first + gw; it < last; it += ngw) { const ConvItem c = mix_item(a, it); f32x4 v[8]; conv_load(c, lane, v); conv_store(c, lane, v); }
}
__device__ __forceinline__ void convert_moe(Frame& F, const KA a, int L, int cw, int nconv) {
    const int gw = F.vcu * nconv + cw, NGW = F.G * nconv;
    if (gw >= 32 * 768) return;
    ConvItem cur = conv_item(a, L, gw); f32x4 v[8]; conv_load(cur, F.lane, v);
    for (int it = gw; it < 32 * 768; it += NGW) {
        const int nx = it + NGW; ConvItem nxt = cur; f32x4 vn[8];
        if (nx < 32 * 768) { nxt = conv_item(a, L, nx); conv_load(nxt, F.lane, vn); }
        conv_store(cur, F.lane, v);
        cur = nxt;
#pragma unroll
        for (int i = 0; i < 8; ++i) v[i] = vn[i];
    }
}

__device__ __forceinline__ void phase_p0a(Frame& F, const KA a) {
    const int gw = F.vcu * NWAVES + F.wave, NGW = F.G * NWAVES;
    const float* c = a.in(1); const float* ada_w = a.in(2); const float* ada_b = a.in(3);
    float* mod = (float*)(a.ws() + WS_MOD);
    if (F.vcu < 4 * 24) {
        LAS float* sl = (LAS float*)(F.lds + RING_OFF + 65536);
        for (int idx = F.tid; idx < 16 * 1024; idx += 512) { const int k = idx & 1023, b = idx >> 10; const float cv = c[idx]; sl[k * 16 + b] = cv * sigmoid_f(cv); }
        __syncthreads();
    }
    for (int it = F.vcu; it < 4 * 24; it += F.G) {
        const int i = it / 24, nb = it % 24;
        f32x4 acc[16];
#pragma unroll
        for (int b = 0; b < 16; ++b) acc[b] = (f32x4){0.f, 0.f, 0.f, 0.f};
        const float* wp = ada_w + ((size_t)i * 1024 + F.wave * 128) * 6144 + nb * 256 + 4 * F.lane;
        const LAS float* sw = (const LAS float*)(F.lds + RING_OFF + 65536) + F.wave * 128 * 16;
        for (int k0 = 0; k0 < 128; k0 += 16) {
            f32x4 w4[16];
#pragma unroll
            for (int kk = 0; kk < 16; ++kk) w4[kk] = *(const f32x4*)(wp + (size_t)(k0 + kk) * 6144);
            asm volatile("" ::: "memory");
#pragma unroll
            for (int kk = 0; kk < 16; ++kk) {
                const LAS f32x4* sp = (const LAS f32x4*)(sw + (k0 + kk) * 16);
                const f32x4 s0 = sp[0], s1 = sp[1], s2 = sp[2], s3 = sp[3];
#pragma unroll
                for (int b = 0; b < 4; ++b) { acc[b] += w4[kk] * s0[b]; acc[4 + b] += w4[kk] * s1[b]; acc[8 + b] += w4[kk] * s2[b]; acc[12 + b] += w4[kk] * s3[b]; }
            }
        }
        LAS float* red = (LAS float*)(F.lds + RING_OFF);
#pragma unroll
        for (int hb = 0; hb < 2; ++hb) {
#pragma unroll
            for (int b = 0; b < 8; ++b) *(LAS f32x4*)(red + (F.wave * 8 + b) * 256 + 4 * F.lane) = acc[8 * hb + b];
            __syncthreads();
            const float bias_ = ada_b[i * 6144 + nb * 256 + (F.tid & 255)];
            for (int r = 0; r < 4; ++r) { const int idx = F.tid + 512 * r, b = idx >> 8, col = idx & 255; float s = bias_;
#pragma unroll
                for (int w = 0; w < 8; ++w) s += red[(w * 8 + b) * 256 + col];
                mod[((size_t)i * 16 + 8 * hb + b) * 6144 + nb * 256 + col] = s; }
            __syncthreads();
        }
    }
    {
        float* cs = (float*)(a.ws() + WS_ROPE_C); float* sn = (float*)(a.ws() + WS_ROPE_S);
        for (int idx = gw * 64 + F.lane; idx < SEQ * 32; idx += NGW * 64) {
            const int pos = idx >> 5, j = idx & 31;
            double f = 1.0; const double r1 = 0.74989420933245582730;
            double p = r1;
#pragma unroll
            for (int bit = 0; bit < 5; ++bit) { if (j & (1 << bit)) f *= p; p *= p; }
            const double ang = (double)pos * f;
            const double kq = __builtin_rint(ang * 0.63661977236758134308);
            const double rr = (ang - kq * 1.57079632679489655800e+00) - kq * 6.12323399573676603587e-17;
            const double r2 = rr * rr;
            const double sp = rr * (1.0 + r2 * (-1.0 / 6 + r2 * (1.0 / 120 + r2 * (-1.0 / 5040 + r2 * (1.0 / 362880 + r2 * (-1.0 / 39916800 + r2 * (1.0 / 6227020800.0)))))));
            const double cp = 1.0 + r2 * (-0.5 + r2 * (1.0 / 24 + r2 * (-1.0 / 720 + r2 * (1.0 / 40320 + r2 * (-1.0 / 3628800 + r2 * (1.0 / 479001600.0 + r2 * (-1.0 / 87178291200.0)))))));
            const int q = ((int)kq) & 3;
            const double sv = (q == 0) ? sp : (q == 1) ? cp : (q == 2) ? -sp : -cp;
            const double cv = (q == 0) ? cp : (q == 1) ? -sp : (q == 2) ? -cp : sp;
            cs[idx] = (float)cv; sn[idx] = (float)sv;
        }
    }
    {
        float* rt = (float*)(a.ws() + WS_RT); const float* rgw = a.in(14); const float* rew = a.in(16);
        for (int idx = gw * 64 + F.lane; idx < 4 * 36 * 1024; idx += NGW * 64) {
            const int l = idx / 36864, e = (idx >> 10) % 36, k = idx & 1023;
            rt[idx] = (e < 4) ? rgw[((size_t)l * 1024 + k) * 4 + e] : rew[((size_t)l * 1024 + k) * 32 + (e - 4)];
        }
    }
    convert_mixer(a, F.lane, 0, MIX_FIRST, gw, NGW);
}

__device__ __forceinline__ void phase_p0b(Frame& F, const KA a) {
    const int gw = F.vcu * NWAVES + F.wave, NGW = F.G * NWAVES;
    const float* x = a.in(0); const float* mod = (const float*)(a.ws() + WS_MOD); bf16* h = (bf16*)(a.ws() + WS_BUF0);
#define P0B_LOAD(X, t_) do { _Pragma("unroll") for (int tt = 0; tt < 4; ++tt) _Pragma("unroll") for (int j = 0; j < 4; ++j) X[tt][j] = *(const f32x4*)(x + (size_t)((t_) + tt) * D + 4 * F.lane + 256 * j); } while (0)
#define P0B_PROC(X, t_) do { const float* mb = mod + (size_t)((t_) >> 12) * 6144; \
        _Pragma("unroll") for (int j = 0; j < 4; ++j) { const int col = 4 * F.lane + 256 * j; const f32x4 sh = *(const f32x4*)(mb + col), sc = *(const f32x4*)(mb + 1024 + col) + 1.0f; \
            _Pragma("unroll") for (int tt = 0; tt < 4; ++tt) { const f32x4 hv = X[tt][j] * sc + sh; \
                *(u64*)(h + (size_t)((t_) + tt) * D + col) = (u64)pkbf(hv[0], hv[1]) | ((u64)pkbf(hv[2], hv[3]) << 32); } } } while (0)
    const int step = NGW * 4;
    f32x4 xa[4][4], xb[4][4];
    int t0 = gw * 4;
    if (t0 < M) P0B_LOAD(xa, t0);
    for (; t0 < M; t0 += 2 * step) {
        const int t1 = t0 + step, t2 = t1 + step;
        if (t1 < M) P0B_LOAD(xb, t1);
        P0B_PROC(xa, t0);
        if (t2 < M) P0B_LOAD(xa, t2);
        if (t1 < M) P0B_PROC(xb, t1);
    }
#undef P0B_LOAD
#undef P0B_PROC
}

__device__ __forceinline__ void phase_hgrn_prep(Frame& F, const KA a, int j) {
    bf16* Qb = (bf16*)(a.ws() + WS_BUF0 + 1 * BUFSZ); bf16* Zb = (bf16*)(a.ws() + WS_BUF0 + 2 * BUFSZ);
    float* dd = (float*)(a.ws() + WS_HGD);
    const float* lb = a.in(8);
    const int grp = F.tid >> 7, jt = F.tid & 127, col = 8 * jt, h = col >> 7, pos = col & 127;
    const int ch0 = swap23(pos), ch1 = swap23(pos + 4);
    float oml[8];
#pragma unroll
    for (int c = 0; c < 8; ++c) oml[c] = 1.0f;
    if (j == 1) {
#pragma unroll
        for (int c = 0; c < 4; ++c) { oml[c] = 1.0f - sigmoid_f(lb[1024 + h * 128 + ch0 + c] - lb[h * 128 + ch0 + c]); oml[4 + c] = 1.0f - sigmoid_f(lb[1024 + h * 128 + ch1 + c] - lb[h * 128 + ch1 + c]); } }
    constexpr int NIT = BATCH * HG_NCH;
    float bs[8];
#define HP_IT(s_) (F.vcu + F.G * (grp + 4 * ((s_) >> 2)))
#define HP_LOAD(Z, Q, s_) do { int it_ = HP_IT(s_); it_ = (it_ < NIT) ? it_ : 0;        \
        const size_t tk_ = (size_t)(it_ >> 7) * SEQ + (it_ & (HG_NCH - 1)) * HG_CHUNK + 8 * ((s_) & 3); \
        _Pragma("unroll") for (int t = 0; t < 8; ++t) { Z[t] = *(const v4u*)(Zb + (tk_ + t) * D + col); Q[t] = *(const v4u*)(Qb + (tk_ + t) * D + col); } } while (0)
#define HP_PROC(Z, Q, s_) do { const int it_ = HP_IT(s_); const int chunk_ = it_ & (HG_NCH - 1), b_ = it_ >> 7; const size_t tk_ = (size_t)b_ * SEQ + chunk_ * HG_CHUNK + 8 * ((s_) & 3); \
        if (((s_) & 3) == 0) { _Pragma("unroll") for (int c = 0; c < 8; ++c) bs[c] = 0.f; } \
        _Pragma("unroll") for (int t = 0; t < 8; ++t) { v4u qo, ko; \
            _Pragma("unroll") for (int i = 0; i < 4; ++i) { \
                const float k0 = oml[2 * i] * sigmoid_f(-bflo(Z[t][i])), k1 = oml[2 * i + 1] * sigmoid_f(-bfhi(Z[t][i])); \
                const float g0 = (k0 < 0.05f) ? -k0 * (1.0f + k0 * (0.5f + k0 * (0.33333333f + k0 * 0.25f))) : 0.69314718056f * __builtin_amdgcn_logf(1.0f - k0); \
                const float g1 = (k1 < 0.05f) ? -k1 * (1.0f + k1 * (0.5f + k1 * (0.33333333f + k1 * 0.25f))) : 0.69314718056f * __builtin_amdgcn_logf(1.0f - k1); \
                bs[2 * i] += g0; bs[2 * i + 1] += g1; \
                qo[i] = pkbf(bflo(Q[t][i]) * fexp(bs[2 * i]), bfhi(Q[t][i]) * fexp(bs[2 * i + 1])); \
                ko[i] = pkbf(k0 * fexp(fminf(-bs[2 * i], 80.0f)), k1 * fexp(fminf(-bs[2 * i + 1], 80.0f))); } \
            *(v4u*)(Qb + (tk_ + t) * D + col) = qo; *(v4u*)(Zb + (tk_ + t) * D + col) = ko; } \
        if (((s_) & 3) == 3) { const size_t rowbase_ = ((size_t)(b_ * 8 + h) * HG_NCH + chunk_) * 128; \
            *(f32x4*)(dd + rowbase_ + ch0) = (f32x4){fexp(bs[0]), fexp(bs[1]), fexp(bs[2]), fexp(bs[3])}; *(f32x4*)(dd + rowbase_ + ch1) = (f32x4){fexp(bs[4]), fexp(bs[5]), fexp(bs[6]), fexp(bs[7])}; } } while (0)
    v4u za[8], qa[8], zb[8], qb[8];
    int s = 0;
    HP_LOAD(za, qa, 0);
    for (; HP_IT(s) < NIT; s += 2) {
        HP_LOAD(zb, qb, s + 1);
        HP_PROC(za, qa, s);
        HP_LOAD(za, qa, s + 2);
        HP_PROC(zb, qb, s + 1);
    }
#undef HP_IT
#undef HP_LOAD
#undef HP_PROC
}

#define MFMA32(a_, b_, c_) __builtin_amdgcn_mfma_f32_32x32x16_bf16((a_), (b_), (c_), 0, 0, 0)
typedef float f32x2_pk __attribute__((ext_vector_type(2))); typedef __bf16 bf16x2_pk __attribute__((ext_vector_type(2)));
__device__ __forceinline__ unsigned cvt2(float lo, float hi) { const f32x2_pk v = {lo, hi}; return __builtin_bit_cast(unsigned, __builtin_convertvector(v, bf16x2_pk)); }
__device__ __forceinline__ bf16x8 pack_half(const f32x16& x, int s) {
    v4u p; p.x = cvt2(x[8 * s + 0], x[8 * s + 1]); p.y = cvt2(x[8 * s + 2], x[8 * s + 3]); p.z = cvt2(x[8 * s + 4], x[8 * s + 5]); p.w = cvt2(x[8 * s + 6], x[8 * s + 7]);
    return __builtin_bit_cast(bf16x8, p);
}
constexpr int HS_Q = 0, HS_K = 8192, HS_V = 16384, HS_D = 18432, HS_BUF = 18944, HS_NBUF = 3, HS_WAVE = HS_NBUF * HS_BUF, HS_OST = 2 * HS_WAVE, HS_CONV = HS_OST + 4096, HS_NCONV = 6;
static_assert(HS_CONV <= RING_BYTES, "scan LDS map");
typedef short s16x4_t __attribute__((ext_vector_type(4)));
__device__ __forceinline__ void phase_hgrn_scan(Frame& F, const KA a, int layer) {
    const bf16* Qt = (const bf16*)(a.ws() + WS_BUF0 + 1 * BUFSZ); const bf16* Kt = (const bf16*)(a.ws() + WS_BUF0 + 2 * BUFSZ);
    const bf16* Vb = (const bf16*)(a.ws() + WS_BUF0 + 3 * BUFSZ); const float* dd = (const float*)(a.ws() + WS_HGD);
    bf16* O = (bf16*)(a.ws() + WS_BUF0 + 6 * BUFSZ);
    if (F.wave >= 2) {
        if (F.wave < 2 + HS_NCONV) { if (layer == 0) convert_mixer(a, F.lane, MIX_FIRST, 2 * MIX_PER, F.vcu * HS_NCONV + F.wave - 2, F.G * HS_NCONV);
            convert_moe(F, a, layer, F.wave - 2, HS_NCONV); convert_moe(F, a, layer + 1, F.wave - 2, HS_NCONV); }
        return; }
    LAS unsigned char* ring = F.lds + RING_OFF + F.wave * HS_WAVE;
    LAS unsigned char* ost = F.lds + RING_OFF + HS_OST + F.wave * 2048;
    for (int u = F.vcu; u < BATCH * 8 * 2; u += F.G) {
        const int bh = u >> 1, vt = (u & 1) * 2 + F.wave, b = bh >> 3, h = bh & 7;
        const int r = F.lane & 31, hh = F.lane >> 5;
        f32x16 S[4];
#pragma unroll
        for (int kt = 0; kt < 4; ++kt)
#pragma unroll
            for (int i = 0; i < 16; ++i) S[kt][i] = 0.f;
        const bf16* Qp = Qt + ((size_t)b * SEQ + r) * D + h * 128 + 8 * hh;
        const bf16* Kp = Kt + ((size_t)b * SEQ + r) * D + h * 128 + 8 * hh;
        const bf16* Vp = Vb + ((size_t)b * SEQ + (F.lane >> 2)) * D + h * 128 + 32 * vt + 8 * (F.lane & 3);
        const float* dp = dd + (size_t)bh * HG_NCH * 128 + F.lane;
        bf16* op2 = O + ((size_t)b * SEQ + 4 * hh) * D + h * 128 + 32 * vt + r;
        const int i16 = F.lane & 15, blk = (F.lane >> 4) & 1, tq = i16 >> 2, tp = i16 & 3, tpp = ((tp & 1) << 1) | (tp >> 1);
        const int trb = HS_K + blk * 1024 + (tpp >> 1) * 512 + (4 * hh + tq) * 16 + (tpp & 1) * 8;
        const int vtrb = HS_V + (4 * hh + tq) * 64 + 32 * blk + 8 * tp;
#define HS_DMA(c_, buf_) do { LAS unsigned char* bb_ = ring + (buf_) * HS_BUF; \
        _Pragma("unroll") for (int ks = 0; ks < 8; ++ks) { __builtin_amdgcn_global_load_lds((const unsigned*)(Qp + (size_t)(c_) * 32 * D + 16 * ks), (LAS unsigned*)(bb_ + HS_Q + ks * 1024), 16, 0, 0); \
                                                        __builtin_amdgcn_global_load_lds((const unsigned*)(Kp + (size_t)(c_) * 32 * D + 16 * ks), (LAS unsigned*)(bb_ + HS_K + ks * 1024), 16, 0, 0); } \
        _Pragma("unroll") for (int st = 0; st < 2; ++st) __builtin_amdgcn_global_load_lds((const unsigned*)(Vp + ((size_t)(c_) * 32 + 16 * st) * D), (LAS unsigned*)(bb_ + HS_V + st * 1024), 16, 0, 0); \
        _Pragma("unroll") for (int q_ = 0; q_ < 2; ++q_) __builtin_amdgcn_global_load_lds((const unsigned*)(dp + (size_t)(c_) * 128 + 64 * q_), (LAS unsigned*)(bb_ + HS_D + q_ * 256), 4, 0, 0); } while (0)
        asm volatile("s_waitcnt lgkmcnt(0)" ::: "memory");
        HS_DMA(0, 0); HS_DMA(1, 1);
        int bcur = 0, bnext = 2;
        for (int c = 0; c < HG_NCH; ++c) {
            const int cn = (c + 2 < HG_NCH) ? c + 2 : HG_NCH - 1;
            HS_DMA(cn, bnext);
            if (c == 0) asm volatile("s_waitcnt vmcnt(40)" ::: "memory");
            else asm volatile("s_waitcnt vmcnt(56)" ::: "memory");
            const LAS unsigned char* bbase = ring + bcur * HS_BUF;
            const LAS unsigned char* bb = bbase + F.lane * 16;
            bf16x8 Qf[8], Kf[8], Vf[2];
            { const unsigned vba = (unsigned)(uintptr_t)(bbase + vtrb); s16x4_t v0, v1, v2, v3;
              asm volatile("ds_read_b64_tr_b16 %0, %1 offset:0" : "=&v"(v0) : "v"(vba) : "memory"); asm volatile("ds_read_b64_tr_b16 %0, %1 offset:512" : "=&v"(v1) : "v"(vba) : "memory");
              asm volatile("ds_read_b64_tr_b16 %0, %1 offset:1024" : "=&v"(v2) : "v"(vba) : "memory"); asm volatile("ds_read_b64_tr_b16 %0, %1 offset:1536" : "=&v"(v3) : "v"(vba) : "memory");
#pragma unroll
              for (int ks = 0; ks < 8; ++ks) { Qf[ks] = *(const LAS bf16x8*)(bb + HS_Q + ks * 1024); Kf[ks] = *(const LAS bf16x8*)(bb + HS_K + ks * 1024); }
              asm volatile("s_waitcnt lgkmcnt(0)" : "+v"(v0), "+v"(v1), "+v"(v2), "+v"(v3) :: "memory");
              Vf[0] = (bf16x8){v0[0], v0[1], v0[2], v0[3], v1[0], v1[1], v1[2], v1[3]}; Vf[1] = (bf16x8){v2[0], v2[1], v2[2], v2[3], v3[0], v3[1], v3[2], v3[3]}; }
            f32x16 sc0, sc1;
#pragma unroll
            for (int i = 0; i < 16; ++i) { sc0[i] = 0.f; sc1[i] = 0.f; }
#pragma unroll
            for (int ks = 0; ks < 8; ks += 2) { sc0 = MFMA32(Kf[ks], Qf[ks], sc0); sc1 = MFMA32(Kf[ks + 1], Qf[ks + 1], sc1); }
#pragma unroll
            for (int i = 0; i < 16; ++i) sc0[i] = (crow16(i, hh) > r) ? 0.f : (sc0[i] + sc1[i]);
            f32x16 oA, oB;
#pragma unroll
            for (int i = 0; i < 16; ++i) { oA[i] = 0.f; oB[i] = 0.f; }
#pragma unroll
            for (int kt = 0; kt < 4; kt += 2)
#pragma unroll
                for (int st = 0; st < 2; ++st) { oA = MFMA32(Qf[2 * kt + st], pack_half(S[kt], st), oA); oB = MFMA32(Qf[2 * kt + 2 + st], pack_half(S[kt + 1], st), oB); }
            oA = MFMA32(pack_half(sc0, 0), Vf[0], oA); oB = MFMA32(pack_half(sc0, 1), Vf[1], oB);
            const LAS float* dl = (const LAS float*)(bbase + HS_D) + 4 * hh;
            const unsigned tba = (unsigned)(uintptr_t)(bbase + trb);
            s16x4_t klo[8], khi[8];
#pragma unroll
            for (int f = 0; f < 8; ++f) {
                asm volatile("ds_read_b64_tr_b16 %0, %1 offset:%c2" : "=&v"(klo[f]) : "v"(tba), "i"((f >> 1) * 2048 + (f & 1) * 256) : "memory");
                asm volatile("ds_read_b64_tr_b16 %0, %1 offset:%c2" : "=&v"(khi[f]) : "v"(tba), "i"((f >> 1) * 2048 + (f & 1) * 256 + 128) : "memory"); }
            asm volatile("s_waitcnt lgkmcnt(0)" : "+v"(klo[0]), "+v"(klo[1]), "+v"(klo[2]), "+v"(klo[3]), "+v"(klo[4]), "+v"(klo[5]), "+v"(klo[6]), "+v"(klo[7]) :: "memory");
            asm volatile("" : "+v"(khi[0]), "+v"(khi[1]), "+v"(khi[2]), "+v"(khi[3]), "+v"(khi[4]), "+v"(khi[5]), "+v"(khi[6]), "+v"(khi[7]) :: "memory");
#pragma unroll
            for (int kt = 0; kt < 4; ++kt) {
#pragma unroll
                for (int st = 0; st < 2; ++st) { const int f = kt * 2 + st;
                    const bf16x8 kh = (bf16x8){klo[f][0], klo[f][1], klo[f][2], klo[f][3], khi[f][0], khi[f][1], khi[f][2], khi[f][3]};
                    S[kt] = MFMA32(kh, Vf[st], S[kt]); }
#pragma unroll
                for (int g = 0; g < 4; ++g) { const f32x4 dv = *(const LAS f32x4*)(dl + 32 * kt + 8 * g);
#pragma unroll
                    for (int i = 0; i < 4; ++i) S[kt][4 * g + i] *= dv[i]; }
            }
#pragma unroll
            for (int i = 0; i < 16; ++i) *(unsigned short*)(op2 + ((size_t)c * 32 + crow16(i, 0)) * D) = (unsigned short)(pkbf(oA[i] + oB[i], 0.f) & 0xffffu);
            asm volatile("s_waitcnt lgkmcnt(0)" ::: "memory");
            bcur = (bcur == HS_NBUF - 1) ? 0 : bcur + 1; bnext = (bnext == HS_NBUF - 1) ? 0 : bnext + 1;
        }
        asm volatile("s_waitcnt vmcnt(0)" ::: "memory");
#undef HS_DMA
    }
}

template <int MODE>
__device__ __forceinline__ void phase_normgate(Frame& F, const bf16* P0, const bf16* P1, bf16* out, const float* w, float lam, float mul) {
    const int gw = F.vcu * NWAVES + F.wave, NGW = F.G * NWAVES;
    float wv[16];
#pragma unroll
    for (int i = 0; i < 16; ++i) wv[i] = w[((16 * F.lane) & 127) + i] * mul;
    const int tpw = ((M + NGW - 1) / NGW + 3) & ~3;
#define NG_LOAD(A0, A1, B0, B1, t_) do { _Pragma("unroll") for (int tt = 0; tt < 4; ++tt) { const size_t off = (size_t)((t_) + tt) * D + 16 * F.lane; \
        A0[tt] = *(const v4u*)(P0 + off); A1[tt] = *(const v4u*)(P0 + off + 8); B0[tt] = *(const v4u*)(P1 + off); B1[tt] = *(const v4u*)(P1 + off + 8); } } while (0)
#define NG_PROC(A0, A1, B0, B1, t_) do { _Pragma("unroll") for (int tt = 0; tt < 4; ++tt) { \
            float av[16], bv[16]; \
            _Pragma("unroll") for (int i = 0; i < 4; ++i) { av[2 * i] = bflo(A0[tt][i]); av[2 * i + 1] = bfhi(A0[tt][i]); av[8 + 2 * i] = bflo(A1[tt][i]); av[8 + 2 * i + 1] = bfhi(A1[tt][i]); \
                                          bv[2 * i] = bflo(B0[tt][i]); bv[2 * i + 1] = bfhi(B0[tt][i]); bv[8 + 2 * i] = bflo(B1[tt][i]); bv[8 + 2 * i + 1] = bfhi(B1[tt][i]); } \
            float ss = 0.f; \
            _Pragma("unroll") for (int i = 0; i < 16; ++i) { if (MODE == 1) av[i] = av[i] - lam * bv[i]; ss += av[i] * av[i]; } \
            ss = row8_sum(ss); \
            const float rs = 1.0f / sqrtf(ss * (1.0f / 128.0f) + LN_EPS); \
            v4u o0, o1; \
            _Pragma("unroll") for (int i = 0; i < 8; ++i) { float v0 = av[2 * i] * rs * wv[2 * i], v1 = av[2 * i + 1] * rs * wv[2 * i + 1]; \
                if (MODE == 0) { v0 *= bv[2 * i] * sigmoid_f(bv[2 * i]); v1 *= bv[2 * i + 1] * sigmoid_f(bv[2 * i + 1]); } \
                if (i < 4) o0[i] = pkbf(v0, v1); else o1[i - 4] = pkbf(v0, v1); } \
            const size_t off = (size_t)((t_) + tt) * D + 16 * F.lane; \
            *(v4u*)(out + off) = o0; *(v4u*)(out + off + 8) = o1; } } while (0)
    const int tend = ((gw + 1) * tpw < M) ? (gw + 1) * tpw : M;
    v4u a0[4], a1[4], b0[4], b1[4], c0[4], c1[4], e0[4], e1[4];
    int t0 = gw * tpw;
    if (t0 < tend) NG_LOAD(a0, a1, b0, b1, t0);
    for (; t0 < tend; t0 += 8) {
        if (t0 + 4 < tend) NG_LOAD(c0, c1, e0, e1, t0 + 4);
        NG_PROC(a0, a1, b0, b1, t0);
        if (t0 + 8 < tend) NG_LOAD(a0, a1, b0, b1, t0 + 8);
        if (t0 + 4 < tend) NG_PROC(c0, c1, e0, e1, t0 + 4);
    }
#undef NG_LOAD
#undef NG_PROC
}

__device__ __forceinline__ void phase_l1(Frame& F, const KA a, int layer, const float* xin, const bool dry) {
    const int gw = F.vcu * NWAVES + F.wave, NGW = F.G * NWAVES;
    LAS float* Wr = (LAS float*)(F.lds + RING_OFF);
    LAS unsigned* hist = (LAS unsigned*)(F.lds + LDSCTL_OFF);
    { const f32x4* src = (const f32x4*)((const float*)(a.ws() + WS_RT) + (size_t)layer * 36 * 1024);
      f32x4 tmp[18];
#pragma unroll
      for (int k = 0; k < 18; ++k) tmp[k] = src[F.tid + 512 * k];
#pragma unroll
      for (int k = 0; k < 18; ++k) *(LAS f32x4*)(Wr + 4 * (F.tid + 512 * k)) = tmp[k];
      if (F.tid < 32) hist[F.tid] = 0u; }
    __syncthreads();
    const float* mod = (const float*)(a.ws() + WS_MOD) + (size_t)layer * 16 * 6144;
    const bf16* yb = (const bf16*)(a.ws() + WS_BUF0 + 1 * BUFSZ);
    bf16* h2 = (bf16*)(a.ws() + WS_BUF0);
    const float* lng = a.in(4) + (size_t)(layer * 2 + 0) * D; const float* lnb = a.in(5) + (size_t)(layer * 2 + 0) * D;
    const float* bg = a.in(15) + layer * 4; const float* be = a.in(17) + layer * 32;
    int* eid = (int*)(a.ws() + WS_EID); float* wt = (float*)(a.ws() + WS_WT);
    const unsigned short* xhin = (const unsigned short*)a.out();
    unsigned short* xhout = (unsigned short*)(a.ws() + WS_BUF0 + 1 * BUFSZ);
    const int tpw = ((M + NGW - 1) / NGW + 3) & ~3;
    int curb = -1; f32x4 g1v[4], lgv[4], lbv[4], scv[4], shv[4];
    for (int t0 = gw * tpw; t0 < (gw + 1) * tpw && t0 < M; t0 += 4) {
        const int b = t0 >> 12;
        if (b != curb) { curb = b; const float* mb = mod + (size_t)b * 6144;
#pragma unroll
            for (int j = 0; j < 4; ++j) { const int col = 4 * F.lane + 256 * j; g1v[j] = *(const f32x4*)(mb + 2048 + col); lgv[j] = *(const f32x4*)(lng + col); lbv[j] = *(const f32x4*)(lnb + col);
                scv[j] = *(const f32x4*)(mb + 4096 + col) + 1.0f; shv[j] = *(const f32x4*)(mb + 3072 + col); } }
        f32x4 hv[4][4];
        {
            f32x4 v[4][4]; float s[4] = {0.f, 0.f, 0.f, 0.f};
            u64 yw[4][4];
#pragma unroll
            for (int j = 0; j < 4; ++j)
#pragma unroll
                for (int tt = 0; tt < 4; ++tt) yw[tt][j] = *(const u64*)(yb + (size_t)(t0 + tt) * D + 4 * F.lane + 256 * j);
            if (layer == 0) {
#pragma unroll
                for (int j = 0; j < 4; ++j)
#pragma unroll
                    for (int tt = 0; tt < 4; ++tt) v[tt][j] = *(const f32x4*)(xin + (size_t)(t0 + tt) * D + 4 * F.lane + 256 * j);
            } else { u64 xr[4][4];
#pragma unroll
                for (int j = 0; j < 4; ++j)
#pragma unroll
                    for (int tt = 0; tt < 4; ++tt) xr[tt][j] = *(const u64*)(xhin + (size_t)(t0 + tt) * D + 4 * F.lane + 256 * j);
#pragma unroll
                for (int j = 0; j < 4; ++j)
#pragma unroll
                    for (int tt = 0; tt < 4; ++tt) v[tt][j] = unpk_h4(xr[tt][j]);
            }
#pragma unroll
            for (int j = 0; j < 4; ++j) { const f32x4 g1 = g1v[j];
#pragma unroll
                for (int tt = 0; tt < 4; ++tt) { const u64 y_ = yw[tt][j];
                    f32x4 yv; yv[0] = bflo((unsigned)y_); yv[1] = bfhi((unsigned)y_); yv[2] = bflo((unsigned)(y_ >> 32)); yv[3] = bfhi((unsigned)(y_ >> 32));
                    v[tt][j] = v[tt][j] * DN_ALPHA + g1 * yv; s[tt] += (v[tt][j][0] + v[tt][j][1]) + (v[tt][j][2] + v[tt][j][3]); } }
            float rstd[4];
#pragma unroll
            for (int tt = 0; tt < 4; ++tt) { const float mean = wave_sum(s[tt], F.lane) * (1.0f / D); float s2 = 0.f;
#pragma unroll
                for (int j = 0; j < 4; ++j) { v[tt][j] = v[tt][j] - mean; s2 += (v[tt][j][0] * v[tt][j][0] + v[tt][j][1] * v[tt][j][1]) + (v[tt][j][2] * v[tt][j][2] + v[tt][j][3] * v[tt][j][3]); }
                rstd[tt] = __builtin_amdgcn_rsqf(wave_sum(s2, F.lane) * (1.0f / D) + LN_EPS); }
#pragma unroll
            for (int j = 0; j < 4; ++j) { const int col = 4 * F.lane + 256 * j;
                const f32x4 lg_ = lgv[j], lb_ = lbv[j], sc2 = scv[j], sh2 = shv[j];
#pragma unroll
                for (int tt = 0; tt < 4; ++tt) { const size_t ro = (size_t)(t0 + tt) * D;
                    const f32x4 xo = v[tt][j] * rstd[tt] * lg_ + lb_;
                    *(u64*)(xhout + ro + col) = (u64)pkh(xo[0], xo[1]) | ((u64)pkh(xo[2], xo[3]) << 32);
                    const f32x4 hh2 = xo * sc2 + sh2; hv[tt][j] = hh2;
                    *(u64*)(h2 + ro + col) = (u64)pkbf(hh2[0], hh2[1]) | ((u64)pkbf(hh2[2], hh2[3]) << 32); } }
        }
        float gl[4][4];
        { f32x4 w[4][4];
#pragma unroll
          for (int g = 0; g < 4; ++g)
#pragma unroll
              for (int j = 0; j < 4; ++j) w[g][j] = *(const LAS f32x4*)(Wr + g * 1024 + 4 * F.lane + 256 * j);
#pragma unroll
          for (int tt = 0; tt < 4; ++tt)
#pragma unroll
              for (int g = 0; g < 4; ++g) { float s0 = 0.f;
#pragma unroll
                  for (int j = 0; j < 4; ++j) s0 += (hv[tt][j][0] * w[g][j][0] + hv[tt][j][1] * w[g][j][1]) + (hv[tt][j][2] * w[g][j][2] + hv[tt][j][3] * w[g][j][3]);
                  gl[tt][g] = wave_sum(s0, F.lane) + bg[g]; } }
#pragma unroll
        for (int tt = 0; tt < 4; ++tt) {
            int gi = 0; float gm = gl[tt][0];
#pragma unroll
            for (int g = 1; g < 4; ++g) if (gl[tt][g] > gm) { gm = gl[tt][g]; gi = g; }
            float gs = 0.f;
#pragma unroll
            for (int g = 0; g < 4; ++g) gs += fexp(gl[tt][g] - gm);
            const float gw_ = __builtin_amdgcn_rcpf(gs);
            gi = __builtin_amdgcn_readfirstlane(gi);
            float el[8];
#pragma unroll
            for (int half = 0; half < 2; ++half) { f32x4 w[4][4]; const LAS float* wrow = Wr + (4 + gi * 8 + half * 4) * 1024 + 4 * F.lane;
#pragma unroll
                for (int q = 0; q < 4; ++q)
#pragma unroll
                    for (int j = 0; j < 4; ++j) w[q][j] = *(const LAS f32x4*)(wrow + q * 1024 + 256 * j);
#pragma unroll
                for (int q = 0; q < 4; ++q) { float s0 = 0.f;
#pragma unroll
                    for (int j = 0; j < 4; ++j) s0 += (hv[tt][j][0] * w[q][j][0] + hv[tt][j][1] * w[q][j][1]) + (hv[tt][j][2] * w[q][j][2] + hv[tt][j][3] * w[q][j][3]);
                    el[half * 4 + q] = wave_sum(s0, F.lane) + be[gi * 8 + half * 4 + q]; } }
            int i0 = 0; float m0 = el[0];
#pragma unroll
            for (int q = 1; q < 8; ++q) if (el[q] > m0) { m0 = el[q]; i0 = q; }
            int i1 = -1; float m1 = -INFINITY;
#pragma unroll
            for (int q = 0; q < 8; ++q) if (q != i0 && el[q] > m1) { m1 = el[q]; i1 = q; }
            const float p1 = fexp(m1 - m0); const float rr_ = __builtin_amdgcn_rcpf(1.0f + p1); const float w0 = gw_ * rr_, w1 = gw_ * p1 * rr_;
            if (F.lane == 0) { const int e0 = gi * 8 + i0, e1 = gi * 8 + i1, tok = t0 + tt;
                *(int2*)(eid + 2 * tok) = make_int2(e0, e1); *(float2*)(wt + 2 * tok) = make_float2(w0, w1);
                __hip_atomic_fetch_add(&hist[e0], 1u, __ATOMIC_RELAXED, __HIP_MEMORY_SCOPE_WORKGROUP); __hip_atomic_fetch_add(&hist[e1], 1u, __ATOMIC_RELAXED, __HIP_MEMORY_SCOPE_WORKGROUP); }
        }
    }
    __syncthreads();
    if (F.tid < 32 && !dry) { const unsigned c = hist[F.tid]; if (c) __hip_atomic_fetch_add(F.ctl + CW_CNT + 256 * layer + F.tid, c, RLX_AGENT); }
}

__device__ __forceinline__ void phase_m2(Frame& F, const KA a, int layer) {
    LAS int* pstart = (LAS int*)(F.lds + RING_OFF);
    LAS unsigned* lhist = (LAS unsigned*)(F.lds + RING_OFF + 256);
    LAS int* lbase = (LAS int*)(F.lds + RING_OFF + 512);
    int* blk_e = (int*)(a.ws() + WS_BLKE) + layer * 1024;
    LAS int* cntl = (LAS int*)(F.lds + RING_OFF + 768);
    if (F.tid < 32) cntl[F.tid] = (int)__hip_atomic_load(F.ctl + CW_CNT + 256 * layer + F.tid, RLX_AGENT);
    __syncthreads();
    if (F.tid == 0) { int off = 0;
#pragma unroll 1
        for (int e = 0; e < 32; ++e) { pstart[e] = off; off += ((cntl[e] + 255) >> 8) << 8; }
        pstart[32] = off;
        if (F.bx == 0) __hip_atomic_store(F.ctl + CW_CNT + 256 * layer + 128, (unsigned)(off >> 8), RLX_AGENT); }
    __syncthreads();
    if (F.bx == 0) { const int nblk = pstart[32] >> 8;
        for (int blk = F.tid; blk < nblk; blk += NWAVES * 64) { int e = 0;
#pragma unroll 1
            for (int k = 1; k < 32; ++k) e = (pstart[k] <= blk * 256) ? k : e;
            blk_e[blk] = e; } }
    const int* eid = (const int*)(a.ws() + WS_EID); const float* wt = (const float*)(a.ws() + WS_WT);
    int* tslot = (int*)(a.ws() + WS_TSLOT); float* slotw = (float*)(a.ws() + WS_SLOTW);
    int* stok = (int*)(a.ws() + WS_STOK);
    for (int e = F.vcu; e < 32; e += F.G) { const int c = cntl[e];
        for (int s = pstart[e] + c + F.tid; s < pstart[e + 1]; s += NWAVES * 64) stok[s] = 0; }
    for (int chunk = F.vcu; chunk < M / 256; chunk += F.G) {
        if (F.tid < 32) lhist[F.tid] = 0u;
        __syncthreads();
        const int pi = chunk * 512 + F.tid;
        const int e = eid[pi];
        const unsigned rank = __hip_atomic_fetch_add(&lhist[e], 1u, __ATOMIC_RELAXED, __HIP_MEMORY_SCOPE_WORKGROUP);
        __syncthreads();
        if (F.tid < 32) { const unsigned c = lhist[F.tid]; lbase[F.tid] = pstart[F.tid] + (c ? (int)__hip_atomic_fetch_add(F.ctl + CW_CNT + 256 * layer + 64 + F.tid, c, RLX_AGENT) : 0); }
        __syncthreads();
        const int slot = lbase[e] + (int)rank;
        tslot[pi] = slot; slotw[slot] = wt[pi]; stok[slot] = pi >> 1;
        __syncthreads();
    }
}

__device__ __forceinline__ void phase_l2(Frame& F, const KA a, int layer) {
    const int gw = F.vcu * NWAVES + F.wave, NGW = F.G * NWAVES;
    const float* mod = (const float*)(a.ws() + WS_MOD) + (size_t)layer * 16 * 6144;
    const bf16* ys = (const bf16*)(a.ws() + WS_BUF0 + 2 * BUFSZ); const int* tslot = (const int*)(a.ws() + WS_TSLOT);
    bf16* hn = (bf16*)(a.ws() + WS_BUF0);
    const float* lng = a.in(4) + (size_t)(layer * 2 + 1) * D; const float* lnb = a.in(5) + (size_t)(layer * 2 + 1) * D;
    float* x = a.out(); unsigned short* xho = (unsigned short*)a.out(); const unsigned short* xh = (const unsigned short*)(a.ws() + WS_BUF0 + 1 * BUFSZ);
    const int mlay = (layer < DEPTH - 1) ? 16 * 6144 : 0;
    const int tpw = ((M + NGW - 1) / NGW + 3) & ~3;
    for (int t0 = gw * tpw; t0 < (gw + 1) * tpw && t0 < M; t0 += 4) {
        const int b = t0 >> 12; const float* mb = mod + (size_t)b * 6144;
        int sl[8];
        { const int4 s0 = *(const int4*)(tslot + 2 * t0), s1 = *(const int4*)(tslot + 2 * t0 + 4); sl[0] = s0.x; sl[1] = s0.y; sl[2] = s0.z; sl[3] = s0.w; sl[4] = s1.x; sl[5] = s1.y; sl[6] = s1.z; sl[7] = s1.w; }
        u64 xr[4][4], y0r[4][4], y1r[4][4];
#pragma unroll
        for (int j = 0; j < 4; ++j) { const int col = 4 * F.lane + 256 * j;
#pragma unroll
            for (int tt = 0; tt < 4; ++tt) { xr[tt][j] = *(const u64*)(xh + (size_t)(t0 + tt) * D + col);
                y0r[tt][j] = *(const u64*)(ys + (size_t)sl[2 * tt] * D + col); y1r[tt][j] = *(const u64*)(ys + (size_t)sl[2 * tt + 1] * D + col); } }
        f32x4 g2v[4];
#pragma unroll
        for (int j = 0; j < 4; ++j) g2v[j] = *(const f32x4*)(mb + 5120 + 4 * F.lane + 256 * j);
        asm volatile("" ::: "memory");
        f32x4 v[4][4]; float s[4] = {0.f, 0.f, 0.f, 0.f};
#pragma unroll
        for (int j = 0; j < 4; ++j) { const f32x4 g2 = g2v[j];
#pragma unroll
            for (int tt = 0; tt < 4; ++tt) {
                const f32x4 xv = unpk_h4(xr[tt][j]); const u64 y0 = y0r[tt][j], y1 = y1r[tt][j];
                f32x4 yv; yv[0] = bflo((unsigned)y0) + bflo((unsigned)y1); yv[1] = bfhi((unsigned)y0) + bfhi((unsigned)y1);
                yv[2] = bflo((unsigned)(y0 >> 32)) + bflo((unsigned)(y1 >> 32)); yv[3] = bfhi((unsigned)(y0 >> 32)) + bfhi((unsigned)(y1 >> 32));
                v[tt][j] = xv * DN_ALPHA + g2 * yv; s[tt] += (v[tt][j][0] + v[tt][j][1]) + (v[tt][j][2] + v[tt][j][3]); } }
        f32x4 lgv[4], lbv[4], scv[4], shv[4];
#pragma unroll
        for (int j = 0; j < 4; ++j) { const int col = 4 * F.lane + 256 * j; lgv[j] = *(const f32x4*)(lng + col); lbv[j] = *(const f32x4*)(lnb + col);
            scv[j] = *(const f32x4*)(mb + mlay + 1024 + col); shv[j] = *(const f32x4*)(mb + mlay + col); }
        asm volatile("" ::: "memory");
        float rstd[4];
#pragma unroll
        for (int tt = 0; tt < 4; ++tt) { const float mean = wave_sum(s[tt], F.lane) * (1.0f / D); float s2 = 0.f;
#pragma unroll
            for (int j = 0; j < 4; ++j) { v[tt][j] = v[tt][j] - mean; s2 += (v[tt][j][0] * v[tt][j][0] + v[tt][j][1] * v[tt][j][1]) + (v[tt][j][2] * v[tt][j][2] + v[tt][j][3] * v[tt][j][3]); }
            rstd[tt] = __builtin_amdgcn_rsqf(wave_sum(s2, F.lane) * (1.0f / D) + LN_EPS); }
        if (layer == DEPTH - 1) {
#pragma unroll
            for (int j = 0; j < 4; ++j) { const int col = 4 * F.lane + 256 * j;
#pragma unroll
                for (int tt = 0; tt < 4; ++tt) *(f32x4*)(x + (size_t)(t0 + tt) * D + col) = v[tt][j] * rstd[tt] * lgv[j] + lbv[j]; }
        } else {
#pragma unroll
            for (int j = 0; j < 4; ++j) { const int col = 4 * F.lane + 256 * j;
#pragma unroll
                for (int tt = 0; tt < 4; ++tt) { const size_t ro = (size_t)(t0 + tt) * D;
                    const f32x4 xo = v[tt][j] * rstd[tt] * lgv[j] + lbv[j];
                    *(u64*)(xho + ro + col) = (u64)pkh(xo[0], xo[1]) | ((u64)pkh(xo[2], xo[3]) << 32);
                    const f32x4 hv = xo * (scv[j] + 1.0f) + shv[j];
                    *(u64*)(hn + ro + col) = (u64)pkbf(hv[0], hv[1]) | ((u64)pkbf(hv[2], hv[3]) << 32); } }
        }
    }
}

#ifndef MK_SEPARATE
#define MK_SEPARATE 0
#endif
constexpr int N_PHASES = 2 + 10 * DEPTH;
#ifndef PH_MASK
#define PH_MASK 0xFFFFF
#endif
#define PH_ON(n) (((PH_MASK) >> (n)) & 1)
#ifndef DBL_MASK
#define DBL_MASK 0
#endif
#define DBL(n) for (int rep_ = 0; rep_ < 1 + (((DBL_MASK) >> (n)) & 1); ++rep_)
__global__ void __launch_bounds__(NWAVES * 64, 2) fwd_kernel(Args args) {
    extern __shared__ __attribute__((aligned(16))) unsigned char lds[];
    const int wave_s = __builtin_amdgcn_readfirstlane((int)threadIdx.x >> 6);
    gu32* const ctl0 = (gu32*)(karg_fresh().ws() + WS_CTL);
    for (int u = threadIdx.x; u < (LDS_BYTES - LDSCTL_OFF) / 4; u += NWAVES * 64) ((LAS unsigned*)((LAS unsigned char*)lds + LDSCTL_OFF))[u] = 0u;
    __syncthreads();
    XcdBarrier bar; bar.bar = (unsigned*)(ctl0 + CW_BAR); bar.x = 0; bar.st = nullptr;
    if (!MK_SEPARATE) bar = xcd_barrier_post((unsigned*)(ctl0 + CW_BAR), (volatile LAS unsigned*)((LAS unsigned char*)lds + MISC_OFF) + 8);
    const int lo = karg_fresh().ph_lo(), hi = karg_fresh().ph_hi();
    const bool PANEL = !MK_SEPARATE && gridDim.x == (unsigned)(M / 256);
#define IN(k) (lo <= (k) && (k) < hi)
#define FRESH() const KA ka = karg_fresh(); unsigned char* const ws = ka.ws(); (void)ws; Frame F; { int t_, g_ = gridDim.x, bx_ = blockIdx.x; asm volatile("v_mbcnt_lo_u32_b32 %0, -1, 0\n\tv_mbcnt_hi_u32_b32 %0, -1, %0" : "=v"(t_)); asm volatile("" : "+s"(g_), "+s"(bx_)); t_ |= wave_s << 6; \
        F.lds = (LAS unsigned char*)lds; F.MISC = (volatile LAS unsigned*)(F.lds + MISC_OFF); F.ctl = (gu32*)(ws + WS_CTL); F.tid = t_; F.lane = t_ & 63; F.wave = __builtin_amdgcn_readfirstlane(t_ >> 6); \
        F.G = g_; F.bx = bx_; F.vcu = (g_ % 8 == 0) ? (bx_ % 8) * (g_ / 8) + bx_ / 8 : bx_; }
#ifndef DBL_BARRIER
#define DBL_BARRIER 0
#endif
#define SEAM(k) do { if (IN(k) && IN((k) + 1)) { if (MK_SEPARATE) { } else { xcd_barrier(bar, wave_s); if (DBL_BARRIER) xcd_barrier(bar, wave_s); } } } while (0)
#define BUF(i) ((bf16*)(ws + WS_BUF0 + (size_t)(i) * BUFSZ))

    if (PH_ON(0) && IN(0)) { FRESH(); DBL(0) phase_p0a(F, ka); }
    SEAM(0);
    if (PH_ON(1) && IN(1)) { FRESH(); DBL(1) phase_p0b(F, ka); }
    SEAM(1);
    for (int i = 0; i < DEPTH; ++i) {
        const int pb = 2 + 10 * i, j = i >> 1;
        if ((i & 1) == 0) {
            if (PH_ON(2) && IN(pb)) { FRESH();
                pg8::Gemm g{BUF(0), (const bf16*)(ws + WS_WHIN) + (size_t)j * 4096 * 1024, M, 4096, D, 0, nullptr}; pg8::StaticOrder S; S.init(M, 4096, F.G, F.bx);
                pg8::EpiBf16<0> E{BUF(1), D, nullptr, D, BUFSZ / 2, 1.0f};
                DBL(2) pg8::gemm_phase<pg8::EpiBf16<0>, pg8::StaticOrder, true, true>(F.lds + RING_OFF, g, S, E, F.tid);
            }
            SEAM(pb);
            if (PH_ON(3) && IN(pb + 1)) { FRESH(); phase_hgrn_prep(F, ka, j); }
            SEAM(pb + 1);
            if (PH_ON(4) && IN(pb + 2)) { FRESH(); DBL(4) phase_hgrn_scan(F, ka, i); }
            SEAM(pb + 2);
            if (PH_ON(5) && IN(pb + 3)) { FRESH(); phase_normgate<0>(F, BUF(6), BUF(4), BUF(4), ka.in(9) + j * 128, 0.f, 1.0f); }
            if (!PANEL) SEAM(pb + 3);
        } else {
            if (PH_ON(6) && IN(pb)) { FRESH();
                pg8::Gemm g{BUF(0), (const bf16*)(ws + WS_WAIN) + (size_t)j * 3072 * 1024, M, 3072, D, 0, nullptr}; pg8::StaticOrder S; S.init(M, 3072, F.G, F.bx);
                pg8::EpiRope E{BUF(1), BUF(2), BUF(3), (const float*)(ws + WS_ROPE_C), (const float*)(ws + WS_ROPE_S), attn_body::C2, SEQ - 1};
                DBL(6) pg8::gemm_phase<pg8::EpiRope, pg8::StaticOrder, true, true>(F.lds + RING_OFF, g, S, E, F.tid);
            }
            SEAM(pb);
            if (PH_ON(7) && IN(pb + 1)) { FRESH();
                const attn_body::AttnTensors AT{(const attn_body::bf16*)BUF(1), (const attn_body::bf16*)BUF(2), (const attn_body::bf16*)BUF(3), (attn_body::bf16*)BUF(4), (attn_body::bf16*)BUF(5)};
                static_assert(attn_body::ATTNW_LDS_BYTES <= RING_BYTES, "attention LDS");
                const attn_body::StaticOrderW S((int)F.G, F.vcu);
                const float* lp = ka.in(12) + j * 256;
                const float d1 = wave_sum(lp[F.lane] * lp[64 + F.lane], F.lane), d2 = wave_sum(lp[128 + F.lane] * lp[192 + F.lane], F.lane);
                const float linit = (j == 0) ? 0.35550906759f : 0.55605820415f;
                const float lam = fexp(d1) - fexp(d2) + linit;
                const attn_body::CombineW CB{(const attn_body::bf16*)BUF(4), (attn_body::bf16*)BUF(6), ka.in(13) + j * 128, lam, 1.0f - linit};
                DBL(7) attn_body::attn_phase_w<8>((char*)lds + RING_OFF, AT, S, CB, F.tid);
            }
            SEAM(pb + 1);
        }
        if (PH_ON(9) && IN(pb + 4)) { FRESH();
            const bf16* A = (i & 1) ? BUF(6) : BUF(4);
            const bf16* W = (i & 1) ? (const bf16*)(ws + WS_WAOUT) + (size_t)j * 1024 * 1024 : (const bf16*)(ws + WS_WHOUT) + (size_t)j * 1024 * 1024;
            pg8::Gemm g{A, W, M, D, D, 0, nullptr};
            pg8::EpiBf16<0> E{BUF(1), D, nullptr, 0, 0, 1.0f};
            if (PANEL) {
                __syncthreads();
                pg8::PanelOrder S{F.vcu, D / 256};
                pg8::gemm_phase<pg8::EpiBf16<0>, pg8::PanelOrder, true, true>(F.lds + RING_OFF, g, S, E, F.tid);
                __syncthreads();
            } else {
                pg8::StaticOrder S; S.init(M, D, F.G, F.bx);
                DBL(9) pg8::gemm_phase<pg8::EpiBf16<0>, pg8::StaticOrder, true, true>(F.lds + RING_OFF, g, S, E, F.tid);
            }
        }
        if (!PANEL) SEAM(pb + 4);
        if (PH_ON(10) && IN(pb + 5)) { FRESH(); phase_l1(F, ka, i, i == 0 ? ka.in(0) : (const float*)ka.out(), false);
            if ((((DBL_MASK) >> 10) & 1) && i == 0) { __syncthreads(); phase_l1(F, ka, i, ka.in(0), true); } }
        SEAM(pb + 5);
        if (PH_ON(11) && IN(pb + 6)) { FRESH(); phase_m2(F, ka, i); }
        SEAM(pb + 6);
        if (PH_ON(12) && IN(pb + 7)) { FRESH();
            const int nblk = (int)__hip_atomic_load(F.ctl + CW_CNT + 256 * i + 128, RLX_AGENT);
            pg8::Gemm g{BUF(0), (const bf16*)moe_wbuf(ws, i), nblk * 256, 1024, D, (size_t)1024 * 1024 * 2, (const int*)(ws + WS_STOK)};
            pg8::MoeOrder S; S.init(nblk * 256, 1024, F.G, F.bx); S.blk_e = (const int*)(ws + WS_BLKE) + i * 1024;
            pg8::EpiSwiGLU E{BUF(5)};
            DBL(12) pg8::gemm_phase<pg8::EpiSwiGLU, pg8::MoeOrder, true, true, true>(F.lds + RING_OFF, g, S, E, F.tid);
        }
        SEAM(pb + 7);
        if (PH_ON(13) && IN(pb + 8)) { FRESH();
            const int nblk = (int)__hip_atomic_load(F.ctl + CW_CNT + 256 * i + 128, RLX_AGENT);
            pg8::Gemm g{BUF(5), (const bf16*)(moe_wbuf(ws, i) + 64 * MiB), nblk * 256, 1024, FF, (size_t)1024 * 512 * 2, nullptr};
            pg8::MoeOrder S; S.init(nblk * 256, 1024, F.G, F.bx); S.blk_e = (const int*)(ws + WS_BLKE) + i * 1024;
            pg8::EpiRowScale E{BUF(2), (const float*)(ws + WS_SLOTW)};
            DBL(13) pg8::gemm_phase<pg8::EpiRowScale, pg8::MoeOrder, true, true>(F.lds + RING_OFF, g, S, E, F.tid);
        }
        SEAM(pb + 8);
        if (PH_ON(14) && IN(pb + 9)) { FRESH(); DBL(14) phase_l2(F, ka, i); }
        SEAM(pb + 9);
    }
#undef IN
#undef SEAM
}

extern "C" void kernel_launch(void* const* d_in, const int* in_sizes, int n_in, void* d_out, int out_size, void* d_ws, size_t ws_size, hipStream_t stream) {
    static int grid = 0;
    if (grid == 0) {
        if (n_in != 21 || in_sizes[0] != M * D || out_size != M * D || ws_size < WS_END) { fprintf(stderr, "kernel_launch: unexpected shapes / workspace (n_in %d, ws %zu, need %zu)\n", n_in, ws_size, (size_t)WS_END); grid = -1; return; }
        int dev = 0, cus = 0, per_cu = 0;
        if (hipGetDevice(&dev) != hipSuccess || hipDeviceGetAttribute(&cus, hipDeviceAttributeMultiprocessorCount, dev) != hipSuccess) { grid = -1; return; }
        if (hipFuncSetAttribute((const void*)fwd_kernel, hipFuncAttributeMaxDynamicSharedMemorySize, LDS_BYTES) != hipSuccess) { fprintf(stderr, "kernel_launch: hipFuncSetAttribute failed\n"); grid = -1; return; }
        if (hipOccupancyMaxActiveBlocksPerMultiprocessor(&per_cu, (const void*)fwd_kernel, NWAVES * 64, LDS_BYTES) != hipSuccess || per_cu < 1) fprintf(stderr, "kernel_launch: occupancy query says %d\n", per_cu);
        (void)hipGetLastError();
        grid = cus;
    }
    if (grid < 0) return;
    if (hipMemsetAsync((char*)d_ws + WS_CTL, 0, CTL_ZERO_BYTES, stream) != hipSuccess) return;
    Args a{};
    for (int i = 0; i < 21; ++i) a.in[i] = (const float*)d_in[i];
    a.out = (float*)d_out; a.ws = (unsigned char*)d_ws;
#if MK_SEPARATE
    for (int p = 0; p < N_PHASES; ++p) {
        if (p >= 2 && (((p - 2) / 10) & 1) == 1 && ((p - 2) % 10) == 3) continue;
        a.ph_lo = p; a.ph_hi = p + 1;
        hipLaunchKernelGGL(fwd_kernel, dim3(grid), dim3(NWAVES * 64), LDS_BYTES, stream, a);
    }
#else
    a.ph_lo = 0; a.ph_hi = N_PHASES;
    hipLaunchKernelGGL(fwd_kernel, dim3(grid), dim3(NWAVES * 64), LDS_BYTES, stream, a);
#endif
}
```

```cpp
#include <hip/hip_runtime.h>
#include <cstdio>
#include <cstdint>
namespace pg8 {
#define PG8_LAS __attribute__((address_space(3)))
typedef unsigned short bf16_t;
typedef short bf16x8 __attribute__((ext_vector_type(8)));
typedef float f32x4 __attribute__((ext_vector_type(4)));
typedef unsigned u32x4 __attribute__((ext_vector_type(4)));
constexpr int BM = 256, BK = 64, HALF = 128, HTB = HALF * BK * 2  , STAGE_BYTES = 8 * HTB, NXCD = 8, WGM = 8;

__host__ __device__ __forceinline__ int lds_byte(int r, int c) { const int st = (r >> 4) * 2 + (c >> 5), rr = r & 15, cc = c & 31, ob = rr * 64 + cc * 2; return st * 1024 + (ob ^ (((ob >> 9) & 1) << 5)); }
__host__ __device__ __forceinline__ void stage_rc(int b, int& R, int& C) { const int st = b / 1024, sb = b % 1024, swz = sb ^ (((sb >> 9) & 1) << 5); R = (st >> 1) * 16 + swz / 64; C = (st & 1) * 32 + (swz % 64) / 2; }
__host__ __device__ __forceinline__ int perm32(int rho) { const int n = rho >> 4, i = rho & 15; return 8 * (i >> 2) + 4 * n + (i & 3); }

struct Unit { int pm, pn, e; };
struct Gemm { const bf16_t* A; const bf16_t* Bt; int M, N, K; size_t estride; const int* arow; };

struct StaticOrder {
    int nM, nN, nwg, G, c;
    __host__ __device__ void init(int M, int N, int G_, int c_) { nM = M / BM; nN = N / BM; nwg = nM * nN; G = G_; c = c_; }
    __host__ __device__ bool next(int i, Unit& u) const {
        const long L = (long)i * G + c; if (L >= nwg) return false;
        int wgid = (int)L; { const int q = nwg / NXCD, r = nwg % NXCD, xcd = wgid % NXCD, off = wgid / NXCD; wgid = (xcd < r ? xcd * (q + 1) : r * (q + 1) + (xcd - r) * q) + off; }
        const int nig = WGM * nN, gid = wgid / nig, fm = gid * WGM, gsz = (nM - fm) < WGM ? (nM - fm) : WGM;
        u.pm = fm + ((wgid % nig) % gsz); u.pn = (wgid % nig) / gsz; u.e = 0; return true;
    }
    __device__ __forceinline__ void a_ready(const Unit&) const {}
    __device__ __forceinline__ void done(const Unit&) const {}
};

__device__ __forceinline__ unsigned cvt_pk_bf16(float lo, float hi) { unsigned r; asm volatile("v_cvt_pk_bf16_f32 %0, %1, %2" : "=v"(r) : "v"(lo), "v"(hi)); return r; }
typedef float f32x2 __attribute__((ext_vector_type(2)));
__device__ __forceinline__ f32x2 gelu_pk(f32x2 v) {
    const f32x2 av = __builtin_elementwise_abs(v), d = av * 0.2316418882f + 1.0f;
    f32x2 t; t.x = __builtin_amdgcn_rcpf(d.x); t.y = __builtin_amdgcn_rcpf(d.y);
    f32x2 q = t * 0.5307027145f + (-0.7265760135f); q = q * t + 0.7107068705f; q = q * t + (-0.142248368f); q = q * t + 0.127414796f; q = q * t;
    const f32x2 s = (v * v) * (-0.72134752044f);
    f32x2 e; e.x = __builtin_amdgcn_exp2f(s.x); e.y = __builtin_amdgcn_exp2f(s.y);
    const f32x2 m = v * (q * e), r = v - m;
    f32x2 o; o.x = v.x < 0.f ? m.x : r.x; o.y = v.y < 0.f ? m.y : r.y; return o;
}

template <int ACT  > struct EpiBf16 {
    static constexpr bool PERM = true, AFTER_DRAIN = false; static_assert(ACT == 0 || ACT == 1, "EpiBf16: ACT is 0 (none) or 1 (gelu_pk)");
    bf16_t* O; int ldc; const float* bias; int split_cols; size_t split_stride; float scale0;
    __device__ __forceinline__ void operator()(const f32x4 (&acc)[2][2][4][2], const Unit& u, int wr, int wc, int fr, int fq) const {
        const int row0 = u.pm * BM + wr * 64 + fr; int colt = u.pn * BM; bf16_t* base = O;
        float sc = 1.f; if (split_cols) { const int t = colt / split_cols; base += (size_t)t * split_stride; colt -= t * split_cols; if (t == 0) sc = scale0; }
        const int col0 = colt + wc * 32 + 8 * fq, bcol0 = u.pn * BM + wc * 32 + 8 * fq;
        f32x4 bv[2][2];
#pragma unroll
        for (int bj = 0; bj < 2; ++bj)
#pragma unroll
            for (int n = 0; n < 2; ++n) bv[bj][n] = bias ? *(const f32x4*)(bias + bcol0 + bj * HALF + 4 * n) : (f32x4){0.f, 0.f, 0.f, 0.f};
#pragma unroll
        for (int ai = 0; ai < 2; ++ai)
#pragma unroll
            for (int m = 0; m < 4; ++m) { bf16_t* rowp = base + (size_t)(row0 + ai * HALF + m * 16) * ldc + col0;
#pragma unroll
                for (int bj = 0; bj < 2; ++bj) { f32x4 v0 = acc[ai][bj][m][0] + bv[bj][0], v1 = acc[ai][bj][m][1] + bv[bj][1];
                    if (ACT == 1) { f32x2 a = gelu_pk((f32x2){v0[0], v0[1]}), b = gelu_pk((f32x2){v0[2], v0[3]}), c = gelu_pk((f32x2){v1[0], v1[1]}), d = gelu_pk((f32x2){v1[2], v1[3]});
                        v0 = (f32x4){a.x, a.y, b.x, b.y}; v1 = (f32x4){c.x, c.y, d.x, d.y}; }
                    v0 = v0 * sc; v1 = v1 * sc; u32x4 w; w.x = cvt_pk_bf16(v0[0], v0[1]); w.y = cvt_pk_bf16(v0[2], v0[3]); w.z = cvt_pk_bf16(v1[0], v1[1]); w.w = cvt_pk_bf16(v1[2], v1[3]);
                    *(u32x4*)(rowp + bj * HALF) = w; } }
    }
};

template <class Epi, class Sched, bool ALIGN_EPI = false, bool SP2 = false, bool GATHER = false>
__device__ __forceinline__ void gemm_phase(PG8_LAS unsigned char* lds, const Gemm g, const Sched& S, const Epi& E, const int tid) {
        const int wid = __builtin_amdgcn_readfirstlane(tid >> 6), lane = tid & 63, wr = wid >> 2, wc = wid & 3, fr = lane & 15, fq = lane >> 4;
    const int K = g.K, nt = K / BK;
    unsigned voffA[2], voffB[2], gcolb[2];
#pragma unroll
    for (int i = 0; i < 2; ++i) { int R, C; stage_rc(tid * 16 + i * 8192, R, C); const int Rb = Epi::PERM ? ((R & ~31) + perm32(R & 31)) : R;
        voffA[i] = GATHER ? (unsigned)R * 4u   : (unsigned)(R * K + C) * 2u; voffB[i] = (unsigned)(Rb * K + C) * 2u; gcolb[i] = (unsigned)C * 2u; }
    unsigned gA[2][2] = {{0u, 0u}, {0u, 0u}}, gN[2][2] = {{0u, 0u}, {0u, 0u}};
#define PG8_ROWS(dst, u_) do { const char* rb_ = (const char*)(g.arow + (size_t)(u_).pm * BM); unsigned raw_[2][2];        \
        _Pragma("unroll") for (int _h = 0; _h < 2; ++_h) _Pragma("unroll") for (int _i = 0; _i < 2; ++_i) raw_[_h][_i] = (unsigned)*(const int*)(rb_ + voffA[_i] + _h * HALF * 4); \
        _Pragma("unroll") for (int _h = 0; _h < 2; ++_h) _Pragma("unroll") for (int _i = 0; _i < 2; ++_i) dst[_h][_i] = raw_[_h][_i] * (unsigned)(K * 2) + gcolb[_i]; } while (0)
    const size_t kstep = (size_t)(BK * 2);
    const size_t hstep = (size_t)HALF * K * 2;
    const size_t tstep = 2 * hstep;
    const unsigned ldsw = (unsigned)wid * 1024u;
    const int aoff = lds_byte(wr * 64 + fr, fq * 8), boff = lds_byte(wc * 32 + fr, fq * 8);
#define PG8_SA(b, h) (((b) * 2 + (h)) * HTB)
#define PG8_SB(b, h) ((4 + (b) * 2 + (h)) * HTB)
#define PG8_STAGE(bufoff, gbase, voff) do { _Pragma("unroll") for (int _i = 0; _i < 2; ++_i) \
        __builtin_amdgcn_global_load_lds((const unsigned*)((const char*)(gbase) + (voff)[_i]), (PG8_LAS unsigned*)(lds + (bufoff) + ldsw + _i * 8192), 16, 0, 0); } while (0)
#define PG8_STAGEA(bufoff, gbase, h_, nx_) do { if constexpr (GATHER) { _Pragma("unroll") for (int _i = 0; _i < 2; ++_i) \
        __builtin_amdgcn_global_load_lds((const unsigned*)((const char*)(gbase) + ((nx_) ? gN[h_][_i] : gA[h_][_i])), (PG8_LAS unsigned*)(lds + (bufoff) + ldsw + _i * 8192), 16, 0, 0); } \
        else { PG8_STAGE(bufoff, (gbase) + ((h_) ? hstep : (size_t)0), voffA); } } while (0)
#define PG8_LDA(dst, b, h) do { _Pragma("unroll") for (int m = 0; m < 4; ++m) _Pragma("unroll") for (int k = 0; k < 2; ++k) dst[m][k] = *(const PG8_LAS bf16x8*)(lds + PG8_SA(b, h) + aoff + m * 2048 + k * 1024); } while (0)
#define PG8_LDB(dst, b, h) do { _Pragma("unroll") for (int n = 0; n < 2; ++n) _Pragma("unroll") for (int k = 0; k < 2; ++k) dst[n][k] = *(const PG8_LAS bf16x8*)(lds + PG8_SB(b, h) + boff + n * 2048 + k * 1024); } while (0)
#define PG8_MMA(ai, bj, At, Bt) do { __builtin_amdgcn_s_setprio(1); _Pragma("unroll") for (int m = 0; m < 4; ++m) _Pragma("unroll") for (int n = 0; n < 2; ++n) _Pragma("unroll") for (int k = 0; k < 2; ++k) \
        acc[ai][bj][m][n] = __builtin_amdgcn_mfma_f32_16x16x32_bf16(Bt[n][k], At[m][k], acc[ai][bj][m][n], 0, 0, 0); __builtin_amdgcn_s_setprio(0); } while (0)
#define PG8_WAIT_V(n) asm volatile("s_waitcnt vmcnt(" #n ")" ::: "memory")
#define PG8_WAIT_L(n) asm volatile("s_waitcnt lgkmcnt(" #n ")" ::: "memory")
#define PG8_BAR __builtin_amdgcn_s_barrier()
#define PG8_SCHED __builtin_amdgcn_sched_barrier(0)
    Unit cur, nxt; int ui = 0;
    if (!S.next(0, cur)) return;
    f32x4 acc[2][2][4][2];
#pragma unroll
    for (int a = 0; a < 2; ++a)
#pragma unroll
        for (int b = 0; b < 2; ++b)
#pragma unroll
            for (int m = 0; m < 4; ++m)
#pragma unroll
                for (int n = 0; n < 2; ++n) acc[a][b][m][n] = (f32x4){0.f, 0.f, 0.f, 0.f};
    bf16x8 At[4][2], B0[2][2], B1[2][2];
    const char* cA = (const char*)g.A + (GATHER ? (size_t)0 : (size_t)cur.pm * tstep); const char* cB = (const char*)g.Bt + (size_t)cur.e * g.estride + (size_t)cur.pn * tstep;
    S.a_ready(cur);
    if constexpr (GATHER) PG8_ROWS(gA, cur);
    if constexpr (SP2) {
        PG8_STAGE(PG8_SB(0, 0), cB, voffB); PG8_STAGE(PG8_SB(0, 1), cB + hstep, voffB); PG8_STAGEA(PG8_SA(0, 0), cA, 0, false); PG8_STAGEA(PG8_SA(0, 1), cA, 1, false);
        if (wr == 1) PG8_BAR;
        PG8_WAIT_V(2); PG8_BAR;
        PG8_STAGE(PG8_SB(1, 0), cB + kstep, voffB); PG8_STAGEA(PG8_SA(1, 0), cA + kstep, 0, false); PG8_STAGE(PG8_SB(1, 1), cB + hstep + kstep, voffB);
        PG8_WAIT_V(6); PG8_BAR;
    } else {
        PG8_STAGE(PG8_SB(0, 0), cB, voffB); PG8_STAGEA(PG8_SA(0, 0), cA, 0, false); PG8_STAGE(PG8_SB(0, 1), cB + hstep, voffB); PG8_STAGEA(PG8_SA(0, 1), cA, 1, false);
        if (wr == 1) PG8_BAR;
        PG8_WAIT_V(4); PG8_BAR;
        PG8_STAGE(PG8_SB(1, 0), cB + kstep, voffB); PG8_STAGEA(PG8_SA(1, 0), cA + kstep, 0, false); PG8_STAGE(PG8_SB(1, 1), cB + hstep + kstep, voffB);
        PG8_WAIT_V(6); PG8_BAR;
    }
    for (;;) {
        const bool has_next = S.next(ui + 1, nxt);
        const char* nA = has_next ? (const char*)g.A + (GATHER ? (size_t)0 : (size_t)nxt.pm * tstep) : cA;
        if constexpr (GATHER) { if (has_next) PG8_ROWS(gN, nxt); else { _Pragma("unroll") for (int _h = 0; _h < 2; ++_h) _Pragma("unroll") for (int _i = 0; _i < 2; ++_i) gN[_h][_i] = gA[_h][_i]; } } const char* nB = has_next ? (const char*)g.Bt + (size_t)nxt.e * g.estride + (size_t)nxt.pn * tstep : cB;
        for (int t = 0; t < nt; t += 2) {
            const bool last = (t == nt - 2);
            const char* a1 = cA + (size_t)(t + 1) * kstep;
            const char* a2 = last ? nA : cA + (size_t)(t + 2) * kstep; const char* b2 = last ? nB : cB + (size_t)(t + 2) * kstep;
            const char* a3 = a2 + kstep; const char* b3 = b2 + kstep;
            if (last && has_next) S.a_ready(nxt);
            if constexpr (SP2) {
            PG8_LDB(B0, 0, 0); PG8_LDB(B1, 0, 1); PG8_SCHED; PG8_LDA(At, 0, 0); PG8_STAGEA(PG8_SA(1, 1), a1, 1, false);
            PG8_WAIT_V(8); PG8_WAIT_L(0); PG8_BAR; PG8_MMA(0, 0, At, B0); PG8_MMA(0, 1, At, B1); PG8_BAR; PG8_SCHED;
            PG8_LDA(At, 0, 1); PG8_STAGE(PG8_SB(0, 0), b2, voffB); PG8_STAGE(PG8_SB(0, 1), b2 + hstep, voffB); PG8_STAGEA(PG8_SA(0, 0), a2, 0, last);
            PG8_WAIT_V(8); PG8_WAIT_L(0); PG8_BAR; PG8_MMA(1, 0, At, B0); PG8_MMA(1, 1, At, B1); PG8_BAR; PG8_SCHED;
            PG8_LDB(B0, 1, 0); PG8_LDB(B1, 1, 1); PG8_SCHED; PG8_LDA(At, 1, 0); PG8_STAGEA(PG8_SA(0, 1), a2, 1, last);
            PG8_WAIT_V(8); PG8_WAIT_L(0); PG8_BAR; PG8_MMA(0, 0, At, B0); PG8_MMA(0, 1, At, B1); PG8_BAR; PG8_SCHED;
            PG8_LDA(At, 1, 1); PG8_STAGE(PG8_SB(1, 0), b3, voffB); PG8_STAGE(PG8_SB(1, 1), b3 + hstep, voffB); PG8_STAGEA(PG8_SA(1, 0), a3, 0, last);
            PG8_WAIT_V(8); PG8_WAIT_L(0); PG8_BAR; PG8_MMA(1, 0, At, B0); PG8_MMA(1, 1, At, B1); PG8_BAR; PG8_SCHED;
            } else {
            PG8_LDB(B0, 0, 0); PG8_SCHED; PG8_LDA(At, 0, 0); PG8_STAGEA(PG8_SA(1, 1), a1, 1, false);
            PG8_WAIT_L(8); PG8_BAR; PG8_WAIT_L(0); PG8_MMA(0, 0, At, B0); PG8_BAR; PG8_SCHED;
            PG8_LDB(B1, 0, 1); PG8_STAGE(PG8_SB(0, 0), b2, voffB);
            PG8_BAR; PG8_WAIT_L(0); PG8_MMA(0, 1, At, B1); PG8_BAR;
            PG8_LDA(At, 0, 1); PG8_STAGEA(PG8_SA(0, 0), a2, 0, last);
            PG8_BAR; PG8_WAIT_L(0); PG8_MMA(1, 0, At, B0); PG8_BAR; PG8_SCHED;
            PG8_STAGE(PG8_SB(0, 1), b2 + hstep, voffB);
            PG8_WAIT_V(6); PG8_BAR; PG8_MMA(1, 1, At, B1); PG8_BAR;
            PG8_LDB(B0, 1, 0); PG8_SCHED; PG8_LDA(At, 1, 0); PG8_STAGEA(PG8_SA(0, 1), a2, 1, last);
            PG8_WAIT_L(8); PG8_BAR; PG8_WAIT_L(0); PG8_MMA(0, 0, At, B0); PG8_BAR; PG8_SCHED;
            PG8_LDB(B1, 1, 1); PG8_STAGE(PG8_SB(1, 0), b3, voffB);
            PG8_BAR; PG8_WAIT_L(0); PG8_MMA(0, 1, At, B1); PG8_BAR;
            PG8_LDA(At, 1, 1); PG8_STAGEA(PG8_SA(1, 0), a3, 0, last);
            PG8_BAR; PG8_WAIT_L(0); PG8_MMA(1, 0, At, B0); PG8_BAR; PG8_SCHED;
            PG8_STAGE(PG8_SB(1, 1), b3 + hstep, voffB);
            PG8_WAIT_V(6); PG8_BAR; PG8_MMA(1, 1, At, B1); PG8_BAR;
            }
        }
        if constexpr (ALIGN_EPI) { if (wr == 0) PG8_BAR; }
        if constexpr (!Epi::AFTER_DRAIN) { E(acc, cur, wr, wc, fr, fq); S.done(cur); }
        if (!has_next) break;
#pragma unroll
        for (int a = 0; a < 2; ++a)
#pragma unroll
            for (int b = 0; b < 2; ++b)
#pragma unroll
                for (int m = 0; m < 4; ++m)
#pragma unroll
                    for (int n = 0; n < 2; ++n) acc[a][b][m][n] = (f32x4){0.f, 0.f, 0.f, 0.f};
        cur = nxt; cA = nA; cB = nB; ++ui;
        if constexpr (GATHER) { _Pragma("unroll") for (int _h = 0; _h < 2; ++_h) _Pragma("unroll") for (int _i = 0; _i < 2; ++_i) gA[_h][_i] = gN[_h][_i]; }
        if constexpr (ALIGN_EPI) { if (wr == 1) PG8_BAR; }
    }
    PG8_WAIT_V(0);
    if constexpr (!ALIGN_EPI) { if (wr == 0) PG8_BAR; }
    PG8_BAR;
    if constexpr (Epi::AFTER_DRAIN) { E.fused(acc, cur, wr, wc, fr, fq, lds, wid, lane); S.done(cur); }
#undef PG8_SA
#undef PG8_SB
#undef PG8_STAGE
#undef PG8_STAGEA
#undef PG8_ROWS
#undef PG8_LDA
#undef PG8_LDB
#undef PG8_MMA
#undef PG8_WAIT_V
#undef PG8_WAIT_L
#undef PG8_BAR
#undef PG8_SCHED
}
}

namespace pg8 {
__device__ __forceinline__ u32x4 pack8(const f32x4 a, const f32x4 b) { u32x4 w; w.x = cvt_pk_bf16(a[0], a[1]); w.y = cvt_pk_bf16(a[2], a[3]); w.z = cvt_pk_bf16(b[0], b[1]); w.w = cvt_pk_bf16(b[2], b[3]); return w; }
__device__ __forceinline__ float silu_f(float x) { return x * __builtin_amdgcn_rcpf(1.0f + __builtin_amdgcn_exp2f(-1.4426950408889634f * x)); }

struct EpiRope {
    static constexpr bool PERM = true, AFTER_DRAIN = false;
    bf16_t* Q; bf16_t* Kb; bf16_t* Vb; const float* cs; const float* sn; float qscale; int seqmask;
    __device__ __forceinline__ void operator()(const f32x4 (&acc)[2][2][4][2], const Unit& u, int wr, int wc, int fr, int fq) const {
        const int row0 = u.pm * BM + wr * 64 + fr; const int part = u.pn >> 2, pn4 = u.pn & 3;
        if (part == 2) {
            const int col0 = pn4 * BM + wc * 32 + 8 * fq;
#pragma unroll
            for (int ai = 0; ai < 2; ++ai)
#pragma unroll
                for (int m = 0; m < 4; ++m) { bf16_t* rowp = Vb + (size_t)(row0 + ai * HALF + m * 16) * 1024 + col0;
#pragma unroll
                    for (int bj = 0; bj < 2; ++bj) *(u32x4*)(rowp + bj * HALF) = pack8(acc[ai][bj][m][0], acc[ai][bj][m][1]); }
        } else {
            bf16_t* base = part == 0 ? Q : Kb; const float sc = part == 0 ? qscale : 1.0f;
            const int hm = pn4 * 4 + wc, j0 = 8 * fq;
#pragma unroll
            for (int q = 0; q < 4; ++q) {
                const int ai = q >> 1, mb = (q & 1) * 2;
                f32x4 c0[2], c1[2], s0[2], s1[2];
#pragma unroll
                for (int mm = 0; mm < 2; ++mm) { const int pos = (row0 + ai * HALF + (mb + mm) * 16) & seqmask;
                    c0[mm] = *(const f32x4*)(cs + pos * 32 + j0); c1[mm] = *(const f32x4*)(cs + pos * 32 + j0 + 4); s0[mm] = *(const f32x4*)(sn + pos * 32 + j0); s1[mm] = *(const f32x4*)(sn + pos * 32 + j0 + 4); }
#pragma unroll
                for (int mm = 0; mm < 2; ++mm) { const int m = mb + mm; const int row = row0 + ai * HALF + m * 16;
                    const f32x4 x1a = acc[ai][0][m][0] * sc, x1b = acc[ai][0][m][1] * sc, x2a = acc[ai][1][m][0] * sc, x2b = acc[ai][1][m][1] * sc;
                    const f32x4 o1a = x1a * c0[mm] - x2a * s0[mm], o1b = x1b * c1[mm] - x2b * s1[mm], o2a = x2a * c0[mm] + x1a * s0[mm], o2b = x2b * c1[mm] + x1b * s1[mm];
                    bf16_t* rowp = base + (size_t)row * 1024 + hm * 64 + j0;
                    *(u32x4*)(rowp) = pack8(o1a, o1b); *(u32x4*)(rowp + 32) = pack8(o2a, o2b); }
            }
        }
    }
};
struct EpiSwiGLU {
    static constexpr bool PERM = true, AFTER_DRAIN = false;
    bf16_t* act;
    __device__ __forceinline__ void operator()(const f32x4 (&acc)[2][2][4][2], const Unit& u, int wr, int wc, int fr, int fq) const {
        const int row0 = u.pm * BM + wr * 64 + fr, col0 = u.pn * HALF + wc * 32 + 8 * fq;
#pragma unroll
        for (int ai = 0; ai < 2; ++ai)
#pragma unroll
            for (int m = 0; m < 4; ++m) { f32x4 v0, v1;
#pragma unroll
                for (int j = 0; j < 4; ++j) { v0[j] = silu_f(acc[ai][0][m][0][j]) * acc[ai][1][m][0][j]; v1[j] = silu_f(acc[ai][0][m][1][j]) * acc[ai][1][m][1][j]; }
                *(u32x4*)(act + (size_t)(row0 + ai * HALF + m * 16) * 512 + col0) = pack8(v0, v1); }
    }
};
struct EpiRowScale {
    static constexpr bool PERM = true, AFTER_DRAIN = false;
    bf16_t* O; const float* roww;
    __device__ __forceinline__ void operator()(const f32x4 (&acc)[2][2][4][2], const Unit& u, int wr, int wc, int fr, int fq) const {
        const int row0 = u.pm * BM + wr * 64 + fr, col0 = u.pn * BM + wc * 32 + 8 * fq;
        float w8[8];
#pragma unroll
        for (int q = 0; q < 8; ++q) w8[q] = roww[row0 + (q >> 2) * HALF + (q & 3) * 16];
#pragma unroll
        for (int ai = 0; ai < 2; ++ai)
#pragma unroll
            for (int m = 0; m < 4; ++m) { const int row = row0 + ai * HALF + m * 16; const float w = w8[ai * 4 + m]; bf16_t* rowp = O + (size_t)row * 1024 + col0;
#pragma unroll
                for (int bj = 0; bj < 2; ++bj) *(u32x4*)(rowp + bj * HALF) = pack8(acc[ai][bj][m][0] * w, acc[ai][bj][m][1] * w); }
    }
};
struct PanelOrder {
    int pm, nN;
    __device__ __forceinline__ bool next(int i, Unit& u) const { if (i >= nN) return false; u.pm = pm; u.pn = i; u.e = 0; return true; }
    __device__ __forceinline__ void a_ready(const Unit&) const {}
    __device__ __forceinline__ void done(const Unit&) const {}
};
struct MoeOrder : StaticOrder {
    const int* blk_e;
    __device__ __forceinline__ bool next(int i, Unit& u) const { if (!StaticOrder::next(i, u)) return false; u.e = ((const __attribute__((address_space(4))) int*)blk_e)[u.pm]; return true; }
};
}
#include <hip/hip_bf16.h>
#include <cmath>
namespace attn_body {
using bf16=__hip_bfloat16;
using bf16x8=__attribute__((ext_vector_type(8)))short;
using s16x4=__attribute__((ext_vector_type(4)))short;
using f32x16=__attribute__((ext_vector_type(16)))float;
using u32x4=__attribute__((ext_vector_type(4)))unsigned;
constexpr int BATCH=16,NHEAD=16,SEQ=4096,D=64,DM=NHEAD*D;
constexpr int NW=8,QBLK=32,QB=QBLK*NW,KVBLK=64,NQB=SEQ/QB;
constexpr int ATTN_PITCH=DM, ATTN_UNIT_ROWS=QB;
__device__ __forceinline__ int crow(int r,int hi){return (r&3)+8*(r>>2)+4*hi;}
#define SBAR() __builtin_amdgcn_sched_barrier(0)
__device__ __forceinline__ void cmask(f32x16&p0,f32x16&p1,int jb,int qrel,int hi){
  const float NEG=-INFINITY; int kb=64*jb+4*hi;
  #pragma unroll
  for(int r=0;r<16;++r){int kv=kb+(r&3)+8*(r>>2); if(kv>qrel)p0[r]=NEG; if(kv+32>qrel)p1[r]=NEG;}
}

constexpr int NSLOT=3, SLOTB=8192;
constexpr int LDS_K=0, LDS_V=NSLOT*SLOTB, LDS_WS=2*NSLOT*SLOTB, LDS_OST=LDS_WS+NW*64*4, LDS_BYTES=LDS_OST+NW*4096;
constexpr float C2=0.125f*1.4426950408889634f;
__device__ __forceinline__ void glds16(const void*gsrc,unsigned lds_dst){unsigned keep;
  asm volatile("s_mov_b32 %0, m0\n\ts_mov_b32 m0, %2\n\ts_nop 0\n\tglobal_load_lds_dwordx4 %1, off\n\ts_mov_b32 m0, %0":"=&s"(keep):"v"(gsrc),"s"(lds_dst):"memory");}
__device__ __forceinline__ float max3f(float a,float b,float c){float r;asm("v_max3_f32 %0, %1, %2, %3":"=v"(r):"v"(a),"v"(b),"v"(c));return r;}
__device__ __forceinline__ float max2f(float a,float b){float r;asm("v_max_f32_e32 %0, %1, %2":"=v"(r):"v"(a),"v"(b));return r;}
__device__ __forceinline__ float fadd_s(float a,float b){float r;asm("v_add_f32_e32 %0, %1, %2":"=v"(r):"v"(a),"v"(b));return r;}
__device__ __forceinline__ float fsub_s(float a,float b){float r;asm("v_sub_f32_e32 %0, %1, %2":"=v"(r):"v"(a),"v"(b));return r;}
typedef float f32x2_t __attribute__((ext_vector_type(2))); typedef __bf16 bf16x2_t __attribute__((ext_vector_type(2)));
__device__ __forceinline__ unsigned cvtpk_s(float lo,float hi){f32x2_t v={lo,hi};bf16x2_t b=__builtin_convertvector(v,bf16x2_t);return __builtin_bit_cast(unsigned,b);}
#define WAIT_BAR(N) asm volatile("s_waitcnt vmcnt(" #N ") lgkmcnt(0)\n\ts_barrier":::"memory")

__device__ __forceinline__ void qkt(f32x16&p0,f32x16&p1,const char*Kslot,const bf16x8*qr,const f32x16&negm,int r32,int hi){
  const char*kb=Kslot+hi*1024+r32*16;
  #pragma unroll
  for(int d0=0;d0<4;++d0){
    const bf16x8 b0=*reinterpret_cast<const bf16x8*>(kb+d0*2048);
    const bf16x8 b1=*reinterpret_cast<const bf16x8*>(kb+d0*2048+512);
    if(d0==0){p0=__builtin_amdgcn_mfma_f32_32x32x16_bf16(b0,qr[0],negm,0,0,0);p1=__builtin_amdgcn_mfma_f32_32x32x16_bf16(b1,qr[0],negm,0,0,0);}
    else{p0=__builtin_amdgcn_mfma_f32_32x32x16_bf16(b0,qr[d0],p0,0,0,0);p1=__builtin_amdgcn_mfma_f32_32x32x16_bf16(b1,qr[d0],p1,0,0,0);}}
}
typedef __attribute__((address_space(3))) const char* lds_cptr;
typedef short v4i16_t __attribute__((ext_vector_type(4)));
__device__ __forceinline__ void kload8(bf16x8*kf,lds_cptr kp){
  kf[0]=*(const __attribute__((address_space(3))) bf16x8*)(kp);      kf[1]=*(const __attribute__((address_space(3))) bf16x8*)(kp+512);
  kf[2]=*(const __attribute__((address_space(3))) bf16x8*)(kp+2048); kf[3]=*(const __attribute__((address_space(3))) bf16x8*)(kp+2560);
  kf[4]=*(const __attribute__((address_space(3))) bf16x8*)(kp+4096); kf[5]=*(const __attribute__((address_space(3))) bf16x8*)(kp+4608);
  kf[6]=*(const __attribute__((address_space(3))) bf16x8*)(kp+6144); kf[7]=*(const __attribute__((address_space(3))) bf16x8*)(kp+6656);
}
__device__ __forceinline__ void kload2(bf16x8*kf,lds_cptr kp,int j){ kf[2*j]=*(const __attribute__((address_space(3))) bf16x8*)(kp+j*2048); kf[2*j+1]=*(const __attribute__((address_space(3))) bf16x8*)(kp+j*2048+512); }
__device__ __forceinline__ s16x4 vtr(lds_cptr p){ return __builtin_bit_cast(s16x4,__builtin_amdgcn_ds_read_tr16_b64_v4i16((__attribute__((address_space(3))) v4i16_t*)p)); }
__device__ __forceinline__ float rowmax(const f32x16&p0,const f32x16&p1){
  float a=max3f(p0[0],p0[1],p1[0]),b=max3f(p0[2],p0[3],p1[1]);a=max3f(a,p1[2],p1[3]);
  #pragma unroll
  for(int r=4;r<16;r+=4){a=max3f(a,p0[r],p0[r+1]);b=max3f(b,p0[r+2],p0[r+3]);a=max3f(a,p1[r],p1[r+1]);b=max3f(b,p1[r+2],p1[r+3]);}
  const float m=max2f(a,b);
  auto rr=__builtin_amdgcn_permlane32_swap(__float_as_uint(m),__float_as_uint(m),false,false);
  return max2f(__uint_as_float(rr[0]),__uint_as_float(rr[1]));
}
__device__ __forceinline__ void pv(f32x16*o,int vb,bf16x8 pa0,bf16x8 pa1,bf16x8 pa2,bf16x8 pa3){
  #pragma unroll
  for(int d0=0;d0<2;++d0){s16x4 lo[4],hi[4];
    #pragma unroll
    for(int ks=0;ks<4;++ks){
      asm volatile("ds_read_b64_tr_b16 %0,%1 offset:%c2":"=&v"(lo[ks]):"v"(vb),"i"(d0*4096+ks*1024):"memory");
      asm volatile("ds_read_b64_tr_b16 %0,%1 offset:%c2":"=&v"(hi[ks]):"v"(vb),"i"(d0*4096+ks*1024+512):"memory");}
    asm volatile("s_waitcnt lgkmcnt(0)":::"memory");SBAR();
    #define PK(k) (bf16x8){lo[k][0],lo[k][1],lo[k][2],lo[k][3],hi[k][0],hi[k][1],hi[k][2],hi[k][3]}
    o[d0]=__builtin_amdgcn_mfma_f32_32x32x16_bf16(pa0,PK(0),o[d0],0,0,0);
    o[d0]=__builtin_amdgcn_mfma_f32_32x32x16_bf16(pa1,PK(1),o[d0],0,0,0);
    o[d0]=__builtin_amdgcn_mfma_f32_32x32x16_bf16(pa2,PK(2),o[d0],0,0,0);
    o[d0]=__builtin_amdgcn_mfma_f32_32x32x16_bf16(pa3,PK(3),o[d0],0,0,0);
    #undef PK
  }
}

#ifndef ATTN_STORE16
#define ATTN_STORE16(p,v) (*(u32x4*)(p)=(v))
#endif
template<int THRL> __device__ __forceinline__ void attn_unit(int b,int qcol,int kcol,int vcol,int ocol,int qb,const bf16*Q,const bf16* K,const bf16* V,bf16*O,char*shm,int tid){
  const int lane=tid&63,r32=lane&31,hi=lane>>5; const int wid=__builtin_amdgcn_readfirstlane(tid>>6);
  const long rowbase=(long)b*SEQ; const int q0=qb*QB;
  const bf16*Qw=Q+(rowbase+q0+wid*QBLK)*DM+qcol;
  const bf16*Kh=K+rowbase*DM+kcol,*Vh=V+rowbase*DM+vcol;
  const unsigned lds0=(unsigned)(uintptr_t)shm;
  float*wsf=(float*)(shm+LDS_WS)+wid*64;
  const bf16*ksrc=Kh+(long)lane*DM+wid*8;
  const bf16*vsrc=Vh+(long)(16*(wid&3)+(lane>>2))*DM+(wid>>2)*32+(lane&3)*8;
  const unsigned kdst=lds0+LDS_K+wid*1024, vdst=lds0+LDS_V+wid*1024;
  #define DMA_K(t,slot) glds16(ksrc+(long)(t)*KVBLK*DM,(unsigned)__builtin_amdgcn_readfirstlane(kdst+(slot)))
  #define DMA_V(t,slot) glds16(vsrc+(long)(t)*KVBLK*DM,(unsigned)__builtin_amdgcn_readfirstlane(vdst+(slot)))
  const int vb0=(int)(lds0+LDS_V)+((lane>>4)&1)*32+(lane&3)*8+(4*hi+((lane&15)>>2))*64;
  const char*Kbase=shm+LDS_K; bf16x8 kf[8];
  const lds_cptr shm3=(lds_cptr)shm; const lds_cptr kp0=shm3+LDS_K+hi*1024+r32*16; const lds_cptr vp0=shm3+LDS_V+((lane>>4)&1)*32+(lane&3)*8+(4*hi+((lane&15)>>2))*64;
  const int NT=(q0+QB)/KVBLK;
  DMA_K(0,0);DMA_V(0,0);DMA_K(1,SLOTB);
  bf16x8 qr[4];
  #pragma unroll
  for(int d0=0;d0<4;++d0)qr[d0]=*reinterpret_cast<const bf16x8*>(&Qw[(long)r32*DM+d0*16+hi*8]);
  float mhat=0.f,l_reg=0.f;f32x16 o[2];o[0]=f32x16{};o[1]=f32x16{};f32x16 negm=f32x16{};asm volatile("":"+v"(negm));
  const int qrel=wid*QBLK+r32;
  #define CMASK(P0,P1,t) do{int jb_=(t)-(NT-4); if(jb_>=0)cmask(P0,P1,jb_,qrel,hi);}while(0)
  bool resc=false;
  #define START(P0,P1) do{ const float rm=rowmax(P0,P1); resc=false; \
    { const float dl=rm; mhat=fadd_s(mhat,dl); \
      _Pragma("unroll") for(int r=0;r<16;++r){P0[r]=fsub_s(P0[r],dl);P1[r]=fsub_s(P1[r],dl);} \
      _Pragma("unroll") for(int r=0;r<16;++r)negm[r]=-mhat; asm volatile("":"+v"(negm)); } \
    _Pragma("unroll") for(int r=0;r<16;++r)P0[r]=__builtin_amdgcn_exp2f(P0[r]); }while(0)
  #define RESC() do{ if(resc){ asm volatile("s_waitcnt lgkmcnt(0)":::"memory"); \
      _Pragma("unroll") for(int d_=0;d_<2;++d_) _Pragma("unroll") for(int r=0;r<16;++r)o[d_][r]*=wsf[crow(r,hi)]; } }while(0)
  f32x16 pA0,pA1,pB0,pB1;
  int sl_prev=0,sl_cur=0,sl_next=SLOTB;
  #define ROT() do{sl_prev=sl_cur;sl_cur=sl_next;sl_next=(sl_next==(NSLOT-1)*SLOTB)?0:sl_next+SLOTB;}while(0)
  DMA_K(2,2*SLOTB);
  WAIT_BAR(3);
  qkt(pA0,pA1,Kbase,qr,negm,r32,hi);asm volatile("s_nop 15\n\ts_nop 7":"+v"(pA0),"+v"(pA1));CMASK(pA0,pA1,0);
  START(pA0,pA1);
  _Pragma("unroll") for(int r=0;r<16;++r)pA1[r]=__builtin_amdgcn_exp2f(pA1[r]);
  WAIT_BAR(0);
  DMA_K(3,0);DMA_V(1,SLOTB);
  ROT();
  kload8(kf,kp0+sl_cur);
  WAIT_BAR(2);
  s16x4 vlo[8],vhi[8]; u32x4 pw0,pw1,pw2,pw3;
  #define PKW(P,B) cvtpk_s(P[B],P[B+1])
  #define PAF(k) __builtin_bit_cast(bf16x8,pw##k)
  #define VFR(i) (bf16x8){vlo[i][0],vlo[i][1],vlo[i][2],vlo[i][3],vhi[i][0],vhi[i][1],vhi[i][2],vhi[i][3]}
  #define PIN(x) asm volatile("":"+v"(x))
  #define MX3(a,b,c) __builtin_fmaxf(__builtin_fmaxf((a),(b)),(c))
  #define GAPA(MF,A0,A1,A2,A3,W0,W1,PW) do{ MF; sacc+=A0; sacc+=A1; sacc+=A2; sacc+=A3; PIN(sacc); W0; W1; PIN(PW); SBAR(); }while(0)
  #define EX(v) __builtin_amdgcn_exp2f(v)
  #define GAPB(MF,X,B) do{ MF; X[B]=EX(X[B]); X[B+1]=EX(X[B+1]); X[B+2]=EX(X[B+2]); X[B+3]=EX(X[B+3]); PIN(X); SBAR(); }while(0)
  #define VRD(i) do{ vlo[i]=vtr(vp_+(((i)>>2)*4096+((i)&3)*1024)); vhi[i]=vtr(vp_+(((i)>>2)*4096+((i)&3)*1024+512)); }while(0)
  #define KRD(G,j) do{ if(G){ kload2(kf,kp0+sl_next,j); SBAR(); } }while(0)
  #define STEP(C0,C1,P0,P1,t,GK,GV,GL) do{ SBAR(); \
    const lds_cptr vp_=vp0+sl_prev; \
    VRD(0); SBAR(); float sacc=(P0[0]+P0[1]); \
    GAPA(C0=__builtin_amdgcn_mfma_f32_32x32x16_bf16(kf[0],qr[0],negm,0,0,0), P0[2],P0[3],P0[4],P0[5],     pw0[0]=PKW(P0,0), pw0[1]=PKW(P0,2), pw0); \
    VRD(4); SBAR(); GAPA(C1=__builtin_amdgcn_mfma_f32_32x32x16_bf16(kf[1],qr[0],negm,0,0,0), P0[6],P0[7],P0[8],P0[9],     pw0[2]=PKW(P0,4), pw0[3]=PKW(P0,6), pw0); \
    VRD(1); SBAR(); GAPA(C0=__builtin_amdgcn_mfma_f32_32x32x16_bf16(kf[2],qr[1],C0,0,0,0),   P0[10],P0[11],P0[12],P0[13], pw1[0]=PKW(P0,8), pw1[1]=PKW(P0,10), pw1); \
    VRD(5); SBAR(); GAPA(C1=__builtin_amdgcn_mfma_f32_32x32x16_bf16(kf[3],qr[1],C1,0,0,0),   P0[14],P0[15],P1[0],P1[1],   pw1[2]=PKW(P0,12),pw1[3]=PKW(P0,14), pw1); \
    VRD(2); SBAR(); GAPA(C0=__builtin_amdgcn_mfma_f32_32x32x16_bf16(kf[4],qr[2],C0,0,0,0),   P1[2],P1[3],P1[4],P1[5],     pw2[0]=PKW(P1,0), pw2[1]=PKW(P1,2), pw2); \
    VRD(6); SBAR(); GAPA(C1=__builtin_amdgcn_mfma_f32_32x32x16_bf16(kf[5],qr[2],C1,0,0,0),   P1[6],P1[7],P1[8],P1[9],     pw2[2]=PKW(P1,4), pw2[3]=PKW(P1,6), pw2); \
    VRD(3); SBAR(); GAPA(C0=__builtin_amdgcn_mfma_f32_32x32x16_bf16(kf[6],qr[3],C0,0,0,0),   P1[10],P1[11],P1[12],P1[13], pw3[0]=PKW(P1,8), pw3[1]=PKW(P1,10), pw3); \
    VRD(7); SBAR(); GAPA(C1=__builtin_amdgcn_mfma_f32_32x32x16_bf16(kf[7],qr[3],C1,0,0,0),   P1[14],P1[15],0.f,0.f,       pw3[2]=PKW(P1,12),pw3[3]=PKW(P1,14), pw3); \
    l_reg+=sacc; \
    if(GK){DMA_K((t)+3,sl_cur);} if(GV){DMA_V((t)+1,sl_next);} \
    CMASK(C0,C1,t); \
    { float a=MX3(C0[0],C0[1],C1[0]),b=MX3(C0[2],C0[3],C1[1]); a=MX3(a,C1[2],C1[3]); \
      _Pragma("unroll") for(int r=4;r<16;r+=4){a=MX3(a,C0[r],C0[r+1]);b=MX3(b,C0[r+2],C0[r+3]);a=MX3(a,C1[r],C1[r+1]);b=MX3(b,C1[r+2],C1[r+3]);} \
      float rm=__builtin_fmaxf(a,b); { auto rr=__builtin_amdgcn_permlane32_swap(__float_as_uint(rm),__float_as_uint(rm),false,false); rm=__builtin_fmaxf(__uint_as_float(rr[0]),__uint_as_float(rr[1])); } \
      resc=false; \
      if(__builtin_expect(__any(rm>(float)THRL),0)){ const float dl=__builtin_fmaxf(rm,0.f); mhat+=dl; \
        _Pragma("unroll") for(int r=0;r<16;++r){C0[r]-=dl;C1[r]-=dl;} \
        _Pragma("unroll") for(int r=0;r<16;++r)negm[r]=-mhat; asm volatile("":"+v"(negm)); \
        const float f=__builtin_amdgcn_exp2f(-dl); l_reg*=f; if(hi==0)wsf[r32]=f; resc=true; } } \
    SBAR(); \
    GAPB(o[0]=__builtin_amdgcn_mfma_f32_32x32x16_bf16(PAF(0),VFR(0),o[0],0,0,0), C0,0); \
    GAPB(o[1]=__builtin_amdgcn_mfma_f32_32x32x16_bf16(PAF(0),VFR(4),o[1],0,0,0), C0,4); \
    KRD(GL,0); GAPB(o[0]=__builtin_amdgcn_mfma_f32_32x32x16_bf16(PAF(1),VFR(1),o[0],0,0,0), C0,8); \
    KRD(GL,1); GAPB(o[1]=__builtin_amdgcn_mfma_f32_32x32x16_bf16(PAF(1),VFR(5),o[1],0,0,0), C0,12); \
    KRD(GL,2); GAPB(o[0]=__builtin_amdgcn_mfma_f32_32x32x16_bf16(PAF(2),VFR(2),o[0],0,0,0), C1,0); \
    KRD(GL,3); GAPB(o[1]=__builtin_amdgcn_mfma_f32_32x32x16_bf16(PAF(2),VFR(6),o[1],0,0,0), C1,4); \
    GAPB(o[0]=__builtin_amdgcn_mfma_f32_32x32x16_bf16(PAF(3),VFR(3),o[0],0,0,0), C1,8); \
    GAPB(o[1]=__builtin_amdgcn_mfma_f32_32x32x16_bf16(PAF(3),VFR(7),o[1],0,0,0), C1,12); \
    }while(0)
  int t=1;
  #undef CMASK
  #define CMASK(P0,P1,t) do{}while(0)
  for(;t+5<NT;t+=2){
    STEP(pB0,pB1,pA0,pA1,t,true,true,true);     WAIT_BAR(2); RESC(); ROT();
    STEP(pA0,pA1,pB0,pB1,t+1,true,true,true);   WAIT_BAR(2); RESC(); ROT();
  }
  #undef CMASK
  #define CMASK(P0,P1,t) do{int jb_=(t)-(NT-4); if(jb_>=0)cmask(P0,P1,jb_,qrel,hi);}while(0)
  #define ENDW(tt) do{ if((tt)+3<NT){WAIT_BAR(2);} else if((tt)+2<NT){WAIT_BAR(1);} else {WAIT_BAR(0);} }while(0)
  for(;t+1<NT;t+=2){
    STEP(pB0,pB1,pA0,pA1,t,(t+3<NT),(t+1<NT),(t+1<NT));       ENDW(t);   RESC(); ROT();
    STEP(pA0,pA1,pB0,pB1,t+1,(t+4<NT),(t+2<NT),(t+2<NT));     ENDW(t+1); RESC(); ROT();
  }
  STEP(pB0,pB1,pA0,pA1,NT-1,false,false,false); RESC();
  { float sacc=pB0[0]+pB0[1]; _Pragma("unroll") for(int r=2;r<16;++r)sacc+=pB0[r]; _Pragma("unroll") for(int r=0;r<16;++r)sacc+=pB1[r]; l_reg+=sacc;
    pw0=(u32x4){PKW(pB0,0),PKW(pB0,2),PKW(pB0,4),PKW(pB0,6)};pw1=(u32x4){PKW(pB0,8),PKW(pB0,10),PKW(pB0,12),PKW(pB0,14)};pw2=(u32x4){PKW(pB1,0),PKW(pB1,2),PKW(pB1,4),PKW(pB1,6)};pw3=(u32x4){PKW(pB1,8),PKW(pB1,10),PKW(pB1,12),PKW(pB1,14)};
    SBAR(); pv(o,vb0+sl_cur,PAF(0),PAF(1),PAF(2),PAF(3)); }
  #undef PKW
  #undef PAF
  #undef VFR
  #undef PIN
  #undef MX3
  #undef GAPA
  #undef GAPB
  #undef EX
  #undef VRD
  #undef KRD
  #undef STEP
  #undef ENDW
  {auto rr=__builtin_amdgcn_permlane32_swap(__float_as_uint(l_reg),__float_as_uint(l_reg),false,false);l_reg=__uint_as_float(rr[0])+__uint_as_float(rr[1]);}
  if(hi==0)wsf[32+r32]=l_reg;asm volatile("s_waitcnt lgkmcnt(0)":::"memory");
  float rli[16];
  #pragma unroll
  for(int r=0;r<16;++r)rli[r]=__builtin_amdgcn_rcpf(wsf[32+crow(r,hi)]);
  bf16*Ow=O+(rowbase+q0+wid*QBLK)*DM+ocol;
  { bf16*stg=(bf16*)(shm+LDS_OST)+wid*2048;
    #pragma unroll
    for(int r=0;r<16;++r){const int orow=crow(r,hi);
      #pragma unroll
      for(int d0=0;d0<2;++d0)stg[orow*64+d0*32+r32]=__float2bfloat16(o[d0][r]*rli[r]);}
    asm volatile("s_waitcnt lgkmcnt(0)":::"memory");
    #pragma unroll
    for(int i=0;i<4;++i){const int row=i*8+(lane>>3),ch=lane&7; const u32x4 v=*(const u32x4*)(stg+row*64+ch*8); ATTN_STORE16(Ow+(long)row*DM+ch*8,v);} }
  asm volatile("s_waitcnt lgkmcnt(0)\n\ts_barrier":::"memory");
  #undef DMA_K
  #undef DMA_V
  #undef CMASK
  #undef START
  #undef RESC
  #undef ROT
}
constexpr int ATTN_LDS_BYTES=LDS_BYTES;
struct AttnTensors { const bf16* Q; const bf16* K; const bf16* V; bf16* O0; bf16* O1; };
struct AttnUnit { int b, qcol, kcol, vcol, ocol, m, qb; };
struct StaticOrder {
  int vcu, G;
  __device__ __forceinline__ StaticOrder(int grid,int vcu_):vcu(vcu_),G(grid){}
  __device__ __forceinline__ bool next(int i,AttnUnit&u)const{
    int b,h,m,vhalf,qb;
    if(G==256){ if(i>=32)return false; const int xcd=vcu>>5,l=vcu&31,vh=l&3,qs=l>>2,bh=xcd*16+(i>>1); b=bh>>3; h=bh&7; m=(vh>>1)&1; vhalf=vh&1; qb=(i&1)?qs:15-qs; }
    else { const int ci=vcu+G*(i>>4); if(ci>=BATCH*32)return false; const int vh=ci&31; h=vh>>2; m=(vh>>1)&1; vhalf=vh&1; b=ci>>5; qb=15-(i&15); }
    u.b=b; u.qcol=(2*h+m)*64; u.kcol=u.qcol; u.vcol=h*128+vhalf*64; u.ocol=u.vcol; u.m=m; u.qb=qb; return true; }
  __device__ __forceinline__ void a_ready(const AttnUnit&)const{}
  __device__ __forceinline__ void done(const AttnUnit&)const{}
};
template<class Sched,int THRL=8> __device__ __forceinline__ void attn_phase(char*lds,const AttnTensors&T,const Sched&S,const int tid_){
  AttnUnit u;
  for(int i=0;S.next(i,u);++i){ S.a_ready(u); attn_unit<THRL>(u.b,u.qcol,u.kcol,u.vcol,u.ocol,u.qb,T.Q,T.K,T.V,u.m?T.O1:T.O0,lds,tid_); S.done(u); }
}
constexpr int VSLOTB=16384;
constexpr int WL_K=0, WL_V=NSLOT*SLOTB, WL_WS=WL_V+NSLOT*VSLOTB, WL_Q=WL_WS+NW*64*4, WL_OST=WL_Q+NW*4096, WL_BYTES=WL_OST+NW*4096;
__device__ __forceinline__ void cmask2(f32x16&p0,f32x16&p1,int jb,int qrel,int hi){
  const float NEG=-INFINITY; const int qq=qrel-64*jb-4*hi;
  #pragma unroll
  for(int r=0;r<16;++r){const int c=(r&3)+8*(r>>2); if(c>qq)p0[r]=NEG; if(c+32>qq)p1[r]=NEG;}
}
__device__ __forceinline__ void pv4(f32x16*o,int vb,bf16x8 pa0,bf16x8 pa1,bf16x8 pa2,bf16x8 pa3){
  #pragma unroll
  for(int d0=0;d0<4;++d0){s16x4 lo[4],hi[4];
    #pragma unroll
    for(int ks=0;ks<4;++ks){
      asm volatile("ds_read_b64_tr_b16 %0,%1 offset:%c2":"=&v"(lo[ks]):"v"(vb),"i"(d0*4096+ks*1024):"memory");
      asm volatile("ds_read_b64_tr_b16 %0,%1 offset:%c2":"=&v"(hi[ks]):"v"(vb),"i"(d0*4096+ks*1024+512):"memory");}
    asm volatile("s_waitcnt lgkmcnt(0)":::"memory");SBAR();
    #define PK(k) (bf16x8){lo[k][0],lo[k][1],lo[k][2],lo[k][3],hi[k][0],hi[k][1],hi[k][2],hi[k][3]}
    o[d0]=__builtin_amdgcn_mfma_f32_32x32x16_bf16(pa0,PK(0),o[d0],0,0,0);
    o[d0]=__builtin_amdgcn_mfma_f32_32x32x16_bf16(pa1,PK(1),o[d0],0,0,0);
    o[d0]=__builtin_amdgcn_mfma_f32_32x32x16_bf16(pa2,PK(2),o[d0],0,0,0);
    o[d0]=__builtin_amdgcn_mfma_f32_32x32x16_bf16(pa3,PK(3),o[d0],0,0,0);
    #undef PK
  }
}
using f32x4_t=__attribute__((ext_vector_type(4)))float;
struct CombineW { const bf16* O0; bf16* A2; const float* w; float lam, mul; };
template<int THRL> __device__ __forceinline__ void attn_unit_w(int b,int qcol,int vcol,int qb,int m,const bf16*Q,const bf16* K,const bf16* V,bf16*O,const CombineW&CB,char*shm,int tid){
  const int lane=tid&63,r32=lane&31,hi=lane>>5; const int wid=__builtin_amdgcn_readfirstlane(tid>>6);
  const long rowbase=(long)b*SEQ; const int q0=qb*QB;
  int hi4=4*hi; asm volatile("":"+v"(hi4));
  #define CROWO(r) (((r)&3)+8*((r)>>2)+hi4)
  const bf16*Qw=Q+(rowbase+q0+wid*QBLK)*DM+qcol;
  const bf16*Kh=K+rowbase*DM+qcol,*Vh=V+rowbase*DM+vcol;
  const unsigned lds0=(unsigned)(uintptr_t)shm;
  float*wsf=(float*)(shm+WL_WS)+wid*64;
  const bf16*ksrc=Kh+(long)lane*DM+wid*8;
  const bf16*vsrc=Vh+(long)(16*(wid&3)+(lane>>2))*DM+(wid>>2)*32+(lane&3)*8;
  const unsigned kdst=lds0+WL_K+wid*1024, vdst=lds0+WL_V+wid*1024;
  #define DMA_K(t,slot) glds16(ksrc+(long)(t)*KVBLK*DM,(unsigned)__builtin_amdgcn_readfirstlane(kdst+(slot)))
  #define DMA_V(t,slot) do{ glds16(vsrc+(long)(t)*KVBLK*DM,(unsigned)__builtin_amdgcn_readfirstlane(vdst+2*(slot))); glds16(vsrc+(long)(t)*KVBLK*DM+64,(unsigned)__builtin_amdgcn_readfirstlane(vdst+2*(slot)+8192)); }while(0)
  const int vb0=(int)(lds0+WL_V)+((lane>>4)&1)*32+(lane&3)*8+(4*hi+((lane&15)>>2))*64;
  const char*Kbase=shm+WL_K; bf16x8 kf[8];
  const lds_cptr shm3=(lds_cptr)shm; const lds_cptr kp0=shm3+WL_K+hi*1024+r32*16; const lds_cptr vp0=shm3+WL_V+((lane>>4)&1)*32+(lane&3)*8+(4*hi+((lane&15)>>2))*64;
  const lds_cptr qp=shm3+WL_Q+wid*4096+lane*16;
  const int NT=(q0+QB)/KVBLK;
  DMA_K(0,0);DMA_V(0,0);DMA_K(1,SLOTB);
  bf16x8 qr[4];
  #pragma unroll
  for(int d0=0;d0<4;++d0)qr[d0]=*reinterpret_cast<const bf16x8*>(&Qw[(long)r32*DM+d0*16+hi*8]);
  #pragma unroll
  for(int d0=0;d0<4;++d0)*(__attribute__((address_space(3))) bf16x8*)(qp+d0*1024)=qr[d0];
  float mhat=0.f,l_reg=0.f;f32x16 o[4];o[0]=f32x16{};o[1]=f32x16{};o[2]=f32x16{};o[3]=f32x16{};
  const f32x16 zero16=f32x16{};
  const int qrel=wid*QBLK+r32;
  #define CMASK(P0,P1,t) do{int jb_=(t)-(NT-4); if(jb_>=0)cmask2(P0,P1,jb_,qrel,hi);}while(0)
  bool resc=false;
  #define START(P0,P1) do{ const float rm=rowmax(P0,P1); resc=false; \
    { const float dl=rm; mhat=fadd_s(mhat,dl); \
      _Pragma("unroll") for(int r=0;r<16;++r){P0[r]=fsub_s(P0[r],dl);P1[r]=fsub_s(P1[r],dl);} } \
    _Pragma("unroll") for(int r=0;r<16;++r)P0[r]=__builtin_amdgcn_exp2f(P0[r]); }while(0)
  #define RESC() do{ if(resc){ asm volatile("s_waitcnt lgkmcnt(0)":::"memory"); \
      _Pragma("unroll") for(int d_=0;d_<4;++d_) _Pragma("unroll") for(int r=0;r<16;++r)o[d_][r]*=wsf[CROWO(r)]; } }while(0)
  f32x16 pA0,pA1,pB0,pB1;
  int sl_prev=0,sl_cur=0,sl_next=SLOTB;
  #define ROT() do{sl_prev=sl_cur;sl_cur=sl_next;sl_next=(sl_next==(NSLOT-1)*SLOTB)?0:sl_next+SLOTB;}while(0)
  DMA_K(2,2*SLOTB);
  WAIT_BAR(3);
  qkt(pA0,pA1,Kbase,qr,zero16,r32,hi);asm volatile("s_nop 15\n\ts_nop 7":"+v"(pA0),"+v"(pA1));CMASK(pA0,pA1,0);
  START(pA0,pA1);
  _Pragma("unroll") for(int r=0;r<16;++r)pA1[r]=__builtin_amdgcn_exp2f(pA1[r]);
  WAIT_BAR(0);
  DMA_K(3,0);DMA_V(1,SLOTB);
  ROT();
  kload8(kf,kp0+sl_cur);
  WAIT_BAR(3);
  s16x4 vlo[16],vhi[16]; u32x4 pw0,pw1,pw2,pw3;
  #define PKW(P,B) cvtpk_s(P[B],P[B+1])
  #define PAF(k) __builtin_bit_cast(bf16x8,pw##k)
  #define VFR(i) (bf16x8){vlo[i][0],vlo[i][1],vlo[i][2],vlo[i][3],vhi[i][0],vhi[i][1],vhi[i][2],vhi[i][3]}
  #define PIN(x) asm volatile("":"+v"(x))
  #define MX3(a,b,c) __builtin_fmaxf(__builtin_fmaxf((a),(b)),(c))
  #define GAPA(MF,A0,A1,A2,A3,W0,W1,PW) do{ MF; sacc+=A0; sacc+=A1; sacc+=A2; sacc+=A3; PIN(sacc); W0; W1; PIN(PW); SBAR(); }while(0)
  #define EX(v) __builtin_amdgcn_exp2f(v)
  #define GAPB(MF,X,B) do{ MF; X[B]=EX(X[B]); X[B+1]=EX(X[B+1]); PIN(X); SBAR(); }while(0)
  #define VRD(i) do{ vlo[i]=vtr(vp_+(((i)>>2)*4096+((i)&3)*1024)); vhi[i]=vtr(vp_+(((i)>>2)*4096+((i)&3)*1024+512)); }while(0)
  #define KRD(G,j) do{ if(G){ kload2(kf,kp0+sl_next,j); SBAR(); } }while(0)
  #define QRD(d) (*(const __attribute__((address_space(3))) bf16x8*)(qp+(d)*1024))
  #define MF32(a_,b_,c_) __builtin_amdgcn_mfma_f32_32x32x16_bf16(a_,b_,c_,0,0,0)
  #define STEP(C0,C1,P0,P1,t,GK,GV,GL) do{ SBAR(); \
    const lds_cptr vp_=vp0+2*sl_prev; bf16x8 q0_,q1_,q2_,q3_; \
    q0_=QRD(0); VRD(0); SBAR(); float sacc=(P0[0]+P0[1]); \
    GAPA(C0=MF32(kf[0],q0_,zero16), P0[2],P0[3],P0[4],P0[5],     pw0[0]=PKW(P0,0), pw0[1]=PKW(P0,2), pw0); \
    q1_=QRD(1); SBAR(); GAPA(C1=MF32(kf[1],q0_,zero16), P0[6],P0[7],P0[8],P0[9],     pw0[2]=PKW(P0,4), pw0[3]=PKW(P0,6), pw0); \
    VRD(4); SBAR(); GAPA(C0=MF32(kf[2],q1_,C0),   P0[10],P0[11],P0[12],P0[13], pw1[0]=PKW(P0,8), pw1[1]=PKW(P0,10), pw1); \
    q2_=QRD(2); SBAR(); GAPA(C1=MF32(kf[3],q1_,C1),   P0[14],P0[15],P1[0],P1[1],   pw1[2]=PKW(P0,12),pw1[3]=PKW(P0,14), pw1); \
    VRD(8); SBAR(); GAPA(C0=MF32(kf[4],q2_,C0),   P1[2],P1[3],P1[4],P1[5],     pw2[0]=PKW(P1,0), pw2[1]=PKW(P1,2), pw2); \
    q3_=QRD(3); SBAR(); GAPA(C1=MF32(kf[5],q2_,C1),   P1[6],P1[7],P1[8],P1[9],     pw2[2]=PKW(P1,4), pw2[3]=PKW(P1,6), pw2); \
    VRD(12); SBAR(); GAPA(C0=MF32(kf[6],q3_,C0),   P1[10],P1[11],P1[12],P1[13], pw3[0]=PKW(P1,8), pw3[1]=PKW(P1,10), pw3); \
    GAPA(C1=MF32(kf[7],q3_,C1),   P1[14],P1[15],0.f,0.f,       pw3[2]=PKW(P1,12),pw3[3]=PKW(P1,14), pw3); \
    l_reg+=sacc; \
    if(GK){DMA_K((t)+3,sl_cur);} if(GV){DMA_V((t)+1,sl_next);} \
    CMASK(C0,C1,t); \
    { float a=MX3(C0[0],C0[1],C1[0]),b=MX3(C0[2],C0[3],C1[1]); a=MX3(a,C1[2],C1[3]); \
      _Pragma("unroll") for(int r=4;r<16;r+=4){a=MX3(a,C0[r],C0[r+1]);b=MX3(b,C0[r+2],C0[r+3]);a=MX3(a,C1[r],C1[r+1]);b=MX3(b,C1[r+2],C1[r+3]);} \
      float rm=__builtin_fmaxf(a,b); { auto rr=__builtin_amdgcn_permlane32_swap(__float_as_uint(rm),__float_as_uint(rm),false,false); rm=__builtin_fmaxf(__uint_as_float(rr[0]),__uint_as_float(rr[1])); } \
      rm-=mhat; resc=false; \
      if(__builtin_expect(__any(rm>(float)THRL),0)){ const float dl=__builtin_fmaxf(rm,0.f); mhat+=dl; \
        const float f=__builtin_amdgcn_exp2f(-dl); l_reg*=f; if(hi==0)wsf[r32]=f; resc=true; } \
      _Pragma("unroll") for(int r=0;r<16;++r){C0[r]-=mhat;C1[r]-=mhat;} } \
    SBAR(); \
    VRD(1);  GAPB(o[0]=MF32(PAF(0),VFR(0), o[0]), C0,0); \
    VRD(5);  GAPB(o[1]=MF32(PAF(0),VFR(4), o[1]), C0,2); \
    VRD(9);  GAPB(o[2]=MF32(PAF(0),VFR(8), o[2]), C0,4); \
    VRD(13); GAPB(o[3]=MF32(PAF(0),VFR(12),o[3]), C0,6); \
    VRD(2);  KRD(GL,0); GAPB(o[0]=MF32(PAF(1),VFR(1), o[0]), C0,8); \
    VRD(6);  GAPB(o[1]=MF32(PAF(1),VFR(5), o[1]), C0,10); \
    VRD(10); KRD(GL,1); GAPB(o[2]=MF32(PAF(1),VFR(9), o[2]), C0,12); \
    VRD(14); GAPB(o[3]=MF32(PAF(1),VFR(13),o[3]), C0,14); \
    VRD(3);  KRD(GL,2); GAPB(o[0]=MF32(PAF(2),VFR(2), o[0]), C1,0); \
    VRD(7);  GAPB(o[1]=MF32(PAF(2),VFR(6), o[1]), C1,2); \
    VRD(11); KRD(GL,3); GAPB(o[2]=MF32(PAF(2),VFR(10),o[2]), C1,4); \
    VRD(15); GAPB(o[3]=MF32(PAF(2),VFR(14),o[3]), C1,6); \
    GAPB(o[0]=MF32(PAF(3),VFR(3), o[0]), C1,8); \
    GAPB(o[1]=MF32(PAF(3),VFR(7), o[1]), C1,10); \
    GAPB(o[2]=MF32(PAF(3),VFR(11),o[2]), C1,12); \
    GAPB(o[3]=MF32(PAF(3),VFR(15),o[3]), C1,14); \
    }while(0)
  int t=1;
  #undef CMASK
  #define CMASK(P0,P1,t) do{}while(0)
  for(;t+5<NT;t+=2){
    STEP(pB0,pB1,pA0,pA1,t,true,true,true);     WAIT_BAR(3); RESC(); ROT();
    STEP(pA0,pA1,pB0,pB1,t+1,true,true,true);   WAIT_BAR(3); RESC(); ROT();
  }
  #undef CMASK
  #define CMASK(P0,P1,t) do{int jb_=(t)-(NT-4); if(jb_>=0)cmask2(P0,P1,jb_,qrel,hi);}while(0)
  #define ENDW(tt) do{ if((tt)+3<NT){WAIT_BAR(3);} else if((tt)+2<NT){WAIT_BAR(2);} else {WAIT_BAR(0);} }while(0)
  for(;t+1<NT;t+=2){
    STEP(pB0,pB1,pA0,pA1,t,(t+3<NT),(t+1<NT),(t+1<NT));       ENDW(t);   RESC(); ROT();
    STEP(pA0,pA1,pB0,pB1,t+1,(t+4<NT),(t+2<NT),(t+2<NT));     ENDW(t+1); RESC(); ROT();
  }
  STEP(pB0,pB1,pA0,pA1,NT-1,false,false,false); RESC();
  u32x4 a0v[2][4];
  if(m==1){ const bf16*O0p=CB.O0+(rowbase+q0+wid*QBLK)*DM+vcol;
    #pragma unroll
    for(int half=0;half<2;++half)
      #pragma unroll
      for(int i=0;i<4;++i)a0v[half][i]=*(const u32x4*)(O0p+(long)(i*8+(lane>>3))*DM+half*64+(lane&7)*8);
    asm volatile("":::"memory"); }
  { float sacc=pB0[0]+pB0[1]; _Pragma("unroll") for(int r=2;r<16;++r)sacc+=pB0[r]; _Pragma("unroll") for(int r=0;r<16;++r)sacc+=pB1[r]; l_reg+=sacc;
    pw0=(u32x4){PKW(pB0,0),PKW(pB0,2),PKW(pB0,4),PKW(pB0,6)};pw1=(u32x4){PKW(pB0,8),PKW(pB0,10),PKW(pB0,12),PKW(pB0,14)};pw2=(u32x4){PKW(pB1,0),PKW(pB1,2),PKW(pB1,4),PKW(pB1,6)};pw3=(u32x4){PKW(pB1,8),PKW(pB1,10),PKW(pB1,12),PKW(pB1,14)};
    SBAR(); pv4(o,vb0+2*sl_cur,PAF(0),PAF(1),PAF(2),PAF(3)); }
  #undef PKW
  #undef PAF
  #undef VFR
  #undef PIN
  #undef MX3
  #undef GAPA
  #undef GAPB
  #undef EX
  #undef VRD
  #undef KRD
  #undef QRD
  #undef MF32
  #undef STEP
  #undef ENDW
  {auto rr=__builtin_amdgcn_permlane32_swap(__float_as_uint(l_reg),__float_as_uint(l_reg),false,false);l_reg=__uint_as_float(rr[0])+__uint_as_float(rr[1]);}
  if(hi==0)wsf[32+r32]=l_reg;asm volatile("s_waitcnt lgkmcnt(0)":::"memory");
  float rli[16];
  #pragma unroll
  for(int r=0;r<16;++r)rli[r]=__builtin_amdgcn_rcpf(wsf[32+CROWO(r)]);
  const long obase=(rowbase+q0+wid*QBLK)*DM+vcol;
  bf16*stg=(bf16*)(shm+WL_OST)+wid*2048;
  if(m==0){ bf16*Ow=O+obase;
    #pragma unroll
    for(int half=0;half<2;++half){
      #pragma unroll
      for(int r=0;r<16;++r){const int orow=CROWO(r);
        #pragma unroll
        for(int d0=0;d0<2;++d0)stg[orow*64+d0*32+r32]=__float2bfloat16(o[2*half+d0][r]*rli[r]);}
      asm volatile("s_waitcnt lgkmcnt(0)":::"memory");
      #pragma unroll
      for(int i=0;i<4;++i){const int row=i*8+(lane>>3),ch=lane&7; const u32x4 v=*(const u32x4*)(stg+row*64+ch*8); ATTN_STORE16(Ow+(long)row*DM+half*64+ch*8,v);}
      asm volatile("s_waitcnt lgkmcnt(0)":::"memory"); }
  } else {
    bf16*Aw=CB.A2+obase; const float lam=CB.lam;
    float df[2][4][8]; float ssq[4]={0.f,0.f,0.f,0.f};
    #pragma unroll
    for(int half=0;half<2;++half){
      u32x4 a[4];
      #pragma unroll
      for(int i=0;i<4;++i)a[i]=a0v[half][i];
      #pragma unroll
      for(int r=0;r<16;++r){const int orow=CROWO(r);
        #pragma unroll
        for(int d0=0;d0<2;++d0)stg[orow*64+d0*32+r32]=__float2bfloat16(o[2*half+d0][r]*rli[r]);}
      asm volatile("s_waitcnt lgkmcnt(0)":::"memory");
      #pragma unroll
      for(int i=0;i<4;++i){const int row=i*8+(lane>>3),ch=lane&7; const u32x4 v=*(const u32x4*)(stg+row*64+ch*8);
        #pragma unroll
        for(int k=0;k<4;++k){ const float d0_=__uint_as_float(a[i][k]<<16)-lam*__uint_as_float(v[k]<<16), d1_=__uint_as_float(a[i][k]&0xffff0000u)-lam*__uint_as_float(v[k]&0xffff0000u);
          df[half][i][2*k]=d0_; df[half][i][2*k+1]=d1_; ssq[i]+=d0_*d0_; ssq[i]+=d1_*d1_; } }
      asm volatile("s_waitcnt lgkmcnt(0)":::"memory"); }
    #pragma unroll
    for(int i=0;i<4;++i){ float ss=ssq[i];
      ss+=__builtin_bit_cast(float,__builtin_amdgcn_update_dpp(0,__builtin_bit_cast(int,ss),0xB1,0xF,0xF,true));
      ss+=__builtin_bit_cast(float,__builtin_amdgcn_update_dpp(0,__builtin_bit_cast(int,ss),0x4E,0xF,0xF,true));
      ss+=__builtin_bit_cast(float,__builtin_amdgcn_update_dpp(0,__builtin_bit_cast(int,ss),0x141,0xF,0xF,true));
      ssq[i]=1.0f/sqrtf(ss*(1.0f/128.0f)+1e-5f); }
    #pragma unroll
    for(int half=0;half<2;++half){ const int ch=lane&7;
      const f32x4_t w0=*(const f32x4_t*)(CB.w+half*64+ch*8),w1=*(const f32x4_t*)(CB.w+half*64+ch*8+4);
      #pragma unroll
      for(int i=0;i<4;++i){const int row=i*8+(lane>>3); const float rs=ssq[i]; u32x4 ov;
        #pragma unroll
        for(int k=0;k<4;++k){ const float wa=(k<2?w0[2*k]:w1[2*k-4])*CB.mul, wb=(k<2?w0[2*k+1]:w1[2*k-3])*CB.mul; ov[k]=cvtpk_s(df[half][i][2*k]*rs*wa,df[half][i][2*k+1]*rs*wb); }
        ATTN_STORE16(Aw+(long)row*DM+half*64+ch*8,ov);} }
  }
  asm volatile("s_waitcnt lgkmcnt(0)\n\ts_barrier":::"memory");
  #undef DMA_K
  #undef DMA_V
  #undef CMASK
  #undef START
  #undef RESC
  #undef ROT
  #undef CROWO
}
constexpr int ATTNW_LDS_BYTES=WL_BYTES;
struct AttnUnitW { int b, qcol, vcol, m, qb; };
struct StaticOrderW {
  int vcu, G;
  __device__ __forceinline__ StaticOrderW(int grid,int vcu_):vcu(vcu_),G(grid){}
  __device__ __forceinline__ bool next(int i,AttnUnitW&u)const{
    int b,h,m,qb;
    if(G==256){ if(i>=16)return false; const int xcd=vcu>>5,l=vcu&31,s=l>>1,ip=i>>1,bh=xcd*16+8*(l&1)+ip; m=i&1; b=bh>>3; h=bh&7; qb=(ip&1)?s:15-s; }
    else { const int i2=i>>1,ci=vcu+G*(i2>>4); if(ci>=BATCH*8)return false; h=ci&7; m=i&1; b=ci>>3; qb=15-(i2&15); }
    u.b=b; u.qcol=(2*h+m)*64; u.vcol=h*128; u.m=m; u.qb=qb; return true; }
};
template<int THRL=8> __device__ __forceinline__ void attn_phase_w(char*lds,const AttnTensors&T,const StaticOrderW&S,const CombineW&CB,const int tid_){
  AttnUnitW u;
  for(int i=0;S.next(i,u);++i){ attn_unit_w<THRL>(u.b,u.qcol,u.vcol,u.qb,u.m,T.Q,T.K,T.V,T.O0,CB,lds,tid_); }
}
#undef SBAR
#undef WAIT_BAR
}

constexpr int NWAVES = 8;
constexpr int BATCH = 16, SEQ = 4096, D = 1024, M = BATCH * SEQ, DEPTH = 4;
constexpr int NEXP = 32, FF = 512;
constexpr int NSLOT_MAX = 2 * M + NEXP * 256, NBLK_MAX = NSLOT_MAX / 256;
constexpr float LN_EPS = 1e-5f;
constexpr float DN_ALPHA = 1.681792830507429f;
constexpr int HG_CHUNK = 32, HG_NCH = SEQ / HG_CHUNK;

constexpr size_t MiB = 1u << 20;
constexpr size_t WS_CTL = 0, CTL_ZERO_BYTES = 1 * MiB;
constexpr size_t WS_MOD = 1 * MiB;
constexpr size_t WS_ROPE_C = 3 * MiB, WS_ROPE_S = 3 * MiB + 512 * 1024;
constexpr size_t WS_RT = 4 * MiB;
constexpr size_t WS_EID = 5 * MiB;
constexpr size_t WS_WT = 5 * MiB + 512 * 1024;
constexpr size_t WS_TSLOT = 6 * MiB;
constexpr size_t WS_SLOTW = 6 * MiB + 512 * 1024;
constexpr size_t WS_BLKE = 7 * MiB + 128 * 1024;
constexpr size_t WS_STOK = 7 * MiB + 256 * 1024;
constexpr size_t WS_HGD = 8 * MiB;
constexpr size_t WS_WHIN = 16 * MiB;
constexpr size_t WS_WAIN = 32 * MiB;
constexpr size_t WS_WHOUT = 44 * MiB;
constexpr size_t WS_WAOUT = 48 * MiB;
constexpr size_t WS_W13 = 52 * MiB;
constexpr size_t WS_W2 = 116 * MiB;
constexpr size_t WS_BUF0 = 148 * MiB, BUFSZ = 128 * MiB;
constexpr size_t WS_WB2 = WS_BUF0 + 7 * BUFSZ;
constexpr size_t WS_END = WS_WB2 + 96 * MiB;
constexpr int CW_TMO = 0, CW_CODE = 1;
constexpr int CW_BAR = 4096;
constexpr int CW_CNT = 8192;
static_assert((CW_CNT + 4 * 256) * 4 <= (int)CTL_ZERO_BYTES, "ctl");

constexpr int RING_OFF = 0, RING_BYTES = 147456;
constexpr int LDSCTL_OFF = RING_BYTES, MISC_OFF = LDSCTL_OFF + 512;
constexpr int LDS_BYTES = RING_BYTES + 1024;
static_assert(MISC_OFF + 128 <= LDS_BYTES, "LDS map");
#define GAS __attribute__((address_space(1)))
#define LAS __attribute__((address_space(3)))
typedef unsigned short bf16;
typedef unsigned v4u __attribute__((ext_vector_type(4)));
typedef float f32x4 __attribute__((ext_vector_type(4)));
typedef short bf16x8 __attribute__((ext_vector_type(8)));
typedef GAS unsigned gu32;
typedef GAS unsigned long long gu64;
#define RLX_AGENT __ATOMIC_RELAXED, __HIP_MEMORY_SCOPE_AGENT
#define LDS_WAIT() asm volatile("s_waitcnt lgkmcnt(0)" ::: "memory")
#define VM_WAIT() asm volatile("s_waitcnt vmcnt(0)" ::: "memory")
__device__ __forceinline__ unsigned long long rt() { return __builtin_amdgcn_s_memrealtime(); }
__device__ __forceinline__ unsigned f2bf(float f) { unsigned u = __builtin_bit_cast(unsigned, f); return (u + 0x7fffu + ((u >> 16) & 1u)) >> 16; }
__device__ __forceinline__ unsigned pk2(float lo, float hi) { return f2bf(lo) | (f2bf(hi) << 16); }

#define XB_TMO      128
#define XB_XCNT(j)  (256  + 64 * (j))
#define XB_XSUB(j)  (1280 + 64 * (j))
#define XB_XGEN(j)  (2304 + 64 * (j))
#define XB_TOP      3328
#define XB_TOPGEN   3392
#define XCD_BAR_WORDS 3456
#define XB_SPIN_CAP (1u << 18)

__device__ __forceinline__ unsigned xb_ld(unsigned* p)              { return __hip_atomic_load(p, __ATOMIC_RELAXED, __HIP_MEMORY_SCOPE_AGENT); }
__device__ __forceinline__ unsigned xb_add(unsigned* p, unsigned v) { return __hip_atomic_fetch_add(p, v, __ATOMIC_RELAXED, __HIP_MEMORY_SCOPE_AGENT); }
__device__ __forceinline__ unsigned xb_xcc_id() { return (unsigned)__builtin_amdgcn_s_getreg((3 << 11) | 20) & 0xFu; }
#define XB_SPIN(cond, bar) do { unsigned _sp = 0; while (cond) { __builtin_amdgcn_s_sleep(1); \
    if ((++_sp & 255u) == 0u) { if (xb_ld(&(bar)[XB_TMO])) break; if (_sp > XB_SPIN_CAP) { atomicAdd(&(bar)[XB_TMO], 1u); break; } } } } while (0)

struct XcdBarrier {
    unsigned* bar; unsigned x;
    volatile LAS unsigned* st;
};

__device__ __forceinline__ XcdBarrier xcd_barrier_post(unsigned* bar, volatile LAS unsigned* st) {
    XcdBarrier b; b.bar = bar; b.x = xb_xcc_id(); b.st = st;
    if (threadIdx.x == 0) (void)xb_add(&bar[XB_XCNT(b.x)], 1u);
    return b;
}
__device__ __forceinline__ void xcd_barrier_complete(unsigned* bar, unsigned x, unsigned& nloc, unsigned& nx) {
    const unsigned G = gridDim.x * gridDim.y * gridDim.z;
    unsigned sum, cnt, mine, sp = 0u;
    for (;;) {
        sum = 0u; cnt = 0u; mine = 0u;
#pragma unroll
        for (unsigned j = 0; j < 16; ++j) { const unsigned c = xb_ld(&bar[XB_XCNT(j)]); sum += c; cnt += (c > 0u) ? 1u : 0u; mine = (j == x) ? c : mine; }
        if (sum == G) break;
        __builtin_amdgcn_s_sleep(1);
        if ((++sp & 255u) == 0u) { if (xb_ld(&bar[XB_TMO])) break; if (sp > XB_SPIN_CAP) { atomicAdd(&bar[XB_TMO], 1u); break; } }
    }
    nloc = mine > 0u ? mine : 1u; nx = cnt > 0u ? cnt : 1u;
}

__device__ __forceinline__ void xcd_barrier(const XcdBarrier& b, const int wave_s) {
    asm volatile("s_waitcnt vmcnt(0)" ::: "memory");
    __syncthreads();
    unsigned lane_; asm volatile("v_mbcnt_lo_u32_b32 %0, -1, 0\n\tv_mbcnt_hi_u32_b32 %0, -1, %0" : "=v"(lane_));
    if (wave_s == 0 && lane_ == 0u) {
        unsigned* bar = b.bar; asm volatile("" : "+s"(bar));
        __builtin_amdgcn_s_waitcnt(0);
        unsigned nloc = b.st[0], nx = b.st[1];
        if (nloc == 0u) { xcd_barrier_complete(bar, b.x, nloc, nx); b.st[0] = nloc; b.st[1] = nx; }
        const unsigned old = xb_add(&bar[XB_XSUB(b.x)], 1u);
        const unsigned gen = old / nloc;
        if (old + 1u == (gen + 1u) * nloc) {
            __builtin_amdgcn_fence(__ATOMIC_RELEASE, "agent");
            asm volatile("s_waitcnt vmcnt(0)" ::: "memory");
            const unsigned og = xb_add(&bar[XB_TOP], 1u);
            const unsigned tg = og / nx;
            if (og + 1u == (tg + 1u) * nx) xb_add(&bar[XB_TOPGEN], 1u);
            else XB_SPIN(xb_ld(&bar[XB_TOPGEN]) == tg, bar);
            __builtin_amdgcn_fence(__ATOMIC_ACQUIRE, "agent");
            xb_add(&bar[XB_XGEN(b.x)], 1u);
            asm volatile("s_waitcnt vmcnt(0)" ::: "memory");
        } else {
            XB_SPIN(xb_ld(&bar[XB_XGEN(b.x)]) == gen, bar);
            __builtin_amdgcn_fence(__ATOMIC_ACQUIRE, "agent");
            asm volatile("s_waitcnt vmcnt(0)" ::: "memory");
        }
    }
    __syncthreads();
}

struct Args { const float* in[21]; float* out; unsigned char* ws; int ph_lo, ph_hi; };
#define CAS __attribute__((address_space(4)))
struct KA { const CAS char* p;
    __device__ __forceinline__ const float* in(int k) const { return *(const float* const CAS*)(p + 8 * k); }
    __device__ __forceinline__ float* out() const { return *(float* const CAS*)(p + 8 * 21); }
    __device__ __forceinline__ unsigned char* ws() const { return *(unsigned char* const CAS*)(p + 8 * 22); }
    __device__ __forceinline__ int ph_lo() const { return *(const CAS int*)(p + 8 * 23); }
    __device__ __forceinline__ int ph_hi() const { return *(const CAS int*)(p + 8 * 23 + 4); }
};
__device__ __forceinline__ KA karg_fresh() { const CAS char* q = (const CAS char*)__builtin_amdgcn_kernarg_segment_ptr(); asm volatile("" : "+s"(q)); KA k; k.p = q; return k; }
struct Frame {
    LAS unsigned char* lds; volatile LAS unsigned* MISC; gu32* ctl;
    int tid, lane, wave, vcu, G, bx;
};
typedef unsigned long long u64;
typedef float f32x16 __attribute__((ext_vector_type(16)));
template <int CTRL> __device__ __forceinline__ float dpp_mov(float v) { return __builtin_bit_cast(float, __builtin_amdgcn_update_dpp(0, __builtin_bit_cast(int, v), CTRL, 0xF, 0xF, true)); }
__device__ __forceinline__ float row8_sum(float v) { v += dpp_mov<0xB1>(v); v += dpp_mov<0x4E>(v); v += dpp_mov<0x141>(v); return v; }
__device__ __forceinline__ float wave_sum(float v, int) { v = row8_sum(v); v += dpp_mov<0x140>(v);
    v += __builtin_bit_cast(float, __builtin_amdgcn_update_dpp(0, __builtin_bit_cast(int, v), 0x142, 0xA, 0xF, false));
    v += __builtin_bit_cast(float, __builtin_amdgcn_update_dpp(0, __builtin_bit_cast(int, v), 0x143, 0xC, 0xF, false));
    return __builtin_bit_cast(float, __builtin_amdgcn_readlane(__builtin_bit_cast(int, v), 63)); }
__device__ __forceinline__ float bf2f(unsigned b) { return __uint_as_float(b << 16); }
__device__ __forceinline__ float bflo(unsigned w) { return __uint_as_float(w << 16); }
__device__ __forceinline__ float bfhi(unsigned w) { return __uint_as_float(w & 0xffff0000u); }
__device__ __forceinline__ float fexp(float x) { return __builtin_amdgcn_exp2f(1.4426950408889634f * x); }
__device__ __forceinline__ float sigmoid_f(float x) { return __builtin_amdgcn_rcpf(1.0f + fexp(-x)); }
__device__ __forceinline__ unsigned pkbf(float lo, float hi) { return pg8::cvt_pk_bf16(lo, hi); }
typedef _Float16 f16x2_t __attribute__((ext_vector_type(2))); typedef float f32x2_t2 __attribute__((ext_vector_type(2)));
__device__ __forceinline__ unsigned pkh(float lo, float hi) { const f32x2_t2 v = {lo, hi}; return __builtin_bit_cast(unsigned, __builtin_convertvector(v, f16x2_t)); }
__device__ __forceinline__ f32x4 unpk_h4(u64 w) { const f16x2_t a = __builtin_bit_cast(f16x2_t, (unsigned)w), b = __builtin_bit_cast(f16x2_t, (unsigned)(w >> 32)); return (f32x4){(float)a[0], (float)a[1], (float)b[0], (float)b[1]}; }
__device__ __forceinline__ int swap23(int p) { return (p & ~12) | ((p & 4) << 1) | ((p & 8) >> 1); }
__device__ __forceinline__ int crow16(int i, int hh) { return (i & 3) + 8 * (i >> 2) + 4 * hh; }

struct MapId { __device__ __forceinline__ int operator()(int n) const { return n; } };
struct MapW13 { int add; __device__ __forceinline__ int operator()(int u) const { return ((u >> 7) << 8) + add + (u & 127); } };
struct MapHgrnIn { __device__ __forceinline__ int operator()(int n) const { return (n < 2048) ? ((n & ~1023) | swap23(n & 1023)) : n; } };
struct MapAttnIn { __device__ __forceinline__ int operator()(int n) const { if (n >= 2048) return n; const int part = n >> 10, c = n & 1023, hm = c >> 6, dim = c & 63;
    return part * 1024 + (hm >> 2) * 256 + (dim >> 5) * 128 + (hm & 3) * 32 + (dim & 31); } };
template <class MapF>
__device__ __forceinline__ void transpose_item(const float* W, int K, int N, bf16* WT, LAS float* scr, int item, int lane, MapF map) {
    const int nblk = N / 32, kb = item / nblk, nb = item % nblk, k0 = 64 * kb, n0 = 32 * nb;
#pragma unroll 8
    for (int i = 0; i < 32; ++i) { const int kk = 2 * i + (lane >> 5); scr[kk * 33 + (lane & 31)] = W[(size_t)(k0 + kk) * N + n0 + (lane & 31)]; }
    LDS_WAIT(); asm volatile("" ::: "memory");
    const int c = lane & 7;
#pragma unroll
    for (int j = 0; j < 4; ++j) { const int n = (lane >> 3) + 8 * j; const LAS float* s = scr + (8 * c) * 33 + n;
        v4u o; o.x = pkbf(s[0 * 33], s[1 * 33]); o.y = pkbf(s[2 * 33], s[3 * 33]); o.z = pkbf(s[4 * 33], s[5 * 33]); o.w = pkbf(s[6 * 33], s[7 * 33]);
        *(GAS v4u*)(WT + (size_t)map(n0 + n) * K + k0 + 8 * c) = o; }
    LDS_WAIT(); asm volatile("" ::: "memory");
}
__device__ __forceinline__ unsigned char* moe_wbuf(unsigned char* ws, int L) { return (L & 1) ? ws + WS_WB2 : ws + WS_W13; }
struct ConvItem { const float* W; bf16* WT; int K, N, k0, n0, add; };
__device__ __forceinline__ ConvItem conv_item(const KA a, int L, int it) {
    const int e = it / 768, r = it % 768; const size_t eo = (size_t)(L * 32 + e) * 1024 * 512; ConvItem c;
    bf16* W13 = (bf16*)moe_wbuf(a.ws(), L) + (size_t)e * 1024 * 1024; bf16* W2 = (bf16*)(moe_wbuf(a.ws(), L) + 64 * MiB) + (size_t)e * 1024 * 512;
    if (r < 512) { const int rr = r & 255; c.W = (r < 256 ? a.in(18) : a.in(19)) + eo; c.WT = W13; c.K = 1024; c.N = 512; c.k0 = 64 * (rr >> 4); c.n0 = 32 * (rr & 15); c.add = (r < 256) ? 0 : 128; }
    else { const int rr = r - 512; c.W = a.in(20) + eo; c.WT = W2; c.K = 512; c.N = 1024; c.k0 = 64 * (rr >> 5); c.n0 = 32 * (rr & 31); c.add = -1; }
    return c;
}
__device__ __forceinline__ void conv_load(const ConvItem& c, int lane, f32x4 (&v)[8]) {
#pragma unroll
    for (int i = 0; i < 8; ++i) v[i] = *(const f32x4*)(c.W + (size_t)(c.k0 + 8 * (lane >> 3) + i) * c.N + c.n0 + 4 * (lane & 7));
}
__device__ __forceinline__ void conv_store(const ConvItem& c, int lane, const f32x4 (&v)[8]) {
#pragma unroll
    for (int cc = 0; cc < 4; ++cc) { const int n = c.n0 + 4 * (lane & 7) + cc;
        const int row = (c.add == -1) ? n : (c.add == -2) ? MapHgrnIn{}(n) : (c.add == -3) ? MapAttnIn{}(n) : (((n >> 7) << 8) + c.add + (n & 127));
        v4u o; o.x = pkbf(v[0][cc], v[1][cc]); o.y = pkbf(v[2][cc], v[3][cc]); o.z = pkbf(v[4][cc], v[5][cc]); o.w = pkbf(v[6][cc], v[7][cc]);
        *(GAS v4u*)(c.WT + (size_t)row * c.K + c.k0 + 8 * (lane >> 3)) = o; }
}
constexpr int MIX_HIN = 16 * 128, MIX_OUT = 16 * 32, MIX_AIN = 16 * 96, MIX_PER = MIX_HIN + MIX_OUT + MIX_AIN + MIX_OUT, MIX_FIRST = MIX_HIN + MIX_OUT;
__device__ __forceinline__ ConvItem mix_item(const KA a, int it) {
    const int j = it / MIX_PER; int r = it % MIX_PER; ConvItem c; c.K = 1024;
    if (r < MIX_HIN) { c.W = a.in(6) + (size_t)j * 1024 * 4096; c.WT = (bf16*)(a.ws() + WS_WHIN) + (size_t)j * 4096 * 1024; c.N = 4096; c.add = -2; }
    else if ((r -= MIX_HIN) < MIX_OUT) { c.W = a.in(7) + (size_t)j * 1024 * 1024; c.WT = (bf16*)(a.ws() + WS_WHOUT) + (size_t)j * 1024 * 1024; c.N = 1024; c.add = -1; }
    else if ((r -= MIX_OUT) < MIX_AIN) { c.W = a.in(10) + (size_t)j * 1024 * 3072; c.WT = (bf16*)(a.ws() + WS_WAIN) + (size_t)j * 3072 * 1024; c.N = 3072; c.add = -3; }
    else { r -= MIX_AIN; c.W = a.in(11) + (size_t)j * 1024 * 1024; c.WT = (bf16*)(a.ws() + WS_WAOUT) + (size_t)j * 1024 * 1024; c.N = 1024; c.add = -1; }
    const int nblk = c.N / 32; c.k0 = 64 * (r / nblk); c.n0 = 32 * (r % nblk);
    return c;
}
__device__ __forceinline__ void convert_mixer(const KA a, int lane, int first, int last, int gw, int ngw) {
    for (int it = first + gw; it < last; it += ngw) { const ConvItem c = mix_item(a, it); f32x4 v[8]; conv_load(c, lane, v); conv_store(c, lane, v); }
}
__device__ __forceinline__ void convert_moe(Frame& F, const KA a, int L, int cw, int nconv) {
    const int gw = F.vcu * nconv + cw, NGW = F.G * nconv;
    if (gw >= 32 * 768) return;
    ConvItem cur = conv_item(a, L, gw); f32x4 v[8]; conv_load(cur, F.lane, v);
    for (int it = gw; it < 32 * 768; it += NGW) {
        const int nx = it + NGW; ConvItem nxt = cur; f32x4 vn[8];
        if (nx < 32 * 768) { nxt = conv_item(a, L, nx); conv_load(nxt, F.lane, vn); }
        conv_store(cur, F.lane, v);
        cur = nxt;
#pragma unroll
        for (int i = 0; i < 8; ++i) v[i] = vn[i];
    }
}

__device__ __forceinline__ void phase_p0a(Frame& F, const KA a) {
    const int gw = F.vcu * NWAVES + F.wave, NGW = F.G * NWAVES;
    const float* c = a.in(1); const float* ada_w = a.in(2); const float* ada_b = a.in(3);
    float* mod = (float*)(a.ws() + WS_MOD);
    if (F.vcu < 4 * 24) {
        LAS float* sl = (LAS float*)(F.lds + RING_OFF + 65536);
        for (int idx = F.tid; idx < 16 * 1024; idx += 512) { const int k = idx & 1023, b = idx >> 10; const float cv = c[idx]; sl[k * 16 + b] = cv * sigmoid_f(cv); }
        __syncthreads();
    }
    for (int it = F.vcu; it < 4 * 24; it += F.G) {
        const int i = it / 24, nb = it % 24;
        f32x4 acc[16];
#pragma unroll
        for (int b = 0; b < 16; ++b) acc[b] = (f32x4){0.f, 0.f, 0.f, 0.f};
        const float* wp = ada_w + ((size_t)i * 1024 + F.wave * 128) * 6144 + nb * 256 + 4 * F.lane;
        const LAS float* sw = (const LAS float*)(F.lds + RING_OFF + 65536) + F.wave * 128 * 16;
        for (int k0 = 0; k0 < 128; k0 += 16) {
            f32x4 w4[16];
#pragma unroll
            for (int kk = 0; kk < 16; ++kk) w4[kk] = *(const f32x4*)(wp + (size_t)(k0 + kk) * 6144);
            asm volatile("" ::: "memory");
#pragma unroll
            for (int kk = 0; kk < 16; ++kk) {
                const LAS f32x4* sp = (const LAS f32x4*)(sw + (k0 + kk) * 16);
                const f32x4 s0 = sp[0], s1 = sp[1], s2 = sp[2], s3 = sp[3];
#pragma unroll
                for (int b = 0; b < 4; ++b) { acc[b] += w4[kk] * s0[b]; acc[4 + b] += w4[kk] * s1[b]; acc[8 + b] += w4[kk] * s2[b]; acc[12 + b] += w4[kk] * s3[b]; }
            }
        }
        LAS float* red = (LAS float*)(F.lds + RING_OFF);
#pragma unroll
        for (int hb = 0; hb < 2; ++hb) {
#pragma unroll
            for (int b = 0; b < 8; ++b) *(LAS f32x4*)(red + (F.wave * 8 + b) * 256 + 4 * F.lane) = acc[8 * hb + b];
            __syncthreads();
            const float bias_ = ada_b[i * 6144 + nb * 256 + (F.tid & 255)];
            for (int r = 0; r < 4; ++r) { const int idx = F.tid + 512 * r, b = idx >> 8, col = idx & 255; float s = bias_;
#pragma unroll
                for (int w = 0; w < 8; ++w) s += red[(w * 8 + b) * 256 + col];
                mod[((size_t)i * 16 + 8 * hb + b) * 6144 + nb * 256 + col] = s; }
            __syncthreads();
        }
    }
    {
        float* cs = (float*)(a.ws() + WS_ROPE_C); float* sn = (float*)(a.ws() + WS_ROPE_S);
        for (int idx = gw * 64 + F.lane; idx < SEQ * 32; idx += NGW * 64) {
            const int pos = idx >> 5, j = idx & 31;
            double f = 1.0; const double r1 = 0.74989420933245582730;
            double p = r1;
#pragma unroll
            for (int bit = 0; bit < 5; ++bit) { if (j & (1 << bit)) f *= p; p *= p; }
            const double ang = (double)pos * f;
            const double kq = __builtin_rint(ang * 0.63661977236758134308);
            const double rr = (ang - kq * 1.57079632679489655800e+00) - kq * 6.12323399573676603587e-17;
            const double r2 = rr * rr;
            const double sp = rr * (1.0 + r2 * (-1.0 / 6 + r2 * (1.0 / 120 + r2 * (-1.0 / 5040 + r2 * (1.0 / 362880 + r2 * (-1.0 / 39916800 + r2 * (1.0 / 6227020800.0)))))));
            const double cp = 1.0 + r2 * (-0.5 + r2 * (1.0 / 24 + r2 * (-1.0 / 720 + r2 * (1.0 / 40320 + r2 * (-1.0 / 3628800 + r2 * (1.0 / 479001600.0 + r2 * (-1.0 / 87178291200.0)))))));
            const int q = ((int)kq) & 3;
            const double sv = (q == 0) ? sp : (q == 1) ? cp : (q == 2) ? -sp : -cp;
            const double cv = (q == 0) ? cp : (q == 1) ? -sp : (q == 2) ? -cp : sp;
            cs[idx] = (float)cv; sn[idx] = (float)sv;
        }
    }
    {
        float* rt = (float*)(a.ws() + WS_RT); const float* rgw = a.in(14); const float* rew = a.in(16);
        for (int idx = gw * 64 + F.lane; idx < 4 * 36 * 1024; idx += NGW * 64) {
            const int l = idx / 36864, e = (idx >> 10) % 36, k = idx & 1023;
            rt[idx] = (e < 4) ? rgw[((size_t)l * 1024 + k) * 4 + e] : rew[((size_t)l * 1024 + k) * 32 + (e - 4)];
        }
    }
    convert_mixer(a, F.lane, 0, MIX_FIRST, gw, NGW);
}

__device__ __forceinline__ void phase_p0b(Frame& F, const KA a) {
    const int gw = F.vcu * NWAVES + F.wave, NGW = F.G * NWAVES;
    const float* x = a.in(0); const float* mod = (const float*)(a.ws() + WS_MOD); bf16* h = (bf16*)(a.ws() + WS_BUF0);
#define P0B_LOAD(X, t_) do { _Pragma("unroll") for (int tt = 0; tt < 4; ++tt) _Pragma("unroll") for (int j = 0; j < 4; ++j) X[tt][j] = *(const f32x4*)(x + (size_t)((t_) + tt) * D + 4 * F.lane + 256 * j); } while (0)
#define P0B_PROC(X, t_) do { const float* mb = mod + (size_t)((t_) >> 12) * 6144; \
        _Pragma("unroll") for (int j = 0; j < 4; ++j) { const int col = 4 * F.lane + 256 * j; const f32x4 sh = *(const f32x4*)(mb + col), sc = *(const f32x4*)(mb + 1024 + col) + 1.0f; \
            _Pragma("unroll") for (int tt = 0; tt < 4; ++tt) { const f32x4 hv = X[tt][j] * sc + sh; \
                *(u64*)(h + (size_t)((t_) + tt) * D + col) = (u64)pkbf(hv[0], hv[1]) | ((u64)pkbf(hv[2], hv[3]) << 32); } } } while (0)
    const int step = NGW * 4;
    f32x4 xa[4][4], xb[4][4];
    int t0 = gw * 4;
    if (t0 < M) P0B_LOAD(xa, t0);
    for (; t0 < M; t0 += 2 * step) {
        const int t1 = t0 + step, t2 = t1 + step;
        if (t1 < M) P0B_LOAD(xb, t1);
        P0B_PROC(xa, t0);
        if (t2 < M) P0B_LOAD(xa, t2);
        if (t1 < M) P0B_PROC(xb, t1);
    }
#undef P0B_LOAD
#undef P0B_PROC
}

__device__ __forceinline__ void phase_hgrn_prep(Frame& F, const KA a, int j) {
    bf16* Qb = (bf16*)(a.ws() + WS_BUF0 + 1 * BUFSZ); bf16* Zb = (bf16*)(a.ws() + WS_BUF0 + 2 * BUFSZ);
    float* dd = (float*)(a.ws() + WS_HGD);
    const float* lb = a.in(8);
    const int grp = F.tid >> 7, jt = F.tid & 127, col = 8 * jt, h = col >> 7, pos = col & 127;
    const int ch0 = swap23(pos), ch1 = swap23(pos + 4);
    float oml[8];
#pragma unroll
    for (int c = 0; c < 8; ++c) oml[c] = 1.0f;
    if (j == 1) {
#pragma unroll
        for (int c = 0; c < 4; ++c) { oml[c] = 1.0f - sigmoid_f(lb[1024 + h * 128 + ch0 + c] - lb[h * 128 + ch0 + c]); oml[4 + c] = 1.0f - sigmoid_f(lb[1024 + h * 128 + ch1 + c] - lb[h * 128 + ch1 + c]); } }
    constexpr int NIT = BATCH * HG_NCH;
    float bs[8];
#define HP_IT(s_) (F.vcu + F.G * (grp + 4 * ((s_) >> 2)))
#define HP_LOAD(Z, Q, s_) do { int it_ = HP_IT(s_); it_ = (it_ < NIT) ? it_ : 0;        \
        const size_t tk_ = (size_t)(it_ >> 7) * SEQ + (it_ & (HG_NCH - 1)) * HG_CHUNK + 8 * ((s_) & 3); \
        _Pragma("unroll") for (int t = 0; t < 8; ++t) { Z[t] = *(const v4u*)(Zb + (tk_ + t) * D + col); Q[t] = *(const v4u*)(Qb + (tk_ + t) * D + col); } } while (0)
#define HP_PROC(Z, Q, s_) do { const int it_ = HP_IT(s_); const int chunk_ = it_ & (HG_NCH - 1), b_ = it_ >> 7; const size_t tk_ = (size_t)b_ * SEQ + chunk_ * HG_CHUNK + 8 * ((s_) & 3); \
        if (((s_) & 3) == 0) { _Pragma("unroll") for (int c = 0; c < 8; ++c) bs[c] = 0.f; } \
        _Pragma("unroll") for (int t = 0; t < 8; ++t) { v4u qo, ko; \
            _Pragma("unroll") for (int i = 0; i < 4; ++i) { \
                const float k0 = oml[2 * i] * sigmoid_f(-bflo(Z[t][i])), k1 = oml[2 * i + 1] * sigmoid_f(-bfhi(Z[t][i])); \
                const float g0 = (k0 < 0.05f) ? -k0 * (1.0f + k0 * (0.5f + k0 * (0.33333333f + k0 * 0.25f))) : 0.69314718056f * __builtin_amdgcn_logf(1.0f - k0); \
                const float g1 = (k1 < 0.05f) ? -k1 * (1.0f + k1 * (0.5f + k1 * (0.33333333f + k1 * 0.25f))) : 0.69314718056f * __builtin_amdgcn_logf(1.0f - k1); \
                bs[2 * i] += g0; bs[2 * i + 1] += g1; \
                qo[i] = pkbf(bflo(Q[t][i]) * fexp(bs[2 * i]), bfhi(Q[t][i]) * fexp(bs[2 * i + 1])); \
                ko[i] = pkbf(k0 * fexp(fminf(-bs[2 * i], 80.0f)), k1 * fexp(fminf(-bs[2 * i + 1], 80.0f))); } \
            *(v4u*)(Qb + (tk_ + t) * D + col) = qo; *(v4u*)(Zb + (tk_ + t) * D + col) = ko; } \
        if (((s_) & 3) == 3) { const size_t rowbase_ = ((size_t)(b_ * 8 + h) * HG_NCH + chunk_) * 128; \
            *(f32x4*)(dd + rowbase_ + ch0) = (f32x4){fexp(bs[0]), fexp(bs[1]), fexp(bs[2]), fexp(bs[3])}; *(f32x4*)(dd + rowbase_ + ch1) = (f32x4){fexp(bs[4]), fexp(bs[5]), fexp(bs[6]), fexp(bs[7])}; } } while (0)
    v4u za[8], qa[8], zb[8], qb[8];
    int s = 0;
    HP_LOAD(za, qa, 0);
    for (; HP_IT(s) < NIT; s += 2) {
        HP_LOAD(zb, qb, s + 1);
        HP_PROC(za, qa, s);
        HP_LOAD(za, qa, s + 2);
        HP_PROC(zb, qb, s + 1);
    }
#undef HP_IT
#undef HP_LOAD
#undef HP_PROC
}

#define MFMA32(a_, b_, c_) __builtin_amdgcn_mfma_f32_32x32x16_bf16((a_), (b_), (c_), 0, 0, 0)
typedef float f32x2_pk __attribute__((ext_vector_type(2))); typedef __bf16 bf16x2_pk __attribute__((ext_vector_type(2)));
__device__ __forceinline__ unsigned cvt2(float lo, float hi) { const f32x2_pk v = {lo, hi}; return __builtin_bit_cast(unsigned, __builtin_convertvector(v, bf16x2_pk)); }
__device__ __forceinline__ bf16x8 pack_half(const f32x16& x, int s) {
    v4u p; p.x = cvt2(x[8 * s + 0], x[8 * s + 1]); p.y = cvt2(x[8 * s + 2], x[8 * s + 3]); p.z = cvt2(x[8 * s + 4], x[8 * s + 5]); p.w = cvt2(x[8 * s + 6], x[8 * s + 7]);
    return __builtin_bit_cast(bf16x8, p);
}
constexpr int HS_Q = 0, HS_K = 8192, HS_V = 16384, HS_D = 18432, HS_BUF = 18944, HS_NBUF = 3, HS_WAVE = HS_NBUF * HS_BUF, HS_OST = 2 * HS_WAVE, HS_CONV = HS_OST + 4096, HS_NCONV = 6;
static_assert(HS_CONV <= RING_BYTES, "scan LDS map");
typedef short s16x4_t __attribute__((ext_vector_type(4)));
__device__ __forceinline__ void phase_hgrn_scan(Frame& F, const KA a, int layer) {
    const bf16* Qt = (const bf16*)(a.ws() + WS_BUF0 + 1 * BUFSZ); const bf16* Kt = (const bf16*)(a.ws() + WS_BUF0 + 2 * BUFSZ);
    const bf16* Vb = (const bf16*)(a.ws() + WS_BUF0 + 3 * BUFSZ); const float* dd = (const float*)(a.ws() + WS_HGD);
    bf16* O = (bf16*)(a.ws() + WS_BUF0 + 6 * BUFSZ);
    const int sw = F.wave >> 1;
    if (F.wave != 0 && F.wave != 2) {
        const int cw = (F.wave == 1) ? 0 : (F.wave == 3) ? 1 : F.wave - 2;
        if (cw < HS_NCONV) { if (layer == 0) convert_mixer(a, F.lane, MIX_FIRST, 2 * MIX_PER, F.vcu * HS_NCONV + cw, F.G * HS_NCONV);
            convert_moe(F, a, layer, cw, HS_NCONV); convert_moe(F, a, layer + 1, cw, HS_NCONV); }
        return; }
    LAS unsigned char* ring = F.lds + RING_OFF + sw * HS_WAVE;
    LAS unsigned char* ost = F.lds + RING_OFF + HS_OST + sw * 2048;
    for (int u = F.vcu; u < BATCH * 8 * 2; u += F.G) {
        const int bh = u >> 1, vt = (u & 1) * 2 + sw, b = bh >> 3, h = bh & 7;
        const int r = F.lane & 31, hh = F.lane >> 5;
        f32x16 S[4];
#pragma unroll
        for (int kt = 0; kt < 4; ++kt)
#pragma unroll
            for (int i = 0; i < 16; ++i) S[kt][i] = 0.f;
        const bf16* Qp = Qt + ((size_t)b * SEQ + r) * D + h * 128 + 8 * hh;
        const bf16* Kp = Kt + ((size_t)b * SEQ + r) * D + h * 128 + 8 * hh;
        const bf16* Vp = Vb + ((size_t)b * SEQ + (F.lane >> 2)) * D + h * 128 + 32 * vt + 8 * (F.lane & 3);
        const float* dp = dd + (size_t)bh * HG_NCH * 128 + F.lane;
        bf16* op2 = O + ((size_t)b * SEQ + 4 * hh) * D + h * 128 + 32 * vt + r;
        const int i16 = F.lane & 15, blk = (F.lane >> 4) & 1, tq = i16 >> 2, tp = i16 & 3, tpp = ((tp & 1) << 1) | (tp >> 1);
        const int trb = HS_K + blk * 1024 + (tpp >> 1) * 512 + (4 * hh + tq) * 16 + (tpp & 1) * 8;
        const int vtrb = HS_V + (4 * hh + tq) * 64 + 32 * blk + 8 * tp;
#define HS_DMA(c_, buf_) do { LAS unsigned char* bb_ = ring + (buf_) * HS_BUF; \
        _Pragma("unroll") for (int ks = 0; ks < 8; ++ks) { __builtin_amdgcn_global_load_lds((const unsigned*)(Qp + (size_t)(c_) * 32 * D + 16 * ks), (LAS unsigned*)(bb_ + HS_Q + ks * 1024), 16, 0, 0); \
                                                        __builtin_amdgcn_global_load_lds((const unsigned*)(Kp + (size_t)(c_) * 32 * D + 16 * ks), (LAS unsigned*)(bb_ + HS_K + ks * 1024), 16, 0, 0); } \
        _Pragma("unroll") for (int st = 0; st < 2; ++st) __builtin_amdgcn_global_load_lds((const unsigned*)(Vp + ((size_t)(c_) * 32 + 16 * st) * D), (LAS unsigned*)(bb_ + HS_V + st * 1024), 16, 0, 0); \
        _Pragma("unroll") for (int q_ = 0; q_ < 2; ++q_) __builtin_amdgcn_global_load_lds((const unsigned*)(dp + (size_t)(c_) * 128 + 64 * q_), (LAS unsigned*)(bb_ + HS_D + q_ * 256), 4, 0, 0); } while (0)
        asm volatile("s_waitcnt lgkmcnt(0)" ::: "memory");
        HS_DMA(0, 0); HS_DMA(1, 1);
        int bcur = 0, bnext = 2;
        for (int c = 0; c < HG_NCH; ++c) {
            const int cn = (c + 2 < HG_NCH) ? c + 2 : HG_NCH - 1;
            HS_DMA(cn, bnext);
            if (c == 0) asm volatile("s_waitcnt vmcnt(40)" ::: "memory");
            else asm volatile("s_waitcnt vmcnt(56)" ::: "memory");
            const LAS unsigned char* bbase = ring + bcur * HS_BUF;
            const LAS unsigned char* bb = bbase + F.lane * 16;
            bf16x8 Qf[8], Kf[8], Vf[2];
            { const unsigned vba = (unsigned)(uintptr_t)(bbase + vtrb); s16x4_t v0, v1, v2, v3;
              asm volatile("ds_read_b64_tr_b16 %0, %1 offset:0" : "=&v"(v0) : "v"(vba) : "memory"); asm volatile("ds_read_b64_tr_b16 %0, %1 offset:512" : "=&v"(v1) : "v"(vba) : "memory");
              asm volatile("ds_read_b64_tr_b16 %0, %1 offset:1024" : "=&v"(v2) : "v"(vba) : "memory"); asm volatile("ds_read_b64_tr_b16 %0, %1 offset:1536" : "=&v"(v3) : "v"(vba) : "memory");
#pragma unroll
              for (int ks = 0; ks < 8; ++ks) { Qf[ks] = *(const LAS bf16x8*)(bb + HS_Q + ks * 1024); Kf[ks] = *(const LAS bf16x8*)(bb + HS_K + ks * 1024); }
              asm volatile("s_waitcnt lgkmcnt(0)" : "+v"(v0), "+v"(v1), "+v"(v2), "+v"(v3) :: "memory");
              Vf[0] = (bf16x8){v0[0], v0[1], v0[2], v0[3], v1[0], v1[1], v1[2], v1[3]}; Vf[1] = (bf16x8){v2[0], v2[1], v2[2], v2[3], v3[0], v3[1], v3[2], v3[3]}; }
            f32x16 sc0, sc1;
#pragma unroll
            for (int i = 0; i < 16; ++i) { sc0[i] = 0.f; sc1[i] = 0.f; }
#pragma unroll
            for (int ks = 0; ks < 8; ks += 2) { sc0 = MFMA32(Kf[ks], Qf[ks], sc0); sc1 = MFMA32(Kf[ks + 1], Qf[ks + 1], sc1); }
#pragma unroll
            for (int i = 0; i < 16; ++i) sc0[i] = (crow16(i, hh) > r) ? 0.f : (sc0[i] + sc1[i]);
            f32x16 oA, oB;
#pragma unroll
            for (int i = 0; i < 16; ++i) { oA[i] = 0.f; oB[i] = 0.f; }
#pragma unroll
            for (int kt = 0; kt < 4; kt += 2)
#pragma unroll
                for (int st = 0; st < 2; ++st) { oA = MFMA32(Qf[2 * kt + st], pack_half(S[kt], st), oA); oB = MFMA32(Qf[2 * kt + 2 + st], pack_half(S[kt + 1], st), oB); }
            oA = MFMA32(pack_half(sc0, 0), Vf[0], oA); oB = MFMA32(pack_half(sc0, 1), Vf[1], oB);
            const LAS float* dl = (const LAS float*)(bbase + HS_D) + 4 * hh;
            const unsigned tba = (unsigned)(uintptr_t)(bbase + trb);
            s16x4_t klo[8], khi[8];
#pragma unroll
            for (int f = 0; f < 8; ++f) {
                asm volatile("ds_read_b64_tr_b16 %0, %1 offset:%c2" : "=&v"(klo[f]) : "v"(tba), "i"((f >> 1) * 2048 + (f & 1) * 256) : "memory");
                asm volatile("ds_read_b64_tr_b16 %0, %1 offset:%c2" : "=&v"(khi[f]) : "v"(tba), "i"((f >> 1) * 2048 + (f & 1) * 256 + 128) : "memory"); }
            asm volatile("s_waitcnt lgkmcnt(0)" : "+v"(klo[0]), "+v"(klo[1]), "+v"(klo[2]), "+v"(klo[3]), "+v"(klo[4]), "+v"(klo[5]), "+v"(klo[6]), "+v"(klo[7]) :: "memory");
            asm volatile("" : "+v"(khi[0]), "+v"(khi[1]), "+v"(khi[2]), "+v"(khi[3]), "+v"(khi[4]), "+v"(khi[5]), "+v"(khi[6]), "+v"(khi[7]) :: "memory");
#pragma unroll
            for (int kt = 0; kt < 4; ++kt) {
#pragma unroll
                for (int st = 0; st < 2; ++st) { const int f = kt * 2 + st;
                    const bf16x8 kh = (bf16x8){klo[f][0], klo[f][1], klo[f][2], klo[f][3], khi[f][0], khi[f][1], khi[f][2], khi[f][3]};
                    S[kt] = MFMA32(kh, Vf[st], S[kt]); }
#pragma unroll
                for (int g = 0; g < 4; ++g) { const f32x4 dv = *(const LAS f32x4*)(dl + 32 * kt + 8 * g);
#pragma unroll
                    for (int i = 0; i < 4; ++i) S[kt][4 * g + i] *= dv[i]; }
            }
#pragma unroll
            for (int i = 0; i < 16; ++i) *(unsigned short*)(op2 + ((size_t)c * 32 + crow16(i, 0)) * D) = (unsigned short)(pkbf(oA[i] + oB[i], 0.f) & 0xffffu);
            asm volatile("s_waitcnt lgkmcnt(0)" ::: "memory");
            bcur = (bcur == HS_NBUF - 1) ? 0 : bcur + 1; bnext = (bnext == HS_NBUF - 1) ? 0 : bnext + 1;
        }
        asm volatile("s_waitcnt vmcnt(0)" ::: "memory");
#undef HS_DMA
    }
}

template <int MODE>
__device__ __forceinline__ void phase_normgate(Frame& F, const bf16* P0, const bf16* P1, bf16* out, const float* w, float lam, float mul) {
    const int gw = F.vcu * NWAVES + F.wave, NGW = F.G * NWAVES;
    float wv[16];
#pragma unroll
    for (int i = 0; i < 16; ++i) wv[i] = w[((16 * F.lane) & 127) + i] * mul;
    const int tpw = ((M + NGW - 1) / NGW + 3) & ~3;
#define NG_LOAD(A0, A1, B0, B1, t_) do { _Pragma("unroll") for (int tt = 0; tt < 4; ++tt) { const size_t off = (size_t)((t_) + tt) * D + 16 * F.lane; \
        A0[tt] = *(const v4u*)(P0 + off); A1[tt] = *(const v4u*)(P0 + off + 8); B0[tt] = *(const v4u*)(P1 + off); B1[tt] = *(const v4u*)(P1 + off + 8); } } while (0)
#define NG_PROC(A0, A1, B0, B1, t_) do { _Pragma("unroll") for (int tt = 0; tt < 4; ++tt) { \
            float av[16], bv[16]; \
            _Pragma("unroll") for (int i = 0; i < 4; ++i) { av[2 * i] = bflo(A0[tt][i]); av[2 * i + 1] = bfhi(A0[tt][i]); av[8 + 2 * i] = bflo(A1[tt][i]); av[8 + 2 * i + 1] = bfhi(A1[tt][i]); \
                                          bv[2 * i] = bflo(B0[tt][i]); bv[2 * i + 1] = bfhi(B0[tt][i]); bv[8 + 2 * i] = bflo(B1[tt][i]); bv[8 + 2 * i + 1] = bfhi(B1[tt][i]); } \
            float ss = 0.f; \
            _Pragma("unroll") for (int i = 0; i < 16; ++i) { if (MODE == 1) av[i] = av[i] - lam * bv[i]; ss += av[i] * av[i]; } \
            ss = row8_sum(ss); \
            const float rs = 1.0f / sqrtf(ss * (1.0f / 128.0f) + LN_EPS); \
            v4u o0, o1; \
            _Pragma("unroll") for (int i = 0; i < 8; ++i) { float v0 = av[2 * i] * rs * wv[2 * i], v1 = av[2 * i + 1] * rs * wv[2 * i + 1]; \
                if (MODE == 0) { v0 *= bv[2 * i] * sigmoid_f(bv[2 * i]); v1 *= bv[2 * i + 1] * sigmoid_f(bv[2 * i + 1]); } \
                if (i < 4) o0[i] = pkbf(v0, v1); else o1[i - 4] = pkbf(v0, v1); } \
            const size_t off = (size_t)((t_) + tt) * D + 16 * F.lane; \
            *(v4u*)(out + off) = o0; *(v4u*)(out + off + 8) = o1; } } while (0)
    const int tend = ((gw + 1) * tpw < M) ? (gw + 1) * tpw : M;
    v4u a0[4], a1[4], b0[4], b1[4], c0[4], c1[4], e0[4], e1[4];
    int t0 = gw * tpw;
    if (t0 < tend) NG_LOAD(a0, a1, b0, b1, t0);
    for (; t0 < tend; t0 += 8) {
        if (t0 + 4 < tend) NG_LOAD(c0, c1, e0, e1, t0 + 4);
        NG_PROC(a0, a1, b0, b1, t0);
        if (t0 + 8 < tend) NG_LOAD(a0, a1, b0, b1, t0 + 8);
        if (t0 + 4 < tend) NG_PROC(c0, c1, e0, e1, t0 + 4);
    }
#undef NG_LOAD
#undef NG_PROC
}

__device__ __forceinline__ void phase_l1(Frame& F, const KA a, int layer, const float* xin, const bool dry) {
    const int gw = F.vcu * NWAVES + F.wave, NGW = F.G * NWAVES;
    LAS float* Wr = (LAS float*)(F.lds + RING_OFF);
    LAS unsigned* hist = (LAS unsigned*)(F.lds + LDSCTL_OFF);
    { const f32x4* src = (const f32x4*)((const float*)(a.ws() + WS_RT) + (size_t)layer * 36 * 1024);
      f32x4 tmp[18];
#pragma unroll
      for (int k = 0; k < 18; ++k) tmp[k] = src[F.tid + 512 * k];
#pragma unroll
      for (int k = 0; k < 18; ++k) *(LAS f32x4*)(Wr + 4 * (F.tid + 512 * k)) = tmp[k];
      if (F.tid < 32) hist[F.tid] = 0u; }
    __syncthreads();
    const float* mod = (const float*)(a.ws() + WS_MOD) + (size_t)layer * 16 * 6144;
    const bf16* yb = (const bf16*)(a.ws() + WS_BUF0 + 1 * BUFSZ);
    bf16* h2 = (bf16*)(a.ws() + WS_BUF0);
    const float* lng = a.in(4) + (size_t)(layer * 2 + 0) * D; const float* lnb = a.in(5) + (size_t)(layer * 2 + 0) * D;
    const float* bg = a.in(15) + layer * 4; const float* be = a.in(17) + layer * 32;
    int* eid = (int*)(a.ws() + WS_EID); float* wt = (float*)(a.ws() + WS_WT);
    const unsigned short* xhin = (const unsigned short*)a.out();
    unsigned short* xhout = (unsigned short*)(a.ws() + WS_BUF0 + 1 * BUFSZ);
    const int tpw = ((M + NGW - 1) / NGW + 3) & ~3;
    int curb = -1; f32x4 g1v[4], lgv[4], lbv[4], scv[4], shv[4];
    for (int t0 = gw * tpw; t0 < (gw + 1) * tpw && t0 < M; t0 += 4) {
        const int b = t0 >> 12;
        if (b != curb) { curb = b; const float* mb = mod + (size_t)b * 6144;
#pragma unroll
            for (int j = 0; j < 4; ++j) { const int col = 4 * F.lane + 256 * j; g1v[j] = *(const f32x4*)(mb + 2048 + col); lgv[j] = *(const f32x4*)(lng + col); lbv[j] = *(const f32x4*)(lnb + col);
                scv[j] = *(const f32x4*)(mb + 4096 + col) + 1.0f; shv[j] = *(const f32x4*)(mb + 3072 + col); } }
        f32x4 hv[4][4];
        {
            f32x4 v[4][4]; float s[4] = {0.f, 0.f, 0.f, 0.f};
            u64 yw[4][4];
#pragma unroll
            for (int j = 0; j < 4; ++j)
#pragma unroll
                for (int tt = 0; tt < 4; ++tt) yw[tt][j] = *(const u64*)(yb + (size_t)(t0 + tt) * D + 4 * F.lane + 256 * j);
            if (layer == 0) {
#pragma unroll
                for (int j = 0; j < 4; ++j)
#pragma unroll
                    for (int tt = 0; tt < 4; ++tt) v[tt][j] = *(const f32x4*)(xin + (size_t)(t0 + tt) * D + 4 * F.lane + 256 * j);
            } else { u64 xr[4][4];
#pragma unroll
                for (int j = 0; j < 4; ++j)
#pragma unroll
                    for (int tt = 0; tt < 4; ++tt) xr[tt][j] = *(const u64*)(xhin + (size_t)(t0 + tt) * D + 4 * F.lane + 256 * j);
#pragma unroll
                for (int j = 0; j < 4; ++j)
#pragma unroll
                    for (int tt = 0; tt < 4; ++tt) v[tt][j] = unpk_h4(xr[tt][j]);
            }
#pragma unroll
            for (int j = 0; j < 4; ++j) { const f32x4 g1 = g1v[j];
#pragma unroll
                for (int tt = 0; tt < 4; ++tt) { const u64 y_ = yw[tt][j];
                    f32x4 yv; yv[0] = bflo((unsigned)y_); yv[1] = bfhi((unsigned)y_); yv[2] = bflo((unsigned)(y_ >> 32)); yv[3] = bfhi((unsigned)(y_ >> 32));
                    v[tt][j] = v[tt][j] * DN_ALPHA + g1 * yv; s[tt] += (v[tt][j][0] + v[tt][j][1]) + (v[tt][j][2] + v[tt][j][3]); } }
            float rstd[4];
#pragma unroll
            for (int tt = 0; tt < 4; ++tt) { const float mean = wave_sum(s[tt], F.lane) * (1.0f / D); float s2 = 0.f;
#pragma unroll
                for (int j = 0; j < 4; ++j) { v[tt][j] = v[tt][j] - mean; s2 += (v[tt][j][0] * v[tt][j][0] + v[tt][j][1] * v[tt][j][1]) + (v[tt][j][2] * v[tt][j][2] + v[tt][j][3] * v[tt][j][3]); }
                rstd[tt] = __builtin_amdgcn_rsqf(wave_sum(s2, F.lane) * (1.0f / D) + LN_EPS); }
#pragma unroll
            for (int j = 0; j < 4; ++j) { const int col = 4 * F.lane + 256 * j;
                const f32x4 lg_ = lgv[j], lb_ = lbv[j], sc2 = scv[j], sh2 = shv[j];
#pragma unroll
                for (int tt = 0; tt < 4; ++tt) { const size_t ro = (size_t)(t0 + tt) * D;
                    const f32x4 xo = v[tt][j] * rstd[tt] * lg_ + lb_;
                    *(u64*)(xhout + ro + col) = (u64)pkh(xo[0], xo[1]) | ((u64)pkh(xo[2], xo[3]) << 32);
                    const f32x4 hh2 = xo * sc2 + sh2; hv[tt][j] = hh2;
                    *(u64*)(h2 + ro + col) = (u64)pkbf(hh2[0], hh2[1]) | ((u64)pkbf(hh2[2], hh2[3]) << 32); } }
        }
        float gl[4][4];
        { f32x4 w[4][4];
#pragma unroll
          for (int g = 0; g < 4; ++g)
#pragma unroll
              for (int j = 0; j < 4; ++j) w[g][j] = *(const LAS f32x4*)(Wr + g * 1024 + 4 * F.lane + 256 * j);
#pragma unroll
          for (int tt = 0; tt < 4; ++tt)
#pragma unroll
              for (int g = 0; g < 4; ++g) { float s0 = 0.f;
#pragma unroll
                  for (int j = 0; j < 4; ++j) s0 += (hv[tt][j][0] * w[g][j][0] + hv[tt][j][1] * w[g][j][1]) + (hv[tt][j][2] * w[g][j][2] + hv[tt][j][3] * w[g][j][3]);
                  gl[tt][g] = wave_sum(s0, F.lane) + bg[g]; } }
#pragma unroll
        for (int tt = 0; tt < 4; ++tt) {
            int gi = 0; float gm = gl[tt][0];
#pragma unroll
            for (int g = 1; g < 4; ++g) if (gl[tt][g] > gm) { gm = gl[tt][g]; gi = g; }
            float gs = 0.f;
#pragma unroll
            for (int g = 0; g < 4; ++g) gs += fexp(gl[tt][g] - gm);
            const float gw_ = __builtin_amdgcn_rcpf(gs);
            gi = __builtin_amdgcn_readfirstlane(gi);
            float el[8];
#pragma unroll
            for (int half = 0; half < 2; ++half) { f32x4 w[4][4]; const LAS float* wrow = Wr + (4 + gi * 8 + half * 4) * 1024 + 4 * F.lane;
#pragma unroll
                for (int q = 0; q < 4; ++q)
#pragma unroll
                    for (int j = 0; j < 4; ++j) w[q][j] = *(const LAS f32x4*)(wrow + q * 1024 + 256 * j);
#pragma unroll
                for (int q = 0; q < 4; ++q) { float s0 = 0.f;
#pragma unroll
                    for (int j = 0; j < 4; ++j) s0 += (hv[tt][j][0] * w[q][j][0] + hv[tt][j][1] * w[q][j][1]) + (hv[tt][j][2] * w[q][j][2] + hv[tt][j][3] * w[q][j][3]);
                    el[half * 4 + q] = wave_sum(s0, F.lane) + be[gi * 8 + half * 4 + q]; } }
            int i0 = 0; float m0 = el[0];
#pragma unroll
            for (int q = 1; q < 8; ++q) if (el[q] > m0) { m0 = el[q]; i0 = q; }
            int i1 = -1; float m1 = -INFINITY;
#pragma unroll
            for (int q = 0; q < 8; ++q) if (q != i0 && el[q] > m1) { m1 = el[q]; i1 = q; }
            const float p1 = fexp(m1 - m0); const float rr_ = __builtin_amdgcn_rcpf(1.0f + p1); const float w0 = gw_ * rr_, w1 = gw_ * p1 * rr_;
            if (F.lane == 0) { const int e0 = gi * 8 + i0, e1 = gi * 8 + i1, tok = t0 + tt;
                *(int2*)(eid + 2 * tok) = make_int2(e0, e1); *(float2*)(wt + 2 * tok) = make_float2(w0, w1);
                __hip_atomic_fetch_add(&hist[e0], 1u, __ATOMIC_RELAXED, __HIP_MEMORY_SCOPE_WORKGROUP); __hip_atomic_fetch_add(&hist[e1], 1u, __ATOMIC_RELAXED, __HIP_MEMORY_SCOPE_WORKGROUP); }
        }
    }
    __syncthreads();
    if (F.tid < 32 && !dry) { const unsigned c = hist[F.tid]; if (c) __hip_atomic_fetch_add(F.ctl + CW_CNT + 256 * layer + F.tid, c, RLX_AGENT); }
}

__device__ __forceinline__ void phase_m2(Frame& F, const KA a, int layer) {
    LAS int* pstart = (LAS int*)(F.lds + RING_OFF);
    LAS unsigned* lhist = (LAS unsigned*)(F.lds + RING_OFF + 256);
    LAS int* lbase = (LAS int*)(F.lds + RING_OFF + 512);
    int* blk_e = (int*)(a.ws() + WS_BLKE) + layer * 1024;
    LAS int* cntl = (LAS int*)(F.lds + RING_OFF + 768);
    if (F.tid < 32) cntl[F.tid] = (int)__hip_atomic_load(F.ctl + CW_CNT + 256 * layer + F.tid, RLX_AGENT);
    __syncthreads();
    if (F.tid == 0) { int off = 0;
#pragma unroll 1
        for (int e = 0; e < 32; ++e) { pstart[e] = off; off += ((cntl[e] + 255) >> 8) << 8; }
        pstart[32] = off;
        if (F.bx == 0) __hip_atomic_store(F.ctl + CW_CNT + 256 * layer + 128, (unsigned)(off >> 8), RLX_AGENT); }
    __syncthreads();
    if (F.bx == 0) { const int nblk = pstart[32] >> 8;
        for (int blk = F.tid; blk < nblk; blk += NWAVES * 64) { int e = 0;
#pragma unroll 1
            for (int k = 1; k < 32; ++k) e = (pstart[k] <= blk * 256) ? k : e;
            blk_e[blk] = e; } }
    const int* eid = (const int*)(a.ws() + WS_EID); const float* wt = (const float*)(a.ws() + WS_WT);
    int* tslot = (int*)(a.ws() + WS_TSLOT); float* slotw = (float*)(a.ws() + WS_SLOTW);
    int* stok = (int*)(a.ws() + WS_STOK);
    for (int e = F.vcu; e < 32; e += F.G) { const int c = cntl[e];
        for (int s = pstart[e] + c + F.tid; s < pstart[e + 1]; s += NWAVES * 64) stok[s] = 0; }
    for (int chunk = F.vcu; chunk < M / 256; chunk += F.G) {
        if (F.tid < 32) lhist[F.tid] = 0u;
        __syncthreads();
        const int pi = chunk * 512 + F.tid;
        const int e = eid[pi];
        const unsigned rank = __hip_atomic_fetch_add(&lhist[e], 1u, __ATOMIC_RELAXED, __HIP_MEMORY_SCOPE_WORKGROUP);
        __syncthreads();
        if (F.tid < 32) { const unsigned c = lhist[F.tid]; lbase[F.tid] = pstart[F.tid] + (c ? (int)__hip_atomic_fetch_add(F.ctl + CW_CNT + 256 * layer + 64 + F.tid, c, RLX_AGENT) : 0); }
        __syncthreads();
        const int slot = lbase[e] + (int)rank;
        tslot[pi] = slot; slotw[slot] = wt[pi]; stok[slot] = pi >> 1;
        __syncthreads();
    }
}

__device__ __forceinline__ void phase_l2(Frame& F, const KA a, int layer) {
    const int gw = F.vcu * NWAVES + F.wave, NGW = F.G * NWAVES;
    const float* mod = (const float*)(a.ws() + WS_MOD) + (size_t)layer * 16 * 6144;
    const bf16* ys = (const bf16*)(a.ws() + WS_BUF0 + 2 * BUFSZ); const int* tslot = (const int*)(a.ws() + WS_TSLOT);
    bf16* hn = (bf16*)(a.ws() + WS_BUF0);
    const float* lng = a.in(4) + (size_t)(layer * 2 + 1) * D; const float* lnb = a.in(5) + (size_t)(layer * 2 + 1) * D;
    float* x = a.out(); unsigned short* xho = (unsigned short*)a.out(); const unsigned short* xh = (const unsigned short*)(a.ws() + WS_BUF0 + 1 * BUFSZ);
    const int mlay = (layer < DEPTH - 1) ? 16 * 6144 : 0;
    const int tpw = ((M + NGW - 1) / NGW + 3) & ~3;
    for (int t0 = gw * tpw; t0 < (gw + 1) * tpw && t0 < M; t0 += 4) {
        const int b = t0 >> 12; const float* mb = mod + (size_t)b * 6144;
        int sl[8];
        { const int4 s0 = *(const int4*)(tslot + 2 * t0), s1 = *(const int4*)(tslot + 2 * t0 + 4); sl[0] = s0.x; sl[1] = s0.y; sl[2] = s0.z; sl[3] = s0.w; sl[4] = s1.x; sl[5] = s1.y; sl[6] = s1.z; sl[7] = s1.w; }
        u64 xr[4][4], y0r[4][4], y1r[4][4];
#pragma unroll
        for (int j = 0; j < 4; ++j) { const int col = 4 * F.lane + 256 * j;
#pragma unroll
            for (int tt = 0; tt < 4; ++tt) { xr[tt][j] = *(const u64*)(xh + (size_t)(t0 + tt) * D + col);
                y0r[tt][j] = *(const u64*)(ys + (size_t)sl[2 * tt] * D + col); y1r[tt][j] = *(const u64*)(ys + (size_t)sl[2 * tt + 1] * D + col); } }
        f32x4 g2v[4];
#pragma unroll
        for (int j = 0; j < 4; ++j) g2v[j] = *(const f32x4*)(mb + 5120 + 4 * F.lane + 256 * j);
        asm volatile("" ::: "memory");
        f32x4 v[4][4]; float s[4] = {0.f, 0.f, 0.f, 0.f};
#pragma unroll
        for (int j = 0; j < 4; ++j) { const f32x4 g2 = g2v[j];
#pragma unroll
            for (int tt = 0; tt < 4; ++tt) {
                const f32x4 xv = unpk_h4(xr[tt][j]); const u64 y0 = y0r[tt][j], y1 = y1r[tt][j];
                f32x4 yv; yv[0] = bflo((unsigned)y0) + bflo((unsigned)y1); yv[1] = bfhi((unsigned)y0) + bfhi((unsigned)y1);
                yv[2] = bflo((unsigned)(y0 >> 32)) + bflo((unsigned)(y1 >> 32)); yv[3] = bfhi((unsigned)(y0 >> 32)) + bfhi((unsigned)(y1 >> 32));
                v[tt][j] = xv * DN_ALPHA + g2 * yv; s[tt] += (v[tt][j][0] + v[tt][j][1]) + (v[tt][j][2] + v[tt][j][3]); } }
        f32x4 lgv[4], lbv[4], scv[4], shv[4];
#pragma unroll
        for (int j = 0; j < 4; ++j) { const int col = 4 * F.lane + 256 * j; lgv[j] = *(const f32x4*)(lng + col); lbv[j] = *(const f32x4*)(lnb + col);
            scv[j] = *(const f32x4*)(mb + mlay + 1024 + col); shv[j] = *(const f32x4*)(mb + mlay + col); }
        asm volatile("" ::: "memory");
        float rstd[4];
#pragma unroll
        for (int tt = 0; tt < 4; ++tt) { const float mean = wave_sum(s[tt], F.lane) * (1.0f / D); float s2 = 0.f;
#pragma unroll
            for (int j = 0; j < 4; ++j) { v[tt][j] = v[tt][j] - mean; s2 += (v[tt][j][0] * v[tt][j][0] + v[tt][j][1] * v[tt][j][1]) + (v[tt][j][2] * v[tt][j][2] + v[tt][j][3] * v[tt][j][3]); }
            rstd[tt] = __builtin_amdgcn_rsqf(wave_sum(s2, F.lane) * (1.0f / D) + LN_EPS); }
        if (layer == DEPTH - 1) {
#pragma unroll
            for (int j = 0; j < 4; ++j) { const int col = 4 * F.lane + 256 * j;
#pragma unroll
                for (int tt = 0; tt < 4; ++tt) *(f32x4*)(x + (size_t)(t0 + tt) * D + col) = v[tt][j] * rstd[tt] * lgv[j] + lbv[j]; }
        } else {
#pragma unroll
            for (int j = 0; j < 4; ++j) { const int col = 4 * F.lane + 256 * j;
#pragma unroll
                for (int tt = 0; tt < 4; ++tt) { const size_t ro = (size_t)(t0 + tt) * D;
                    const f32x4 xo = v[tt][j] * rstd[tt] * lgv[j] + lbv[j];
                    *(u64*)(xho + ro + col) = (u64)pkh(xo[0], xo[1]) | ((u64)pkh(xo[2], xo[3]) << 32);
                    const f32x4 hv = xo * (scv[j] + 1.0f) + shv[j];
                    *(u64*)(hn + ro + col) = (u64)pkbf(hv[0], hv[1]) | ((u64)pkbf(hv[2], hv[3]) << 32); } }
        }
    }
}

#ifndef MK_SEPARATE
#define MK_SEPARATE 0
#endif
constexpr int N_PHASES = 2 + 10 * DEPTH;
#ifndef PH_MASK
#define PH_MASK 0xFFFFF
#endif
#define PH_ON(n) (((PH_MASK) >> (n)) & 1)
#ifndef DBL_MASK
#define DBL_MASK 0
#endif
#define DBL(n) for (int rep_ = 0; rep_ < 1 + (((DBL_MASK) >> (n)) & 1); ++rep_)
__global__ void __launch_bounds__(NWAVES * 64, 2) fwd_kernel(Args args) {
    extern __shared__ __attribute__((aligned(16))) unsigned char lds[];
    const int wave_s = __builtin_amdgcn_readfirstlane((int)threadIdx.x >> 6);
    gu32* const ctl0 = (gu32*)(karg_fresh().ws() + WS_CTL);
    for (int u = threadIdx.x; u < (LDS_BYTES - LDSCTL_OFF) / 4; u += NWAVES * 64) ((LAS unsigned*)((LAS unsigned char*)lds + LDSCTL_OFF))[u] = 0u;
    __syncthreads();
    XcdBarrier bar; bar.bar = (unsigned*)(ctl0 + CW_BAR); bar.x = 0; bar.st = nullptr;
    if (!MK_SEPARATE) bar = xcd_barrier_post((unsigned*)(ctl0 + CW_BAR), (volatile LAS unsigned*)((LAS unsigned char*)lds + MISC_OFF) + 8);
    const int lo = karg_fresh().ph_lo(), hi = karg_fresh().ph_hi();
    const bool PANEL = !MK_SEPARATE && gridDim.x == (unsigned)(M / 256);
#define IN(k) (lo <= (k) && (k) < hi)
#define FRESH() const KA ka = karg_fresh(); unsigned char* const ws = ka.ws(); (void)ws; Frame F; { int t_, g_ = gridDim.x, bx_ = blockIdx.x; asm volatile("v_mbcnt_lo_u32_b32 %0, -1, 0\n\tv_mbcnt_hi_u32_b32 %0, -1, %0" : "=v"(t_)); asm volatile("" : "+s"(g_), "+s"(bx_)); t_ |= wave_s << 6; \
        F.lds = (LAS unsigned char*)lds; F.MISC = (volatile LAS unsigned*)(F.lds + MISC_OFF); F.ctl = (gu32*)(ws + WS_CTL); F.tid = t_; F.lane = t_ & 63; F.wave = __builtin_amdgcn_readfirstlane(t_ >> 6); \
        F.G = g_; F.bx = bx_; F.vcu = (g_ % 8 == 0) ? (bx_ % 8) * (g_ / 8) + bx_ / 8 : bx_; }
#ifndef DBL_BARRIER
#define DBL_BARRIER 0
#endif
#define SEAM(k) do { if (IN(k) && IN((k) + 1)) { if (MK_SEPARATE) { } else { xcd_barrier(bar, wave_s); if (DBL_BARRIER) xcd_barrier(bar, wave_s); } } } while (0)
#define BUF(i) ((bf16*)(ws + WS_BUF0 + (size_t)(i) * BUFSZ))

    if (PH_ON(0) && IN(0)) { FRESH(); DBL(0) phase_p0a(F, ka); }
    SEAM(0);
    if (PH_ON(1) && IN(1)) { FRESH(); DBL(1) phase_p0b(F, ka); }
    SEAM(1);
    for (int i = 0; i < DEPTH; ++i) {
        const int pb = 2 + 10 * i, j = i >> 1;
        if ((i & 1) == 0) {
            if (PH_ON(2) && IN(pb)) { FRESH();
                pg8::Gemm g{BUF(0), (const bf16*)(ws + WS_WHIN) + (size_t)j * 4096 * 1024, M, 4096, D, 0, nullptr}; pg8::StaticOrder S; S.init(M, 4096, F.G, F.bx);
                pg8::EpiBf16<0> E{BUF(1), D, nullptr, D, BUFSZ / 2, 1.0f};
                DBL(2) pg8::gemm_phase<pg8::EpiBf16<0>, pg8::StaticOrder, true, true>(F.lds + RING_OFF, g, S, E, F.tid);
            }
            SEAM(pb);
            if (PH_ON(3) && IN(pb + 1)) { FRESH(); phase_hgrn_prep(F, ka, j); }
            SEAM(pb + 1);
            if (PH_ON(4) && IN(pb + 2)) { FRESH(); DBL(4) phase_hgrn_scan(F, ka, i); }
            SEAM(pb + 2);
            if (PH_ON(5) && IN(pb + 3)) { FRESH(); phase_normgate<0>(F, BUF(6), BUF(4), BUF(4), ka.in(9) + j * 128, 0.f, 1.0f); }
            if (!PANEL) SEAM(pb + 3);
        } else {
            if (PH_ON(6) && IN(pb)) { FRESH();
                pg8::Gemm g{BUF(0), (const bf16*)(ws + WS_WAIN) + (size_t)j * 3072 * 1024, M, 3072, D, 0, nullptr}; pg8::StaticOrder S; S.init(M, 3072, F.G, F.bx);
                pg8::EpiRope E{BUF(1), BUF(2), BUF(3), (const float*)(ws + WS_ROPE_C), (const float*)(ws + WS_ROPE_S), attn_body::C2, SEQ - 1};
                DBL(6) pg8::gemm_phase<pg8::EpiRope, pg8::StaticOrder, true, true>(F.lds + RING_OFF, g, S, E, F.tid);
            }
            SEAM(pb);
            if (PH_ON(7) && IN(pb + 1)) { FRESH();
                const attn_body::AttnTensors AT{(const attn_body::bf16*)BUF(1), (const attn_body::bf16*)BUF(2), (const attn_body::bf16*)BUF(3), (attn_body::bf16*)BUF(4), (attn_body::bf16*)BUF(5)};
                static_assert(attn_body::ATTNW_LDS_BYTES <= RING_BYTES, "attention LDS");
                const attn_body::StaticOrderW S((int)F.G, F.vcu);
                const float* lp = ka.in(12) + j * 256;
                const float d1 = wave_sum(lp[F.lane] * lp[64 + F.lane], F.lane), d2 = wave_sum(lp[128 + F.lane] * lp[192 + F.lane], F.lane);
                const float linit = (j == 0) ? 0.35550906759f : 0.55605820415f;
                const float lam = fexp(d1) - fexp(d2) + linit;
                const attn_body::CombineW CB{(const attn_body::bf16*)BUF(4), (attn_body::bf16*)BUF(6), ka.in(13) + j * 128, lam, 1.0f - linit};
                DBL(7) attn_body::attn_phase_w<8>((char*)lds + RING_OFF, AT, S, CB, F.tid);
            }
            SEAM(pb + 1);
        }
        if (PH_ON(9) && IN(pb + 4)) { FRESH();
            const bf16* A = (i & 1) ? BUF(6) : BUF(4);
            const bf16* W = (i & 1) ? (const bf16*)(ws + WS_WAOUT) + (size_t)j * 1024 * 1024 : (const bf16*)(ws + WS_WHOUT) + (size_t)j * 1024 * 1024;
            pg8::Gemm g{A, W, M, D, D, 0, nullptr};
            pg8::EpiBf16<0> E{BUF(1), D, nullptr, 0, 0, 1.0f};
            if (PANEL) {
                __syncthreads();
                pg8::PanelOrder S{F.vcu, D / 256};
                pg8::gemm_phase<pg8::EpiBf16<0>, pg8::PanelOrder, true, true>(F.lds + RING_OFF, g, S, E, F.tid);
                __syncthreads();
            } else {
                pg8::StaticOrder S; S.init(M, D, F.G, F.bx);
                DBL(9) pg8::gemm_phase<pg8::EpiBf16<0>, pg8::StaticOrder, true, true>(F.lds + RING_OFF, g, S, E, F.tid);
            }
        }
        if (!PANEL) SEAM(pb + 4);
        if (PH_ON(10) && IN(pb + 5)) { FRESH(); phase_l1(F, ka, i, i == 0 ? ka.in(0) : (const float*)ka.out(), false);
            if ((((DBL_MASK) >> 10) & 1) && i == 0) { __syncthreads(); phase_l1(F, ka, i, ka.in(0), true); } }
        SEAM(pb + 5);
        if (PH_ON(11) && IN(pb + 6)) { FRESH(); phase_m2(F, ka, i); }
        SEAM(pb + 6);
        if (PH_ON(12) && IN(pb + 7)) { FRESH();
            const int nblk = (int)__hip_atomic_load(F.ctl + CW_CNT + 256 * i + 128, RLX_AGENT);
            pg8::Gemm g{BUF(0), (const bf16*)moe_wbuf(ws, i), nblk * 256, 1024, D, (size_t)1024 * 1024 * 2, (const int*)(ws + WS_STOK)};
            pg8::MoeOrder S; S.init(nblk * 256, 1024, F.G, F.bx); S.blk_e = (const int*)(ws + WS_BLKE) + i * 1024;
            pg8::EpiSwiGLU E{BUF(5)};
            DBL(12) pg8::gemm_phase<pg8::EpiSwiGLU, pg8::MoeOrder, true, true, true>(F.lds + RING_OFF, g, S, E, F.tid);
        }
        SEAM(pb + 7);
        if (PH_ON(13) && IN(pb + 8)) { FRESH();
            const int nblk = (int)__hip_atomic_load(F.ctl + CW_CNT + 256 * i + 128, RLX_AGENT);
            pg8::Gemm g{BUF(5), (const bf16*)(moe_wbuf(ws, i) + 64 * MiB), nblk * 256, 1024, FF, (size_t)1024 * 512 * 2, nullptr};
            pg8::MoeOrder S; S.init(nblk * 256, 1024, F.G, F.bx); S.blk_e = (const int*)(ws + WS_BLKE) + i * 1024;
            pg8::EpiRowScale E{BUF(2), (const float*)(ws + WS_SLOTW)};
            DBL(13) pg8::gemm_phase<pg8::EpiRowScale, pg8::MoeOrder, true, true>(F.lds + RING_OFF, g, S, E, F.tid);
        }
        SEAM(pb + 8);
        if (PH_ON(14) && IN(pb + 9)) { FRESH(); DBL(14) phase_l2(F, ka, i); }
        SEAM(pb + 9);
    }
#undef IN
#undef SEAM
}

extern "C" void kernel_launch(void* const* d_in, const int* in_sizes, int n_in, void* d_out, int out_size, void* d_ws, size_t ws_size, hipStream_t stream) {
    static int grid = 0;
    if (grid == 0) {
        if (n_in != 21 || in_sizes[0] != M * D || out_size != M * D || ws_size < WS_END) { fprintf(stderr, "kernel_launch: unexpected shapes / workspace (n_in %d, ws %zu, need %zu)\n", n_in, ws_size, (size_t)WS_END); grid = -1; return; }
        int dev = 0, cus = 0, per_cu = 0;
        if (hipGetDevice(&dev) != hipSuccess || hipDeviceGetAttribute(&cus, hipDeviceAttributeMultiprocessorCount, dev) != hipSuccess) { grid = -1; return; }
        if (hipFuncSetAttribute((const void*)fwd_kernel, hipFuncAttributeMaxDynamicSharedMemorySize, LDS_BYTES) != hipSuccess) { fprintf(stderr, "kernel_launch: hipFuncSetAttribute failed\n"); grid = -1; return; }
        if (hipOccupancyMaxActiveBlocksPerMultiprocessor(&per_cu, (const void*)fwd_kernel, NWAVES * 64, LDS_BYTES) != hipSuccess || per_cu < 1) fprintf(stderr, "kernel_launch: occupancy query says %d\n", per_cu);
        (void)hipGetLastError();
        grid = cus;
    }
    if (grid < 0) return;
    if (hipMemsetAsync((char*)d_ws + WS_CTL, 0, CTL_ZERO_BYTES, stream) != hipSuccess) return;
    Args a{};
    for (int i = 0; i < 21; ++i) a.in[i] = (const float*)d_in[i];
    a.out = (float*)d_out; a.ws = (unsigned char*)d_ws;
#if MK_SEPARATE
    for (int p = 0; p < N_PHASES; ++p) {
        if (p >= 2 && (((p - 2) / 10) & 1) == 1 && ((p - 2) % 10) == 3) continue;
        a.ph_lo = p; a.ph_hi = p + 1;
        hipLaunchKernelGGL(fwd_kernel, dim3(grid), dim3(NWAVES * 64), LDS_BYTES, stream, a);
    }
#else
    a.ph_lo = 0; a.ph_hi = N_PHASES;
    hipLaunchKernelGGL(fwd_kernel, dim3(grid), dim3(NWAVES * 64), LDS_BYTES, stream, a);
#endif
}
```
